# Optimizing an MI355X kernel written in HIP

```python
import math
import jax, jax.numpy as jnp
from jax import lax
import numpy as np

D_MODEL = 1024
BATCH = 8
SEQ = 2048
DEPTH = 2

GRID_W = 64
CTX_LEN = 256
SSD_WIDTH = D_MODEL // 2
SSD_HEAD_DIM = 64
SSD_HEADS = SSD_WIDTH // SSD_HEAD_DIM
SSD_GROUPS = 2
SSD_STATE = 128
SSD_CONV = 5
SSD_CHUNK = 128
SSD_XBC = SSD_WIDTH + 2 * SSD_GROUPS * SSD_STATE
SSD_COLS = SSD_WIDTH + SSD_XBC + 2 * SSD_HEADS
CONF_WIDTH = D_MODEL // 4
CONF_KERNEL = 31
CONF_COLS = 2 * CONF_WIDTH
S5_WIDTH = D_MODEL // 4
S5_GROUP_CH = 16
S5_GROUPS = S5_WIDTH // S5_GROUP_CH
S5_STATE = 64
S5_COLS = S5_WIDTH
IN_COLS = SSD_COLS + CONF_COLS + S5_COLS
MIX_WIDTH = SSD_WIDTH + CONF_WIDTH + S5_WIDTH
N_EXPERTS = 16
N_EXPERT_GROUPS = 4
EXPERTS_PER_GROUP = N_EXPERTS // N_EXPERT_GROUPS
TOP_K = 2
EXPERT_FF = D_MODEL
N_MOD = 6
EPS = 1e-6
F32 = jnp.float32

kernel_name = "hybrid_ssd_conformer_s5_moe_block"


def rms_norm(x, g):
    x32 = x.astype(F32)
    y = x32 * lax.rsqrt(jnp.mean(x32 * x32, axis=-1, keepdims=True) + EPS)
    return (y * g.astype(F32)).astype(x.dtype)


def layer_norm(x, g, b):
    x32 = x.astype(F32)
    xc = x32 - jnp.mean(x32, axis=-1, keepdims=True)
    y = xc * lax.rsqrt(jnp.mean(xc * xc, axis=-1, keepdims=True) + EPS)
    return (y * g.astype(F32) + b.astype(F32)).astype(x.dtype)


def depthwise_conv(x, w, b):
    k = w.shape[0]
    y = lax.conv_general_dilated(
        x, w[:, None, :].astype(x.dtype), (1,), [(k // 2, k // 2)],
        dimension_numbers=("NWC", "WIO", "NWC"), feature_group_count=x.shape[-1])
    return y + b.astype(x.dtype)


def grid_pos_embed(rows, dtype):
    rr, cc = jnp.meshgrid(jnp.arange(rows, dtype=F32), jnp.arange(GRID_W, dtype=F32), indexing="ij")
    quarter = D_MODEL // 4
    inv_freq = jnp.exp(-math.log(10000.0) * jnp.arange(quarter, dtype=F32) / quarter)

    def emb(pos):
        ang = pos.reshape(-1)[:, None] * inv_freq[None, :]
        return jnp.concatenate([jnp.sin(ang), jnp.cos(ang)], axis=-1)

    return jnp.concatenate([emb(rr), emb(cc)], axis=-1).astype(dtype)


def segsum(a):
    t = a.shape[-1]
    rep = jnp.broadcast_to(a[..., :, None], a.shape + (t,))
    strict = jnp.tril(jnp.ones((t, t), dtype=bool), -1)
    cs = jnp.cumsum(jnp.where(strict, rep, 0.0), axis=-2)
    return jnp.where(jnp.tril(jnp.ones((t, t), dtype=bool)), cs, -jnp.inf)


def ssd_chunked_scan(xdt, a, bm, cm, h0):
    bsz, n, nh, hp = xdt.shape
    nc = n // SSD_CHUNK
    X = xdt.reshape(bsz, nc, SSD_CHUNK, nh, hp)
    A = a.reshape(bsz, nc, SSD_CHUNK, nh).transpose(0, 3, 1, 2)
    Bc = bm.reshape(bsz, nc, SSD_CHUNK, nh, -1)
    Cc = cm.reshape(bsz, nc, SSD_CHUNK, nh, -1)
    a_cs = jnp.cumsum(A, axis=-1)
    scores = jnp.einsum("bclhn,bcshn->bhcls", Cc, Bc) * jnp.exp(segsum(A))
    y_diag = jnp.einsum("bhcls,bcshp->bclhp", scores, X)
    decay_states = jnp.exp(a_cs[..., -1:] - a_cs)
    states = jnp.einsum("bclhn,bhcl,bclhp->bchpn", Bc, decay_states, X)
    states = jnp.concatenate([h0[:, None], states], axis=1)
    chunk_tot = jnp.pad(a_cs[..., -1], ((0, 0), (0, 0), (1, 0)))
    new_states = jnp.einsum("bhzc,bchpn->bzhpn", jnp.exp(segsum(chunk_tot)), states)
    states_in, final = new_states[:, :-1], new_states[:, -1]
    y_off = jnp.einsum("bclhn,bchpn,bhcl->bclhp", Cc, states_in, jnp.exp(a_cs))
    return (y_diag + y_off).reshape(bsz, n, nh, hp), final


def ssd_mixer(cols, conv_w, conv_b, dt_bias, a_log, d_skip, norm_g, h0):
    bsz, n, _ = cols.shape
    z = cols[..., :SSD_WIDTH]
    xbc = cols[..., SSD_WIDTH:SSD_WIDTH + SSD_XBC]
    dt_raw = cols[..., SSD_WIDTH + SSD_XBC:]
    xbc = jax.nn.silu(depthwise_conv(xbc, conv_w, conv_b)).astype(F32)
    gn = SSD_GROUPS * SSD_STATE
    rep = SSD_HEADS // SSD_GROUPS
    xs = xbc[..., :SSD_WIDTH].reshape(bsz, n, SSD_HEADS, SSD_HEAD_DIM)
    bm = jnp.repeat(xbc[..., SSD_WIDTH:SSD_WIDTH + gn].reshape(bsz, n, SSD_GROUPS, SSD_STATE), rep, axis=2)
    cm = jnp.repeat(xbc[..., SSD_WIDTH + gn:].reshape(bsz, n, SSD_GROUPS, SSD_STATE), rep, axis=2)
    dt = jax.nn.softplus(dt_raw.astype(F32).reshape(bsz, n, 2, SSD_HEADS) + dt_bias.astype(F32))
    a = -jnp.exp(a_log.astype(F32))
    y = d_skip.astype(F32)[:, None] * xs
    finals = []
    for d in range(2):
        dt_d = dt[:, :, d]
        args = (xs * dt_d[..., None], dt_d * a[d], bm, cm)
        if d == 1:
            args = tuple(jnp.flip(t, axis=1) for t in args)
        y_d, fin = ssd_chunked_scan(*args, h0[d])
        y = y + (y_d if d == 0 else jnp.flip(y_d, axis=1))
        finals.append(fin)
    y = y.reshape(bsz, n, SSD_WIDTH) * jax.nn.silu(z.astype(F32))
    return rms_norm(y, norm_g).astype(cols.dtype), finals


def conformer_conv(cols, dw_w, dw_b, ln_g, ln_b, pw_w, pw_b):
    u = cols[..., :CONF_WIDTH] * jax.nn.sigmoid(cols[..., CONF_WIDTH:])
    u = depthwise_conv(u, dw_w, dw_b)
    u = jax.nn.silu(layer_norm(u, ln_g, ln_b))
    return u @ pw_w + pw_b


def _complex_linear_combine(e1, e2):
    a1r, a1i, b1r, b1i = e1
    a2r, a2i, b2r, b2i = e2
    return (a2r * a1r - a2i * a1i,
            a2r * a1i + a2i * a1r,
            a2r * b1r - a2i * b1i + b2r,
            a2r * b1i + a2i * b1r + b2i)


def s5_mixer(u, lam_re, lam_im, log_step, b_re, b_im, c_re, c_im, d_skip, glu_w, glu_b, h0):
    bsz, n, _ = u.shape
    u32 = u.astype(F32)
    ug = u32.reshape(bsz, n, S5_GROUPS, S5_GROUP_CH)
    lam_re, lam_im = lam_re.astype(F32), lam_im.astype(F32)
    b_re, b_im, c_re, c_im = (t.astype(F32) for t in (b_re, b_im, c_re, c_im))
    y = jnp.zeros((bsz, n, S5_GROUPS, S5_GROUP_CH), F32)
    finals = []
    for d in range(2):
        step = jnp.exp(log_step[d].astype(F32))[:, None]
        lr, li = lam_re[d], lam_im[d]
        mag = jnp.exp(lr * step)
        ar, ai = mag * jnp.cos(li * step), mag * jnp.sin(li * step)
        inv_den = 1.0 / (lr * lr + li * li)
        cr = ((ar - 1.0) * lr + ai * li) * inv_den
        ci = (ai * lr - (ar - 1.0) * li) * inv_den
        bbr = cr[..., None] * b_re - ci[..., None] * b_im
        bbi = cr[..., None] * b_im + ci[..., None] * b_re
        src = ug if d == 0 else jnp.flip(ug, axis=1)
        bur = jnp.einsum("blgh,gph->blgp", src, bbr)
        bui = jnp.einsum("blgh,gph->blgp", src, bbi)
        h0r, h0i = h0[d]
        bur = bur.at[:, 0].add(ar * h0r - ai * h0i)
        bui = bui.at[:, 0].add(ar * h0i + ai * h0r)
        _, _, hr, hi = lax.associative_scan(
            _complex_linear_combine,
            (jnp.broadcast_to(ar, bur.shape), jnp.broadcast_to(ai, bur.shape), bur, bui), axis=1)
        finals.append((hr[:, -1], hi[:, -1]))
        yd = jnp.einsum("blgp,ghp->blgh", hr, c_re) - jnp.einsum("blgp,ghp->blgh", hi, c_im)
        y = y + (yd if d == 0 else jnp.flip(yd, axis=1))
    y = jax.nn.gelu(y.reshape(bsz, n, S5_WIDTH) + d_skip.astype(F32) * u32)
    gv = y @ glu_w.astype(F32) + glu_b.astype(F32)
    out = gv[..., :S5_WIDTH] * jax.nn.sigmoid(gv[..., S5_WIDTH:])
    return out.astype(u.dtype), finals


def moe_ffn(h, router_w, router_b, w_gate, w_up, w_down):
    n_tok = h.shape[0]
    logits = jnp.matmul(h, router_w).astype(F32) + router_b.astype(F32)
    probs = jax.nn.softmax(logits, axis=-1)
    grp = probs.reshape(n_tok, N_EXPERT_GROUPS, EXPERTS_PER_GROUP)
    group_score = jnp.sum(lax.top_k(grp, TOP_K)[0], axis=-1)
    best = jnp.argmax(group_score, axis=-1)
    in_group = (jnp.arange(N_EXPERTS) // EXPERTS_PER_GROUP)[None, :] == best[:, None]
    vals, idx = lax.top_k(jnp.where(in_group, probs, -jnp.inf), TOP_K)
    gates = vals / jnp.sum(vals, axis=-1, keepdims=True)
    dense_gate = jnp.sum(jax.nn.one_hot(idx, N_EXPERTS, dtype=F32) * gates[..., None], axis=1).astype(h.dtype)
    out = jnp.zeros_like(h)
    for e in range(N_EXPERTS):
        act = jax.nn.silu(h @ w_gate[e]) * (h @ w_up[e])
        out = out + dense_gate[:, e:e + 1] * (act @ w_down[e])
    return out


def hybrid_layer(x, ctx, mod_lat, mod_ctx, p, router_w, router_b, with_ctx_out):
    sh1, sc1, g1, sh2, sc2, g2 = jnp.split(mod_lat, N_MOD, axis=-1)
    csh1, csc1, cg1, csh2, csc2, cg2 = jnp.split(mod_ctx, N_MOD, axis=-1)
    bsz = x.shape[0]
    h = rms_norm(x, p["g_mix"]) * (1 + sc1) + sh1
    hc = rms_norm(ctx, p["g_mix"]) * (1 + csc1) + csh1
    cols = h @ p["w_in"]
    ccols = hc @ p["w_in"]
    o_b, o_c = SSD_COLS, SSD_COLS + CONF_COLS

    ssd_args = (p["ssd_conv_w"], p["ssd_conv_b"], p["ssd_dt_bias"], p["ssd_a_log"], p["ssd_d"], p["ssd_norm_g"])
    zero_ssd = jnp.zeros((bsz, SSD_HEADS, SSD_HEAD_DIM, SSD_STATE), F32)
    a_ctx, ssd_states = ssd_mixer(ccols[..., :o_b], *ssd_args, [zero_ssd, zero_ssd])
    a_lat, _ = ssd_mixer(cols[..., :o_b], *ssd_args, ssd_states)

    s5_args = (p["s5_lambda_re"], p["s5_lambda_im"], p["s5_log_step"], p["s5_b_re"], p["s5_b_im"],
               p["s5_c_re"], p["s5_c_im"], p["s5_d"], p["s5_glu_w"], p["s5_glu_b"])
    zero_s5 = (jnp.zeros((bsz, S5_GROUPS, S5_STATE), F32), jnp.zeros((bsz, S5_GROUPS, S5_STATE), F32))
    s_ctx, s5_states = s5_mixer(ccols[..., o_c:], *s5_args, [zero_s5, zero_s5])
    s_lat, _ = s5_mixer(cols[..., o_c:], *s5_args, s5_states)

    conf_args = (p["conf_dw_w"], p["conf_dw_b"], p["conf_ln_g"], p["conf_ln_b"], p["conf_pw_w"], p["conf_pw_b"])
    b_lat = conformer_conv(cols[..., o_b:o_c], *conf_args)

    mix = jnp.concatenate([a_lat, b_lat.astype(x.dtype), s_lat], axis=-1)
    x = x + g1 * (mix @ p["w_out"])
    h2 = rms_norm(x, p["g_ffn"]) * (1 + sc2) + sh2
    moe_w = (p["exp_w_gate"], p["exp_w_up"], p["exp_w_down"])
    if with_ctx_out:
        b_ctx = conformer_conv(ccols[..., o_b:o_c], *conf_args)
        cmix = jnp.concatenate([a_ctx, b_ctx.astype(ctx.dtype), s_ctx], axis=-1)
        ctx = ctx + cg1 * (cmix @ p["w_out"])
        hc2 = rms_norm(ctx, p["g_ffn"]) * (1 + csc2) + csh2
        n_lat = h2.shape[0] * h2.shape[1]
        tokens = jnp.concatenate([h2.reshape(-1, D_MODEL), hc2.reshape(-1, D_MODEL)], axis=0)
        ff = moe_ffn(tokens, router_w, router_b, *moe_w)
        x = x + g2 * ff[:n_lat].reshape(x.shape)
        ctx = ctx + cg2 * ff[n_lat:].reshape(ctx.shape)
    else:
        x = x + g2 * moe_ffn(h2.reshape(-1, D_MODEL), router_w, router_b, *moe_w).reshape(x.shape)
    return x, ctx


def setup_inputs(seed: int = 0) -> dict:
    key = jax.random.key(seed)
    ks = iter(jax.random.split(key, 64))
    L = DEPTH

    def nrm(shape, scale):
        return jax.random.normal(next(ks), shape, F32) * scale

    def gain(shape):
        return 1.0 + nrm(shape, 0.01)

    def unif(shape, lo, hi):
        return jax.random.uniform(next(ks), shape, F32, minval=lo, maxval=hi)

    dt0 = jnp.exp(unif((L, 2, SSD_HEADS), math.log(1e-3), math.log(1e-1)))
    s5_n = jnp.arange(S5_STATE, dtype=F32)
    return {
        "x": nrm((BATCH, SEQ, D_MODEL), 1.0),
        "c": nrm((BATCH, D_MODEL), 1.0),
        "ctx": nrm((BATCH, CTX_LEN, D_MODEL), 1.0),
        "c_ctx": nrm((D_MODEL,), 1.0),
        "w_ada": nrm((L, D_MODEL, N_MOD * D_MODEL), 0.5 * D_MODEL ** -0.5),
        "b_ada": nrm((L, N_MOD * D_MODEL), 0.01),
        "g_mix": gain((L, D_MODEL)),
        "w_in": nrm((L, D_MODEL, IN_COLS), D_MODEL ** -0.5),
        "ssd_conv_w": nrm((L, SSD_CONV, SSD_XBC), SSD_CONV ** -0.5),
        "ssd_conv_b": nrm((L, SSD_XBC), 0.01),
        "ssd_dt_bias": dt0 + jnp.log(-jnp.expm1(-dt0)),
        "ssd_a_log": jnp.log(unif((L, 2, SSD_HEADS), 1.0, 16.0)),
        "ssd_d": gain((L, SSD_HEADS)),
        "ssd_norm_g": gain((L, SSD_WIDTH)),
        "conf_dw_w": nrm((L, CONF_KERNEL, CONF_WIDTH), CONF_KERNEL ** -0.5),
        "conf_dw_b": nrm((L, CONF_WIDTH), 0.01),
        "conf_ln_g": gain((L, CONF_WIDTH)),
        "conf_ln_b": nrm((L, CONF_WIDTH), 0.01),
        "conf_pw_w": nrm((L, CONF_WIDTH, CONF_WIDTH), CONF_WIDTH ** -0.5),
        "conf_pw_b": nrm((L, CONF_WIDTH), 0.01),
        "s5_lambda_re": -0.5 + nrm((L, 2, S5_GROUPS, S5_STATE), 0.01),
        "s5_lambda_im": math.pi * s5_n + nrm((L, 2, S5_GROUPS, S5_STATE), 0.01),
        "s5_log_step": unif((L, 2, S5_GROUPS), math.log(1e-3), math.log(1e-1)),
        "s5_b_re": nrm((L, S5_GROUPS, S5_STATE, S5_GROUP_CH), (2 * S5_GROUP_CH) ** -0.5),
        "s5_b_im": nrm((L, S5_GROUPS, S5_STATE, S5_GROUP_CH), (2 * S5_GROUP_CH) ** -0.5),
        "s5_c_re": nrm((L, S5_GROUPS, S5_GROUP_CH, S5_STATE), (2 * S5_STATE) ** -0.5),
        "s5_c_im": nrm((L, S5_GROUPS, S5_GROUP_CH, S5_STATE), (2 * S5_STATE) ** -0.5),
        "s5_d": nrm((L, S5_WIDTH), 1.0),
        "s5_glu_w": nrm((L, S5_WIDTH, 2 * S5_WIDTH), S5_WIDTH ** -0.5),
        "s5_glu_b": nrm((L, 2 * S5_WIDTH), 0.01),
        "w_out": nrm((L, MIX_WIDTH, D_MODEL), MIX_WIDTH ** -0.5),
        "g_ffn": gain((L, D_MODEL)),
        "router_w": nrm((D_MODEL, N_EXPERTS), D_MODEL ** -0.5),
        "router_b": nrm((N_EXPERTS,), 0.01),
        "exp_w_gate": nrm((L, N_EXPERTS, D_MODEL, EXPERT_FF), D_MODEL ** -0.5),
        "exp_w_up": nrm((L, N_EXPERTS, D_MODEL, EXPERT_FF), D_MODEL ** -0.5),
        "exp_w_down": nrm((L, N_EXPERTS, EXPERT_FF, D_MODEL), EXPERT_FF ** -0.5),
        "g_final": gain((D_MODEL,)),
    }


def reference(x, c, ctx, c_ctx, w_ada, b_ada, g_mix, w_in, ssd_conv_w, ssd_conv_b, ssd_dt_bias,
              ssd_a_log, ssd_d, ssd_norm_g, conf_dw_w, conf_dw_b, conf_ln_g, conf_ln_b, conf_pw_w,
              conf_pw_b, s5_lambda_re, s5_lambda_im, s5_log_step, s5_b_re, s5_b_im, s5_c_re, s5_c_im,
              s5_d, s5_glu_w, s5_glu_b, w_out, g_ffn, router_w, router_b, exp_w_gate, exp_w_up,
              exp_w_down, g_final):
    rows = x.shape[1] // GRID_W
    x = x + grid_pos_embed(rows, x.dtype)[None]
    cond_lat = jax.nn.silu(c)
    cond_ctx = jax.nn.silu(c_ctx)
    for l in range(DEPTH):
        mod_lat = (cond_lat @ w_ada[l] + b_ada[l])[:, None, :]
        mod_ctx = (cond_ctx @ w_ada[l] + b_ada[l])[None, None, :]
        p = dict(
            g_mix=g_mix[l], w_in=w_in[l], ssd_conv_w=ssd_conv_w[l], ssd_conv_b=ssd_conv_b[l],
            ssd_dt_bias=ssd_dt_bias[l], ssd_a_log=ssd_a_log[l], ssd_d=ssd_d[l], ssd_norm_g=ssd_norm_g[l],
            conf_dw_w=conf_dw_w[l], conf_dw_b=conf_dw_b[l], conf_ln_g=conf_ln_g[l], conf_ln_b=conf_ln_b[l],
            conf_pw_w=conf_pw_w[l], conf_pw_b=conf_pw_b[l], s5_lambda_re=s5_lambda_re[l],
            s5_lambda_im=s5_lambda_im[l], s5_log_step=s5_log_step[l], s5_b_re=s5_b_re[l],
            s5_b_im=s5_b_im[l], s5_c_re=s5_c_re[l], s5_c_im=s5_c_im[l], s5_d=s5_d[l],
            s5_glu_w=s5_glu_w[l], s5_glu_b=s5_glu_b[l], w_out=w_out[l], g_ffn=g_ffn[l],
            exp_w_gate=exp_w_gate[l], exp_w_up=exp_w_up[l], exp_w_down=exp_w_down[l])
        x, ctx = hybrid_layer(x, ctx, mod_lat, mod_ctx, p, router_w, router_b, l < DEPTH - 1)
    return rms_norm(x, g_final)
```

```cpp
#include <hip/hip_runtime.h>
#include <cstdio>
#include <cstdint>

#ifndef MK_ONE_LAUNCH
#define MK_ONE_LAUNCH 0
#endif

#define GAS __attribute__((address_space(1)))
#define LAS __attribute__((address_space(3)))
typedef unsigned short bf16;
typedef float f32x4 __attribute__((ext_vector_type(4)));
typedef float f32x2 __attribute__((ext_vector_type(2)));
typedef unsigned u32x4 __attribute__((ext_vector_type(4)));
typedef unsigned u32x2 __attribute__((ext_vector_type(2)));

constexpr int D = 1024, NB = 8, SEQ = 2048, CTXL = 256, DEPTH = 2;
constexpr int TL = NB * SEQ, TC = NB * CTXL, TT = TL + TC;
constexpr int INC = 2320;
constexpr int NCOL = 2304;
constexpr int VSEQ = CTXL + SEQ;
constexpr int NEXP = 16;
constexpr float EPS = 1e-6f;

enum { I_X = 0, I_C, I_CTX, I_CCTX, I_WADA, I_BADA, I_GMIX, I_WIN, I_SCW, I_SCB, I_SDTB, I_SALOG, I_SD, I_SNG,
       I_CDW, I_CDB, I_CLG, I_CLB, I_CPW, I_CPB, I_LRE, I_LIM, I_LSTEP, I_BRE, I_BIM, I_CRE, I_CIM, I_S5D, I_GLUW, I_GLUB,
       I_WOUT, I_GFFN, I_RW, I_RB, I_WG, I_WU, I_WD, I_GFIN, N_IN };

constexpr size_t MiB = 1u << 20;
constexpr size_t WS_CTL = 0, CTL_ZERO_BYTES = 64 * 1024;
constexpr size_t WS_MOD = 1 * MiB;
constexpr size_t WS_MODP = 2 * MiB;
constexpr size_t WS_DT = 6 * MiB;
constexpr size_t WS_TOKI = 7 * MiB + 512 * 1024;
constexpr size_t WS_TOKW = WS_TOKI + (size_t)TT * 16;
constexpr size_t WS_XS = 8 * MiB;
constexpr size_t WS_HN = 80 * MiB;
constexpr size_t WS_COLS = 116 * MiB;
constexpr size_t WS_XBCC = 197 * MiB;
constexpr size_t WS_YSSD = 233 * MiB;
constexpr size_t WS_MIX = 305 * MiB;
constexpr size_t WS_YS5 = 341 * MiB;
constexpr size_t WS_CU = 377 * MiB;
constexpr size_t WS_CV = 395 * MiB;
constexpr size_t WS_LIST = 413 * MiB;
constexpr size_t WS_END = 415 * MiB;
constexpr int MOE_ROWS = 2 * TT + NEXP * 256;
constexpr size_t WS_HMID = WS_COLS;
constexpr size_t WS_YDN = WS_XBCC;
static_assert(WS_HMID + (size_t)MOE_ROWS * 1024 * 2 <= WS_XBCC, "HMID overlay");
static_assert(WS_YDN + (size_t)MOE_ROWS * 1024 * 4 <= WS_CU, "YDN overlay");
constexpr int CW_CNT = 64;
constexpr int CW_BAR = 1024;

constexpr int NWAVES = 8, NTHR = 512;
constexpr int LDS_BYTES = 147456;
constexpr int MISC_OFF = 131072 + 320;

__device__ __forceinline__ float bf2f(bf16 v) { return __uint_as_float((unsigned)v << 16); }
__device__ __forceinline__ unsigned f2bf(float f) { unsigned u = __float_as_uint(f); return (u + 0x7fffu + ((u >> 16) & 1u)) >> 16; }
__device__ __forceinline__ unsigned pk2(float lo, float hi) { return f2bf(lo) | (f2bf(hi) << 16); }
__device__ __forceinline__ float wave_sum(float v) {
#pragma unroll
    for (int o = 1; o < 64; o <<= 1) v += __shfl_xor(v, o);
    return v;
}
__device__ __forceinline__ float sigmoidf_(float x) { return 1.f / (1.f + __expf(-x)); }
__device__ __forceinline__ float siluf_(float x) { return x / (1.f + __expf(-x)); }
__device__ __forceinline__ float softplusf_(float x) { return fmaxf(x, 0.f) + log1pf(__expf(-fabsf(x))); }
__device__ __forceinline__ float gelu_tanh(float x) { const float u = 0.7978845608028654f * (x + 0.044715f * x * x * x); return 0.5f * x * (1.f + tanhf(u)); }
__device__ __forceinline__ void sincos_red(float x, float& s, float& c) {
    const float k = rintf(x * 0.15915494309189535f);
    float r = fmaf(-k, 6.2831854820251465f, x); r = fmaf(-k, -1.7484555e-7f, r);
    s = __sinf(r); c = __cosf(r);
}
__device__ __forceinline__ int opaque_v(int v) { asm volatile("" : "+v"(v)); return v; }
__device__ __forceinline__ int modrow(int r) { return r < TL ? (r >> 11) : 8; }
__device__ __forceinline__ void seq_bounds(int r, int& lo, int& hi) {
    if (r < TL) { lo = r & ~(SEQ - 1); hi = lo + SEQ; } else { lo = TL + ((r - TL) & ~(CTXL - 1)); hi = lo + CTXL; }
}
__device__ __forceinline__ int vrow(int b, int dir, int s) {
    if (s < CTXL) return TL + b * CTXL + (dir ? CTXL - 1 - s : s);
    const int t = s - CTXL; return b * SEQ + (dir ? SEQ - 1 - t : t);
}

#define XB_TMO      128
#define XB_XCNT(j)  (256  + 64 * (j))
#define XB_XSUB(j)  (1280 + 64 * (j))
#define XB_XGEN(j)  (2304 + 64 * (j))
#define XB_TOP      3328
#define XB_TOPGEN   3392
#define XCD_BAR_WORDS 3456
#define XB_SPIN_CAP (1u << 18)
__device__ __forceinline__ unsigned xb_ld(unsigned* p)              { return __hip_atomic_load(p, __ATOMIC_RELAXED, __HIP_MEMORY_SCOPE_AGENT); }
__device__ __forceinline__ unsigned xb_add(unsigned* p, unsigned v) { return __hip_atomic_fetch_add(p, v, __ATOMIC_RELAXED, __HIP_MEMORY_SCOPE_AGENT); }
__device__ __forceinline__ unsigned xb_xcc_id() { return (unsigned)__builtin_amdgcn_s_getreg((3 << 11) | 20) & 0xFu; }
#define XB_SPIN(cond, bar) do { unsigned _sp = 0; while (cond) { __builtin_amdgcn_s_sleep(1); \
    if ((++_sp & 255u) == 0u) { if (xb_ld(&(bar)[XB_TMO])) break; if (_sp > XB_SPIN_CAP) { atomicAdd(&(bar)[XB_TMO], 1u); break; } } } } while (0)
struct XcdBarrier { unsigned* bar; unsigned x; volatile LAS unsigned* st; };
__device__ __forceinline__ XcdBarrier xcd_barrier_post(unsigned* bar, volatile LAS unsigned* st) {
    XcdBarrier b; b.bar = bar; b.x = xb_xcc_id(); b.st = st;
    if (threadIdx.x == 0) (void)xb_add(&bar[XB_XCNT(b.x)], 1u);
    return b;
}
__device__ __forceinline__ void xcd_barrier_complete(unsigned* bar, unsigned x, unsigned& nloc, unsigned& nx) {
    const unsigned G = gridDim.x * gridDim.y * gridDim.z;
    unsigned sum, cnt, mine, sp = 0u;
    for (;;) {
        sum = 0u; cnt = 0u; mine = 0u;
#pragma unroll
        for (unsigned j = 0; j < 16; ++j) { const unsigned c = xb_ld(&bar[XB_XCNT(j)]); sum += c; cnt += (c > 0u) ? 1u : 0u; mine = (j == x) ? c : mine; }
        if (sum == G) break;
        __builtin_amdgcn_s_sleep(1);
        if ((++sp & 255u) == 0u) { if (xb_ld(&bar[XB_TMO])) break; if (sp > XB_SPIN_CAP) { atomicAdd(&bar[XB_TMO], 1u); break; } }
    }
    nloc = mine > 0u ? mine : 1u; nx = cnt > 0u ? cnt : 1u;
}
__device__ __forceinline__ void xcd_barrier(const XcdBarrier& b) {
    asm volatile("s_waitcnt vmcnt(0)" ::: "memory");
    __syncthreads();
    if (threadIdx.x == 0) {
        unsigned* bar = b.bar;
        __builtin_amdgcn_s_waitcnt(0);
        unsigned nloc = b.st[0], nx = b.st[1];
        if (nloc == 0u) { xcd_barrier_complete(bar, b.x, nloc, nx); b.st[0] = nloc; b.st[1] = nx; }
        const unsigned old = xb_add(&bar[XB_XSUB(b.x)], 1u);
        const unsigned gen = old / nloc;
        if (old + 1u == (gen + 1u) * nloc) {
            __builtin_amdgcn_fence(__ATOMIC_RELEASE, "agent");
            asm volatile("s_waitcnt vmcnt(0)" ::: "memory");
            const unsigned og = xb_add(&bar[XB_TOP], 1u);
            const unsigned tg = og / nx;
            if (og + 1u == (tg + 1u) * nx) xb_add(&bar[XB_TOPGEN], 1u);
            else XB_SPIN(xb_ld(&bar[XB_TOPGEN]) == tg, bar);
            __builtin_amdgcn_fence(__ATOMIC_ACQUIRE, "agent");
            xb_add(&bar[XB_XGEN(b.x)], 1u);
            asm volatile("s_waitcnt vmcnt(0)" ::: "memory");
        } else {
            XB_SPIN(xb_ld(&bar[XB_XGEN(b.x)]) == gen, bar);
            __builtin_amdgcn_fence(__ATOMIC_ACQUIRE, "agent");
            asm volatile("s_waitcnt vmcnt(0)" ::: "memory");
        }
    }
    __syncthreads();
}

struct Args { const float* in[N_IN]; float* out; unsigned char* ws; int ph_lo, ph_hi; };
struct Frame {
    LAS unsigned char* lds;
    int tid, lane, wave, G, bid;
    const float* const* in;
    float* out; unsigned char* ws;
    unsigned* ctl;
    float *MOD, *MODP, *DT, *XS, *YSSD, *YS5, *CU, *CV, *YDN;
    bf16 *HN, *COLS, *XBCC, *MIX, *HMID;
    int* LIST; int* TOKI; float* TOKW;
};

__device__ __forceinline__ void ld4(const float* p, float (&v)[4]) { const f32x4 t = *(const f32x4*)p; v[0] = t.x; v[1] = t.y; v[2] = t.z; v[3] = t.w; }
__device__ __forceinline__ void ld4(const bf16* p, float (&v)[4]) { const u32x2 t = *(const u32x2*)p; v[0] = __uint_as_float(t.x << 16); v[1] = __uint_as_float(t.x & 0xffff0000u); v[2] = __uint_as_float(t.y << 16); v[3] = __uint_as_float(t.y & 0xffff0000u); }

__device__ __forceinline__ void ld8(const bf16* p, float (&v)[8]) { const u32x4 t = *(const u32x4*)p;
    v[0] = __uint_as_float(t.x << 16); v[1] = __uint_as_float(t.x & 0xffff0000u); v[2] = __uint_as_float(t.y << 16); v[3] = __uint_as_float(t.y & 0xffff0000u);
    v[4] = __uint_as_float(t.z << 16); v[5] = __uint_as_float(t.z & 0xffff0000u); v[6] = __uint_as_float(t.w << 16); v[7] = __uint_as_float(t.w & 0xffff0000u); }

template <class AT, bool DUAL, class RowF, class Epi>
__device__ __forceinline__ void ngemm_tile(const AT* A, int lda, int K, const RowF& rowf, const float* B, const float* B2, int ldb, int n0, int nvalid,
                                           LAS float* lds, const Epi& epi, int tid) {
    constexpr int BK = 16, AST = 132;
    LAS float* As = lds; LAS float* Bs = lds + BK * AST; LAS float* Bs2 = Bs + BK * 64;
    const int ty = tid >> 4, tx = tid & 15;
    const int ar = tid >> 2, ak = (tid & 3) * 4;
    const int arow = rowf(ar);
    const AT* ap = A + (size_t)(arow < 0 ? 0 : arow) * lda + ak;
    const int bt = tid & 255, bk = bt >> 4, bn = (bt & 15) * 4;
    const bool second = tid >= 256;
    const float* bp = ((DUAL && second) ? B2 : B) + (size_t)bk * ldb + n0 + bn;
    const bool bload = (DUAL || !second) && (bn < nvalid);
    float acc[4][4], acc2[4][4];
#pragma unroll
    for (int i = 0; i < 4; ++i)
#pragma unroll
        for (int j = 0; j < 4; ++j) { acc[i][j] = 0.f; acc2[i][j] = 0.f; }
    for (int k0 = 0; k0 < K; k0 += BK) {
        float a4[4] = {0.f, 0.f, 0.f, 0.f};
        if (arow >= 0) ld4(ap + k0, a4);
        f32x4 b4 = {0.f, 0.f, 0.f, 0.f};
        if (bload) b4 = *(const f32x4*)(bp + (size_t)k0 * ldb);
        __syncthreads();
#pragma unroll
        for (int i = 0; i < 4; ++i) As[(ak + i) * AST + ar] = a4[i];
        if (DUAL || !second) *(LAS f32x4*)&((second ? Bs2 : Bs)[bk * 64 + bn]) = b4;
        __syncthreads();
#pragma unroll
        for (int kk = 0; kk < BK; ++kk) {
            const f32x4 av = *(const LAS f32x4*)&As[kk * AST + ty * 4];
            const f32x4 bv = *(const LAS f32x4*)&Bs[kk * 64 + tx * 4];
#pragma unroll
            for (int i = 0; i < 4; ++i)
#pragma unroll
                for (int j = 0; j < 4; ++j) acc[i][j] = fmaf(av[i], bv[j], acc[i][j]);
            if (DUAL) {
                const f32x4 bv2 = *(const LAS f32x4*)&Bs2[kk * 64 + tx * 4];
#pragma unroll
                for (int i = 0; i < 4; ++i)
#pragma unroll
                    for (int j = 0; j < 4; ++j) acc2[i][j] = fmaf(av[i], bv2[j], acc2[i][j]);
            }
        }
    }
#pragma unroll
    for (int i = 0; i < 4; ++i) epi(ty * 4 + i, tx * 4, acc[i], acc2[i]);
    __syncthreads();
}

__device__ __forceinline__ void phase_p0(const Frame& F0)  {
    Frame F = F0; F.tid = opaque_v(F0.tid); F.lane = F.tid & 63; F.wave = __builtin_amdgcn_readfirstlane(F.tid >> 6);
    {
        const size_t gt = (size_t)F.bid * NTHR + F.tid, NG = (size_t)F.G * NTHR;
        for (size_t i = gt; i < (size_t)TT * 256; i += NG) {
            const int r = (int)(i >> 8), c4 = (int)(i & 255) * 4;
            f32x4 v;
            if (r < TL) {
                v = *(const f32x4*)(F.in[I_X] + (size_t)r * D + c4);
                const int n = r & (SEQ - 1), rr = n >> 6, cc = n & 63, q = c4 >> 8, ii = c4 & 255;
                const float pos = (float)(q < 2 ? rr : cc);
                float pe[4];
#pragma unroll
                for (int k = 0; k < 4; ++k) {
                    const float invf = expf(-9.210340371976184f * (float)(ii + k) * (1.f / 256.f));
                    float s, c; sincos_red(pos * invf, s, c);
                    pe[k] = (q & 1) ? c : s;
                }
                v.x += pe[0]; v.y += pe[1]; v.z += pe[2]; v.w += pe[3];
            } else {
                v = *(const f32x4*)(F.in[I_CTX] + (size_t)(r - TL) * D + c4);
            }
            *(f32x4*)(F.XS + (size_t)r * D + c4) = v;
        }
    }
    LAS float* sc = (LAS float*)F.lds;
    for (int it = F.bid; it < 192; it += F.G) {
        const int l = it / 96, kc = (it / 12) % 8, jb = it % 12, j = jb * 512 + F.tid;
        __syncthreads();
        for (int t = F.tid; t < 9 * 128; t += NTHR) {
            const int r9 = t >> 7, kk = t & 127;
            const float cv = r9 < 8 ? F.in[I_C][r9 * D + kc * 128 + kk] : F.in[I_CCTX][kc * 128 + kk];
            sc[t] = siluf_(cv);
        }
        __syncthreads();
        float acc[9];
#pragma unroll
        for (int r9 = 0; r9 < 9; ++r9) acc[r9] = 0.f;
        const float* wp = F.in[I_WADA] + ((size_t)l * D + kc * 128) * 6144 + j;
        for (int kk = 0; kk < 128; ++kk) {
            const float w = wp[(size_t)kk * 6144];
#pragma unroll
            for (int r9 = 0; r9 < 9; ++r9) acc[r9] = fmaf(sc[r9 * 128 + kk], w, acc[r9]);
        }
#pragma unroll
        for (int r9 = 0; r9 < 9; ++r9) F.MODP[((size_t)(kc * 2 + l) * 9 + r9) * 6144 + j] = acc[r9];
    }
}
__device__ __forceinline__ void phase_p1(const Frame& F0)  {
    Frame F = F0; F.tid = opaque_v(F0.tid); F.lane = F.tid & 63; F.wave = __builtin_amdgcn_readfirstlane(F.tid >> 6);
    const int gt = F.bid * NTHR + F.tid, NG = F.G * NTHR;
    for (int i = gt; i < 2 * 9 * 6144; i += NG) {
        const int j = i % 6144, l = i / (9 * 6144);
        float s = F.in[I_BADA][l * 6144 + j];
#pragma unroll
        for (int kc = 0; kc < 8; ++kc) s += F.MODP[(size_t)kc * 2 * 9 * 6144 + i];
        F.MOD[i] = s;
    }
}
__device__ __forceinline__ void moe_tables(Frame& F, int l, LAS int* tab, int TM) {
    __syncthreads();
    if (F.tid == 0) {
        int t = 0, bs = 0;
        for (int e = 0; e < NEXP; ++e) {
            const int c = (int)F.ctl[CW_CNT + l * 64 + e];
            tab[e] = bs; tab[16 + e] = t; tab[40 + e] = c;
            t += (c + TM - 1) / TM; bs += ((c + 255) / 256) * 256;
        }
        tab[32] = t;
    }
    __syncthreads();
}
__device__ __forceinline__ void phase_rowA(const Frame& F0, int l)  {
    Frame F = F0; F.tid = opaque_v(F0.tid); F.lane = F.tid & 63; F.wave = __builtin_amdgcn_readfirstlane(F.tid >> 6);
    LAS int* tab = (LAS int*)F.lds;
    if (l > 0) moe_tables(F, l - 1, tab, 128);
    const int gw = F.bid * NWAVES + F.wave, NGW = F.G * NWAVES;
    const int RL = (l == DEPTH) ? TL : TT;
    const float* gvec = (l == DEPTH) ? F.in[I_GFIN] : F.in[I_GMIX] + l * D;
    for (int r = gw; r < RL; r += NGW) {
        const int mr = modrow(r);
        f32x4 v[4];
#pragma unroll
        for (int j = 0; j < 4; ++j) v[j] = *(const f32x4*)(F.XS + (size_t)r * D + 4 * F.lane + 256 * j);
        if (l > 0) {
            const int4 ti = *(const int4*)(F.TOKI + (size_t)r * 4);
            const f32x2 tw = *(const f32x2*)(F.TOKW + (size_t)r * 2);
            const size_t ra = (size_t)(tab[ti.x] + ti.y), rb = (size_t)(tab[ti.z] + ti.w);
            const float* g2 = F.MOD + ((size_t)(l - 1) * 9 + mr) * 6144 + 5120;
#pragma unroll
            for (int j = 0; j < 4; ++j) {
                const int c = 4 * F.lane + 256 * j;
                const f32x4 ya = *(const f32x4*)(F.YDN + ra * D + c), yb = *(const f32x4*)(F.YDN + rb * D + c), g = *(const f32x4*)(g2 + c);
                v[j] += g * (ya * tw.x + yb * tw.y);
            }
            if (l < DEPTH) {
#pragma unroll
                for (int j = 0; j < 4; ++j) *(f32x4*)(F.XS + (size_t)r * D + 4 * F.lane + 256 * j) = v[j];
            }
        }
        float ss = 0.f;
#pragma unroll
        for (int j = 0; j < 4; ++j) ss += (v[j].x * v[j].x + v[j].y * v[j].y) + (v[j].z * v[j].z + v[j].w * v[j].w);
        const float rstd = rsqrtf(wave_sum(ss) * (1.f / D) + EPS);
        if (l == DEPTH) {
#pragma unroll
            for (int j = 0; j < 4; ++j) { const int c = 4 * F.lane + 256 * j; const f32x4 g = *(const f32x4*)(gvec + c); *(f32x4*)(F.out + (size_t)r * D + c) = v[j] * rstd * g; }
        } else {
            const float* md = F.MOD + ((size_t)l * 9 + mr) * 6144;
#pragma unroll
            for (int j = 0; j < 4; ++j) {
                const int c = 4 * F.lane + 256 * j;
                const f32x4 g = *(const f32x4*)(gvec + c), sh = *(const f32x4*)(md + c), scl = *(const f32x4*)(md + 1024 + c);
                const f32x4 h = v[j] * rstd * g * (scl + 1.f) + sh;
                u32x2 o; o.x = pk2(h.x, h.y); o.y = pk2(h.z, h.w);
                *(u32x2*)(F.HN + (size_t)r * D + c) = o;
            }
        }
    }
}
__device__ __forceinline__ void phase_inproj(const Frame& F0, int l)  {
    Frame F = F0; F.tid = opaque_v(F0.tid); F.lane = F.tid & 63; F.wave = __builtin_amdgcn_readfirstlane(F.tid >> 6);
    const float* W = F.in[I_WIN] + (size_t)l * D * INC;
    const int NU = (TT / 128) * 37;
    for (int u = F.bid; u < NU; u += F.G) {
        const int mt = u / 37, nt = u % 37;
        int n0, nvalid, dcol;
        if (nt < 24) { n0 = nt * 64; nvalid = 64; dcol = n0; }
        else if (nt < 36) { n0 = 1552 + (nt - 24) * 64; nvalid = 64; dcol = 1536 + (nt - 24) * 64; }
        else { n0 = 1536; nvalid = 16; dcol = -1; }
        const int r0 = mt * 128;
        auto rowf = [=](int m) { return r0 + m; };
        bf16* COLS = F.COLS; float* DT = F.DT;
        auto epi = [=](int m, int n, const float (&a)[4], const float (&)[4]) {
            if (dcol >= 0) { u32x2 o; o.x = pk2(a[0], a[1]); o.y = pk2(a[2], a[3]); *(u32x2*)(COLS + (size_t)(r0 + m) * NCOL + dcol + n) = o; }
            else if (n < 16) { *(f32x4*)(DT + (size_t)(r0 + m) * 16 + n) = (f32x4){a[0], a[1], a[2], a[3]}; }
        };
        ngemm_tile<bf16, false>(F.HN, D, D, rowf, W, W, INC, n0, nvalid, (LAS float*)F.lds, epi, F.tid);
    }
}
__device__ __forceinline__ void phase_elem(const Frame& F0, int l)  {
    Frame F = F0; F.tid = opaque_v(F0.tid); F.lane = F.tid & 63; F.wave = __builtin_amdgcn_readfirstlane(F.tid >> 6);
    const size_t gt = (size_t)F.bid * NTHR + F.tid, NG = (size_t)F.G * NTHR;
    const float* cw = F.in[I_SCW] + (size_t)l * 5 * 1024; const float* cb = F.in[I_SCB] + l * 1024;
    for (size_t i = gt; i < (size_t)TT * 256; i += NG) {
        const int r = (int)(i >> 8), c = (int)(i & 255) * 4;
        int lo, hi; seq_bounds(r, lo, hi);
        float acc[4];
        { const f32x4 b = *(const f32x4*)(cb + c); acc[0] = b.x; acc[1] = b.y; acc[2] = b.z; acc[3] = b.w; }
#pragma unroll
        for (int j = 0; j < 5; ++j) {
            const int rr = r + j - 2;
            if (rr >= lo && rr < hi) {
                float x4[4]; ld4(F.COLS + (size_t)rr * NCOL + 512 + c, x4);
                const f32x4 w = *(const f32x4*)(cw + j * 1024 + c);
                acc[0] = fmaf(w.x, x4[0], acc[0]); acc[1] = fmaf(w.y, x4[1], acc[1]); acc[2] = fmaf(w.z, x4[2], acc[2]); acc[3] = fmaf(w.w, x4[3], acc[3]);
            }
        }
        u32x2 o; o.x = pk2(siluf_(acc[0]), siluf_(acc[1])); o.y = pk2(siluf_(acc[2]), siluf_(acc[3]));
        *(u32x2*)(F.XBCC + (size_t)r * 1024 + c) = o;
    }
    for (size_t i = gt; i < (size_t)TT * 64; i += NG) {
        const int r = (int)(i >> 6), c = (int)(i & 63) * 4;
        float a[4], g[4]; ld4(F.COLS + (size_t)r * NCOL + 1536 + c, a); ld4(F.COLS + (size_t)r * NCOL + 1792 + c, g);
        *(f32x4*)(F.CU + (size_t)r * 256 + c) = (f32x4){a[0] * sigmoidf_(g[0]), a[1] * sigmoidf_(g[1]), a[2] * sigmoidf_(g[2]), a[3] * sigmoidf_(g[3])};
    }
}
__device__ __forceinline__ void phase_scan(const Frame& F0, int l)  {
    Frame F = F0; F.tid = opaque_v(F0.tid); F.lane = F.tid & 63; F.wave = __builtin_amdgcn_readfirstlane(F.tid >> 6);
    const int RLc = (l == 0) ? TT : TL;
    const int NU = 128 + 32 + RLc / 64;
    for (int u = F.bid; u < NU; u += F.G) {
        if (u < 128) {
            const int b = u >> 4, h = (u >> 1) & 7, dir = u & 1, g = h >> 2;
            const float a = -expf(F.in[I_SALOG][l * 16 + dir * 8 + h]), dtb = F.in[I_SDTB][l * 16 + dir * 8 + h];
            LAS float* Bc = (LAS float*)F.lds; LAS float* Cc = Bc + 64 * 128; LAS float* xv = Cc + 64 * 128; LAS float* dtv = xv + 64 * 64;
            const int p = F.tid >> 3, nq = F.tid & 7;
            float hst[16];
#pragma unroll
            for (int i = 0; i < 16; ++i) hst[i] = 0.f;
#pragma unroll 1
            for (int s0 = 0; s0 < VSEQ; s0 += 64) {
                __syncthreads();
#pragma unroll 2
                for (int i = 0; i < 16; ++i) {
                    const int idx = F.tid + 512 * i, s = idx >> 7, n = idx & 127; const size_t row = (size_t)vrow(b, dir, s0 + s);
                    Bc[idx] = bf2f(F.XBCC[row * 1024 + 512 + g * 128 + n]); Cc[idx] = bf2f(F.XBCC[row * 1024 + 768 + g * 128 + n]);
                }
#pragma unroll 2
                for (int i = 0; i < 8; ++i) {
                    const int idx = F.tid + 512 * i, s = idx >> 6, pp = idx & 63; const size_t row = (size_t)vrow(b, dir, s0 + s);
                    xv[idx] = bf2f(F.XBCC[row * 1024 + h * 64 + pp]);
                }
                if (F.tid < 64) { const size_t row = (size_t)vrow(b, dir, s0 + F.tid); dtv[F.tid] = softplusf_(F.DT[row * 16 + dir * 8 + h] + dtb); }
                __syncthreads();
#pragma unroll 1
                for (int s = 0; s < 64; ++s) {
                    const float dt = dtv[s], dec = __expf(dt * a), xd = xv[s * 64 + p] * dt;
                    float y = 0.f;
#pragma unroll
                    for (int i4 = 0; i4 < 4; ++i4) {
                        const f32x4 bv = *(const LAS f32x4*)&Bc[s * 128 + nq * 16 + i4 * 4], cv = *(const LAS f32x4*)&Cc[s * 128 + nq * 16 + i4 * 4];
#pragma unroll
                        for (int k = 0; k < 4; ++k) { hst[i4 * 4 + k] = fmaf(hst[i4 * 4 + k], dec, bv[k] * xd); y = fmaf(cv[k], hst[i4 * 4 + k], y); }
                    }
                    y += __shfl_xor(y, 1); y += __shfl_xor(y, 2); y += __shfl_xor(y, 4);
                    if (nq == 0) F.YSSD[((size_t)dir * TT + vrow(b, dir, s0 + s)) * 512 + h * 64 + p] = y;
                }
            }
            __syncthreads();
        } else if (u < 160) {
            const int cidx = (u - 128) * 8 + F.wave, b = cidx >> 5, g = (cidx >> 1) & 15, dir = cidx & 1, p = F.lane;
            LAS float* ubuf = (LAS float*)F.lds + F.wave * (64 * 16 + 128); LAS float* hbuf = ubuf + 64 * 16;
            const int pi = ((l * 2 + dir) * 16 + g) * 64 + p;
            const float step = expf(F.in[I_LSTEP][(l * 2 + dir) * 16 + g]);
            const float lr = F.in[I_LRE][pi], li = F.in[I_LIM][pi];
            const float mag = expf(lr * step); float sn, cs; sincos_red(li * step, sn, cs);
            const float ar = mag * cs, ai = mag * sn, inv_den = 1.f / (lr * lr + li * li);
            const float cr = ((ar - 1.f) * lr + ai * li) * inv_den, ci = (ai * lr - (ar - 1.f) * li) * inv_den;
            float bbr[16], bbi[16], cre[16], cim[16];
            const float* bre = F.in[I_BRE] + ((size_t)(l * 16 + g) * 64 + p) * 16; const float* bim = F.in[I_BIM] + ((size_t)(l * 16 + g) * 64 + p) * 16;
#pragma unroll
            for (int i = 0; i < 16; ++i) { const float br = bre[i], bi = bim[i]; bbr[i] = cr * br - ci * bi; bbi[i] = cr * bi + ci * br; }
            const int hh = F.lane & 15, q = F.lane >> 4;
            const float* crp = F.in[I_CRE] + ((size_t)(l * 16 + g) * 16 + hh) * 64 + q * 16; const float* cip = F.in[I_CIM] + ((size_t)(l * 16 + g) * 16 + hh) * 64 + q * 16;
#pragma unroll
            for (int i = 0; i < 16; ++i) { cre[i] = crp[i]; cim[i] = cip[i]; }
            float hr = 0.f, hi = 0.f;
#pragma unroll 1
            for (int s0 = 0; s0 < VSEQ; s0 += 64) {
                {
                    const size_t row = (size_t)vrow(b, dir, s0 + F.lane);
                    const bf16* up = F.COLS + row * NCOL + 2048 + g * 16;
                    float t4[4];
#pragma unroll
                    for (int k = 0; k < 4; ++k) { ld4(up + 4 * k, t4); *(LAS f32x4*)&ubuf[F.lane * 16 + 4 * k] = (f32x4){t4[0], t4[1], t4[2], t4[3]}; }
                }
                asm volatile("s_waitcnt lgkmcnt(0)" ::: "memory");
#pragma unroll 1
                for (int s = 0; s < 64; ++s) {
                    float bur = 0.f, bui = 0.f;
#pragma unroll
                    for (int k = 0; k < 4; ++k) {
                        const f32x4 uv = *(const LAS f32x4*)&ubuf[s * 16 + 4 * k];
#pragma unroll
                        for (int e = 0; e < 4; ++e) { bur = fmaf(uv[e], bbr[4 * k + e], bur); bui = fmaf(uv[e], bbi[4 * k + e], bui); }
                    }
                    const float nr = ar * hr - ai * hi + bur, ni = ar * hi + ai * hr + bui; hr = nr; hi = ni;
                    hbuf[p] = hr; hbuf[64 + p] = hi;
                    asm volatile("s_waitcnt lgkmcnt(0)" ::: "memory");
                    float acc = 0.f;
#pragma unroll
                    for (int k = 0; k < 4; ++k) {
                        const f32x4 a4 = *(const LAS f32x4*)&hbuf[q * 16 + 4 * k], b4 = *(const LAS f32x4*)&hbuf[64 + q * 16 + 4 * k];
#pragma unroll
                        for (int e = 0; e < 4; ++e) acc += a4[e] * cre[4 * k + e] - b4[e] * cim[4 * k + e];
                    }
                    asm volatile("s_waitcnt lgkmcnt(0)" ::: "memory");
                    acc += __shfl_xor(acc, 16); acc += __shfl_xor(acc, 32);
                    if (q == 0) F.YS5[((size_t)dir * TT + vrow(b, dir, s0 + s)) * 256 + g * 16 + hh] = acc;
                }
            }
        } else {
            const int rbase = (u - 160) * 64 + F.wave * 8, ch = 4 * F.lane;
            const float* dw = F.in[I_CDW] + (size_t)l * 31 * 256;
            const f32x4 db = *(const f32x4*)(F.in[I_CDB] + l * 256 + ch), lg = *(const f32x4*)(F.in[I_CLG] + l * 256 + ch), lb = *(const f32x4*)(F.in[I_CLB] + l * 256 + ch);
            for (int i = 0; i < 8; ++i) {
                const int r = rbase + i; int lo, hi; seq_bounds(r, lo, hi);
                f32x4 acc = db;
#pragma unroll 1
                for (int j = 0; j < 31; ++j) {
                    const int rr = r + j - 15;
                    if (rr >= lo && rr < hi) acc += *(const f32x4*)(dw + j * 256 + ch) * *(const f32x4*)(F.CU + (size_t)rr * 256 + ch);
                }
                const float mean = wave_sum((acc.x + acc.y) + (acc.z + acc.w)) * (1.f / 256.f);
                const f32x4 d = acc - mean;
                const float var = wave_sum((d.x * d.x + d.y * d.y) + (d.z * d.z + d.w * d.w)) * (1.f / 256.f);
                const f32x4 y = d * rsqrtf(var + EPS) * lg + lb;
                *(f32x4*)(F.CV + (size_t)r * 256 + ch) = (f32x4){siluf_(y.x), siluf_(y.y), siluf_(y.z), siluf_(y.w)};
            }
        }
    }
}
__device__ __forceinline__ void phase_mix1(const Frame& F0, int l)  {
    Frame F = F0; F.tid = opaque_v(F0.tid); F.lane = F.tid & 63; F.wave = __builtin_amdgcn_readfirstlane(F.tid >> 6);
    const int gw = F.bid * NWAVES + F.wave, NGW = F.G * NWAVES;
    const int RL = (l == 0) ? TT : TL;
    for (int r = gw; r < RL; r += NGW) {
        const int ch = 8 * F.lane, h = F.lane >> 3;
        const float dsk = F.in[I_SD][l * 8 + h];
        float xs[8], z[8];
        ld8(F.XBCC + (size_t)r * 1024 + ch, xs); ld8(F.COLS + (size_t)r * NCOL + ch, z);
        float y[8]; float ss = 0.f;
#pragma unroll
        for (int k = 0; k < 8; k += 4) {
            const f32x4 y0 = *(const f32x4*)(F.YSSD + (size_t)r * 512 + ch + k), y1 = *(const f32x4*)(F.YSSD + ((size_t)TT + r) * 512 + ch + k);
#pragma unroll
            for (int e = 0; e < 4; ++e) { const float t = (dsk * xs[k + e] + y0[e] + y1[e]) * siluf_(z[k + e]); y[k + e] = t; ss = fmaf(t, t, ss); }
        }
        const float rstd = rsqrtf(wave_sum(ss) * (1.f / 512.f) + EPS);
        const float* ng = F.in[I_SNG] + l * 512 + ch;
        u32x4 o; o.x = pk2(y[0] * rstd * ng[0], y[1] * rstd * ng[1]); o.y = pk2(y[2] * rstd * ng[2], y[3] * rstd * ng[3]);
        o.z = pk2(y[4] * rstd * ng[4], y[5] * rstd * ng[5]); o.w = pk2(y[6] * rstd * ng[6], y[7] * rstd * ng[7]);
        *(u32x4*)(F.MIX + (size_t)r * 1024 + ch) = o;
    }
    {
        const size_t gt = (size_t)F.bid * NTHR + F.tid, NG = (size_t)F.G * NTHR;
        const float* dsk = F.in[I_S5D] + l * 256;
        for (size_t i = gt; i < (size_t)RL * 64; i += NG) {
            const int r = (int)(i >> 6), c = (int)(i & 63) * 4;
            float u4[4]; ld4(F.COLS + (size_t)r * NCOL + 2048 + c, u4);
            const f32x4 y0 = *(const f32x4*)(F.YS5 + (size_t)r * 256 + c), y1 = *(const f32x4*)(F.YS5 + ((size_t)TT + r) * 256 + c), dk = *(const f32x4*)(dsk + c);
            f32x4 o;
#pragma unroll
            for (int e = 0; e < 4; ++e) o[e] = gelu_tanh(y0[e] + y1[e] + dk[e] * u4[e]);
            *(f32x4*)(F.YS5 + (size_t)r * 256 + c) = o;
        }
    }
    {
        const float* W = F.in[I_CPW] + (size_t)l * 256 * 256; const float* pb = F.in[I_CPB] + l * 256;
        const int NU = (RL / 128) * 4;
        for (int u = F.bid; u < NU; u += F.G) {
            const int mt = u >> 2, nt = u & 3, r0 = mt * 128, n0 = nt * 64;
            auto rowf = [=](int m) { return r0 + m; };
            bf16* MIX = F.MIX;
            auto epi = [=](int m, int n, const float (&a)[4], const float (&)[4]) {
                const f32x4 b = *(const f32x4*)(pb + n0 + n);
                u32x2 o; o.x = pk2(a[0] + b.x, a[1] + b.y); o.y = pk2(a[2] + b.z, a[3] + b.w);
                *(u32x2*)(MIX + (size_t)(r0 + m) * 1024 + 512 + n0 + n) = o;
            };
            ngemm_tile<float, false>(F.CV, 256, 256, rowf, W, W, 256, n0, 64, (LAS float*)F.lds, epi, F.tid);
        }
    }
}
__device__ __forceinline__ void phase_s5glu(const Frame& F0, int l)  {
    Frame F = F0; F.tid = opaque_v(F0.tid); F.lane = F.tid & 63; F.wave = __builtin_amdgcn_readfirstlane(F.tid >> 6);
    const int RL = (l == 0) ? TT : TL;
    const float* W = F.in[I_GLUW] + (size_t)l * 256 * 512; const float* gb = F.in[I_GLUB] + l * 512;
    const int NU = (RL / 128) * 4;
    for (int u = F.bid; u < NU; u += F.G) {
        const int mt = u >> 2, nt = u & 3, r0 = mt * 128, n0 = nt * 64;
        auto rowf = [=](int m) { return r0 + m; };
        bf16* MIX = F.MIX;
        auto epi = [=](int m, int n, const float (&a)[4], const float (&a2)[4]) {
            const f32x4 b1 = *(const f32x4*)(gb + n0 + n), b2 = *(const f32x4*)(gb + 256 + n0 + n);
            float o[4];
#pragma unroll
            for (int e = 0; e < 4; ++e) o[e] = (a[e] + b1[e]) * sigmoidf_(a2[e] + b2[e]);
            u32x2 w; w.x = pk2(o[0], o[1]); w.y = pk2(o[2], o[3]);
            *(u32x2*)(MIX + (size_t)(r0 + m) * 1024 + 768 + n0 + n) = w;
        };
        ngemm_tile<float, true>(F.YS5, 256, 256, rowf, W, W + 256, 512, n0, 64, (LAS float*)F.lds, epi, F.tid);
    }
}
__device__ __forceinline__ void phase_wout(const Frame& F0, int l)  {
    Frame F = F0; F.tid = opaque_v(F0.tid); F.lane = F.tid & 63; F.wave = __builtin_amdgcn_readfirstlane(F.tid >> 6);
    const int RL = (l == 0) ? TT : TL;
    const float* W = F.in[I_WOUT] + (size_t)l * D * D;
    const int NU = (RL / 128) * 16;
    for (int u = F.bid; u < NU; u += F.G) {
        const int mt = u >> 4, nt = u & 15, r0 = mt * 128, n0 = nt * 64;
        auto rowf = [=](int m) { return r0 + m; };
        float* XS = F.XS; const float* MOD = F.MOD;
        auto epi = [=](int m, int n, const float (&a)[4], const float (&)[4]) {
            const int r = r0 + m; const float* g1 = MOD + ((size_t)l * 9 + modrow(r)) * 6144 + 2048 + n0 + n;
            float* xp = XS + (size_t)r * D + n0 + n;
            f32x4 x = *(const f32x4*)xp; const f32x4 g = *(const f32x4*)g1;
            x.x += g.x * a[0]; x.y += g.y * a[1]; x.z += g.z * a[2]; x.w += g.w * a[3];
            *(f32x4*)xp = x;
        };
        ngemm_tile<bf16, false>(F.MIX, D, D, rowf, W, W, D, n0, 64, (LAS float*)F.lds, epi, F.tid);
    }
}
__device__ __forceinline__ void phase_norm2(const Frame& F0, int l)  {
    Frame F = F0; F.tid = opaque_v(F0.tid); F.lane = F.tid & 63; F.wave = __builtin_amdgcn_readfirstlane(F.tid >> 6);
    const int RL = (l == 0) ? TT : TL;
    LAS float* RW = (LAS float*)F.lds;
    __syncthreads();
    for (int i = F.tid; i < 1024 * 16 / 4; i += NTHR) *(LAS f32x4*)&RW[i * 4] = *(const f32x4*)(F.in[I_RW] + i * 4);
    __syncthreads();
    const int gw = F.bid * NWAVES + F.wave, NGW = F.G * NWAVES;
    const float* gvec = F.in[I_GFFN] + l * D;
    for (int r = gw; r < RL; r += NGW) {
        const int mr = modrow(r);
        f32x4 v[4]; float ss = 0.f;
#pragma unroll
        for (int j = 0; j < 4; ++j) { v[j] = *(const f32x4*)(F.XS + (size_t)r * D + 4 * F.lane + 256 * j); ss += (v[j].x * v[j].x + v[j].y * v[j].y) + (v[j].z * v[j].z + v[j].w * v[j].w); }
        const float rstd = rsqrtf(wave_sum(ss) * (1.f / D) + EPS);
        const float* md = F.MOD + ((size_t)l * 9 + mr) * 6144;
        float lg[16];
#pragma unroll
        for (int e = 0; e < 16; ++e) lg[e] = 0.f;
#pragma unroll
        for (int j = 0; j < 4; ++j) {
            const int c = 4 * F.lane + 256 * j;
            const f32x4 g = *(const f32x4*)(gvec + c), sh = *(const f32x4*)(md + 3072 + c), scl = *(const f32x4*)(md + 4096 + c);
            const f32x4 h = v[j] * rstd * g * (scl + 1.f) + sh;
            u32x2 o; o.x = pk2(h.x, h.y); o.y = pk2(h.z, h.w);
            *(u32x2*)(F.HN + (size_t)r * D + c) = o;
#pragma unroll
            for (int k = 0; k < 4; ++k) {
#pragma unroll
                for (int e4 = 0; e4 < 4; ++e4) {
                    const f32x4 w = *(const LAS f32x4*)&RW[(c + k) * 16 + e4 * 4];
#pragma unroll
                    for (int e = 0; e < 4; ++e) lg[e4 * 4 + e] = fmaf(h[k], w[e], lg[e4 * 4 + e]);
                }
                asm volatile("" ::: "memory");
            }
        }
        float mx = -3.0e38f;
#pragma unroll
        for (int e = 0; e < 16; ++e) { lg[e] = wave_sum(lg[e]) + F.in[I_RB][e]; mx = fmaxf(mx, lg[e]); }
        float den = 0.f;
#pragma unroll
        for (int e = 0; e < 16; ++e) { lg[e] = expf(lg[e] - mx); den += lg[e]; }
        const float inv = 1.f / den;
#pragma unroll
        for (int e = 0; e < 16; ++e) lg[e] *= inv;
        float gs[4];
#pragma unroll
        for (int gI = 0; gI < 4; ++gI) {
            const float p0 = lg[gI * 4], p1 = lg[gI * 4 + 1], p2 = lg[gI * 4 + 2], p3 = lg[gI * 4 + 3];
            const float h01 = fmaxf(p0, p1), l01 = fminf(p0, p1), h23 = fmaxf(p2, p3), l23 = fminf(p2, p3);
            gs[gI] = fmaxf(h01, h23) + fmaxf(fminf(h01, h23), fmaxf(l01, l23));
        }
        int best = 0; float bsv = gs[0];
#pragma unroll
        for (int gI = 1; gI < 4; ++gI) if (gs[gI] > bsv) { bsv = gs[gI]; best = gI; }
        float q[4];
#pragma unroll
        for (int i = 0; i < 4; ++i) q[i] = best == 0 ? lg[i] : (best == 1 ? lg[4 + i] : (best == 2 ? lg[8 + i] : lg[12 + i]));
        int i0 = 0; float v0 = q[0];
#pragma unroll
        for (int i = 1; i < 4; ++i) if (q[i] > v0) { v0 = q[i]; i0 = i; }
        int i1 = -1; float v1 = -1.f;
#pragma unroll
        for (int i = 0; i < 4; ++i) if (i != i0 && q[i] > v1) { v1 = q[i]; i1 = i; }
        const float ginv = 1.f / (v0 + v1);
        if (F.lane == 0) {
            const int e0 = best * 4 + i0, e1 = best * 4 + i1;
            const int p0 = (int)atomicAdd(&F.ctl[CW_CNT + l * 64 + e0], 1u), p1 = (int)atomicAdd(&F.ctl[CW_CNT + l * 64 + e1], 1u);
            F.LIST[(size_t)e0 * TT + p0] = r; F.LIST[(size_t)e1 * TT + p1] = r;
            *(int4*)(F.TOKI + (size_t)r * 4) = make_int4(e0, p0, e1, p1);
            *(f32x2*)(F.TOKW + (size_t)r * 2) = (f32x2){v0 * ginv, v1 * ginv};
        }
    }
}
__device__ __forceinline__ void phase_gateup(const Frame& F0, int l)  {
    Frame F = F0; F.tid = opaque_v(F0.tid); F.lane = F.tid & 63; F.wave = __builtin_amdgcn_readfirstlane(F.tid >> 6);
    LAS int* tab = (LAS int*)(F.lds + 65536);
    moe_tables(F, l, tab, 128);
    const int NU = tab[32] * 16;
    for (int u = F.bid; u < NU; u += F.G) {
        const int mtile = u >> 4, nt = u & 15, n0 = nt * 64;
        int e = 0;
        for (int k = 1; k < NEXP; ++k) if (mtile >= tab[16 + k]) e = k;
        const int m0 = (mtile - tab[16 + e]) * 128, cnt = tab[40 + e], ob = tab[e] + m0;
        const int* list = F.LIST + (size_t)e * TT + m0;
        auto rowf = [=](int m) { return (m0 + m < cnt) ? list[m] : -1; };
        bf16* HMID = F.HMID;
        auto epi = [=](int m, int n, const float (&a)[4], const float (&a2)[4]) {
            if (m0 + m < cnt) { u32x2 o; o.x = pk2(siluf_(a[0]) * a2[0], siluf_(a[1]) * a2[1]); o.y = pk2(siluf_(a[2]) * a2[2], siluf_(a[3]) * a2[3]);
                *(u32x2*)(HMID + (size_t)(ob + m) * 1024 + n0 + n) = o; }
        };
        const float* Wg = F.in[I_WG] + ((size_t)l * NEXP + e) * D * D; const float* Wu = F.in[I_WU] + ((size_t)l * NEXP + e) * D * D;
        ngemm_tile<bf16, true>(F.HN, D, D, rowf, Wg, Wu, D, n0, 64, (LAS float*)F.lds, epi, F.tid);
    }
}
__device__ __forceinline__ void phase_down(const Frame& F0, int l)  {
    Frame F = F0; F.tid = opaque_v(F0.tid); F.lane = F.tid & 63; F.wave = __builtin_amdgcn_readfirstlane(F.tid >> 6);
    LAS int* tab = (LAS int*)(F.lds + 65536);
    moe_tables(F, l, tab, 128);
    const int NU = tab[32] * 16;
    for (int u = F.bid; u < NU; u += F.G) {
        const int mtile = u >> 4, nt = u & 15, n0 = nt * 64;
        int e = 0;
        for (int k = 1; k < NEXP; ++k) if (mtile >= tab[16 + k]) e = k;
        const int m0 = (mtile - tab[16 + e]) * 128, cnt = tab[40 + e], ob = tab[e] + m0;
        auto rowf = [=](int m) { return (m0 + m < cnt) ? ob + m : -1; };
        float* YDN = F.YDN;
        auto epi = [=](int m, int n, const float (&a)[4], const float (&)[4]) {
            if (m0 + m < cnt) *(f32x4*)(YDN + (size_t)(ob + m) * 1024 + n0 + n) = (f32x4){a[0], a[1], a[2], a[3]};
        };
        const float* Wd = F.in[I_WD] + ((size_t)l * NEXP + e) * D * D;
        ngemm_tile<bf16, false>(F.HMID, D, D, rowf, Wd, Wd, D, n0, 64, (LAS float*)F.lds, epi, F.tid);
    }
}

constexpr int PH_PER_LAYER = 10, N_PHASES = 2 + DEPTH * PH_PER_LAYER + 1;

__global__ void __launch_bounds__(NTHR, 2) fwd_kernel(Args args) {
    extern __shared__ __attribute__((aligned(16))) unsigned char lds_raw[];
    Frame F;
    F.lds = (LAS unsigned char*)lds_raw;
    F.tid = threadIdx.x; F.lane = F.tid & 63; F.wave = __builtin_amdgcn_readfirstlane(F.tid >> 6);
    F.G = gridDim.x; F.bid = blockIdx.x;
    F.in = args.in; F.out = args.out; F.ws = args.ws;
    unsigned char* ws = args.ws;
    F.ctl = (unsigned*)(ws + WS_CTL);
    F.MOD = (float*)(ws + WS_MOD); F.MODP = (float*)(ws + WS_MODP); F.DT = (float*)(ws + WS_DT); F.XS = (float*)(ws + WS_XS);
    F.YSSD = (float*)(ws + WS_YSSD); F.YS5 = (float*)(ws + WS_YS5); F.CU = (float*)(ws + WS_CU); F.CV = (float*)(ws + WS_CV); F.YDN = (float*)(ws + WS_YDN);
    F.HN = (bf16*)(ws + WS_HN); F.COLS = (bf16*)(ws + WS_COLS); F.XBCC = (bf16*)(ws + WS_XBCC); F.MIX = (bf16*)(ws + WS_MIX); F.HMID = (bf16*)(ws + WS_HMID);
    F.LIST = (int*)(ws + WS_LIST); F.TOKI = (int*)(ws + WS_TOKI); F.TOKW = (float*)(ws + WS_TOKW);
    volatile LAS unsigned* MISC = (volatile LAS unsigned*)(F.lds + MISC_OFF);
    if (F.tid < 32) MISC[F.tid] = 0u;
    __syncthreads();
    const int lo = args.ph_lo, hi = args.ph_hi;
    const bool multi = (hi - lo) > 1;
    XcdBarrier bar; bar.bar = F.ctl + CW_BAR; bar.x = 0; bar.st = MISC + 8;
    if (multi) bar = xcd_barrier_post(F.ctl + CW_BAR, MISC + 8);
#define IN(k) (lo <= (k) && (k) < hi)
#define SEAM(k) do { if (IN(k) && IN((k) + 1)) xcd_barrier(bar); } while (0)
    if (IN(0)) phase_p0(F);
    SEAM(0);
    if (IN(1)) phase_p1(F);
    SEAM(1);
    for (int l = 0; l < DEPTH; ++l) {
        const int pb = 2 + l * PH_PER_LAYER;
        if (IN(pb + 0)) phase_rowA(F, l);
        SEAM(pb + 0);
        if (IN(pb + 1)) phase_inproj(F, l);
        SEAM(pb + 1);
        if (IN(pb + 2)) phase_elem(F, l);
        SEAM(pb + 2);
        if (IN(pb + 3)) phase_scan(F, l);
        SEAM(pb + 3);
        if (IN(pb + 4)) phase_mix1(F, l);
        SEAM(pb + 4);
        if (IN(pb + 5)) phase_s5glu(F, l);
        SEAM(pb + 5);
        if (IN(pb + 6)) phase_wout(F, l);
        SEAM(pb + 6);
        if (IN(pb + 7)) phase_norm2(F, l);
        SEAM(pb + 7);
        if (IN(pb + 8)) phase_gateup(F, l);
        SEAM(pb + 8);
        if (IN(pb + 9)) phase_down(F, l);
        SEAM(pb + 9);
    }
    if (IN(N_PHASES - 1)) phase_rowA(F, DEPTH);
#undef IN
#undef SEAM
}

extern "C" void kernel_launch(void* const* d_in, const int* in_sizes, int n_in, void* d_out, int out_size, void* d_ws, size_t ws_size, hipStream_t stream) {
    static int grid = 0;
    if (grid == 0) {
        if (n_in != N_IN || out_size != TL * D || ws_size < WS_END) { fprintf(stderr, "kernel_launch: unexpected shapes (n_in %d out %d ws %zu)\n", n_in, out_size, ws_size); grid = -1; return; }
        int dev = 0, cus = 0, per_cu = 0;
        if (hipGetDevice(&dev) != hipSuccess || hipDeviceGetAttribute(&cus, hipDeviceAttributeMultiprocessorCount, dev) != hipSuccess) { grid = -1; return; }
        if (hipFuncSetAttribute((const void*)fwd_kernel, hipFuncAttributeMaxDynamicSharedMemorySize, LDS_BYTES) != hipSuccess) { fprintf(stderr, "kernel_launch: hipFuncSetAttribute failed\n"); grid = -1; return; }
        if (hipOccupancyMaxActiveBlocksPerMultiprocessor(&per_cu, (const void*)fwd_kernel, NTHR, LDS_BYTES) != hipSuccess || per_cu < 1) { fprintf(stderr, "kernel_launch: occupancy query says %d\n", per_cu); }
        (void)hipGetLastError();
        grid = cus;
    }
    if (grid < 0) return;
    if (hipMemsetAsync((char*)d_ws + WS_CTL, 0, CTL_ZERO_BYTES, stream) != hipSuccess) return;
    Args a{};
    for (int i = 0; i < N_IN; ++i) a.in[i] = (const float*)d_in[i];
    a.out = (float*)d_out; a.ws = (unsigned char*)d_ws;
#if MK_ONE_LAUNCH
    a.ph_lo = 0; a.ph_hi = N_PHASES;
    hipLaunchKernelGGL(fwd_kernel, dim3(grid), dim3(NTHR), LDS_BYTES, stream, a);
#else
    for (int p = 0; p < N_PHASES; ++p) { a.ph_lo = p; a.ph_hi = p + 1; hipLaunchKernelGGL(fwd_kernel, dim3(grid), dim3(NTHR), LDS_BYTES, stream, a); }
#endif
}
```

```cpp
#include <hip/hip_runtime.h>
#include <cstdio>
#include <cstdint>

#ifndef MK_ONE_LAUNCH
#define MK_ONE_LAUNCH 1
#endif

#define GAS __attribute__((address_space(1)))
#define LAS __attribute__((address_space(3)))
typedef unsigned short bf16;
typedef float f32x4 __attribute__((ext_vector_type(4)));
typedef float f32x2 __attribute__((ext_vector_type(2)));
typedef unsigned u32x4 __attribute__((ext_vector_type(4)));
typedef unsigned u32x2 __attribute__((ext_vector_type(2)));

constexpr int D = 1024, NB = 8, SEQ = 2048, CTXL = 256, DEPTH = 2;
constexpr int TL = NB * SEQ, TC = NB * CTXL, TT = TL + TC;
constexpr int INC = 2320;
constexpr int NCOL = 2304;
constexpr int VSEQ = CTXL + SEQ;
constexpr int NEXP = 16;
constexpr float EPS = 1e-6f;

enum { I_X = 0, I_C, I_CTX, I_CCTX, I_WADA, I_BADA, I_GMIX, I_WIN, I_SCW, I_SCB, I_SDTB, I_SALOG, I_SD, I_SNG,
       I_CDW, I_CDB, I_CLG, I_CLB, I_CPW, I_CPB, I_LRE, I_LIM, I_LSTEP, I_BRE, I_BIM, I_CRE, I_CIM, I_S5D, I_GLUW, I_GLUB,
       I_WOUT, I_GFFN, I_RW, I_RB, I_WG, I_WU, I_WD, I_GFIN, N_IN };

constexpr size_t MiB = 1u << 20;
constexpr size_t WS_CTL = 0, CTL_ZERO_BYTES = 64 * 1024;
constexpr size_t WS_MOD = 1 * MiB;
constexpr size_t WS_MODP = 2 * MiB;
constexpr size_t WS_DT = 6 * MiB;
constexpr size_t WS_TOKI = 7 * MiB + 512 * 1024;
constexpr size_t WS_TOKW = WS_TOKI + (size_t)TT * 16;
constexpr size_t WS_XS = 8 * MiB;
constexpr size_t WS_HN = 80 * MiB;
constexpr size_t WS_COLS = 116 * MiB;
constexpr size_t WS_XBCC = 197 * MiB;
constexpr size_t WS_YSSD = 233 * MiB;
constexpr size_t WS_MIX = 305 * MiB;
constexpr size_t WS_YS5 = 341 * MiB;
constexpr size_t WS_CU = 377 * MiB;
constexpr size_t WS_CV = 395 * MiB;
constexpr size_t WS_LIST = 413 * MiB;
constexpr size_t WS_END = 415 * MiB;
constexpr int MOE_ROWS = 2 * TT + NEXP * 256;
constexpr size_t WS_HMID = WS_COLS;
constexpr size_t WS_YDN = WS_XBCC;
static_assert(WS_HMID + (size_t)MOE_ROWS * 1024 * 2 <= WS_XBCC, "HMID overlay");
static_assert(WS_YDN + (size_t)MOE_ROWS * 1024 * 4 <= WS_CU, "YDN overlay");
constexpr int CW_CNT = 64;
constexpr int CW_BAR = 1024;

constexpr int NWAVES = 8, NTHR = 512;
constexpr int LDS_BYTES = 147456;
constexpr int MISC_OFF = 131072 + 320;

__device__ __forceinline__ float bf2f(bf16 v) { return __uint_as_float((unsigned)v << 16); }
__device__ __forceinline__ unsigned f2bf(float f) { unsigned u = __float_as_uint(f); return (u + 0x7fffu + ((u >> 16) & 1u)) >> 16; }
__device__ __forceinline__ unsigned pk2(float lo, float hi) { return f2bf(lo) | (f2bf(hi) << 16); }
__device__ __forceinline__ float wave_sum(float v) {
#pragma unroll
    for (int o = 1; o < 64; o <<= 1) v += __shfl_xor(v, o);
    return v;
}
__device__ __forceinline__ float sigmoidf_(float x) { return 1.f / (1.f + __expf(-x)); }
__device__ __forceinline__ float siluf_(float x) { return x / (1.f + __expf(-x)); }
__device__ __forceinline__ float softplusf_(float x) { return fmaxf(x, 0.f) + log1pf(__expf(-fabsf(x))); }
__device__ __forceinline__ float gelu_tanh(float x) { const float u = 0.7978845608028654f * (x + 0.044715f * x * x * x); return 0.5f * x * (1.f + tanhf(u)); }
__device__ __forceinline__ void sincos_red(float x, float& s, float& c) {
    const float k = rintf(x * 0.15915494309189535f);
    float r = fmaf(-k, 6.2831854820251465f, x); r = fmaf(-k, -1.7484555e-7f, r);
    s = __sinf(r); c = __cosf(r);
}
__device__ __forceinline__ int opaque_v(int v) { asm volatile("" : "+v"(v)); return v; }
__device__ __forceinline__ int modrow(int r) { return r < TL ? (r >> 11) : 8; }
__device__ __forceinline__ void seq_bounds(int r, int& lo, int& hi) {
    if (r < TL) { lo = r & ~(SEQ - 1); hi = lo + SEQ; } else { lo = TL + ((r - TL) & ~(CTXL - 1)); hi = lo + CTXL; }
}
__device__ __forceinline__ int vrow(int b, int dir, int s) {
    if (s < CTXL) return TL + b * CTXL + (dir ? CTXL - 1 - s : s);
    const int t = s - CTXL; return b * SEQ + (dir ? SEQ - 1 - t : t);
}

#define XB_TMO      128
#define XB_XCNT(j)  (256  + 64 * (j))
#define XB_XSUB(j)  (1280 + 64 * (j))
#define XB_XGEN(j)  (2304 + 64 * (j))
#define XB_TOP      3328
#define XB_TOPGEN   3392
#define XCD_BAR_WORDS 3456
#define XB_SPIN_CAP (1u << 18)
__device__ __forceinline__ unsigned xb_ld(unsigned* p)              { return __hip_atomic_load(p, __ATOMIC_RELAXED, __HIP_MEMORY_SCOPE_AGENT); }
__device__ __forceinline__ unsigned xb_add(unsigned* p, unsigned v) { return __hip_atomic_fetch_add(p, v, __ATOMIC_RELAXED, __HIP_MEMORY_SCOPE_AGENT); }
__device__ __forceinline__ unsigned xb_xcc_id() { return (unsigned)__builtin_amdgcn_s_getreg((3 << 11) | 20) & 0xFu; }
#define XB_SPIN(cond, bar) do { unsigned _sp = 0; while (cond) { __builtin_amdgcn_s_sleep(1); \
    if ((++_sp & 255u) == 0u) { if (xb_ld(&(bar)[XB_TMO])) break; if (_sp > XB_SPIN_CAP) { atomicAdd(&(bar)[XB_TMO], 1u); break; } } } } while (0)
struct XcdBarrier { unsigned* bar; unsigned x; volatile LAS unsigned* st; };
__device__ __forceinline__ XcdBarrier xcd_barrier_post(unsigned* bar, volatile LAS unsigned* st) {
    XcdBarrier b; b.bar = bar; b.x = xb_xcc_id(); b.st = st;
    if (threadIdx.x == 0) (void)xb_add(&bar[XB_XCNT(b.x)], 1u);
    return b;
}
__device__ __forceinline__ void xcd_barrier_complete(unsigned* bar, unsigned x, unsigned& nloc, unsigned& nx) {
    const unsigned G = gridDim.x * gridDim.y * gridDim.z;
    unsigned sum, cnt, mine, sp = 0u;
    for (;;) {
        sum = 0u; cnt = 0u; mine = 0u;
#pragma unroll
        for (unsigned j = 0; j < 16; ++j) { const unsigned c = xb_ld(&bar[XB_XCNT(j)]); sum += c; cnt += (c > 0u) ? 1u : 0u; mine = (j == x) ? c : mine; }
        if (sum == G) break;
        __builtin_amdgcn_s_sleep(1);
        if ((++sp & 255u) == 0u) { if (xb_ld(&bar[XB_TMO])) break; if (sp > XB_SPIN_CAP) { atomicAdd(&bar[XB_TMO], 1u); break; } }
    }
    nloc = mine > 0u ? mine : 1u; nx = cnt > 0u ? cnt : 1u;
}
__device__ __forceinline__ void xcd_barrier(const XcdBarrier& b) {
    asm volatile("s_waitcnt vmcnt(0)" ::: "memory");
    __syncthreads();
    if (threadIdx.x == 0) {
        unsigned* bar = b.bar;
        __builtin_amdgcn_s_waitcnt(0);
        unsigned nloc = b.st[0], nx = b.st[1];
        if (nloc == 0u) { xcd_barrier_complete(bar, b.x, nloc, nx); b.st[0] = nloc; b.st[1] = nx; }
        const unsigned old = xb_add(&bar[XB_XSUB(b.x)], 1u);
        const unsigned gen = old / nloc;
        if (old + 1u == (gen + 1u) * nloc) {
            __builtin_amdgcn_fence(__ATOMIC_RELEASE, "agent");
            asm volatile("s_waitcnt vmcnt(0)" ::: "memory");
            const unsigned og = xb_add(&bar[XB_TOP], 1u);
            const unsigned tg = og / nx;
            if (og + 1u == (tg + 1u) * nx) xb_add(&bar[XB_TOPGEN], 1u);
            else XB_SPIN(xb_ld(&bar[XB_TOPGEN]) == tg, bar);
            __builtin_amdgcn_fence(__ATOMIC_ACQUIRE, "agent");
            xb_add(&bar[XB_XGEN(b.x)], 1u);
            asm volatile("s_waitcnt vmcnt(0)" ::: "memory");
        } else {
            XB_SPIN(xb_ld(&bar[XB_XGEN(b.x)]) == gen, bar);
            __builtin_amdgcn_fence(__ATOMIC_ACQUIRE, "agent");
            asm volatile("s_waitcnt vmcnt(0)" ::: "memory");
        }
    }
    __syncthreads();
}

struct Args { const float* in[N_IN]; float* out; unsigned char* ws; int ph_lo, ph_hi; };
struct Frame {
    LAS unsigned char* lds;
    int tid, lane, wave, G, bid;
    const float* const* in;
    float* out; unsigned char* ws;
    unsigned* ctl;
    float *MOD, *MODP, *DT, *XS, *YSSD, *YS5, *CU, *CV, *YDN;
    bf16 *HN, *COLS, *XBCC, *MIX, *HMID;
    int* LIST; int* TOKI; float* TOKW;
};

__device__ __forceinline__ void ld4(const float* p, float (&v)[4]) { const f32x4 t = *(const f32x4*)p; v[0] = t.x; v[1] = t.y; v[2] = t.z; v[3] = t.w; }
__device__ __forceinline__ void ld4(const bf16* p, float (&v)[4]) { const u32x2 t = *(const u32x2*)p; v[0] = __uint_as_float(t.x << 16); v[1] = __uint_as_float(t.x & 0xffff0000u); v[2] = __uint_as_float(t.y << 16); v[3] = __uint_as_float(t.y & 0xffff0000u); }

__device__ __forceinline__ void ld8(const bf16* p, float (&v)[8]) { const u32x4 t = *(const u32x4*)p;
    v[0] = __uint_as_float(t.x << 16); v[1] = __uint_as_float(t.x & 0xffff0000u); v[2] = __uint_as_float(t.y << 16); v[3] = __uint_as_float(t.y & 0xffff0000u);
    v[4] = __uint_as_float(t.z << 16); v[5] = __uint_as_float(t.z & 0xffff0000u); v[6] = __uint_as_float(t.w << 16); v[7] = __uint_as_float(t.w & 0xffff0000u); }

template <class AT, bool DUAL, class RowF, class Epi>
__device__ __forceinline__ void ngemm_tile(const AT* A, int lda, int K, const RowF& rowf, const float* B, const float* B2, int ldb, int n0, int nvalid,
                                           LAS float* lds, const Epi& epi, int tid) {
    constexpr int BK = 16, AST = 132;
    LAS float* As = lds; LAS float* Bs = lds + BK * AST; LAS float* Bs2 = Bs + BK * 64;
    const int ty = tid >> 4, tx = tid & 15;
    const int ar = tid >> 2, ak = (tid & 3) * 4;
    const int arow = rowf(ar);
    const AT* ap = A + (size_t)(arow < 0 ? 0 : arow) * lda + ak;
    const int bt = tid & 255, bk = bt >> 4, bn = (bt & 15) * 4;
    const bool second = tid >= 256;
    const float* bp = ((DUAL && second) ? B2 : B) + (size_t)bk * ldb + n0 + bn;
    const bool bload = (DUAL || !second) && (bn < nvalid);
    float acc[4][4], acc2[4][4];
#pragma unroll
    for (int i = 0; i < 4; ++i)
#pragma unroll
        for (int j = 0; j < 4; ++j) { acc[i][j] = 0.f; acc2[i][j] = 0.f; }
    for (int k0 = 0; k0 < K; k0 += BK) {
        float a4[4] = {0.f, 0.f, 0.f, 0.f};
        if (arow >= 0) ld4(ap + k0, a4);
        f32x4 b4 = {0.f, 0.f, 0.f, 0.f};
        if (bload) b4 = *(const f32x4*)(bp + (size_t)k0 * ldb);
        __syncthreads();
#pragma unroll
        for (int i = 0; i < 4; ++i) As[(ak + i) * AST + ar] = a4[i];
        if (DUAL || !second) *(LAS f32x4*)&((second ? Bs2 : Bs)[bk * 64 + bn]) = b4;
        __syncthreads();
#pragma unroll
        for (int kk = 0; kk < BK; ++kk) {
            const f32x4 av = *(const LAS f32x4*)&As[kk * AST + ty * 4];
            const f32x4 bv = *(const LAS f32x4*)&Bs[kk * 64 + tx * 4];
#pragma unroll
            for (int i = 0; i < 4; ++i)
#pragma unroll
                for (int j = 0; j < 4; ++j) acc[i][j] = fmaf(av[i], bv[j], acc[i][j]);
            if (DUAL) {
                const f32x4 bv2 = *(const LAS f32x4*)&Bs2[kk * 64 + tx * 4];
#pragma unroll
                for (int i = 0; i < 4; ++i)
#pragma unroll
                    for (int j = 0; j < 4; ++j) acc2[i][j] = fmaf(av[i], bv2[j], acc2[i][j]);
            }
        }
    }
#pragma unroll
    for (int i = 0; i < 4; ++i) epi(ty * 4 + i, tx * 4, acc[i], acc2[i]);
    __syncthreads();
}

__device__ __forceinline__ void phase_p0(const Frame& F0)  {
    Frame F = F0; F.tid = opaque_v(F0.tid); F.lane = F.tid & 63; F.wave = __builtin_amdgcn_readfirstlane(F.tid >> 6);
    {
        const size_t gt = (size_t)F.bid * NTHR + F.tid, NG = (size_t)F.G * NTHR;
        for (size_t i = gt; i < (size_t)TT * 256; i += NG) {
            const int r = (int)(i >> 8), c4 = (int)(i & 255) * 4;
            f32x4 v;
            if (r < TL) {
                v = *(const f32x4*)(F.in[I_X] + (size_t)r * D + c4);
                const int n = r & (SEQ - 1), rr = n >> 6, cc = n & 63, q = c4 >> 8, ii = c4 & 255;
                const float pos = (float)(q < 2 ? rr : cc);
                float pe[4];
#pragma unroll
                for (int k = 0; k < 4; ++k) {
                    const float invf = expf(-9.210340371976184f * (float)(ii + k) * (1.f / 256.f));
                    float s, c; sincos_red(pos * invf, s, c);
                    pe[k] = (q & 1) ? c : s;
                }
                v.x += pe[0]; v.y += pe[1]; v.z += pe[2]; v.w += pe[3];
            } else {
                v = *(const f32x4*)(F.in[I_CTX] + (size_t)(r - TL) * D + c4);
            }
            *(f32x4*)(F.XS + (size_t)r * D + c4) = v;
        }
    }
    LAS float* sc = (LAS float*)F.lds;
    for (int it = F.bid; it < 192; it += F.G) {
        const int l = it / 96, kc = (it / 12) % 8, jb = it % 12, j = jb * 512 + F.tid;
        __syncthreads();
        for (int t = F.tid; t < 9 * 128; t += NTHR) {
            const int r9 = t >> 7, kk = t & 127;
            const float cv = r9 < 8 ? F.in[I_C][r9 * D + kc * 128 + kk] : F.in[I_CCTX][kc * 128 + kk];
            sc[t] = siluf_(cv);
        }
        __syncthreads();
        float acc[9];
#pragma unroll
        for (int r9 = 0; r9 < 9; ++r9) acc[r9] = 0.f;
        const float* wp = F.in[I_WADA] + ((size_t)l * D + kc * 128) * 6144 + j;
        for (int kk = 0; kk < 128; ++kk) {
            const float w = wp[(size_t)kk * 6144];
#pragma unroll
            for (int r9 = 0; r9 < 9; ++r9) acc[r9] = fmaf(sc[r9 * 128 + kk], w, acc[r9]);
        }
#pragma unroll
        for (int r9 = 0; r9 < 9; ++r9) F.MODP[((size_t)(kc * 2 + l) * 9 + r9) * 6144 + j] = acc[r9];
    }
}
__device__ __forceinline__ void phase_p1(const Frame& F0)  {
    Frame F = F0; F.tid = opaque_v(F0.tid); F.lane = F.tid & 63; F.wave = __builtin_amdgcn_readfirstlane(F.tid >> 6);
    const int gt = F.bid * NTHR + F.tid, NG = F.G * NTHR;
    for (int i = gt; i < 2 * 9 * 6144; i += NG) {
        const int j = i % 6144, l = i / (9 * 6144);
        float s = F.in[I_BADA][l * 6144 + j];
#pragma unroll
        for (int kc = 0; kc < 8; ++kc) s += F.MODP[(size_t)kc * 2 * 9 * 6144 + i];
        F.MOD[i] = s;
    }
}
__device__ __forceinline__ void moe_tables(Frame& F, int l, LAS int* tab, int TM) {
    __syncthreads();
    if (F.tid == 0) {
        int t = 0, bs = 0;
        for (int e = 0; e < NEXP; ++e) {
            const int c = (int)F.ctl[CW_CNT + l * 64 + e];
            tab[e] = bs; tab[16 + e] = t; tab[40 + e] = c;
            t += (c + TM - 1) / TM; bs += ((c + 255) / 256) * 256;
        }
        tab[32] = t;
    }
    __syncthreads();
}
__device__ __forceinline__ void phase_rowA(const Frame& F0, int l)  {
    Frame F = F0; F.tid = opaque_v(F0.tid); F.lane = F.tid & 63; F.wave = __builtin_amdgcn_readfirstlane(F.tid >> 6);
    LAS int* tab = (LAS int*)F.lds;
    if (l > 0) moe_tables(F, l - 1, tab, 128);
    const int gw = F.bid * NWAVES + F.wave, NGW = F.G * NWAVES;
    const int RL = (l == DEPTH) ? TL : TT;
    const float* gvec = (l == DEPTH) ? F.in[I_GFIN] : F.in[I_GMIX] + l * D;
    for (int r = gw; r < RL; r += NGW) {
        const int mr = modrow(r);
        f32x4 v[4];
#pragma unroll
        for (int j = 0; j < 4; ++j) v[j] = *(const f32x4*)(F.XS + (size_t)r * D + 4 * F.lane + 256 * j);
        if (l > 0) {
            const int4 ti = *(const int4*)(F.TOKI + (size_t)r * 4);
            const f32x2 tw = *(const f32x2*)(F.TOKW + (size_t)r * 2);
            const size_t ra = (size_t)(tab[ti.x] + ti.y), rb = (size_t)(tab[ti.z] + ti.w);
            const float* g2 = F.MOD + ((size_t)(l - 1) * 9 + mr) * 6144 + 5120;
#pragma unroll
            for (int j = 0; j < 4; ++j) {
                const int c = 4 * F.lane + 256 * j;
                const f32x4 ya = *(const f32x4*)(F.YDN + ra * D + c), yb = *(const f32x4*)(F.YDN + rb * D + c), g = *(const f32x4*)(g2 + c);
                v[j] += g * (ya * tw.x + yb * tw.y);
            }
            if (l < DEPTH) {
#pragma unroll
                for (int j = 0; j < 4; ++j) *(f32x4*)(F.XS + (size_t)r * D + 4 * F.lane + 256 * j) = v[j];
            }
        }
        float ss = 0.f;
#pragma unroll
        for (int j = 0; j < 4; ++j) ss += (v[j].x * v[j].x + v[j].y * v[j].y) + (v[j].z * v[j].z + v[j].w * v[j].w);
        const float rstd = rsqrtf(wave_sum(ss) * (1.f / D) + EPS);
        if (l == DEPTH) {
#pragma unroll
            for (int j = 0; j < 4; ++j) { const int c = 4 * F.lane + 256 * j; const f32x4 g = *(const f32x4*)(gvec + c); *(f32x4*)(F.out + (size_t)r * D + c) = v[j] * rstd * g; }
        } else {
            const float* md = F.MOD + ((size_t)l * 9 + mr) * 6144;
#pragma unroll
            for (int j = 0; j < 4; ++j) {
                const int c = 4 * F.lane + 256 * j;
                const f32x4 g = *(const f32x4*)(gvec + c), sh = *(const f32x4*)(md + c), scl = *(const f32x4*)(md + 1024 + c);
                const f32x4 h = v[j] * rstd * g * (scl + 1.f) + sh;
                u32x2 o; o.x = pk2(h.x, h.y); o.y = pk2(h.z, h.w);
                *(u32x2*)(F.HN + (size_t)r * D + c) = o;
            }
        }
    }
}
__device__ __forceinline__ void phase_inproj(const Frame& F0, int l)  {
    Frame F = F0; F.tid = opaque_v(F0.tid); F.lane = F.tid & 63; F.wave = __builtin_amdgcn_readfirstlane(F.tid >> 6);
    const float* W = F.in[I_WIN] + (size_t)l * D * INC;
    const int NU = (TT / 128) * 37;
    for (int u = F.bid; u < NU; u += F.G) {
        const int mt = u / 37, nt = u % 37;
        int n0, nvalid, dcol;
        if (nt < 24) { n0 = nt * 64; nvalid = 64; dcol = n0; }
        else if (nt < 36) { n0 = 1552 + (nt - 24) * 64; nvalid = 64; dcol = 1536 + (nt - 24) * 64; }
        else { n0 = 1536; nvalid = 16; dcol = -1; }
        const int r0 = mt * 128;
        auto rowf = [=](int m) { return r0 + m; };
        bf16* COLS = F.COLS; float* DT = F.DT;
        auto epi = [=](int m, int n, const float (&a)[4], const float (&)[4]) {
            if (dcol >= 0) { u32x2 o; o.x = pk2(a[0], a[1]); o.y = pk2(a[2], a[3]); *(u32x2*)(COLS + (size_t)(r0 + m) * NCOL + dcol + n) = o; }
            else if (n < 16) { *(f32x4*)(DT + (size_t)(r0 + m) * 16 + n) = (f32x4){a[0], a[1], a[2], a[3]}; }
        };
        ngemm_tile<bf16, false>(F.HN, D, D, rowf, W, W, INC, n0, nvalid, (LAS float*)F.lds, epi, F.tid);
    }
}
__device__ __forceinline__ void phase_elem(const Frame& F0, int l)  {
    Frame F = F0; F.tid = opaque_v(F0.tid); F.lane = F.tid & 63; F.wave = __builtin_amdgcn_readfirstlane(F.tid >> 6);
    const size_t gt = (size_t)F.bid * NTHR + F.tid, NG = (size_t)F.G * NTHR;
    const float* cw = F.in[I_SCW] + (size_t)l * 5 * 1024; const float* cb = F.in[I_SCB] + l * 1024;
    for (size_t i = gt; i < (size_t)TT * 256; i += NG) {
        const int r = (int)(i >> 8), c = (int)(i & 255) * 4;
        int lo, hi; seq_bounds(r, lo, hi);
        float acc[4];
        { const f32x4 b = *(const f32x4*)(cb + c); acc[0] = b.x; acc[1] = b.y; acc[2] = b.z; acc[3] = b.w; }
#pragma unroll
        for (int j = 0; j < 5; ++j) {
            const int rr = r + j - 2;
            if (rr >= lo && rr < hi) {
                float x4[4]; ld4(F.COLS + (size_t)rr * NCOL + 512 + c, x4);
                const f32x4 w = *(const f32x4*)(cw + j * 1024 + c);
                acc[0] = fmaf(w.x, x4[0], acc[0]); acc[1] = fmaf(w.y, x4[1], acc[1]); acc[2] = fmaf(w.z, x4[2], acc[2]); acc[3] = fmaf(w.w, x4[3], acc[3]);
            }
        }
        u32x2 o; o.x = pk2(siluf_(acc[0]), siluf_(acc[1])); o.y = pk2(siluf_(acc[2]), siluf_(acc[3]));
        *(u32x2*)(F.XBCC + (size_t)r * 1024 + c) = o;
    }
    for (size_t i = gt; i < (size_t)TT * 64; i += NG) {
        const int r = (int)(i >> 6), c = (int)(i & 63) * 4;
        float a[4], g[4]; ld4(F.COLS + (size_t)r * NCOL + 1536 + c, a); ld4(F.COLS + (size_t)r * NCOL + 1792 + c, g);
        *(f32x4*)(F.CU + (size_t)r * 256 + c) = (f32x4){a[0] * sigmoidf_(g[0]), a[1] * sigmoidf_(g[1]), a[2] * sigmoidf_(g[2]), a[3] * sigmoidf_(g[3])};
    }
}
__device__ __forceinline__ void phase_scan(const Frame& F0, int l)  {
    Frame F = F0; F.tid = opaque_v(F0.tid); F.lane = F.tid & 63; F.wave = __builtin_amdgcn_readfirstlane(F.tid >> 6);
    const int RLc = (l == 0) ? TT : TL;
    const int NU = 128 + 32 + RLc / 64;
    for (int u = F.bid; u < NU; u += F.G) {
        if (u < 128) {
            const int b = u >> 4, h = (u >> 1) & 7, dir = u & 1, g = h >> 2;
            const float a = -expf(F.in[I_SALOG][l * 16 + dir * 8 + h]), dtb = F.in[I_SDTB][l * 16 + dir * 8 + h];
            LAS float* Bc = (LAS float*)F.lds; LAS float* Cc = Bc + 64 * 128; LAS float* xv = Cc + 64 * 128; LAS float* dtv = xv + 64 * 64;
            const int p = F.tid >> 3, nq = F.tid & 7;
            float hst[16];
#pragma unroll
            for (int i = 0; i < 16; ++i) hst[i] = 0.f;
#pragma unroll 1
            for (int s0 = 0; s0 < VSEQ; s0 += 64) {
                __syncthreads();
#pragma unroll 2
                for (int i = 0; i < 16; ++i) {
                    const int idx = F.tid + 512 * i, s = idx >> 7, n = idx & 127; const size_t row = (size_t)vrow(b, dir, s0 + s);
                    Bc[idx] = bf2f(F.XBCC[row * 1024 + 512 + g * 128 + n]); Cc[idx] = bf2f(F.XBCC[row * 1024 + 768 + g * 128 + n]);
                }
#pragma unroll 2
                for (int i = 0; i < 8; ++i) {
                    const int idx = F.tid + 512 * i, s = idx >> 6, pp = idx & 63; const size_t row = (size_t)vrow(b, dir, s0 + s);
                    xv[idx] = bf2f(F.XBCC[row * 1024 + h * 64 + pp]);
                }
                if (F.tid < 64) { const size_t row = (size_t)vrow(b, dir, s0 + F.tid); dtv[F.tid] = softplusf_(F.DT[row * 16 + dir * 8 + h] + dtb); }
                __syncthreads();
#pragma unroll 1
                for (int s = 0; s < 64; ++s) {
                    const float dt = dtv[s], dec = __expf(dt * a), xd = xv[s * 64 + p] * dt;
                    float y = 0.f;
#pragma unroll
                    for (int i4 = 0; i4 < 4; ++i4) {
                        const f32x4 bv = *(const LAS f32x4*)&Bc[s * 128 + nq * 16 + i4 * 4], cv = *(const LAS f32x4*)&Cc[s * 128 + nq * 16 + i4 * 4];
#pragma unroll
                        for (int k = 0; k < 4; ++k) { hst[i4 * 4 + k] = fmaf(hst[i4 * 4 + k], dec, bv[k] * xd); y = fmaf(cv[k], hst[i4 * 4 + k], y); }
                    }
                    y += __shfl_xor(y, 1); y += __shfl_xor(y, 2); y += __shfl_xor(y, 4);
                    if (nq == 0) F.YSSD[((size_t)dir * TT + vrow(b, dir, s0 + s)) * 512 + h * 64 + p] = y;
                }
            }
            __syncthreads();
        } else if (u < 160) {
            const int cidx = (u - 128) * 8 + F.wave, b = cidx >> 5, g = (cidx >> 1) & 15, dir = cidx & 1, p = F.lane;
            LAS float* ubuf = (LAS float*)F.lds + F.wave * (64 * 16 + 128); LAS float* hbuf = ubuf + 64 * 16;
            const int pi = ((l * 2 + dir) * 16 + g) * 64 + p;
            const float step = expf(F.in[I_LSTEP][(l * 2 + dir) * 16 + g]);
            const float lr = F.in[I_LRE][pi], li = F.in[I_LIM][pi];
            const float mag = expf(lr * step); float sn, cs; sincos_red(li * step, sn, cs);
            const float ar = mag * cs, ai = mag * sn, inv_den = 1.f / (lr * lr + li * li);
            const float cr = ((ar - 1.f) * lr + ai * li) * inv_den, ci = (ai * lr - (ar - 1.f) * li) * inv_den;
            float bbr[16], bbi[16], cre[16], cim[16];
            const float* bre = F.in[I_BRE] + ((size_t)(l * 16 + g) * 64 + p) * 16; const float* bim = F.in[I_BIM] + ((size_t)(l * 16 + g) * 64 + p) * 16;
#pragma unroll
            for (int i = 0; i < 16; ++i) { const float br = bre[i], bi = bim[i]; bbr[i] = cr * br - ci * bi; bbi[i] = cr * bi + ci * br; }
            const int hh = F.lane & 15, q = F.lane >> 4;
            const float* crp = F.in[I_CRE] + ((size_t)(l * 16 + g) * 16 + hh) * 64 + q * 16; const float* cip = F.in[I_CIM] + ((size_t)(l * 16 + g) * 16 + hh) * 64 + q * 16;
#pragma unroll
            for (int i = 0; i < 16; ++i) { cre[i] = crp[i]; cim[i] = cip[i]; }
            float hr = 0.f, hi = 0.f;
#pragma unroll 1
            for (int s0 = 0; s0 < VSEQ; s0 += 64) {
                {
                    const size_t row = (size_t)vrow(b, dir, s0 + F.lane);
                    const bf16* up = F.COLS + row * NCOL + 2048 + g * 16;
                    float t4[4];
#pragma unroll
                    for (int k = 0; k < 4; ++k) { ld4(up + 4 * k, t4); *(LAS f32x4*)&ubuf[F.lane * 16 + 4 * k] = (f32x4){t4[0], t4[1], t4[2], t4[3]}; }
                }
                asm volatile("s_waitcnt lgkmcnt(0)" ::: "memory");
#pragma unroll 1
                for (int s = 0; s < 64; ++s) {
                    float bur = 0.f, bui = 0.f;
#pragma unroll
                    for (int k = 0; k < 4; ++k) {
                        const f32x4 uv = *(const LAS f32x4*)&ubuf[s * 16 + 4 * k];
#pragma unroll
                        for (int e = 0; e < 4; ++e) { bur = fmaf(uv[e], bbr[4 * k + e], bur); bui = fmaf(uv[e], bbi[4 * k + e], bui); }
                    }
                    const float nr = ar * hr - ai * hi + bur, ni = ar * hi + ai * hr + bui; hr = nr; hi = ni;
                    hbuf[p] = hr; hbuf[64 + p] = hi;
                    asm volatile("s_waitcnt lgkmcnt(0)" ::: "memory");
                    float acc = 0.f;
#pragma unroll
                    for (int k = 0; k < 4; ++k) {
                        const f32x4 a4 = *(const LAS f32x4*)&hbuf[q * 16 + 4 * k], b4 = *(const LAS f32x4*)&hbuf[64 + q * 16 + 4 * k];
#pragma unroll
                        for (int e = 0; e < 4; ++e) acc += a4[e] * cre[4 * k + e] - b4[e] * cim[4 * k + e];
                    }
                    asm volatile("s_waitcnt lgkmcnt(0)" ::: "memory");
                    acc += __shfl_xor(acc, 16); acc += __shfl_xor(acc, 32);
                    if (q == 0) F.YS5[((size_t)dir * TT + vrow(b, dir, s0 + s)) * 256 + g * 16 + hh] = acc;
                }
            }
        } else {
            const int rbase = (u - 160) * 64 + F.wave * 8, ch = 4 * F.lane;
            const float* dw = F.in[I_CDW] + (size_t)l * 31 * 256;
            const f32x4 db = *(const f32x4*)(F.in[I_CDB] + l * 256 + ch), lg = *(const f32x4*)(F.in[I_CLG] + l * 256 + ch), lb = *(const f32x4*)(F.in[I_CLB] + l * 256 + ch);
            for (int i = 0; i < 8; ++i) {
                const int r = rbase + i; int lo, hi; seq_bounds(r, lo, hi);
                f32x4 acc = db;
#pragma unroll 1
                for (int j = 0; j < 31; ++j) {
                    const int rr = r + j - 15;
                    if (rr >= lo && rr < hi) acc += *(const f32x4*)(dw + j * 256 + ch) * *(const f32x4*)(F.CU + (size_t)rr * 256 + ch);
                }
                const float mean = wave_sum((acc.x + acc.y) + (acc.z + acc.w)) * (1.f / 256.f);
                const f32x4 d = acc - mean;
                const float var = wave_sum((d.x * d.x + d.y * d.y) + (d.z * d.z + d.w * d.w)) * (1.f / 256.f);
                const f32x4 y = d * rsqrtf(var + EPS) * lg + lb;
                *(f32x4*)(F.CV + (size_t)r * 256 + ch) = (f32x4){siluf_(y.x), siluf_(y.y), siluf_(y.z), siluf_(y.w)};
            }
        }
    }
}
__device__ __forceinline__ void phase_mix1(const Frame& F0, int l)  {
    Frame F = F0; F.tid = opaque_v(F0.tid); F.lane = F.tid & 63; F.wave = __builtin_amdgcn_readfirstlane(F.tid >> 6);
    const int gw = F.bid * NWAVES + F.wave, NGW = F.G * NWAVES;
    const int RL = (l == 0) ? TT : TL;
    for (int r = gw; r < RL; r += NGW) {
        const int ch = 8 * F.lane, h = F.lane >> 3;
        const float dsk = F.in[I_SD][l * 8 + h];
        float xs[8], z[8];
        ld8(F.XBCC + (size_t)r * 1024 + ch, xs); ld8(F.COLS + (size_t)r * NCOL + ch, z);
        float y[8]; float ss = 0.f;
#pragma unroll
        for (int k = 0; k < 8; k += 4) {
            const f32x4 y0 = *(const f32x4*)(F.YSSD + (size_t)r * 512 + ch + k), y1 = *(const f32x4*)(F.YSSD + ((size_t)TT + r) * 512 + ch + k);
#pragma unroll
            for (int e = 0; e < 4; ++e) { const float t = (dsk * xs[k + e] + y0[e] + y1[e]) * siluf_(z[k + e]); y[k + e] = t; ss = fmaf(t, t, ss); }
        }
        const float rstd = rsqrtf(wave_sum(ss) * (1.f / 512.f) + EPS);
        const float* ng = F.in[I_SNG] + l * 512 + ch;
        u32x4 o; o.x = pk2(y[0] * rstd * ng[0], y[1] * rstd * ng[1]); o.y = pk2(y[2] * rstd * ng[2], y[3] * rstd * ng[3]);
        o.z = pk2(y[4] * rstd * ng[4], y[5] * rstd * ng[5]); o.w = pk2(y[6] * rstd * ng[6], y[7] * rstd * ng[7]);
        *(u32x4*)(F.MIX + (size_t)r * 1024 + ch) = o;
    }
    {
        const size_t gt = (size_t)F.bid * NTHR + F.tid, NG = (size_t)F.G * NTHR;
        const float* dsk = F.in[I_S5D] + l * 256;
        for (size_t i = gt; i < (size_t)RL * 64; i += NG) {
            const int r = (int)(i >> 6), c = (int)(i & 63) * 4;
            float u4[4]; ld4(F.COLS + (size_t)r * NCOL + 2048 + c, u4);
            const f32x4 y0 = *(const f32x4*)(F.YS5 + (size_t)r * 256 + c), y1 = *(const f32x4*)(F.YS5 + ((size_t)TT + r) * 256 + c), dk = *(const f32x4*)(dsk + c);
            f32x4 o;
#pragma unroll
            for (int e = 0; e < 4; ++e) o[e] = gelu_tanh(y0[e] + y1[e] + dk[e] * u4[e]);
            *(f32x4*)(F.YS5 + (size_t)r * 256 + c) = o;
        }
    }
    {
        const float* W = F.in[I_CPW] + (size_t)l * 256 * 256; const float* pb = F.in[I_CPB] + l * 256;
        const int NU = (RL / 128) * 4;
        for (int u = F.bid; u < NU; u += F.G) {
            const int mt = u >> 2, nt = u & 3, r0 = mt * 128, n0 = nt * 64;
            auto rowf = [=](int m) { return r0 + m; };
            bf16* MIX = F.MIX;
            auto epi = [=](int m, int n, const float (&a)[4], const float (&)[4]) {
                const f32x4 b = *(const f32x4*)(pb + n0 + n);
                u32x2 o; o.x = pk2(a[0] + b.x, a[1] + b.y); o.y = pk2(a[2] + b.z, a[3] + b.w);
                *(u32x2*)(MIX + (size_t)(r0 + m) * 1024 + 512 + n0 + n) = o;
            };
            ngemm_tile<float, false>(F.CV, 256, 256, rowf, W, W, 256, n0, 64, (LAS float*)F.lds, epi, F.tid);
        }
    }
}
__device__ __forceinline__ void phase_s5glu(const Frame& F0, int l)  {
    Frame F = F0; F.tid = opaque_v(F0.tid); F.lane = F.tid & 63; F.wave = __builtin_amdgcn_readfirstlane(F.tid >> 6);
    const int RL = (l == 0) ? TT : TL;
    const float* W = F.in[I_GLUW] + (size_t)l * 256 * 512; const float* gb = F.in[I_GLUB] + l * 512;
    const int NU = (RL / 128) * 4;
    for (int u = F.bid; u < NU; u += F.G) {
        const int mt = u >> 2, nt = u & 3, r0 = mt * 128, n0 = nt * 64;
        auto rowf = [=](int m) { return r0 + m; };
        bf16* MIX = F.MIX;
        auto epi = [=](int m, int n, const float (&a)[4], const float (&a2)[4]) {
            const f32x4 b1 = *(const f32x4*)(gb + n0 + n), b2 = *(const f32x4*)(gb + 256 + n0 + n);
            float o[4];
#pragma unroll
            for (int e = 0; e < 4; ++e) o[e] = (a[e] + b1[e]) * sigmoidf_(a2[e] + b2[e]);
            u32x2 w; w.x = pk2(o[0], o[1]); w.y = pk2(o[2], o[3]);
            *(u32x2*)(MIX + (size_t)(r0 + m) * 1024 + 768 + n0 + n) = w;
        };
        ngemm_tile<float, true>(F.YS5, 256, 256, rowf, W, W + 256, 512, n0, 64, (LAS float*)F.lds, epi, F.tid);
    }
}
__device__ __forceinline__ void phase_wout(const Frame& F0, int l)  {
    Frame F = F0; F.tid = opaque_v(F0.tid); F.lane = F.tid & 63; F.wave = __builtin_amdgcn_readfirstlane(F.tid >> 6);
    const int RL = (l == 0) ? TT : TL;
    const float* W = F.in[I_WOUT] + (size_t)l * D * D;
    const int NU = (RL / 128) * 16;
    for (int u = F.bid; u < NU; u += F.G) {
        const int mt = u >> 4, nt = u & 15, r0 = mt * 128, n0 = nt * 64;
        auto rowf = [=](int m) { return r0 + m; };
        float* XS = F.XS; const float* MOD = F.MOD;
        auto epi = [=](int m, int n, const float (&a)[4], const float (&)[4]) {
            const int r = r0 + m; const float* g1 = MOD + ((size_t)l * 9 + modrow(r)) * 6144 + 2048 + n0 + n;
            float* xp = XS + (size_t)r * D + n0 + n;
            f32x4 x = *(const f32x4*)xp; const f32x4 g = *(const f32x4*)g1;
            x.x += g.x * a[0]; x.y += g.y * a[1]; x.z += g.z * a[2]; x.w += g.w * a[3];
            *(f32x4*)xp = x;
        };
        ngemm_tile<bf16, false>(F.MIX, D, D, rowf, W, W, D, n0, 64, (LAS float*)F.lds, epi, F.tid);
    }
}
__device__ __forceinline__ void phase_norm2(const Frame& F0, int l)  {
    Frame F = F0; F.tid = opaque_v(F0.tid); F.lane = F.tid & 63; F.wave = __builtin_amdgcn_readfirstlane(F.tid >> 6);
    const int RL = (l == 0) ? TT : TL;
    LAS float* RW = (LAS float*)F.lds;
    __syncthreads();
    for (int i = F.tid; i < 1024 * 16 / 4; i += NTHR) *(LAS f32x4*)&RW[i * 4] = *(const f32x4*)(F.in[I_RW] + i * 4);
    __syncthreads();
    const int gw = F.bid * NWAVES + F.wave, NGW = F.G * NWAVES;
    const float* gvec = F.in[I_GFFN] + l * D;
    for (int r = gw; r < RL; r += NGW) {
        const int mr = modrow(r);
        f32x4 v[4]; float ss = 0.f;
#pragma unroll
        for (int j = 0; j < 4; ++j) { v[j] = *(const f32x4*)(F.XS + (size_t)r * D + 4 * F.lane + 256 * j); ss += (v[j].x * v[j].x + v[j].y * v[j].y) + (v[j].z * v[j].z + v[j].w * v[j].w); }
        const float rstd = rsqrtf(wave_sum(ss) * (1.f / D) + EPS);
        const float* md = F.MOD + ((size_t)l * 9 + mr) * 6144;
        float lg[16];
#pragma unroll
        for (int e = 0; e < 16; ++e) lg[e] = 0.f;
#pragma unroll
        for (int j = 0; j < 4; ++j) {
            const int c = 4 * F.lane + 256 * j;
            const f32x4 g = *(const f32x4*)(gvec + c), sh = *(const f32x4*)(md + 3072 + c), scl = *(const f32x4*)(md + 4096 + c);
            const f32x4 h = v[j] * rstd * g * (scl + 1.f) + sh;
            u32x2 o; o.x = pk2(h.x, h.y); o.y = pk2(h.z, h.w);
            *(u32x2*)(F.HN + (size_t)r * D + c) = o;
#pragma unroll
            for (int k = 0; k < 4; ++k) {
#pragma unroll
                for (int e4 = 0; e4 < 4; ++e4) {
                    const f32x4 w = *(const LAS f32x4*)&RW[(c + k) * 16 + e4 * 4];
#pragma unroll
                    for (int e = 0; e < 4; ++e) lg[e4 * 4 + e] = fmaf(h[k], w[e], lg[e4 * 4 + e]);
                }
                asm volatile("" ::: "memory");
            }
        }
        float mx = -3.0e38f;
#pragma unroll
        for (int e = 0; e < 16; ++e) { lg[e] = wave_sum(lg[e]) + F.in[I_RB][e]; mx = fmaxf(mx, lg[e]); }
        float den = 0.f;
#pragma unroll
        for (int e = 0; e < 16; ++e) { lg[e] = expf(lg[e] - mx); den += lg[e]; }
        const float inv = 1.f / den;
#pragma unroll
        for (int e = 0; e < 16; ++e) lg[e] *= inv;
        float gs[4];
#pragma unroll
        for (int gI = 0; gI < 4; ++gI) {
            const float p0 = lg[gI * 4], p1 = lg[gI * 4 + 1], p2 = lg[gI * 4 + 2], p3 = lg[gI * 4 + 3];
            const float h01 = fmaxf(p0, p1), l01 = fminf(p0, p1), h23 = fmaxf(p2, p3), l23 = fminf(p2, p3);
            gs[gI] = fmaxf(h01, h23) + fmaxf(fminf(h01, h23), fmaxf(l01, l23));
        }
        int best = 0; float bsv = gs[0];
#pragma unroll
        for (int gI = 1; gI < 4; ++gI) if (gs[gI] > bsv) { bsv = gs[gI]; best = gI; }
        float q[4];
#pragma unroll
        for (int i = 0; i < 4; ++i) q[i] = best == 0 ? lg[i] : (best == 1 ? lg[4 + i] : (best == 2 ? lg[8 + i] : lg[12 + i]));
        int i0 = 0; float v0 = q[0];
#pragma unroll
        for (int i = 1; i < 4; ++i) if (q[i] > v0) { v0 = q[i]; i0 = i; }
        int i1 = -1; float v1 = -1.f;
#pragma unroll
        for (int i = 0; i < 4; ++i) if (i != i0 && q[i] > v1) { v1 = q[i]; i1 = i; }
        const float ginv = 1.f / (v0 + v1);
        if (F.lane == 0) {
            const int e0 = best * 4 + i0, e1 = best * 4 + i1;
            const int p0 = (int)atomicAdd(&F.ctl[CW_CNT + l * 64 + e0], 1u), p1 = (int)atomicAdd(&F.ctl[CW_CNT + l * 64 + e1], 1u);
            F.LIST[(size_t)e0 * TT + p0] = r; F.LIST[(size_t)e1 * TT + p1] = r;
            *(int4*)(F.TOKI + (size_t)r * 4) = make_int4(e0, p0, e1, p1);
            *(f32x2*)(F.TOKW + (size_t)r * 2) = (f32x2){v0 * ginv, v1 * ginv};
        }
    }
}
__device__ __forceinline__ void phase_gateup(const Frame& F0, int l)  {
    Frame F = F0; F.tid = opaque_v(F0.tid); F.lane = F.tid & 63; F.wave = __builtin_amdgcn_readfirstlane(F.tid >> 6);
    LAS int* tab = (LAS int*)(F.lds + 65536);
    moe_tables(F, l, tab, 128);
    const int NU = tab[32] * 16;
    for (int u = F.bid; u < NU; u += F.G) {
        const int mtile = u >> 4, nt = u & 15, n0 = nt * 64;
        int e = 0;
        for (int k = 1; k < NEXP; ++k) if (mtile >= tab[16 + k]) e = k;
        const int m0 = (mtile - tab[16 + e]) * 128, cnt = tab[40 + e], ob = tab[e] + m0;
        const int* list = F.LIST + (size_t)e * TT + m0;
        auto rowf = [=](int m) { return (m0 + m < cnt) ? list[m] : -1; };
        bf16* HMID = F.HMID;
        auto epi = [=](int m, int n, const float (&a)[4], const float (&a2)[4]) {
            if (m0 + m < cnt) { u32x2 o; o.x = pk2(siluf_(a[0]) * a2[0], siluf_(a[1]) * a2[1]); o.y = pk2(siluf_(a[2]) * a2[2], siluf_(a[3]) * a2[3]);
                *(u32x2*)(HMID + (size_t)(ob + m) * 1024 + n0 + n) = o; }
        };
        const float* Wg = F.in[I_WG] + ((size_t)l * NEXP + e) * D * D; const float* Wu = F.in[I_WU] + ((size_t)l * NEXP + e) * D * D;
        ngemm_tile<bf16, true>(F.HN, D, D, rowf, Wg, Wu, D, n0, 64, (LAS float*)F.lds, epi, F.tid);
    }
}
__device__ __forceinline__ void phase_down(const Frame& F0, int l)  {
    Frame F = F0; F.tid = opaque_v(F0.tid); F.lane = F.tid & 63; F.wave = __builtin_amdgcn_readfirstlane(F.tid >> 6);
    LAS int* tab = (LAS int*)(F.lds + 65536);
    moe_tables(F, l, tab, 128);
    const int NU = tab[32] * 16;
    for (int u = F.bid; u < NU; u += F.G) {
        const int mtile = u >> 4, nt = u & 15, n0 = nt * 64;
        int e = 0;
        for (int k = 1; k < NEXP; ++k) if (mtile >= tab[16 + k]) e = k;
        const int m0 = (mtile - tab[16 + e]) * 128, cnt = tab[40 + e], ob = tab[e] + m0;
        auto rowf = [=](int m) { return (m0 + m < cnt) ? ob + m : -1; };
        float* YDN = F.YDN;
        auto epi = [=](int m, int n, const float (&a)[4], const float (&)[4]) {
            if (m0 + m < cnt) *(f32x4*)(YDN + (size_t)(ob + m) * 1024 + n0 + n) = (f32x4){a[0], a[1], a[2], a[3]};
        };
        const float* Wd = F.in[I_WD] + ((size_t)l * NEXP + e) * D * D;
        ngemm_tile<bf16, false>(F.HMID, D, D, rowf, Wd, Wd, D, n0, 64, (LAS float*)F.lds, epi, F.tid);
    }
}

constexpr int PH_PER_LAYER = 10, N_PHASES = 2 + DEPTH * PH_PER_LAYER + 1;

__global__ void __launch_bounds__(NTHR, 2) fwd_kernel(Args args) {
    extern __shared__ __attribute__((aligned(16))) unsigned char lds_raw[];
    Frame F;
    F.lds = (LAS unsigned char*)lds_raw;
    F.tid = threadIdx.x; F.lane = F.tid & 63; F.wave = __builtin_amdgcn_readfirstlane(F.tid >> 6);
    F.G = gridDim.x; F.bid = blockIdx.x;
    F.in = args.in; F.out = args.out; F.ws = args.ws;
    unsigned char* ws = args.ws;
    F.ctl = (unsigned*)(ws + WS_CTL);
    F.MOD = (float*)(ws + WS_MOD); F.MODP = (float*)(ws + WS_MODP); F.DT = (float*)(ws + WS_DT); F.XS = (float*)(ws + WS_XS);
    F.YSSD = (float*)(ws + WS_YSSD); F.YS5 = (float*)(ws + WS_YS5); F.CU = (float*)(ws + WS_CU); F.CV = (float*)(ws + WS_CV); F.YDN = (float*)(ws + WS_YDN);
    F.HN = (bf16*)(ws + WS_HN); F.COLS = (bf16*)(ws + WS_COLS); F.XBCC = (bf16*)(ws + WS_XBCC); F.MIX = (bf16*)(ws + WS_MIX); F.HMID = (bf16*)(ws + WS_HMID);
    F.LIST = (int*)(ws + WS_LIST); F.TOKI = (int*)(ws + WS_TOKI); F.TOKW = (float*)(ws + WS_TOKW);
    volatile LAS unsigned* MISC = (volatile LAS unsigned*)(F.lds + MISC_OFF);
    if (F.tid < 32) MISC[F.tid] = 0u;
    __syncthreads();
    const int lo = args.ph_lo, hi = args.ph_hi;
    const bool multi = (hi - lo) > 1;
    XcdBarrier bar; bar.bar = F.ctl + CW_BAR; bar.x = 0; bar.st = MISC + 8;
    if (multi) bar = xcd_barrier_post(F.ctl + CW_BAR, MISC + 8);
#define IN(k) (lo <= (k) && (k) < hi)
#define SEAM(k) do { if (IN(k) && IN((k) + 1)) xcd_barrier(bar); } while (0)
    if (IN(0)) phase_p0(F);
    SEAM(0);
    if (IN(1)) phase_p1(F);
    SEAM(1);
    for (int l = 0; l < DEPTH; ++l) {
        const int pb = 2 + l * PH_PER_LAYER;
        if (IN(pb + 0)) phase_rowA(F, l);
        SEAM(pb + 0);
        if (IN(pb + 1)) phase_inproj(F, l);
        SEAM(pb + 1);
        if (IN(pb + 2)) phase_elem(F, l);
        SEAM(pb + 2);
        if (IN(pb + 3)) phase_scan(F, l);
        SEAM(pb + 3);
        if (IN(pb + 4)) phase_mix1(F, l);
        SEAM(pb + 4);
        if (IN(pb + 5)) phase_s5glu(F, l);
        SEAM(pb + 5);
        if (IN(pb + 6)) phase_wout(F, l);
        SEAM(pb + 6);
        if (IN(pb + 7)) phase_norm2(F, l);
        SEAM(pb + 7);
        if (IN(pb + 8)) phase_gateup(F, l);
        SEAM(pb + 8);
        if (IN(pb + 9)) phase_down(F, l);
        SEAM(pb + 9);
    }
    if (IN(N_PHASES - 1)) phase_rowA(F, DEPTH);
#undef IN
#undef SEAM
}

extern "C" void kernel_launch(void* const* d_in, const int* in_sizes, int n_in, void* d_out, int out_size, void* d_ws, size_t ws_size, hipStream_t stream) {
    static int grid = 0;
    if (grid == 0) {
        if (n_in != N_IN || out_size != TL * D || ws_size < WS_END) { fprintf(stderr, "kernel_launch: unexpected shapes (n_in %d out %d ws %zu)\n", n_in, out_size, ws_size); grid = -1; return; }
        int dev = 0, cus = 0, per_cu = 0;
        if (hipGetDevice(&dev) != hipSuccess || hipDeviceGetAttribute(&cus, hipDeviceAttributeMultiprocessorCount, dev) != hipSuccess) { grid = -1; return; }
        if (hipFuncSetAttribute((const void*)fwd_kernel, hipFuncAttributeMaxDynamicSharedMemorySize, LDS_BYTES) != hipSuccess) { fprintf(stderr, "kernel_launch: hipFuncSetAttribute failed\n"); grid = -1; return; }
        if (hipOccupancyMaxActiveBlocksPerMultiprocessor(&per_cu, (const void*)fwd_kernel, NTHR, LDS_BYTES) != hipSuccess || per_cu < 1) { fprintf(stderr, "kernel_launch: occupancy query says %d\n", per_cu); }
        (void)hipGetLastError();
        grid = cus;
    }
    if (grid < 0) return;
    if (hipMemsetAsync((char*)d_ws + WS_CTL, 0, CTL_ZERO_BYTES, stream) != hipSuccess) return;
    Args a{};
    for (int i = 0; i < N_IN; ++i) a.in[i] = (const float*)d_in[i];
    a.out = (float*)d_out; a.ws = (unsigned char*)d_ws;
#if MK_ONE_LAUNCH
    a.ph_lo = 0; a.ph_hi = N_PHASES;
    hipLaunchKernelGGL(fwd_kernel, dim3(grid), dim3(NTHR), LDS_BYTES, stream, a);
#else
    for (int p = 0; p < N_PHASES; ++p) { a.ph_lo = p; a.ph_hi = p + 1; hipLaunchKernelGGL(fwd_kernel, dim3(grid), dim3(NTHR), LDS_BYTES, stream, a); }
#endif
}
```

```cpp
#include <hip/hip_runtime.h>
#include <cstdio>
#include <cstdint>

#ifndef MK_ONE_LAUNCH
#define MK_ONE_LAUNCH 1
#endif

#define GAS __attribute__((address_space(1)))
#define LAS __attribute__((address_space(3)))
#define CAS __attribute__((address_space(4)))
typedef const float* cfp_t;
typedef unsigned short bf16;
typedef float f32x4 __attribute__((ext_vector_type(4)));
typedef float f32x2 __attribute__((ext_vector_type(2)));
typedef unsigned u32x4 __attribute__((ext_vector_type(4)));
typedef unsigned u32x2 __attribute__((ext_vector_type(2)));

constexpr int D = 1024, NB = 8, SEQ = 2048, CTXL = 256, DEPTH = 2;
constexpr int TL = NB * SEQ, TC = NB * CTXL, TT = TL + TC;
constexpr int INC = 2320;
constexpr int NCOL = 2304;
constexpr int VSEQ = CTXL + SEQ;
constexpr int NEXP = 16;
constexpr float EPS = 1e-6f;

enum { I_X = 0, I_C, I_CTX, I_CCTX, I_WADA, I_BADA, I_GMIX, I_WIN, I_SCW, I_SCB, I_SDTB, I_SALOG, I_SD, I_SNG,
       I_CDW, I_CDB, I_CLG, I_CLB, I_CPW, I_CPB, I_LRE, I_LIM, I_LSTEP, I_BRE, I_BIM, I_CRE, I_CIM, I_S5D, I_GLUW, I_GLUB,
       I_WOUT, I_GFFN, I_RW, I_RB, I_WG, I_WU, I_WD, I_GFIN, N_IN };

constexpr size_t MiB = 1u << 20;
constexpr size_t WS_CTL = 0, CTL_ZERO_BYTES = 64 * 1024;
constexpr size_t WS_MOD = 1 * MiB;
constexpr size_t WS_MODP = 2 * MiB;
constexpr size_t WS_DT = 6 * MiB;
constexpr size_t WS_TOKI = 7 * MiB + 512 * 1024;
constexpr size_t WS_TOKW = WS_TOKI + (size_t)TT * 16;
constexpr size_t WS_XS = 8 * MiB;
constexpr size_t WS_HN = 80 * MiB;
constexpr size_t WS_COLS = 116 * MiB;
constexpr size_t WS_XBCC = 197 * MiB;
constexpr size_t WS_YSSD = 233 * MiB;
constexpr size_t WS_MIX = 305 * MiB;
constexpr size_t WS_YS5 = 341 * MiB;
constexpr size_t WS_CU = 377 * MiB;
constexpr size_t WS_CV = 395 * MiB;
constexpr size_t WS_LIST = 413 * MiB;
constexpr size_t WS_WIN_T = 415 * MiB;
constexpr size_t WS_WOUT_T = 424 * MiB;
constexpr size_t WS_PW_T = 428 * MiB;
constexpr size_t WS_GLU_T = 428 * MiB + 512 * 1024;
constexpr size_t WS_WGU_T = 429 * MiB;
constexpr size_t WS_WD_T = 493 * MiB;
constexpr size_t WS_END = 525 * MiB;
constexpr int MOE_ROWS = 2 * TT + NEXP * 256;
constexpr size_t WS_HMID = WS_COLS;
constexpr size_t WS_YDN = WS_XBCC;
constexpr size_t WS_YG = WS_CU;
static_assert(WS_HMID + (size_t)MOE_ROWS * 1024 * 2 <= WS_XBCC, "HMID overlay");
static_assert(WS_YDN + (size_t)MOE_ROWS * 1024 * 2 <= WS_MIX, "YDN overlay");
constexpr int CW_CNT = 64;
constexpr int CW_BAR = 1024;

constexpr int NWAVES = 8, NTHR = 512;
constexpr int LDS_BYTES = 147456;
constexpr int MISC_OFF = 131072 + 320;
constexpr int TAB_OFF = 131072 + 512, ROWS_OFF = TAB_OFF + 256;

__device__ __forceinline__ float bf2f(bf16 v) { return __uint_as_float((unsigned)v << 16); }
__device__ __forceinline__ unsigned f2bf(float f) { unsigned u = __float_as_uint(f); return (u + 0x7fffu + ((u >> 16) & 1u)) >> 16; }
__device__ __forceinline__ unsigned pk2(float lo, float hi) { return f2bf(lo) | (f2bf(hi) << 16); }
__device__ __forceinline__ float wave_sum(float v) {
#pragma unroll
    for (int o = 1; o < 64; o <<= 1) v += __shfl_xor(v, o);
    return v;
}
__device__ __forceinline__ float sigmoidf_(float x) { return 1.f / (1.f + __expf(-x)); }
__device__ __forceinline__ float siluf_(float x) { return x / (1.f + __expf(-x)); }
__device__ __forceinline__ float softplusf_(float x) { return fmaxf(x, 0.f) + log1pf(__expf(-fabsf(x))); }
__device__ __forceinline__ float gelu_tanh(float x) { const float u = 0.7978845608028654f * (x + 0.044715f * x * x * x); return 0.5f * x * (1.f + tanhf(u)); }
__device__ __forceinline__ void sincos_red(float x, float& s, float& c) {
    const float k = rintf(x * 0.15915494309189535f);
    float r = fmaf(-k, 6.2831854820251465f, x); r = fmaf(-k, -1.7484555e-7f, r);
    s = __sinf(r); c = __cosf(r);
}
__device__ __forceinline__ int opaque_v(int v) { asm volatile("" : "+v"(v)); return v; }
__device__ __forceinline__ int modrow(int r) { return r < TL ? (r >> 11) : 8; }
__device__ __forceinline__ void seq_bounds(int r, int& lo, int& hi) {
    if (r < TL) { lo = r & ~(SEQ - 1); hi = lo + SEQ; } else { lo = TL + ((r - TL) & ~(CTXL - 1)); hi = lo + CTXL; }
}
__device__ __forceinline__ int vrow(int b, int dir, int s) {
    if (s < CTXL) return TL + b * CTXL + (dir ? CTXL - 1 - s : s);
    const int t = s - CTXL; return b * SEQ + (dir ? SEQ - 1 - t : t);
}

#define XB_TMO      128
#define XB_XCNT(j)  (256  + 64 * (j))
#define XB_XSUB(j)  (1280 + 64 * (j))
#define XB_XGEN(j)  (2304 + 64 * (j))
#define XB_TOP      3328
#define XB_TOPGEN   3392
#define XCD_BAR_WORDS 3456
#define XB_SPIN_CAP (1u << 18)
__device__ __forceinline__ unsigned xb_ld(unsigned* p)              { return __hip_atomic_load(p, __ATOMIC_RELAXED, __HIP_MEMORY_SCOPE_AGENT); }
__device__ __forceinline__ unsigned xb_add(unsigned* p, unsigned v) { return __hip_atomic_fetch_add(p, v, __ATOMIC_RELAXED, __HIP_MEMORY_SCOPE_AGENT); }
__device__ __forceinline__ unsigned xb_xcc_id() { return (unsigned)__builtin_amdgcn_s_getreg((3 << 11) | 20) & 0xFu; }
#define XB_SPIN(cond, bar) do { unsigned _sp = 0; while (cond) { __builtin_amdgcn_s_sleep(1); \
    if ((++_sp & 255u) == 0u) { if (xb_ld(&(bar)[XB_TMO])) break; if (_sp > XB_SPIN_CAP) { atomicAdd(&(bar)[XB_TMO], 1u); break; } } } } while (0)
struct XcdBarrier { unsigned* bar; unsigned x; volatile LAS unsigned* st; };
__device__ __forceinline__ XcdBarrier xcd_barrier_post(unsigned* bar, volatile LAS unsigned* st) {
    XcdBarrier b; b.bar = bar; b.x = xb_xcc_id(); b.st = st;
    if (threadIdx.x == 0) (void)xb_add(&bar[XB_XCNT(b.x)], 1u);
    return b;
}
__device__ __forceinline__ void xcd_barrier_complete(unsigned* bar, unsigned x, unsigned& nloc, unsigned& nx) {
    const unsigned G = gridDim.x * gridDim.y * gridDim.z;
    unsigned sum, cnt, mine, sp = 0u;
    for (;;) {
        sum = 0u; cnt = 0u; mine = 0u;
#pragma unroll
        for (unsigned j = 0; j < 16; ++j) { const unsigned c = xb_ld(&bar[XB_XCNT(j)]); sum += c; cnt += (c > 0u) ? 1u : 0u; mine = (j == x) ? c : mine; }
        if (sum == G) break;
        __builtin_amdgcn_s_sleep(1);
        if ((++sp & 255u) == 0u) { if (xb_ld(&bar[XB_TMO])) break; if (sp > XB_SPIN_CAP) { atomicAdd(&bar[XB_TMO], 1u); break; } }
    }
    nloc = mine > 0u ? mine : 1u; nx = cnt > 0u ? cnt : 1u;
}
__device__ __forceinline__ void xcd_barrier(const XcdBarrier& b) {
    asm volatile("s_waitcnt vmcnt(0)" ::: "memory");
    __syncthreads();
    if (threadIdx.x == 0) {
        unsigned* bar = b.bar;
        const unsigned bx = xb_xcc_id();
        __builtin_amdgcn_s_waitcnt(0);
        unsigned nloc = b.st[0], nx = b.st[1];
        if (nloc == 0u) { xcd_barrier_complete(bar, bx, nloc, nx); b.st[0] = nloc; b.st[1] = nx; }
        const unsigned old = xb_add(&bar[XB_XSUB(bx)], 1u);
        const unsigned gen = old / nloc;
        if (old + 1u == (gen + 1u) * nloc) {
            __builtin_amdgcn_fence(__ATOMIC_RELEASE, "agent");
            asm volatile("s_waitcnt vmcnt(0)" ::: "memory");
            const unsigned og = xb_add(&bar[XB_TOP], 1u);
            const unsigned tg = og / nx;
            if (og + 1u == (tg + 1u) * nx) xb_add(&bar[XB_TOPGEN], 1u);
            else XB_SPIN(xb_ld(&bar[XB_TOPGEN]) == tg, bar);
            __builtin_amdgcn_fence(__ATOMIC_ACQUIRE, "agent");
            xb_add(&bar[XB_XGEN(bx)], 1u);
            asm volatile("s_waitcnt vmcnt(0)" ::: "memory");
        } else {
            XB_SPIN(xb_ld(&bar[XB_XGEN(bx)]) == gen, bar);
            __builtin_amdgcn_fence(__ATOMIC_ACQUIRE, "agent");
            asm volatile("s_waitcnt vmcnt(0)" ::: "memory");
        }
    }
    __syncthreads();
}

struct Args { const float* in[N_IN]; float* out; unsigned char* ws; int ph_lo, ph_hi; };
struct Frame {
    LAS unsigned char* lds;
    int tid, lane, wave, G, bid;
    const CAS cfp_t* in;
    float* out; unsigned char* ws;
    unsigned* ctl;
    float *MOD, *MODP, *DT, *XS, *YSSD, *YS5, *CU;
    bf16 *HN, *COLS, *XBCC, *MIX, *HMID, *CV, *YG, *YDN, *WIN_T, *WOUT_T, *PW_T, *GLU_T, *WGU_T, *WD_T;
    int* LIST; int* TOKI; float* TOKW;
};
__device__ __forceinline__ void frame_ptrs(Frame& F, unsigned char* ws) {
    F.ws = ws; F.ctl = (unsigned*)(ws + WS_CTL);
    F.MOD = (float*)(ws + WS_MOD); F.MODP = (float*)(ws + WS_MODP); F.DT = (float*)(ws + WS_DT); F.XS = (float*)(ws + WS_XS);
    F.YSSD = (float*)(ws + WS_YSSD); F.YS5 = (float*)(ws + WS_YS5); F.CU = (float*)(ws + WS_CU); F.CV = (bf16*)(ws + WS_CV); F.YDN = (bf16*)(ws + WS_YDN); F.YG = (bf16*)(ws + WS_YG);
    F.WIN_T = (bf16*)(ws + WS_WIN_T); F.WOUT_T = (bf16*)(ws + WS_WOUT_T); F.PW_T = (bf16*)(ws + WS_PW_T); F.GLU_T = (bf16*)(ws + WS_GLU_T); F.WGU_T = (bf16*)(ws + WS_WGU_T); F.WD_T = (bf16*)(ws + WS_WD_T);
    F.HN = (bf16*)(ws + WS_HN); F.COLS = (bf16*)(ws + WS_COLS); F.XBCC = (bf16*)(ws + WS_XBCC); F.MIX = (bf16*)(ws + WS_MIX); F.HMID = (bf16*)(ws + WS_HMID);
    F.LIST = (int*)(ws + WS_LIST); F.TOKI = (int*)(ws + WS_TOKI); F.TOKW = (float*)(ws + WS_TOKW);
}
__device__ __forceinline__ Frame enter_phase(const Frame& F0) {
    Frame F = F0; unsigned om = ~0u; asm volatile("" : "+s"(om)); int ln = (int)__builtin_amdgcn_mbcnt_hi(om, __builtin_amdgcn_mbcnt_lo(om, 0u)); asm volatile("" : "+v"(ln));
    F.lane = ln; F.tid = F0.wave * 64 + ln;
    unsigned char* ws = F0.ws; asm volatile("" : "+s"(ws)); frame_ptrs(F, ws);
    const CAS cfp_t* ka = (const CAS cfp_t*)__builtin_amdgcn_kernarg_segment_ptr(); asm volatile("" : "+s"(ka)); F.in = ka;
    return F;
}

__device__ __forceinline__ void ld4(const float* p, float (&v)[4]) { const f32x4 t = *(const f32x4*)p; v[0] = t.x; v[1] = t.y; v[2] = t.z; v[3] = t.w; }
__device__ __forceinline__ void ld4(const bf16* p, float (&v)[4]) { const u32x2 t = *(const u32x2*)p; v[0] = __uint_as_float(t.x << 16); v[1] = __uint_as_float(t.x & 0xffff0000u); v[2] = __uint_as_float(t.y << 16); v[3] = __uint_as_float(t.y & 0xffff0000u); }

__device__ __forceinline__ void ld8(const bf16* p, float (&v)[8]) { const u32x4 t = *(const u32x4*)p;
    v[0] = __uint_as_float(t.x << 16); v[1] = __uint_as_float(t.x & 0xffff0000u); v[2] = __uint_as_float(t.y << 16); v[3] = __uint_as_float(t.y & 0xffff0000u);
    v[4] = __uint_as_float(t.z << 16); v[5] = __uint_as_float(t.z & 0xffff0000u); v[6] = __uint_as_float(t.w << 16); v[7] = __uint_as_float(t.w & 0xffff0000u); }

namespace pg8 {
typedef short bf16x8 __attribute__((ext_vector_type(8)));
constexpr int BM = 256, BK = 64, HALF = 128, HTB = HALF * BK * 2, STAGE_BYTES = 8 * HTB, NXCD = 8, WGM = 8;
__device__ __forceinline__ int lds_byte(int r, int c) { const int st = (r >> 4) * 2 + (c >> 5), rr = r & 15, cc = c & 31, ob = rr * 64 + cc * 2; return st * 1024 + (ob ^ (((ob >> 9) & 1) << 5)); }
__device__ __forceinline__ void stage_rc(int b, int& R, int& C) { const int st = b / 1024, sb = b % 1024, swz = sb ^ (((sb >> 9) & 1) << 5); R = (st >> 1) * 16 + swz / 64; C = (st & 1) * 32 + (swz % 64) / 2; }
__device__ __forceinline__ int perm32(int rho) { const int n = rho >> 4, i = rho & 15; return 8 * (i >> 2) + 4 * n + (i & 3); }
struct Unit { int pm, pn, idx; };
struct TileOrder {
    int nM, nN, nwg, G, c;
    __device__ __forceinline__ void init(int nM_, int nN_, int G_, int c_) { nM = nM_; nN = nN_; nwg = nM * nN; G = G_; c = c_; }
    __device__ __forceinline__ bool next(int i, Unit& u) const {
        const long L = (long)i * G + c; if (L >= nwg) return false;
        int wgid = (int)L; { const int q = nwg / NXCD, r = nwg % NXCD, xcd = wgid % NXCD, off = wgid / NXCD; wgid = (xcd < r ? xcd * (q + 1) : r * (q + 1) + (xcd - r) * q) + off; }
        const int nig = WGM * nN, gid = wgid / nig, fm = gid * WGM, gsz = (nM - fm) < WGM ? (nM - fm) : WGM;
        u.pm = fm + ((wgid % nig) % gsz); u.pn = (wgid % nig) / gsz; u.idx = i; return true;
    }
};
__device__ __forceinline__ unsigned cvt_pk_bf16(float lo, float hi) { unsigned r; asm volatile("v_cvt_pk_bf16_f32 %0, %1, %2" : "=v"(r) : "v"(lo), "v"(hi)); return r; }

template <class Epi, class Sched, bool ALIGN_EPI>
__device__ __forceinline__ void gemm_phase(LAS unsigned char* lds, const bf16* Abase, int K, const Sched& S, const Epi& E, int tid) {
    const int wid = __builtin_amdgcn_readfirstlane(tid >> 6), lane = tid & 63, wr = wid >> 2, wc = wid & 3, fr = lane & 15, fq = lane >> 4;
    const int nt = K / BK;
    int Rr[2], Cc[2]; unsigned voffB[2];
#pragma unroll
    for (int i = 0; i < 2; ++i) { int R, C; stage_rc(tid * 16 + i * 8192, R, C); Rr[i] = R; Cc[i] = C; const int Rb = Epi::PERM ? ((R & ~31) + perm32(R & 31)) : R; voffB[i] = (unsigned)(Rb * K + C) * 2u; }
    const size_t kstep = (size_t)(BK * 2);
    const size_t hstep = (size_t)HALF * K * 2;
    const unsigned ldsw = (unsigned)wid * 1024u;
    const int aoff = lds_byte(wr * 64 + fr, fq * 8), boff = lds_byte(wc * 32 + fr, fq * 8);
#define PG8_SA(b, h) (((b) * 2 + (h)) * HTB)
#define PG8_SB(b, h) ((4 + (b) * 2 + (h)) * HTB)
#define PG8_STAGE(bufoff, gbase, voff) do { _Pragma("unroll") for (int _i = 0; _i < 2; ++_i) \
        __builtin_amdgcn_global_load_lds((const unsigned*)((const char*)(gbase) + (voff)[_i]), (LAS unsigned*)(lds + (bufoff) + ldsw + _i * 8192), 16, 0, 0); } while (0)
#define PG8_LDA(dst, b, h) do { _Pragma("unroll") for (int m = 0; m < 4; ++m) _Pragma("unroll") for (int k = 0; k < 2; ++k) dst[m][k] = *(const LAS bf16x8*)(lds + PG8_SA(b, h) + aoff + m * 2048 + k * 1024); } while (0)
#define PG8_LDB(dst, b, h) do { _Pragma("unroll") for (int n = 0; n < 2; ++n) _Pragma("unroll") for (int k = 0; k < 2; ++k) dst[n][k] = *(const LAS bf16x8*)(lds + PG8_SB(b, h) + boff + n * 2048 + k * 1024); } while (0)
#define PG8_MMA(ai, bj, At, Bt) do { __builtin_amdgcn_s_setprio(1); _Pragma("unroll") for (int m = 0; m < 4; ++m) _Pragma("unroll") for (int n = 0; n < 2; ++n) _Pragma("unroll") for (int k = 0; k < 2; ++k) \
        acc[ai][bj][m][n] = __builtin_amdgcn_mfma_f32_16x16x32_bf16(Bt[n][k], At[m][k], acc[ai][bj][m][n], 0, 0, 0); __builtin_amdgcn_s_setprio(0); } while (0)
#define PG8_WAIT_V(n) asm volatile("s_waitcnt vmcnt(" #n ")" ::: "memory")
#define PG8_WAIT_L(n) asm volatile("s_waitcnt lgkmcnt(" #n ")" ::: "memory")
#define PG8_BAR __builtin_amdgcn_s_barrier()
#define PG8_SCHED __builtin_amdgcn_sched_barrier(0)
#define PG8_SETV(v, u) do { _Pragma("unroll") for (int _h = 0; _h < 2; ++_h) _Pragma("unroll") for (int _i = 0; _i < 2; ++_i) v[_h][_i] = (unsigned)(S.arow(u, _h * HALF + Rr[_i]) * K + Cc[_i]) * 2u; } while (0)
    Unit cur, nxt; int ui = 0;
    if (!S.next(0, cur)) return;
    f32x4 acc[2][2][4][2];
#pragma unroll
    for (int a = 0; a < 2; ++a)
#pragma unroll
        for (int b = 0; b < 2; ++b)
#pragma unroll
            for (int m = 0; m < 4; ++m)
#pragma unroll
                for (int n = 0; n < 2; ++n) acc[a][b][m][n] = (f32x4){0.f, 0.f, 0.f, 0.f};
    bf16x8 At[4][2], B0[2][2], B1[2][2];
    unsigned vC[2][2], vN[2][2];
    PG8_SETV(vC, cur);
    const char* cA = (const char*)Abase; const char* cB = S.bbase(cur);
    PG8_WAIT_L(0);
    PG8_STAGE(PG8_SB(0, 0), cB, voffB); PG8_STAGE(PG8_SB(0, 1), cB + hstep, voffB); PG8_STAGE(PG8_SA(0, 0), cA, vC[0]); PG8_STAGE(PG8_SA(0, 1), cA, vC[1]);
    if (wr == 1) PG8_BAR;
    PG8_WAIT_V(2); PG8_BAR;
    PG8_STAGE(PG8_SB(1, 0), cB + kstep, voffB); PG8_STAGE(PG8_SA(1, 0), cA + kstep, vC[0]); PG8_STAGE(PG8_SB(1, 1), cB + hstep + kstep, voffB);
    PG8_WAIT_V(6); PG8_BAR;
    for (;;) {
        const bool has_next = S.next(ui + 1, nxt);
        const char* nB = cB;
        if (has_next) { PG8_SETV(vN, nxt); nB = S.bbase(nxt); }
        else {
#pragma unroll
            for (int _h = 0; _h < 2; ++_h)
#pragma unroll
                for (int _i = 0; _i < 2; ++_i) vN[_h][_i] = vC[_h][_i];
        }
        PG8_WAIT_L(0);
        for (int t = 0; t < nt; t += 2) {
            const bool last = (t == nt - 2);
            const char* a1 = cA + (size_t)(t + 1) * kstep;
            const char* a2 = last ? cA : cA + (size_t)(t + 2) * kstep; const char* b2 = last ? nB : cB + (size_t)(t + 2) * kstep;
            const char* a3 = a2 + kstep; const char* b3 = b2 + kstep;
            unsigned w0[2], w1[2];
#pragma unroll
            for (int _i = 0; _i < 2; ++_i) { w0[_i] = last ? vN[0][_i] : vC[0][_i]; w1[_i] = last ? vN[1][_i] : vC[1][_i]; }
            PG8_LDB(B0, 0, 0); PG8_LDB(B1, 0, 1); PG8_SCHED; PG8_LDA(At, 0, 0); PG8_STAGE(PG8_SA(1, 1), a1, vC[1]);
            PG8_WAIT_V(8); PG8_WAIT_L(0); PG8_BAR; PG8_MMA(0, 0, At, B0); PG8_MMA(0, 1, At, B1); PG8_BAR; PG8_SCHED;
            PG8_LDA(At, 0, 1); PG8_STAGE(PG8_SB(0, 0), b2, voffB); PG8_STAGE(PG8_SB(0, 1), b2 + hstep, voffB); PG8_STAGE(PG8_SA(0, 0), a2, w0);
            PG8_WAIT_V(8); PG8_WAIT_L(0); PG8_BAR; PG8_MMA(1, 0, At, B0); PG8_MMA(1, 1, At, B1); PG8_BAR; PG8_SCHED;
            PG8_LDB(B0, 1, 0); PG8_LDB(B1, 1, 1); PG8_SCHED; PG8_LDA(At, 1, 0); PG8_STAGE(PG8_SA(0, 1), a2, w1);
            PG8_WAIT_V(8); PG8_WAIT_L(0); PG8_BAR; PG8_MMA(0, 0, At, B0); PG8_MMA(0, 1, At, B1); PG8_BAR; PG8_SCHED;
            PG8_LDA(At, 1, 1); PG8_STAGE(PG8_SB(1, 0), b3, voffB); PG8_STAGE(PG8_SB(1, 1), b3 + hstep, voffB); PG8_STAGE(PG8_SA(1, 0), a3, w0);
            PG8_WAIT_V(8); PG8_WAIT_L(0); PG8_BAR; PG8_MMA(1, 0, At, B0); PG8_MMA(1, 1, At, B1); PG8_BAR; PG8_SCHED;
        }
        if constexpr (ALIGN_EPI) { if (wr == 0) PG8_BAR; }
        E(acc, cur, wr, wc, fr, fq);
        if (!has_next) break;
#pragma unroll
        for (int a = 0; a < 2; ++a)
#pragma unroll
            for (int b = 0; b < 2; ++b)
#pragma unroll
                for (int m = 0; m < 4; ++m)
#pragma unroll
                    for (int n = 0; n < 2; ++n) acc[a][b][m][n] = (f32x4){0.f, 0.f, 0.f, 0.f};
        cur = nxt; cB = nB; ++ui;
#pragma unroll
        for (int _h = 0; _h < 2; ++_h)
#pragma unroll
            for (int _i = 0; _i < 2; ++_i) vC[_h][_i] = vN[_h][_i];
        if constexpr (ALIGN_EPI) { if (wr == 1) PG8_BAR; }
    }
    PG8_WAIT_V(0);
    if constexpr (!ALIGN_EPI) { if (wr == 0) PG8_BAR; }
    PG8_BAR;
#undef PG8_SA
#undef PG8_SB
#undef PG8_STAGE
#undef PG8_LDA
#undef PG8_LDB
#undef PG8_MMA
#undef PG8_WAIT_V
#undef PG8_WAIT_L
#undef PG8_BAR
#undef PG8_SCHED
#undef PG8_SETV
}

struct PlainSched {
    TileOrder T; const char* Bt; int K;
    __device__ __forceinline__ bool next(int i, Unit& u) const { return T.next(i, u); }
    __device__ __forceinline__ int arow(const Unit& u, int r) const { return u.pm * BM + r; }
    __device__ __forceinline__ const char* bbase(const Unit& u) const { return Bt + (size_t)u.pn * BM * K * 2; }
};
struct MoeSched {
    TileOrder T; const char* Bt; int K, NE; const LAS int* tab; const LAS int* rows;
    __device__ __forceinline__ bool next(int i, Unit& u) const { return T.next(i, u); }
    __device__ __forceinline__ int expert(int pm) const { const int s = pm * BM; int e = 0;
#pragma unroll
        for (int k = 1; k < NEXP; ++k) if (s >= tab[k]) e = k;
        return e; }
    __device__ __forceinline__ int arow(const Unit& u, int r) const { return rows ? rows[u.idx * BM + r] : u.pm * BM + r; }
    __device__ __forceinline__ const char* bbase(const Unit& u) const { return Bt + ((size_t)expert(u.pm) * NE + (size_t)u.pn * BM) * K * 2; }
};
struct EpiStoreBf16 {
    static constexpr bool PERM = true;
    bf16* O; int ldc, col0; const float* bias;
    __device__ __forceinline__ void operator()(const f32x4 (&acc)[2][2][4][2], const Unit& u, int wr, int wc, int fr, int fq) const {
        const int row0 = u.pm * BM + wr * 64 + fr, ct0 = u.pn * BM + wc * 32 + 8 * fq;
        f32x4 bv[2][2];
#pragma unroll
        for (int bj = 0; bj < 2; ++bj)
#pragma unroll
            for (int n = 0; n < 2; ++n) bv[bj][n] = bias ? *(const f32x4*)(bias + ct0 + bj * HALF + 4 * n) : (f32x4){0.f, 0.f, 0.f, 0.f};
#pragma unroll
        for (int ai = 0; ai < 2; ++ai)
#pragma unroll
            for (int m = 0; m < 4; ++m) { bf16* rowp = O + (size_t)(row0 + ai * HALF + m * 16) * ldc + col0 + ct0;
#pragma unroll
                for (int bj = 0; bj < 2; ++bj) { const f32x4 v0 = acc[ai][bj][m][0] + bv[bj][0], v1 = acc[ai][bj][m][1] + bv[bj][1];
                    u32x4 w; w.x = cvt_pk_bf16(v0[0], v0[1]); w.y = cvt_pk_bf16(v0[2], v0[3]); w.z = cvt_pk_bf16(v1[0], v1[1]); w.w = cvt_pk_bf16(v1[2], v1[3]);
                    *(u32x4*)(rowp + bj * HALF) = w; } }
    }
};
template <int ACT>
struct EpiPairBf16 {
    static constexpr bool PERM = true;
    bf16* O; int ldc, col0; const float* bias; int nb;
    __device__ __forceinline__ void operator()(const f32x4 (&acc)[2][2][4][2], const Unit& u, int wr, int wc, int fr, int fq) const {
        const int row0 = u.pm * BM + wr * 64 + fr, ct0 = u.pn * HALF + wc * 32 + 8 * fq;
        f32x4 ba[2], bb[2];
#pragma unroll
        for (int n = 0; n < 2; ++n) { ba[n] = (ACT == 1) ? *(const f32x4*)(bias + ct0 + 4 * n) : (f32x4){0.f, 0.f, 0.f, 0.f}; bb[n] = (ACT == 1) ? *(const f32x4*)(bias + nb + ct0 + 4 * n) : (f32x4){0.f, 0.f, 0.f, 0.f}; }
#pragma unroll
        for (int ai = 0; ai < 2; ++ai)
#pragma unroll
            for (int m = 0; m < 4; ++m) {
                float o[8];
#pragma unroll
                for (int n = 0; n < 2; ++n)
#pragma unroll
                    for (int j = 0; j < 4; ++j) { const float a = acc[ai][0][m][n][j] + ba[n][j], b = acc[ai][1][m][n][j] + bb[n][j];
                        o[n * 4 + j] = (ACT == 0) ? (a / (1.f + __expf(-a))) * b : a / (1.f + __expf(-b)); }
                u32x4 w; w.x = cvt_pk_bf16(o[0], o[1]); w.y = cvt_pk_bf16(o[2], o[3]); w.z = cvt_pk_bf16(o[4], o[5]); w.w = cvt_pk_bf16(o[6], o[7]);
                *(u32x4*)(O + (size_t)(row0 + ai * HALF + m * 16) * ldc + col0 + ct0) = w; }
    }
};
struct EpiResidual {
    static constexpr bool PERM = false;
    float* XS; const float* g1;
    __device__ __forceinline__ void operator()(const f32x4 (&acc)[2][2][4][2], const Unit& u, int wr, int wc, int fr, int fq) const {
        const int row0 = u.pm * BM + wr * 64 + fr, ct0 = u.pn * BM + wc * 32 + 4 * fq;
#pragma unroll
        for (int ai = 0; ai < 2; ++ai)
#pragma unroll
            for (int m = 0; m < 4; ++m) { const int row = row0 + ai * HALF + m * 16; float* xp = XS + (size_t)row * D + ct0; const float* gp = g1 + (size_t)modrow(row) * 6144 + ct0;
#pragma unroll
                for (int bj = 0; bj < 2; ++bj)
#pragma unroll
                    for (int n = 0; n < 2; ++n) { const int o = bj * HALF + n * 16; const f32x4 g = *(const f32x4*)(gp + o); f32x4 x = *(const f32x4*)(xp + o); x += g * acc[ai][bj][m][n]; *(f32x4*)(xp + o) = x; }
                if (m & 1) asm volatile("" ::: "memory"); }
    }
};
}

template <class RowMap>
__device__ __forceinline__ void transpose_item(const float* W, int K, int N, bf16* WT, const RowMap& rowmap, LAS float* scr, int item, int lane) {
    const int nblk = (N + 31) / 32, kb = item / nblk, nb = item % nblk, k0 = 64 * kb, n0 = 32 * nb;
    const bool cok = n0 + (lane & 31) < N;
#pragma unroll 8
    for (int i = 0; i < 32; ++i) { const int kk = 2 * i + (lane >> 5); scr[kk * 33 + (lane & 31)] = cok ? W[(size_t)(k0 + kk) * N + n0 + (lane & 31)] : 0.f; }
    asm volatile("s_waitcnt lgkmcnt(0)" ::: "memory");
    const int c = lane & 7;
#pragma unroll
    for (int j = 0; j < 4; ++j) { const int n = (lane >> 3) + 8 * j; const LAS float* sp = scr + (8 * c) * 33 + n;
        u32x4 o; o.x = pk2(sp[0 * 33], sp[1 * 33]); o.y = pk2(sp[2 * 33], sp[3 * 33]); o.z = pk2(sp[4 * 33], sp[5 * 33]); o.w = pk2(sp[6 * 33], sp[7 * 33]);
        const int dr = rowmap(n0 + n);
        if (dr >= 0) *(u32x4*)(WT + (size_t)dr * K + k0 + 8 * c) = o; }
    asm volatile("s_waitcnt lgkmcnt(0)" ::: "memory");
}

__device__ __forceinline__ void phase_p0(const Frame& F0)  {
    Frame F = enter_phase(F0);
    {
        const size_t gt = (size_t)F.bid * NTHR + F.tid, NG = (size_t)F.G * NTHR;
        for (size_t i = gt; i < (size_t)TT * 256; i += NG) {
            const int r = (int)(i >> 8), c4 = (int)(i & 255) * 4;
            f32x4 v;
            if (r < TL) {
                v = *(const f32x4*)(F.in[I_X] + (size_t)r * D + c4);
                const int n = r & (SEQ - 1), rr = n >> 6, cc = n & 63, q = c4 >> 8, ii = c4 & 255;
                const float pos = (float)(q < 2 ? rr : cc);
                float pe[4];
#pragma unroll
                for (int k = 0; k < 4; ++k) {
                    const float invf = expf(-9.210340371976184f * (float)(ii + k) * (1.f / 256.f));
                    float s, c; sincos_red(pos * invf, s, c);
                    pe[k] = (q & 1) ? c : s;
                }
                v.x += pe[0]; v.y += pe[1]; v.z += pe[2]; v.w += pe[3];
            } else {
                v = *(const f32x4*)(F.in[I_CTX] + (size_t)(r - TL) * D + c4);
            }
            *(f32x4*)(F.XS + (size_t)r * D + c4) = v;
        }
    }
    {
        LAS float* scr = (LAS float*)F.lds + F.wave * (64 * 33);
        const int gw = F.bid * NWAVES + F.wave, NGW = F.G * NWAVES;
        constexpr int I_IN = 16 * 73, I_OUT = 16 * 32, I_PW = 4 * 8, I_GLU = 4 * 16, I_L = I_IN + I_OUT + I_PW + I_GLU;
        for (int it = gw; it < 2 * I_L; it += NGW) {
            const int l = it / I_L; int r = it % I_L;
            if (r < I_IN) { transpose_item(F.in[I_WIN] + (size_t)l * D * INC, D, INC, F.WIN_T + (size_t)l * NCOL * D, [](int n) { return n < 1536 ? n : (n < 1552 ? -1 : (n < INC ? n - 16 : -1)); }, scr, r, F.lane); continue; } r -= I_IN;
            if (r < I_OUT) { transpose_item(F.in[I_WOUT] + (size_t)l * D * D, D, D, F.WOUT_T + (size_t)l * D * D, [](int n) { return n; }, scr, r, F.lane); continue; } r -= I_OUT;
            if (r < I_PW) { transpose_item(F.in[I_CPW] + (size_t)l * 256 * 256, 256, 256, F.PW_T + (size_t)l * 256 * 256, [](int n) { return n; }, scr, r, F.lane); continue; } r -= I_PW;
            transpose_item(F.in[I_GLUW] + (size_t)l * 256 * 512, 256, 512, F.GLU_T + (size_t)l * 512 * 256, [](int n) { const int g = n & 255; return (g >> 7) * 256 + (n >> 8) * 128 + (g & 127); }, scr, r, F.lane);
        }
        __syncthreads();
    }
    LAS float* sc = (LAS float*)F.lds;
    for (int it = F.bid; it < 192; it += F.G) {
        const int l = it / 96, kc = (it / 12) % 8, jb = it % 12, j = jb * 512 + F.tid;
        __syncthreads();
        for (int t = F.tid; t < 9 * 128; t += NTHR) {
            const int r9 = t >> 7, kk = t & 127;
            const float cv = r9 < 8 ? F.in[I_C][r9 * D + kc * 128 + kk] : F.in[I_CCTX][kc * 128 + kk];
            sc[t] = siluf_(cv);
        }
        __syncthreads();
        float acc[9];
#pragma unroll
        for (int r9 = 0; r9 < 9; ++r9) acc[r9] = 0.f;
        const float* wp = F.in[I_WADA] + ((size_t)l * D + kc * 128) * 6144 + j;
        for (int kk = 0; kk < 128; ++kk) {
            const float w = wp[(size_t)kk * 6144];
#pragma unroll
            for (int r9 = 0; r9 < 9; ++r9) acc[r9] = fmaf(sc[r9 * 128 + kk], w, acc[r9]);
        }
#pragma unroll
        for (int r9 = 0; r9 < 9; ++r9) F.MODP[((size_t)(kc * 2 + l) * 9 + r9) * 6144 + j] = acc[r9];
    }
}
__device__ __forceinline__ void phase_p1(const Frame& F0)  {
    Frame F = enter_phase(F0);
    const int gt = F.bid * NTHR + F.tid, NG = F.G * NTHR;
    for (int i = gt; i < 2 * 9 * 6144; i += NG) {
        const int j = i % 6144, l = i / (9 * 6144);
        float s = F.in[I_BADA][l * 6144 + j];
#pragma unroll
        for (int kc = 0; kc < 8; ++kc) s += F.MODP[(size_t)kc * 2 * 9 * 6144 + i];
        F.MOD[i] = s;
    }
}
__device__ __forceinline__ LAS int* moe_tables(const Frame& F, int l) {
    LAS int* tab = (LAS int*)(F.lds + TAB_OFF);
    __syncthreads();
    if (F.tid == 0) {
        int bs = 0;
        for (int e = 0; e < NEXP; ++e) { const int c = (int)F.ctl[CW_CNT + l * 64 + e]; tab[e] = bs; tab[40 + e] = c; bs += ((c + 255) / 256) * 256; }
        tab[16] = bs;
    }
    __syncthreads();
    return tab;
}
__device__ __forceinline__ void phase_rowA(const Frame& F0, int l)  {
    Frame F = enter_phase(F0);
    LAS int* tab = (LAS int*)(F.lds + TAB_OFF);
    if (l > 0) tab = moe_tables(F, l - 1);
    LAS float* WDT = (LAS float*)F.lds;
    if (l < DEPTH) {
        __syncthreads();
        for (int i = F.tid; i < 4096; i += NTHR) { const int k = i >> 2, j4 = (i & 3) * 4; *(LAS f32x4*)&WDT[k * 16 + j4] = *(const f32x4*)(F.in[I_WIN] + ((size_t)l * D + k) * INC + 1536 + j4); }
        __syncthreads();
    }
    const int gw = F.bid * NWAVES + F.wave, NGW = F.G * NWAVES;
    const int RL = (l == DEPTH) ? TL : TT;
    const float* gvec = (l == DEPTH) ? F.in[I_GFIN] : F.in[I_GMIX] + l * D;
    for (int r = gw; r < RL; r += NGW) {
        const int mr = modrow(r);
        f32x4 v[4];
#pragma unroll
        for (int j = 0; j < 4; ++j) v[j] = *(const f32x4*)(F.XS + (size_t)r * D + 4 * F.lane + 256 * j);
        if (l > 0) {
            const int4 ti = *(const int4*)(F.TOKI + (size_t)r * 4);
            const f32x2 tw = *(const f32x2*)(F.TOKW + (size_t)r * 2);
            const size_t ra = (size_t)(tab[ti.x] + ti.y), rb = (size_t)(tab[ti.z] + ti.w);
            const float* g2 = F.MOD + ((size_t)(l - 1) * 9 + mr) * 6144 + 5120;
#pragma unroll
            for (int j = 0; j < 4; ++j) {
                const int c = 4 * F.lane + 256 * j;
                float ya[4], yb[4]; ld4(F.YDN + ra * D + c, ya); ld4(F.YDN + rb * D + c, yb);
                const f32x4 g = *(const f32x4*)(g2 + c);
#pragma unroll
                for (int e = 0; e < 4; ++e) v[j][e] += g[e] * (ya[e] * tw.x + yb[e] * tw.y);
            }
            if (l < DEPTH) {
#pragma unroll
                for (int j = 0; j < 4; ++j) *(f32x4*)(F.XS + (size_t)r * D + 4 * F.lane + 256 * j) = v[j];
            }
        }
        float ss = 0.f;
#pragma unroll
        for (int j = 0; j < 4; ++j) ss += (v[j].x * v[j].x + v[j].y * v[j].y) + (v[j].z * v[j].z + v[j].w * v[j].w);
        const float rstd = rsqrtf(wave_sum(ss) * (1.f / D) + EPS);
        if (l == DEPTH) {
#pragma unroll
            for (int j = 0; j < 4; ++j) { const int c = 4 * F.lane + 256 * j; const f32x4 g = *(const f32x4*)(gvec + c); *(f32x4*)(F.out + (size_t)r * D + c) = v[j] * rstd * g; }
        } else {
            const float* md = F.MOD + ((size_t)l * 9 + mr) * 6144;
            float dtp[16];
#pragma unroll
            for (int e = 0; e < 16; ++e) dtp[e] = 0.f;
#pragma unroll
            for (int j = 0; j < 4; ++j) {
                const int c = 4 * F.lane + 256 * j;
                const f32x4 g = *(const f32x4*)(gvec + c), sh = *(const f32x4*)(md + c), scl = *(const f32x4*)(md + 1024 + c);
                const f32x4 h = v[j] * rstd * g * (scl + 1.f) + sh;
                u32x2 o; o.x = pk2(h.x, h.y); o.y = pk2(h.z, h.w);
                *(u32x2*)(F.HN + (size_t)r * D + c) = o;
#pragma unroll
                for (int k = 0; k < 4; ++k) {
#pragma unroll
                    for (int e4 = 0; e4 < 4; ++e4) {
                        const f32x4 w = *(const LAS f32x4*)&WDT[(c + k) * 16 + e4 * 4];
#pragma unroll
                        for (int e = 0; e < 4; ++e) dtp[e4 * 4 + e] = fmaf(h[k], w[e], dtp[e4 * 4 + e]);
                    }
                    asm volatile("" ::: "memory");
                }
            }
#pragma unroll
            for (int e = 0; e < 16; ++e) dtp[e] = wave_sum(dtp[e]);
            if (F.lane == 0) {
#pragma unroll
                for (int e4 = 0; e4 < 4; ++e4) *(f32x4*)(F.DT + (size_t)r * 16 + e4 * 4) = (f32x4){dtp[e4 * 4], dtp[e4 * 4 + 1], dtp[e4 * 4 + 2], dtp[e4 * 4 + 3]};
            }
        }
    }
}
__device__ __forceinline__ void phase_inproj(const Frame& F0, int l)  {
    Frame F = enter_phase(F0);
    pg8::PlainSched S; S.T.init(TT / 256, NCOL / 256, F.G, F.bid); S.Bt = (const char*)(F.WIN_T + (size_t)l * NCOL * D); S.K = D;
    pg8::EpiStoreBf16 E{F.COLS, NCOL, 0, nullptr};
    pg8::gemm_phase<pg8::EpiStoreBf16, pg8::PlainSched, true>(F.lds, F.HN, D, S, E, F.tid);
}
__device__ __forceinline__ void phase_elem(const Frame& F0, int l)  {
    Frame F = enter_phase(F0);
    const size_t gt = (size_t)F.bid * NTHR + F.tid, NG = (size_t)F.G * NTHR;
    const float* cw = F.in[I_SCW] + (size_t)l * 5 * 1024; const float* cb = F.in[I_SCB] + l * 1024;
    for (size_t i = gt; i < (size_t)TT * 256; i += NG) {
        const int r = (int)(i >> 8), c = (int)(i & 255) * 4;
        int lo, hi; seq_bounds(r, lo, hi);
        float acc[4];
        { const f32x4 b = *(const f32x4*)(cb + c); acc[0] = b.x; acc[1] = b.y; acc[2] = b.z; acc[3] = b.w; }
#pragma unroll
        for (int j = 0; j < 5; ++j) {
            const int rr = r + j - 2;
            if (rr >= lo && rr < hi) {
                float x4[4]; ld4(F.COLS + (size_t)rr * NCOL + 512 + c, x4);
                const f32x4 w = *(const f32x4*)(cw + j * 1024 + c);
                acc[0] = fmaf(w.x, x4[0], acc[0]); acc[1] = fmaf(w.y, x4[1], acc[1]); acc[2] = fmaf(w.z, x4[2], acc[2]); acc[3] = fmaf(w.w, x4[3], acc[3]);
            }
        }
        u32x2 o; o.x = pk2(siluf_(acc[0]), siluf_(acc[1])); o.y = pk2(siluf_(acc[2]), siluf_(acc[3]));
        *(u32x2*)(F.XBCC + (size_t)r * 1024 + c) = o;
    }
    {
        LAS float* scr = (LAS float*)F.lds + F.wave * (64 * 33);
        const int gw = F.bid * NWAVES + F.wave, NGW = F.G * NWAVES;
        for (int it = gw; it < 48 * 512; it += NGW) {
            const int mtx = it >> 9, r = it & 511, e = mtx / 3, kind = mtx % 3;
            const size_t wofs = ((size_t)l * NEXP + e) * D * D;
            if (kind == 0) transpose_item(F.in[I_WG] + wofs, D, D, F.WGU_T + (size_t)e * 2048 * D, [](int n) { return (n >> 7) * 256 + (n & 127); }, scr, r, F.lane);
            else if (kind == 1) transpose_item(F.in[I_WU] + wofs, D, D, F.WGU_T + (size_t)e * 2048 * D, [](int n) { return (n >> 7) * 256 + 128 + (n & 127); }, scr, r, F.lane);
            else transpose_item(F.in[I_WD] + wofs, D, D, F.WD_T + (size_t)e * D * D, [](int n) { return n; }, scr, r, F.lane);
        }
    }
    for (size_t i = gt; i < (size_t)TT * 64; i += NG) {
        const int r = (int)(i >> 6), c = (int)(i & 63) * 4;
        float a[4], g[4]; ld4(F.COLS + (size_t)r * NCOL + 1536 + c, a); ld4(F.COLS + (size_t)r * NCOL + 1792 + c, g);
        *(f32x4*)(F.CU + (size_t)r * 256 + c) = (f32x4){a[0] * sigmoidf_(g[0]), a[1] * sigmoidf_(g[1]), a[2] * sigmoidf_(g[2]), a[3] * sigmoidf_(g[3])};
    }
}
__device__ __forceinline__ void phase_scan(const Frame& F0, int l)  {
    Frame F = enter_phase(F0);
    const int RLc = (l == 0) ? TT : TL;
    const int NU = 128 + 32 + RLc / 64;
    for (int u = F.bid; u < NU; u += F.G) {
        if (u < 128) {
            const int b = u >> 4, h = (u >> 1) & 7, dir = u & 1, g = h >> 2;
            const float a = -expf(F.in[I_SALOG][l * 16 + dir * 8 + h]), dtb = F.in[I_SDTB][l * 16 + dir * 8 + h];
            LAS float* Bc = (LAS float*)F.lds; LAS float* Cc = Bc + 64 * 128; LAS float* xv = Cc + 64 * 128; LAS float* dtv = xv + 64 * 64;
            const int p = F.tid >> 3, nq = F.tid & 7;
            float hst[16];
#pragma unroll
            for (int i = 0; i < 16; ++i) hst[i] = 0.f;
#pragma unroll 1
            for (int s0 = 0; s0 < VSEQ; s0 += 64) {
                __syncthreads();
#pragma unroll 2
                for (int i = 0; i < 16; ++i) {
                    const int idx = F.tid + 512 * i, s = idx >> 7, n = idx & 127; const size_t row = (size_t)vrow(b, dir, s0 + s);
                    Bc[idx] = bf2f(F.XBCC[row * 1024 + 512 + g * 128 + n]); Cc[idx] = bf2f(F.XBCC[row * 1024 + 768 + g * 128 + n]);
                }
#pragma unroll 2
                for (int i = 0; i < 8; ++i) {
                    const int idx = F.tid + 512 * i, s = idx >> 6, pp = idx & 63; const size_t row = (size_t)vrow(b, dir, s0 + s);
                    xv[idx] = bf2f(F.XBCC[row * 1024 + h * 64 + pp]);
                }
                if (F.tid < 64) { const size_t row = (size_t)vrow(b, dir, s0 + F.tid); dtv[F.tid] = softplusf_(F.DT[row * 16 + dir * 8 + h] + dtb); }
                __syncthreads();
#pragma unroll 1
                for (int s = 0; s < 64; ++s) {
                    const float dt = dtv[s], dec = __expf(dt * a), xd = xv[s * 64 + p] * dt;
                    float y = 0.f;
#pragma unroll
                    for (int i4 = 0; i4 < 4; ++i4) {
                        const f32x4 bv = *(const LAS f32x4*)&Bc[s * 128 + nq * 16 + i4 * 4], cv = *(const LAS f32x4*)&Cc[s * 128 + nq * 16 + i4 * 4];
#pragma unroll
                        for (int k = 0; k < 4; ++k) { hst[i4 * 4 + k] = fmaf(hst[i4 * 4 + k], dec, bv[k] * xd); y = fmaf(cv[k], hst[i4 * 4 + k], y); }
                    }
                    y += __shfl_xor(y, 1); y += __shfl_xor(y, 2); y += __shfl_xor(y, 4);
                    if (nq == 0) F.YSSD[((size_t)dir * TT + vrow(b, dir, s0 + s)) * 512 + h * 64 + p] = y;
                }
            }
            __syncthreads();
        } else if (u < 160) {
            const int cidx = (u - 128) * 8 + F.wave, b = cidx >> 5, g = (cidx >> 1) & 15, dir = cidx & 1, p = F.lane;
            LAS float* ubuf = (LAS float*)F.lds + F.wave * (64 * 16 + 128); LAS float* hbuf = ubuf + 64 * 16;
            const int pi = ((l * 2 + dir) * 16 + g) * 64 + p;
            const float step = expf(F.in[I_LSTEP][(l * 2 + dir) * 16 + g]);
            const float lr = F.in[I_LRE][pi], li = F.in[I_LIM][pi];
            const float mag = expf(lr * step); float sn, cs; sincos_red(li * step, sn, cs);
            const float ar = mag * cs, ai = mag * sn, inv_den = 1.f / (lr * lr + li * li);
            const float cr = ((ar - 1.f) * lr + ai * li) * inv_den, ci = (ai * lr - (ar - 1.f) * li) * inv_den;
            float bbr[16], bbi[16], cre[16], cim[16];
            const float* bre = F.in[I_BRE] + ((size_t)(l * 16 + g) * 64 + p) * 16; const float* bim = F.in[I_BIM] + ((size_t)(l * 16 + g) * 64 + p) * 16;
#pragma unroll
            for (int i = 0; i < 16; ++i) { const float br = bre[i], bi = bim[i]; bbr[i] = cr * br - ci * bi; bbi[i] = cr * bi + ci * br; }
            const int hh = F.lane & 15, q = F.lane >> 4;
            const float* crp = F.in[I_CRE] + ((size_t)(l * 16 + g) * 16 + hh) * 64 + q * 16; const float* cip = F.in[I_CIM] + ((size_t)(l * 16 + g) * 16 + hh) * 64 + q * 16;
#pragma unroll
            for (int i = 0; i < 16; ++i) { cre[i] = crp[i]; cim[i] = cip[i]; }
            float hr = 0.f, hi = 0.f;
#pragma unroll 1
            for (int s0 = 0; s0 < VSEQ; s0 += 64) {
                {
                    const size_t row = (size_t)vrow(b, dir, s0 + F.lane);
                    const bf16* up = F.COLS + row * NCOL + 2048 + g * 16;
                    float t4[4];
#pragma unroll
                    for (int k = 0; k < 4; ++k) { ld4(up + 4 * k, t4); *(LAS f32x4*)&ubuf[F.lane * 16 + 4 * k] = (f32x4){t4[0], t4[1], t4[2], t4[3]}; }
                }
                asm volatile("s_waitcnt lgkmcnt(0)" ::: "memory");
#pragma unroll 1
                for (int s = 0; s < 64; ++s) {
                    float bur = 0.f, bui = 0.f;
#pragma unroll
                    for (int k = 0; k < 4; ++k) {
                        const f32x4 uv = *(const LAS f32x4*)&ubuf[s * 16 + 4 * k];
#pragma unroll
                        for (int e = 0; e < 4; ++e) { bur = fmaf(uv[e], bbr[4 * k + e], bur); bui = fmaf(uv[e], bbi[4 * k + e], bui); }
                    }
                    const float nr = ar * hr - ai * hi + bur, ni = ar * hi + ai * hr + bui; hr = nr; hi = ni;
                    hbuf[p] = hr; hbuf[64 + p] = hi;
                    asm volatile("s_waitcnt lgkmcnt(0)" ::: "memory");
                    float acc = 0.f;
#pragma unroll
                    for (int k = 0; k < 4; ++k) {
                        const f32x4 a4 = *(const LAS f32x4*)&hbuf[q * 16 + 4 * k], b4 = *(const LAS f32x4*)&hbuf[64 + q * 16 + 4 * k];
#pragma unroll
                        for (int e = 0; e < 4; ++e) acc += a4[e] * cre[4 * k + e] - b4[e] * cim[4 * k + e];
                    }
                    asm volatile("s_waitcnt lgkmcnt(0)" ::: "memory");
                    acc += __shfl_xor(acc, 16); acc += __shfl_xor(acc, 32);
                    if (q == 0) F.YS5[((size_t)dir * TT + vrow(b, dir, s0 + s)) * 256 + g * 16 + hh] = acc;
                }
            }
        } else {
            const int rbase = (u - 160) * 64 + F.wave * 8, ch = 4 * F.lane;
            const float* dw = F.in[I_CDW] + (size_t)l * 31 * 256;
            const f32x4 db = *(const f32x4*)(F.in[I_CDB] + l * 256 + ch), lg = *(const f32x4*)(F.in[I_CLG] + l * 256 + ch), lb = *(const f32x4*)(F.in[I_CLB] + l * 256 + ch);
            for (int i = 0; i < 8; ++i) {
                const int r = rbase + i; int lo, hi; seq_bounds(r, lo, hi);
                f32x4 acc = db;
#pragma unroll 1
                for (int j = 0; j < 31; ++j) {
                    const int rr = r + j - 15;
                    if (rr >= lo && rr < hi) acc += *(const f32x4*)(dw + j * 256 + ch) * *(const f32x4*)(F.CU + (size_t)rr * 256 + ch);
                }
                const float mean = wave_sum((acc.x + acc.y) + (acc.z + acc.w)) * (1.f / 256.f);
                const f32x4 d = acc - mean;
                const float var = wave_sum((d.x * d.x + d.y * d.y) + (d.z * d.z + d.w * d.w)) * (1.f / 256.f);
                const f32x4 y = d * rsqrtf(var + EPS) * lg + lb;
                u32x2 o; o.x = pk2(siluf_(y.x), siluf_(y.y)); o.y = pk2(siluf_(y.z), siluf_(y.w));
                *(u32x2*)(F.CV + (size_t)r * 256 + ch) = o;
            }
        }
    }
}
__device__ __forceinline__ void phase_mix1(const Frame& F0, int l)  {
    Frame F = enter_phase(F0);
    const int gw = F.bid * NWAVES + F.wave, NGW = F.G * NWAVES;
    const int RL = (l == 0) ? TT : TL;
    for (int r = gw; r < RL; r += NGW) {
        const int ch = 8 * F.lane, h = F.lane >> 3;
        const float dsk = F.in[I_SD][l * 8 + h];
        float xs[8], z[8];
        ld8(F.XBCC + (size_t)r * 1024 + ch, xs); ld8(F.COLS + (size_t)r * NCOL + ch, z);
        float y[8]; float ss = 0.f;
#pragma unroll
        for (int k = 0; k < 8; k += 4) {
            const f32x4 y0 = *(const f32x4*)(F.YSSD + (size_t)r * 512 + ch + k), y1 = *(const f32x4*)(F.YSSD + ((size_t)TT + r) * 512 + ch + k);
#pragma unroll
            for (int e = 0; e < 4; ++e) { const float t = (dsk * xs[k + e] + y0[e] + y1[e]) * siluf_(z[k + e]); y[k + e] = t; ss = fmaf(t, t, ss); }
        }
        const float rstd = rsqrtf(wave_sum(ss) * (1.f / 512.f) + EPS);
        const float* ng = F.in[I_SNG] + l * 512 + ch;
        u32x4 o; o.x = pk2(y[0] * rstd * ng[0], y[1] * rstd * ng[1]); o.y = pk2(y[2] * rstd * ng[2], y[3] * rstd * ng[3]);
        o.z = pk2(y[4] * rstd * ng[4], y[5] * rstd * ng[5]); o.w = pk2(y[6] * rstd * ng[6], y[7] * rstd * ng[7]);
        *(u32x4*)(F.MIX + (size_t)r * 1024 + ch) = o;
    }
    {
        const size_t gt = (size_t)F.bid * NTHR + F.tid, NG = (size_t)F.G * NTHR;
        const float* dsk = F.in[I_S5D] + l * 256;
        for (size_t i = gt; i < (size_t)RL * 64; i += NG) {
            const int r = (int)(i >> 6), c = (int)(i & 63) * 4;
            float u4[4]; ld4(F.COLS + (size_t)r * NCOL + 2048 + c, u4);
            const f32x4 y0 = *(const f32x4*)(F.YS5 + (size_t)r * 256 + c), y1 = *(const f32x4*)(F.YS5 + ((size_t)TT + r) * 256 + c), dk = *(const f32x4*)(dsk + c);
            float o[4];
#pragma unroll
            for (int e = 0; e < 4; ++e) o[e] = gelu_tanh(y0[e] + y1[e] + dk[e] * u4[e]);
            u32x2 w; w.x = pk2(o[0], o[1]); w.y = pk2(o[2], o[3]);
            *(u32x2*)(F.YG + (size_t)r * 256 + c) = w;
        }
    }
    {
        __syncthreads();
        pg8::PlainSched S; S.T.init(RL / 256, 1, F.G, F.bid); S.Bt = (const char*)(F.PW_T + (size_t)l * 256 * 256); S.K = 256;
        pg8::EpiStoreBf16 E{F.MIX, 1024, 512, F.in[I_CPB] + l * 256};
        pg8::gemm_phase<pg8::EpiStoreBf16, pg8::PlainSched, true>(F.lds, F.CV, 256, S, E, F.tid);
    }
}
__device__ __forceinline__ void phase_s5glu(const Frame& F0, int l)  {
    Frame F = enter_phase(F0);
    const int RL = (l == 0) ? TT : TL;
    pg8::PlainSched S; S.T.init(RL / 256, 2, F.G, F.bid); S.Bt = (const char*)(F.GLU_T + (size_t)l * 512 * 256); S.K = 256;
    pg8::EpiPairBf16<1> E{F.MIX, 1024, 768, F.in[I_GLUB] + l * 512, 256};
    pg8::gemm_phase<pg8::EpiPairBf16<1>, pg8::PlainSched, true>(F.lds, F.YG, 256, S, E, F.tid);
}
__device__ __forceinline__ void phase_wout(const Frame& F0, int l)  {
    Frame F = enter_phase(F0);
    const int RL = (l == 0) ? TT : TL;
    pg8::PlainSched S; S.T.init(RL / 256, D / 256, F.G, F.bid); S.Bt = (const char*)(F.WOUT_T + (size_t)l * D * D); S.K = D;
    pg8::EpiResidual E{F.XS, F.MOD + (size_t)l * 9 * 6144 + 2048};
    pg8::gemm_phase<pg8::EpiResidual, pg8::PlainSched, true>(F.lds, F.MIX, D, S, E, F.tid);
}
__device__ __forceinline__ void phase_norm2(const Frame& F0, int l)  {
    Frame F = enter_phase(F0);
    const int RL = (l == 0) ? TT : TL;
    LAS float* RW = (LAS float*)F.lds;
    __syncthreads();
    for (int i = F.tid; i < 1024 * 16 / 4; i += NTHR) *(LAS f32x4*)&RW[i * 4] = *(const f32x4*)(F.in[I_RW] + i * 4);
    __syncthreads();
    const int gw = F.bid * NWAVES + F.wave, NGW = F.G * NWAVES;
    const float* gvec = F.in[I_GFFN] + l * D;
    for (int r = gw; r < RL; r += NGW) {
        const int mr = modrow(r);
        f32x4 v[4]; float ss = 0.f;
#pragma unroll
        for (int j = 0; j < 4; ++j) { v[j] = *(const f32x4*)(F.XS + (size_t)r * D + 4 * F.lane + 256 * j); ss += (v[j].x * v[j].x + v[j].y * v[j].y) + (v[j].z * v[j].z + v[j].w * v[j].w); }
        const float rstd = rsqrtf(wave_sum(ss) * (1.f / D) + EPS);
        const float* md = F.MOD + ((size_t)l * 9 + mr) * 6144;
        float lg[16];
#pragma unroll
        for (int e = 0; e < 16; ++e) lg[e] = 0.f;
#pragma unroll
        for (int j = 0; j < 4; ++j) {
            const int c = 4 * F.lane + 256 * j;
            const f32x4 g = *(const f32x4*)(gvec + c), sh = *(const f32x4*)(md + 3072 + c), scl = *(const f32x4*)(md + 4096 + c);
            const f32x4 h = v[j] * rstd * g * (scl + 1.f) + sh;
            u32x2 o; o.x = pk2(h.x, h.y); o.y = pk2(h.z, h.w);
            *(u32x2*)(F.HN + (size_t)r * D + c) = o;
#pragma unroll
            for (int k = 0; k < 4; ++k) {
#pragma unroll
                for (int e4 = 0; e4 < 4; ++e4) {
                    const f32x4 w = *(const LAS f32x4*)&RW[(c + k) * 16 + e4 * 4];
#pragma unroll
                    for (int e = 0; e < 4; ++e) lg[e4 * 4 + e] = fmaf(h[k], w[e], lg[e4 * 4 + e]);
                }
                asm volatile("" ::: "memory");
            }
        }
        float mx = -3.0e38f;
#pragma unroll
        for (int e = 0; e < 16; ++e) { lg[e] = wave_sum(lg[e]) + F.in[I_RB][e]; mx = fmaxf(mx, lg[e]); }
        float den = 0.f;
#pragma unroll
        for (int e = 0; e < 16; ++e) { lg[e] = expf(lg[e] - mx); den += lg[e]; }
        const float inv = 1.f / den;
#pragma unroll
        for (int e = 0; e < 16; ++e) lg[e] *= inv;
        float gs[4];
#pragma unroll
        for (int gI = 0; gI < 4; ++gI) {
            const float p0 = lg[gI * 4], p1 = lg[gI * 4 + 1], p2 = lg[gI * 4 + 2], p3 = lg[gI * 4 + 3];
            const float h01 = fmaxf(p0, p1), l01 = fminf(p0, p1), h23 = fmaxf(p2, p3), l23 = fminf(p2, p3);
            gs[gI] = fmaxf(h01, h23) + fmaxf(fminf(h01, h23), fmaxf(l01, l23));
        }
        int best = 0; float bsv = gs[0];
#pragma unroll
        for (int gI = 1; gI < 4; ++gI) if (gs[gI] > bsv) { bsv = gs[gI]; best = gI; }
        float q[4];
#pragma unroll
        for (int i = 0; i < 4; ++i) q[i] = best == 0 ? lg[i] : (best == 1 ? lg[4 + i] : (best == 2 ? lg[8 + i] : lg[12 + i]));
        int i0 = 0; float v0 = q[0];
#pragma unroll
        for (int i = 1; i < 4; ++i) if (q[i] > v0) { v0 = q[i]; i0 = i; }
        int i1 = -1; float v1 = -1.f;
#pragma unroll
        for (int i = 0; i < 4; ++i) if (i != i0 && q[i] > v1) { v1 = q[i]; i1 = i; }
        const float ginv = 1.f / (v0 + v1);
        if (F.lane == 0) {
            const int e0 = best * 4 + i0, e1 = best * 4 + i1;
            const int p0 = (int)atomicAdd(&F.ctl[CW_CNT + l * 64 + e0], 1u), p1 = (int)atomicAdd(&F.ctl[CW_CNT + l * 64 + e1], 1u);
            F.LIST[(size_t)e0 * TT + p0] = r; F.LIST[(size_t)e1 * TT + p1] = r;
            *(int4*)(F.TOKI + (size_t)r * 4) = make_int4(e0, p0, e1, p1);
            *(f32x2*)(F.TOKW + (size_t)r * 2) = (f32x2){v0 * ginv, v1 * ginv};
        }
    }
}
__device__ __forceinline__ void phase_gateup(const Frame& F0, int l)  {
    Frame F = enter_phase(F0);
    LAS int* tab = moe_tables(F, l);
    LAS int* rows = (LAS int*)(F.lds + ROWS_OFF);
    pg8::MoeSched S; S.T.init(tab[16] / 256, 8, F.G, F.bid); S.Bt = (const char*)F.WGU_T; S.K = D; S.NE = 2048; S.tab = tab; S.rows = rows;
    {
        pg8::Unit u;
        for (int i = 0; i < 15 && S.next(i, u); ++i) {
            if (F.tid < 256) { const int sr = u.pm * 256 + F.tid, e = S.expert(u.pm), pos = sr - tab[e], cnt = tab[40 + e];
                rows[i * 256 + F.tid] = F.LIST[(size_t)e * TT + (pos < cnt ? pos : 0)]; }
        }
        __syncthreads();
    }
    pg8::EpiPairBf16<0> E{F.HMID, 1024, 0, nullptr, 0};
    pg8::gemm_phase<pg8::EpiPairBf16<0>, pg8::MoeSched, true>(F.lds, F.HN, D, S, E, F.tid);
}
__device__ __forceinline__ void phase_down(const Frame& F0, int l)  {
    Frame F = enter_phase(F0);
    LAS int* tab = moe_tables(F, l);
    pg8::MoeSched S; S.T.init(tab[16] / 256, 4, F.G, F.bid); S.Bt = (const char*)F.WD_T; S.K = D; S.NE = 1024; S.tab = tab; S.rows = nullptr;
    pg8::EpiStoreBf16 E{F.YDN, 1024, 0, nullptr};
    pg8::gemm_phase<pg8::EpiStoreBf16, pg8::MoeSched, true>(F.lds, F.HMID, D, S, E, F.tid);
}

constexpr int PH_PER_LAYER = 10, N_PHASES = 2 + DEPTH * PH_PER_LAYER + 1;

__global__ void __launch_bounds__(NTHR, 2) fwd_kernel(Args args) {
    extern __shared__ __attribute__((aligned(16))) unsigned char lds_raw[];
    Frame F;
    F.lds = (LAS unsigned char*)lds_raw;
    F.tid = threadIdx.x; F.lane = F.tid & 63; F.wave = __builtin_amdgcn_readfirstlane(F.tid >> 6);
    F.G = gridDim.x; F.bid = blockIdx.x;
    F.in = (const CAS cfp_t*)__builtin_amdgcn_kernarg_segment_ptr(); F.out = args.out; F.ws = args.ws;
    frame_ptrs(F, args.ws);
    volatile LAS unsigned* MISC = (volatile LAS unsigned*)(F.lds + MISC_OFF);
    if (F.tid < 32) MISC[F.tid] = 0u;
    __syncthreads();
    const int lo = args.ph_lo, hi = args.ph_hi;
    const bool multi = (hi - lo) > 1;
    XcdBarrier bar; bar.bar = F.ctl + CW_BAR; bar.x = 0; bar.st = MISC + 8;
    if (multi) bar = xcd_barrier_post(F.ctl + CW_BAR, MISC + 8);
#define IN(k) (lo <= (k) && (k) < hi)
#define SEAM(k) do { if (IN(k) && IN((k) + 1)) { XcdBarrier bb_ = bar; asm volatile("" : "+s"(bb_.bar)); xcd_barrier(bb_); } } while (0)
    if (IN(0)) phase_p0(F);
    SEAM(0);
    if (IN(1)) phase_p1(F);
    SEAM(1);
    for (int l = 0; l < DEPTH; ++l) {
        const int pb = 2 + l * PH_PER_LAYER;
        if (IN(pb + 0)) phase_rowA(F, l);
        SEAM(pb + 0);
        if (IN(pb + 1)) phase_inproj(F, l);
        SEAM(pb + 1);
        if (IN(pb + 2)) phase_elem(F, l);
        SEAM(pb + 2);
        if (IN(pb + 3)) phase_scan(F, l);
        SEAM(pb + 3);
        if (IN(pb + 4)) phase_mix1(F, l);
        SEAM(pb + 4);
        if (IN(pb + 5)) phase_s5glu(F, l);
        SEAM(pb + 5);
        if (IN(pb + 6)) phase_wout(F, l);
        SEAM(pb + 6);
        if (IN(pb + 7)) phase_norm2(F, l);
        SEAM(pb + 7);
        if (IN(pb + 8)) phase_gateup(F, l);
        SEAM(pb + 8);
        if (IN(pb + 9)) phase_down(F, l);
        SEAM(pb + 9);
    }
    if (IN(N_PHASES - 1)) phase_rowA(F, DEPTH);
#undef IN
#undef SEAM
}

extern "C" void kernel_launch(void* const* d_in, const int* in_sizes, int n_in, void* d_out, int out_size, void* d_ws, size_t ws_size, hipStream_t stream) {
    static int grid = 0;
    if (grid == 0) {
        if (n_in != N_IN || out_size != TL * D || ws_size < WS_END) { fprintf(stderr, "kernel_launch: unexpected shapes (n_in %d out %d ws %zu)\n", n_in, out_size, ws_size); grid = -1; return; }
        int dev = 0, cus = 0, per_cu = 0;
        if (hipGetDevice(&dev) != hipSuccess || hipDeviceGetAttribute(&cus, hipDeviceAttributeMultiprocessorCount, dev) != hipSuccess) { grid = -1; return; }
        if (hipFuncSetAttribute((const void*)fwd_kernel, hipFuncAttributeMaxDynamicSharedMemorySize, LDS_BYTES) != hipSuccess) { fprintf(stderr, "kernel_launch: hipFuncSetAttribute failed\n"); grid = -1; return; }
        if (hipOccupancyMaxActiveBlocksPerMultiprocessor(&per_cu, (const void*)fwd_kernel, NTHR, LDS_BYTES) != hipSuccess || per_cu < 1) { fprintf(stderr, "kernel_launch: occupancy query says %d\n", per_cu); }
        (void)hipGetLastError();
        grid = cus;
    }
    if (grid < 0) return;
    if (hipMemsetAsync((char*)d_ws + WS_CTL, 0, CTL_ZERO_BYTES, stream) != hipSuccess) return;
    Args a{};
    for (int i = 0; i < N_IN; ++i) a.in[i] = (const float*)d_in[i];
    a.out = (float*)d_out; a.ws = (unsigned char*)d_ws;
#if MK_ONE_LAUNCH
    a.ph_lo = 0; a.ph_hi = N_PHASES;
    hipLaunchKernelGGL(fwd_kernel, dim3(grid), dim3(NTHR), LDS_BYTES, stream, a);
#else
    for (int p = 0; p < N_PHASES; ++p) { a.ph_lo = p; a.ph_hi = p + 1; hipLaunchKernelGGL(fwd_kernel, dim3(grid), dim3(NTHR), LDS_BYTES, stream, a); }
#endif
}
```

```cpp
#include <hip/hip_runtime.h>
#include <cstdio>
#include <cstdint>

#ifndef MK_ONE_LAUNCH
#define MK_ONE_LAUNCH 1
#endif

#define GAS __attribute__((address_space(1)))
#define LAS __attribute__((address_space(3)))
#define CAS __attribute__((address_space(4)))
typedef const float* cfp_t;
typedef unsigned short bf16;
typedef float f32x4 __attribute__((ext_vector_type(4)));
typedef float f32x2 __attribute__((ext_vector_type(2)));
typedef unsigned u32x4 __attribute__((ext_vector_type(4)));
typedef unsigned u32x2 __attribute__((ext_vector_type(2)));

constexpr int D = 1024, NB = 8, SEQ = 2048, CTXL = 256, DEPTH = 2;
constexpr int TL = NB * SEQ, TC = NB * CTXL, TT = TL + TC;
constexpr int INC = 2320;
constexpr int NCOL = 2304;
constexpr int VSEQ = CTXL + SEQ;
constexpr int NEXP = 16;
constexpr float EPS = 1e-6f;

enum { I_X = 0, I_C, I_CTX, I_CCTX, I_WADA, I_BADA, I_GMIX, I_WIN, I_SCW, I_SCB, I_SDTB, I_SALOG, I_SD, I_SNG,
       I_CDW, I_CDB, I_CLG, I_CLB, I_CPW, I_CPB, I_LRE, I_LIM, I_LSTEP, I_BRE, I_BIM, I_CRE, I_CIM, I_S5D, I_GLUW, I_GLUB,
       I_WOUT, I_GFFN, I_RW, I_RB, I_WG, I_WU, I_WD, I_GFIN, N_IN };

constexpr size_t MiB = 1u << 20;
constexpr size_t WS_CTL = 0, CTL_ZERO_BYTES = 64 * 1024;
constexpr size_t WS_MOD = 1 * MiB;
constexpr size_t WS_MODP = 2 * MiB;
constexpr size_t WS_DT = 6 * MiB;
constexpr size_t WS_S5AA = 5 * MiB + 512 * 1024;
constexpr size_t WS_S5BB = WS_S5AA + 32 * 1024;
constexpr size_t WS_S5CM = WS_S5BB + 256 * 1024;
constexpr size_t WS_TOKI = 7 * MiB + 512 * 1024;
constexpr size_t WS_TOKW = WS_TOKI + (size_t)TT * 16;
constexpr size_t WS_XS = 8 * MiB;
constexpr size_t WS_HN = 80 * MiB;
constexpr size_t WS_COLS = 116 * MiB;
constexpr size_t WS_XBCC = 197 * MiB;
constexpr size_t WS_CC = 197 * MiB;
constexpr size_t WS_YI = 207 * MiB;
constexpr size_t WS_SST = 226 * MiB;
constexpr size_t WS_HIN = 264 * MiB;
constexpr size_t WS_EDEC = 302 * MiB;
constexpr size_t WS_TOT = 304 * MiB;
constexpr size_t WS_YSSD = 233 * MiB;
constexpr size_t WS_MIX = 305 * MiB;
constexpr size_t WS_YS5 = 341 * MiB;
constexpr size_t WS_S5HL = 341 * MiB;
constexpr size_t WS_S5HI = 346 * MiB;
constexpr size_t WS_CU = 377 * MiB;
constexpr size_t WS_CV = 395 * MiB;
constexpr size_t WS_LIST = 413 * MiB;
constexpr size_t WS_WIN_T = 415 * MiB;
constexpr size_t WS_WOUT_T = 424 * MiB;
constexpr size_t WS_PW_T = 428 * MiB;
constexpr size_t WS_GLU_T = 428 * MiB + 512 * 1024;
constexpr size_t WS_WGU_T = 429 * MiB;
constexpr size_t WS_WD_T = 493 * MiB;
constexpr size_t WS_END = 525 * MiB;
constexpr int MOE_ROWS = 2 * TT + NEXP * 256;
constexpr size_t WS_HMID = WS_COLS;
constexpr size_t WS_YDN = WS_XBCC;
constexpr size_t WS_YG = WS_CU;
static_assert(WS_HMID + (size_t)MOE_ROWS * 1024 * 2 <= WS_XBCC, "HMID overlay");
static_assert(WS_YDN + (size_t)MOE_ROWS * 1024 * 2 <= WS_MIX, "YDN overlay");
constexpr int CW_CNT = 64;
constexpr int CW_BAR = 1024;

constexpr int NWAVES = 8, NTHR = 512;
constexpr int LDS_BYTES = 147456;
constexpr int MISC_OFF = 131072 + 320;
constexpr int TAB_OFF = 131072 + 512, ROWS_OFF = TAB_OFF + 256;

__device__ __forceinline__ float bf2f(bf16 v) { return __uint_as_float((unsigned)v << 16); }
__device__ __forceinline__ unsigned f2bf(float f) { unsigned u = __float_as_uint(f); return (u + 0x7fffu + ((u >> 16) & 1u)) >> 16; }
__device__ __forceinline__ unsigned pk2(float lo, float hi) { return f2bf(lo) | (f2bf(hi) << 16); }
__device__ __forceinline__ float shx(float v, int m, int lane) { return __int_as_float(__builtin_amdgcn_ds_bpermute((lane ^ m) << 2, __float_as_int(v))); }
__device__ __forceinline__ float wave_sum(float v, int lane) {
#pragma unroll
    for (int o = 1; o < 64; o <<= 1) v += shx(v, o, lane);
    return v;
}
__device__ __forceinline__ float sigmoidf_(float x) { return 1.f / (1.f + __expf(-x)); }
__device__ __forceinline__ float siluf_(float x) { return x / (1.f + __expf(-x)); }
__device__ __forceinline__ float softplusf_(float x) { return fmaxf(x, 0.f) + log1pf(__expf(-fabsf(x))); }
__device__ __forceinline__ float gelu_tanh(float x) { const float u = 0.7978845608028654f * (x + 0.044715f * x * x * x); return 0.5f * x * (1.f + tanhf(u)); }
__device__ __forceinline__ void sincos_red(float x, float& s, float& c) {
    const float k = rintf(x * 0.15915494309189535f);
    float r = fmaf(-k, 6.2831854820251465f, x); r = fmaf(-k, -1.7484555e-7f, r);
    s = __sinf(r); c = __cosf(r);
}
__device__ __forceinline__ int opaque_v(int v) { asm volatile("" : "+v"(v)); return v; }
__device__ __forceinline__ int modrow(int r) { return r < TL ? (r >> 11) : 8; }
__device__ __forceinline__ void seq_bounds(int r, int& lo, int& hi) {
    if (r < TL) { lo = r & ~(SEQ - 1); hi = lo + SEQ; } else { lo = TL + ((r - TL) & ~(CTXL - 1)); hi = lo + CTXL; }
}
__device__ __forceinline__ int vrow(int b, int dir, int s) {
    if (s < CTXL) return TL + b * CTXL + (dir ? CTXL - 1 - s : s);
    const int t = s - CTXL; return b * SEQ + (dir ? SEQ - 1 - t : t);
}

#define XB_TMO      128
#define XB_XCNT(j)  (256  + 64 * (j))
#define XB_XSUB(j)  (1280 + 64 * (j))
#define XB_XGEN(j)  (2304 + 64 * (j))
#define XB_TOP      3328
#define XB_TOPGEN   3392
#define XCD_BAR_WORDS 3456
#define XB_SPIN_CAP (1u << 18)
__device__ __forceinline__ unsigned xb_ld(unsigned* p)              { return __hip_atomic_load(p, __ATOMIC_RELAXED, __HIP_MEMORY_SCOPE_AGENT); }
__device__ __forceinline__ unsigned xb_add(unsigned* p, unsigned v) { return __hip_atomic_fetch_add(p, v, __ATOMIC_RELAXED, __HIP_MEMORY_SCOPE_AGENT); }
__device__ __forceinline__ unsigned xb_xcc_id() { return (unsigned)__builtin_amdgcn_s_getreg((3 << 11) | 20) & 0xFu; }
#define XB_SPIN(cond, bar) do { unsigned _sp = 0; while (cond) { __builtin_amdgcn_s_sleep(1); \
    if ((++_sp & 255u) == 0u) { if (xb_ld(&(bar)[XB_TMO])) break; if (_sp > XB_SPIN_CAP) { atomicAdd(&(bar)[XB_TMO], 1u); break; } } } } while (0)
struct XcdBarrier { unsigned* bar; unsigned x; volatile LAS unsigned* st; };
__device__ __forceinline__ XcdBarrier xcd_barrier_post(unsigned* bar, volatile LAS unsigned* st) {
    XcdBarrier b; b.bar = bar; b.x = xb_xcc_id(); b.st = st;
    if (threadIdx.x == 0) (void)xb_add(&bar[XB_XCNT(b.x)], 1u);
    return b;
}
__device__ __forceinline__ void xcd_barrier_complete(unsigned* bar, unsigned x, unsigned& nloc, unsigned& nx) {
    const unsigned G = gridDim.x * gridDim.y * gridDim.z;
    unsigned sum, cnt, mine, sp = 0u;
    for (;;) {
        sum = 0u; cnt = 0u; mine = 0u;
#pragma unroll
        for (unsigned j = 0; j < 16; ++j) { const unsigned c = xb_ld(&bar[XB_XCNT(j)]); sum += c; cnt += (c > 0u) ? 1u : 0u; mine = (j == x) ? c : mine; }
        if (sum == G) break;
        __builtin_amdgcn_s_sleep(1);
        if ((++sp & 255u) == 0u) { if (xb_ld(&bar[XB_TMO])) break; if (sp > XB_SPIN_CAP) { atomicAdd(&bar[XB_TMO], 1u); break; } }
    }
    nloc = mine > 0u ? mine : 1u; nx = cnt > 0u ? cnt : 1u;
}
__device__ __forceinline__ void xcd_barrier(const XcdBarrier& b) {
    asm volatile("s_waitcnt vmcnt(0)" ::: "memory");
    __syncthreads();
    if (threadIdx.x == 0) {
        unsigned* bar = b.bar;
        const unsigned bx = xb_xcc_id();
        __builtin_amdgcn_s_waitcnt(0);
        unsigned nloc = b.st[0], nx = b.st[1];
        if (nloc == 0u) { xcd_barrier_complete(bar, bx, nloc, nx); b.st[0] = nloc; b.st[1] = nx; }
        const unsigned old = xb_add(&bar[XB_XSUB(bx)], 1u);
        const unsigned gen = old / nloc;
        if (old + 1u == (gen + 1u) * nloc) {
            __builtin_amdgcn_fence(__ATOMIC_RELEASE, "agent");
            asm volatile("s_waitcnt vmcnt(0)" ::: "memory");
            const unsigned og = xb_add(&bar[XB_TOP], 1u);
            const unsigned tg = og / nx;
            if (og + 1u == (tg + 1u) * nx) xb_add(&bar[XB_TOPGEN], 1u);
            else XB_SPIN(xb_ld(&bar[XB_TOPGEN]) == tg, bar);
            __builtin_amdgcn_fence(__ATOMIC_ACQUIRE, "agent");
            xb_add(&bar[XB_XGEN(bx)], 1u);
            asm volatile("s_waitcnt vmcnt(0)" ::: "memory");
        } else {
            XB_SPIN(xb_ld(&bar[XB_XGEN(bx)]) == gen, bar);
            __builtin_amdgcn_fence(__ATOMIC_ACQUIRE, "agent");
            asm volatile("s_waitcnt vmcnt(0)" ::: "memory");
        }
    }
    __syncthreads();
}

struct Args { const float* in[N_IN]; float* out; unsigned char* ws; int ph_lo, ph_hi; };
struct Frame {
    LAS unsigned char* lds;
    int tid, lane, wave, G, bid;
    const CAS cfp_t* in;
    float* out; unsigned char* ws;
    unsigned* ctl;
    float *MOD, *MODP, *DT, *XS, *YSSD, *YS5, *CU;
    bf16 *HN, *COLS, *XBCC, *MIX, *HMID, *CV, *YG, *YDN, *WIN_T, *WOUT_T, *PW_T, *GLU_T, *WGU_T, *WD_T;
    int* LIST; int* TOKI; float* TOKW;
};
__device__ __forceinline__ void frame_ptrs(Frame& F, unsigned char* ws) {
    F.ws = ws; F.ctl = (unsigned*)(ws + WS_CTL);
    F.MOD = (float*)(ws + WS_MOD); F.MODP = (float*)(ws + WS_MODP); F.DT = (float*)(ws + WS_DT); F.XS = (float*)(ws + WS_XS);
    F.YSSD = (float*)(ws + WS_YSSD); F.YS5 = (float*)(ws + WS_YS5); F.CU = (float*)(ws + WS_CU); F.CV = (bf16*)(ws + WS_CV); F.YDN = (bf16*)(ws + WS_YDN); F.YG = (bf16*)(ws + WS_YG);
    F.WIN_T = (bf16*)(ws + WS_WIN_T); F.WOUT_T = (bf16*)(ws + WS_WOUT_T); F.PW_T = (bf16*)(ws + WS_PW_T); F.GLU_T = (bf16*)(ws + WS_GLU_T); F.WGU_T = (bf16*)(ws + WS_WGU_T); F.WD_T = (bf16*)(ws + WS_WD_T);
    F.HN = (bf16*)(ws + WS_HN); F.COLS = (bf16*)(ws + WS_COLS); F.XBCC = (bf16*)(ws + WS_XBCC); F.MIX = (bf16*)(ws + WS_MIX); F.HMID = (bf16*)(ws + WS_HMID);
    F.LIST = (int*)(ws + WS_LIST); F.TOKI = (int*)(ws + WS_TOKI); F.TOKW = (float*)(ws + WS_TOKW);
}
__device__ __forceinline__ Frame enter_phase(const Frame& F0) {
    Frame F = F0; unsigned om = ~0u; asm volatile("" : "+s"(om)); int ln = (int)__builtin_amdgcn_mbcnt_hi(om, __builtin_amdgcn_mbcnt_lo(om, 0u)); asm volatile("" : "+v"(ln));
    F.lane = ln; F.tid = F0.wave * 64 + ln;
    unsigned char* ws = F0.ws; asm volatile("" : "+s"(ws)); frame_ptrs(F, ws);
    const CAS cfp_t* ka = (const CAS cfp_t*)__builtin_amdgcn_kernarg_segment_ptr(); asm volatile("" : "+s"(ka)); F.in = ka;
    return F;
}

__device__ __forceinline__ void ld4(const float* p, float (&v)[4]) { const f32x4 t = *(const f32x4*)p; v[0] = t.x; v[1] = t.y; v[2] = t.z; v[3] = t.w; }
__device__ __forceinline__ void ld4(const bf16* p, float (&v)[4]) { const u32x2 t = *(const u32x2*)p; v[0] = __uint_as_float(t.x << 16); v[1] = __uint_as_float(t.x & 0xffff0000u); v[2] = __uint_as_float(t.y << 16); v[3] = __uint_as_float(t.y & 0xffff0000u); }

__device__ __forceinline__ void ld8(const bf16* p, float (&v)[8]) { const u32x4 t = *(const u32x4*)p;
    v[0] = __uint_as_float(t.x << 16); v[1] = __uint_as_float(t.x & 0xffff0000u); v[2] = __uint_as_float(t.y << 16); v[3] = __uint_as_float(t.y & 0xffff0000u);
    v[4] = __uint_as_float(t.z << 16); v[5] = __uint_as_float(t.z & 0xffff0000u); v[6] = __uint_as_float(t.w << 16); v[7] = __uint_as_float(t.w & 0xffff0000u); }

namespace pg8 {
typedef short bf16x8 __attribute__((ext_vector_type(8)));
constexpr int BM = 256, BK = 64, HALF = 128, HTB = HALF * BK * 2, STAGE_BYTES = 8 * HTB, NXCD = 8, WGM = 8;
__device__ __forceinline__ int lds_byte(int r, int c) { const int st = (r >> 4) * 2 + (c >> 5), rr = r & 15, cc = c & 31, ob = rr * 64 + cc * 2; return st * 1024 + (ob ^ (((ob >> 9) & 1) << 5)); }
__device__ __forceinline__ void stage_rc(int b, int& R, int& C) { const int st = b / 1024, sb = b % 1024, swz = sb ^ (((sb >> 9) & 1) << 5); R = (st >> 1) * 16 + swz / 64; C = (st & 1) * 32 + (swz % 64) / 2; }
__device__ __forceinline__ int perm32(int rho) { const int n = rho >> 4, i = rho & 15; return 8 * (i >> 2) + 4 * n + (i & 3); }
struct Unit { int pm, pn, idx; };
struct TileOrder {
    int nM, nN, nwg, G, c;
    __device__ __forceinline__ void init(int nM_, int nN_, int G_, int c_) { nM = nM_; nN = nN_; nwg = nM * nN; G = G_; c = c_; }
    __device__ __forceinline__ bool next(int i, Unit& u) const {
        const long L = (long)i * G + c; if (L >= nwg) return false;
        int wgid = (int)L; { const int q = nwg / NXCD, r = nwg % NXCD, xcd = wgid % NXCD, off = wgid / NXCD; wgid = (xcd < r ? xcd * (q + 1) : r * (q + 1) + (xcd - r) * q) + off; }
        const int nig = WGM * nN, gid = wgid / nig, fm = gid * WGM, gsz = (nM - fm) < WGM ? (nM - fm) : WGM;
        u.pm = fm + ((wgid % nig) % gsz); u.pn = (wgid % nig) / gsz; u.idx = i; return true;
    }
};
__device__ __forceinline__ unsigned cvt_pk_bf16(float lo, float hi) { unsigned r; asm volatile("v_cvt_pk_bf16_f32 %0, %1, %2" : "=v"(r) : "v"(lo), "v"(hi)); return r; }

template <class Epi, class Sched, bool ALIGN_EPI>
__device__ __forceinline__ void gemm_phase(LAS unsigned char* lds, const bf16* Abase, int K, const Sched& S, const Epi& E, int tid) {
    const int wid = __builtin_amdgcn_readfirstlane(tid >> 6), lane = tid & 63, wr = wid >> 2, wc = wid & 3, fr = lane & 15, fq = lane >> 4;
    const int nt = K / BK;
    unsigned voffB[2];
#pragma unroll
    for (int i = 0; i < 2; ++i) { int R, C; stage_rc(tid * 16 + i * 8192, R, C); const int Rb = Epi::PERM ? ((R & ~31) + perm32(R & 31)) : R; voffB[i] = (unsigned)(Rb * K + C) * 2u; }
    const size_t kstep = (size_t)(BK * 2);
    const size_t hstep = (size_t)HALF * K * 2;
    const unsigned ldsw = (unsigned)wid * 1024u;
    const int aoff = lds_byte(wr * 64 + fr, fq * 8), boff = lds_byte(wc * 32 + fr, fq * 8);
#define PG8_SA(b, h) (((b) * 2 + (h)) * HTB)
#define PG8_SB(b, h) ((4 + (b) * 2 + (h)) * HTB)
#define PG8_STAGE(bufoff, gbase, voff) do { _Pragma("unroll") for (int _i = 0; _i < 2; ++_i) \
        __builtin_amdgcn_global_load_lds((const unsigned*)((const char*)(gbase) + (voff)[_i]), (LAS unsigned*)(lds + (bufoff) + ldsw + _i * 8192), 16, 0, 0); } while (0)
#define PG8_LDA(dst, b, h) do { _Pragma("unroll") for (int m = 0; m < 4; ++m) _Pragma("unroll") for (int k = 0; k < 2; ++k) dst[m][k] = *(const LAS bf16x8*)(lds + PG8_SA(b, h) + aoff + m * 2048 + k * 1024); } while (0)
#define PG8_LDB(dst, b, h) do { _Pragma("unroll") for (int n = 0; n < 2; ++n) _Pragma("unroll") for (int k = 0; k < 2; ++k) dst[n][k] = *(const LAS bf16x8*)(lds + PG8_SB(b, h) + boff + n * 2048 + k * 1024); } while (0)
#define PG8_MMA(ai, bj, At, Bt) do { __builtin_amdgcn_s_setprio(1); _Pragma("unroll") for (int m = 0; m < 4; ++m) _Pragma("unroll") for (int n = 0; n < 2; ++n) _Pragma("unroll") for (int k = 0; k < 2; ++k) \
        acc[ai][bj][m][n] = __builtin_amdgcn_mfma_f32_16x16x32_bf16(Bt[n][k], At[m][k], acc[ai][bj][m][n], 0, 0, 0); __builtin_amdgcn_s_setprio(0); } while (0)
#define PG8_WAIT_V(n) asm volatile("s_waitcnt vmcnt(" #n ")" ::: "memory")
#define PG8_WAIT_L(n) asm volatile("s_waitcnt lgkmcnt(" #n ")" ::: "memory")
#define PG8_BAR __builtin_amdgcn_s_barrier()
#define PG8_SCHED __builtin_amdgcn_sched_barrier(0)
#define PG8_SETV(v, u) do { _Pragma("unroll") for (int _i = 0; _i < 2; ++_i) { int _R, _C; stage_rc(tid * 16 + _i * 8192, _R, _C); _Pragma("unroll") for (int _h = 0; _h < 2; ++_h) v[_h][_i] = (unsigned)(S.arow(u, _h * HALF + _R) * K + _C) * 2u; } } while (0)
    Unit cur, nxt; int ui = 0;
    if (!S.next(0, cur)) return;
    f32x4 acc[2][2][4][2];
#pragma unroll
    for (int a = 0; a < 2; ++a)
#pragma unroll
        for (int b = 0; b < 2; ++b)
#pragma unroll
            for (int m = 0; m < 4; ++m)
#pragma unroll
                for (int n = 0; n < 2; ++n) acc[a][b][m][n] = (f32x4){0.f, 0.f, 0.f, 0.f};
    bf16x8 At[4][2], B0[2][2], B1[2][2];
    unsigned vC[2][2], vN[2][2];
    PG8_SETV(vC, cur);
    const char* cA = (const char*)Abase; const char* cB = S.bbase(cur);
    PG8_WAIT_L(0);
    PG8_STAGE(PG8_SB(0, 0), cB, voffB); PG8_STAGE(PG8_SB(0, 1), cB + hstep, voffB); PG8_STAGE(PG8_SA(0, 0), cA, vC[0]); PG8_STAGE(PG8_SA(0, 1), cA, vC[1]);
    if (wr == 1) PG8_BAR;
    PG8_WAIT_V(2); PG8_BAR;
    PG8_STAGE(PG8_SB(1, 0), cB + kstep, voffB); PG8_STAGE(PG8_SA(1, 0), cA + kstep, vC[0]); PG8_STAGE(PG8_SB(1, 1), cB + hstep + kstep, voffB);
    PG8_WAIT_V(6); PG8_BAR;
    for (;;) {
        const bool has_next = S.next(ui + 1, nxt);
        const char* nB = cB;
        if (has_next) { PG8_SETV(vN, nxt); nB = S.bbase(nxt); }
        else {
#pragma unroll
            for (int _h = 0; _h < 2; ++_h)
#pragma unroll
                for (int _i = 0; _i < 2; ++_i) vN[_h][_i] = vC[_h][_i];
        }
        PG8_WAIT_L(0);
        for (int t = 0; t < nt; t += 2) {
            const bool last = (t == nt - 2);
            const char* a1 = cA + (size_t)(t + 1) * kstep;
            const char* a2 = last ? cA : cA + (size_t)(t + 2) * kstep; const char* b2 = last ? nB : cB + (size_t)(t + 2) * kstep;
            const char* a3 = a2 + kstep; const char* b3 = b2 + kstep;
            PG8_LDB(B0, 0, 0); PG8_LDB(B1, 0, 1); PG8_SCHED; PG8_LDA(At, 0, 0); PG8_STAGE(PG8_SA(1, 1), a1, vC[1]);
            if (last) {
#pragma unroll
                for (int _h = 0; _h < 2; ++_h)
#pragma unroll
                    for (int _i = 0; _i < 2; ++_i) vC[_h][_i] = vN[_h][_i];
            }
            PG8_WAIT_V(8); PG8_WAIT_L(0); PG8_BAR; PG8_MMA(0, 0, At, B0); PG8_MMA(0, 1, At, B1); PG8_BAR; PG8_SCHED;
            PG8_LDA(At, 0, 1); PG8_STAGE(PG8_SB(0, 0), b2, voffB); PG8_STAGE(PG8_SB(0, 1), b2 + hstep, voffB); PG8_STAGE(PG8_SA(0, 0), a2, vC[0]);
            PG8_WAIT_V(8); PG8_WAIT_L(0); PG8_BAR; PG8_MMA(1, 0, At, B0); PG8_MMA(1, 1, At, B1); PG8_BAR; PG8_SCHED;
            PG8_LDB(B0, 1, 0); PG8_LDB(B1, 1, 1); PG8_SCHED; PG8_LDA(At, 1, 0); PG8_STAGE(PG8_SA(0, 1), a2, vC[1]);
            PG8_WAIT_V(8); PG8_WAIT_L(0); PG8_BAR; PG8_MMA(0, 0, At, B0); PG8_MMA(0, 1, At, B1); PG8_BAR; PG8_SCHED;
            PG8_LDA(At, 1, 1); PG8_STAGE(PG8_SB(1, 0), b3, voffB); PG8_STAGE(PG8_SB(1, 1), b3 + hstep, voffB); PG8_STAGE(PG8_SA(1, 0), a3, vC[0]);
            PG8_WAIT_V(8); PG8_WAIT_L(0); PG8_BAR; PG8_MMA(1, 0, At, B0); PG8_MMA(1, 1, At, B1); PG8_BAR; PG8_SCHED;
        }
        if constexpr (ALIGN_EPI) { if (wr == 0) PG8_BAR; }
        E(acc, cur, wr, wc, fr, fq);
        if (!has_next) break;
#pragma unroll
        for (int a = 0; a < 2; ++a)
#pragma unroll
            for (int b = 0; b < 2; ++b)
#pragma unroll
                for (int m = 0; m < 4; ++m)
#pragma unroll
                    for (int n = 0; n < 2; ++n) acc[a][b][m][n] = (f32x4){0.f, 0.f, 0.f, 0.f};
        cur = nxt; cB = nB; ++ui;
        if constexpr (ALIGN_EPI) { if (wr == 1) PG8_BAR; }
    }
    PG8_WAIT_V(0);
    if constexpr (!ALIGN_EPI) { if (wr == 0) PG8_BAR; }
    PG8_BAR;
#undef PG8_SA
#undef PG8_SB
#undef PG8_STAGE
#undef PG8_LDA
#undef PG8_LDB
#undef PG8_MMA
#undef PG8_WAIT_V
#undef PG8_WAIT_L
#undef PG8_BAR
#undef PG8_SCHED
#undef PG8_SETV
}

struct PlainSched {
    TileOrder T; const char* Bt; int K;
    __device__ __forceinline__ bool next(int i, Unit& u) const { return T.next(i, u); }
    __device__ __forceinline__ int arow(const Unit& u, int r) const { return u.pm * BM + r; }
    __device__ __forceinline__ const char* bbase(const Unit& u) const { return Bt + (size_t)u.pn * BM * K * 2; }
};
template <bool GATHER> struct MoeSched {
    TileOrder T; const char* Bt; int K, NE; const LAS int* tab; const LAS int* rows;
    __device__ __forceinline__ bool next(int i, Unit& u) const { return T.next(i, u); }
    __device__ __forceinline__ int expert(int pm) const { const int s = pm * BM; int e = 0;
#pragma unroll
        for (int k = 1; k < NEXP; ++k) if (s >= tab[k]) e = k;
        return e; }
    __device__ __forceinline__ int arow(const Unit& u, int r) const { return GATHER ? rows[u.idx * BM + r] : u.pm * BM + r; }
    __device__ __forceinline__ const char* bbase(const Unit& u) const { return Bt + ((size_t)expert(u.pm) * NE + (size_t)u.pn * BM) * K * 2; }
};
struct EpiStoreBf16 {
    static constexpr bool PERM = true;
    bf16* O; int ldc, col0; const float* bias;
    __device__ __forceinline__ void operator()(const f32x4 (&acc)[2][2][4][2], const Unit& u, int wr, int wc, int fr, int fq) const {
        const int row0 = u.pm * BM + wr * 64 + fr, ct0 = u.pn * BM + wc * 32 + 8 * fq;
        f32x4 bv[2][2];
#pragma unroll
        for (int bj = 0; bj < 2; ++bj)
#pragma unroll
            for (int n = 0; n < 2; ++n) bv[bj][n] = bias ? *(const f32x4*)(bias + ct0 + bj * HALF + 4 * n) : (f32x4){0.f, 0.f, 0.f, 0.f};
#pragma unroll
        for (int ai = 0; ai < 2; ++ai)
#pragma unroll
            for (int m = 0; m < 4; ++m) { bf16* rowp = O + (size_t)(row0 + ai * HALF + m * 16) * ldc + col0 + ct0;
#pragma unroll
                for (int bj = 0; bj < 2; ++bj) { const f32x4 v0 = acc[ai][bj][m][0] + bv[bj][0], v1 = acc[ai][bj][m][1] + bv[bj][1];
                    u32x4 w; w.x = cvt_pk_bf16(v0[0], v0[1]); w.y = cvt_pk_bf16(v0[2], v0[3]); w.z = cvt_pk_bf16(v1[0], v1[1]); w.w = cvt_pk_bf16(v1[2], v1[3]);
                    *(u32x4*)(rowp + bj * HALF) = w; } }
    }
};
template <int ACT>
struct EpiPairBf16 {
    static constexpr bool PERM = true;
    bf16* O; int ldc, col0; const float* bias; int nb;
    __device__ __forceinline__ void operator()(const f32x4 (&acc)[2][2][4][2], const Unit& u, int wr, int wc, int fr, int fq) const {
        const int row0 = u.pm * BM + wr * 64 + fr, ct0 = u.pn * HALF + wc * 32 + 8 * fq;
        f32x4 ba[2], bb[2];
#pragma unroll
        for (int n = 0; n < 2; ++n) { ba[n] = (ACT == 1) ? *(const f32x4*)(bias + ct0 + 4 * n) : (f32x4){0.f, 0.f, 0.f, 0.f}; bb[n] = (ACT == 1) ? *(const f32x4*)(bias + nb + ct0 + 4 * n) : (f32x4){0.f, 0.f, 0.f, 0.f}; }
#pragma unroll
        for (int ai = 0; ai < 2; ++ai)
#pragma unroll
            for (int m = 0; m < 4; ++m) {
                float o[8];
#pragma unroll
                for (int n = 0; n < 2; ++n)
#pragma unroll
                    for (int j = 0; j < 4; ++j) { const float a = acc[ai][0][m][n][j] + ba[n][j], b = acc[ai][1][m][n][j] + bb[n][j];
                        o[n * 4 + j] = (ACT == 0) ? (a / (1.f + __expf(-a))) * b : a / (1.f + __expf(-b)); }
                u32x4 w; w.x = cvt_pk_bf16(o[0], o[1]); w.y = cvt_pk_bf16(o[2], o[3]); w.z = cvt_pk_bf16(o[4], o[5]); w.w = cvt_pk_bf16(o[6], o[7]);
                *(u32x4*)(O + (size_t)(row0 + ai * HALF + m * 16) * ldc + col0 + ct0) = w; }
    }
};
struct EpiResidual {
    static constexpr bool PERM = false;
    float* XS; const float* g1;
    __device__ __forceinline__ void operator()(const f32x4 (&acc)[2][2][4][2], const Unit& u, int wr, int wc, int fr, int fq) const {
        const int row0 = u.pm * BM + wr * 64 + fr, ct0 = u.pn * BM + wc * 32 + 4 * fq;
#pragma unroll
        for (int ai = 0; ai < 2; ++ai)
#pragma unroll
            for (int m = 0; m < 4; ++m) { const int row = row0 + ai * HALF + m * 16; float* xp = XS + (size_t)row * D + ct0; const float* gp = g1 + (size_t)modrow(row) * 6144 + ct0;
#pragma unroll
                for (int bj = 0; bj < 2; ++bj)
#pragma unroll
                    for (int n = 0; n < 2; ++n) { const int o = bj * HALF + n * 16; const f32x4 g = *(const f32x4*)(gp + o); f32x4 x = *(const f32x4*)(xp + o); x += g * acc[ai][bj][m][n]; *(f32x4*)(xp + o) = x; }
                if (m & 1) asm volatile("" ::: "memory"); }
    }
};
}

template <class RowMap>
__device__ __forceinline__ void transpose_item(const float* W, int K, int N, bf16* WT, const RowMap& rowmap, LAS float* scr, int item, int lane) {
    const int nblk = (N + 31) / 32, kb = item / nblk, nb = item % nblk, k0 = 64 * kb, n0 = 32 * nb;
    const bool cok = n0 + (lane & 31) < N;
#pragma unroll 8
    for (int i = 0; i < 32; ++i) { const int kk = 2 * i + (lane >> 5); scr[kk * 33 + (lane & 31)] = cok ? W[(size_t)(k0 + kk) * N + n0 + (lane & 31)] : 0.f; }
    asm volatile("s_waitcnt lgkmcnt(0)" ::: "memory");
    const int c = lane & 7;
#pragma unroll
    for (int j = 0; j < 4; ++j) { const int n = (lane >> 3) + 8 * j; const LAS float* sp = scr + (8 * c) * 33 + n;
        u32x4 o; o.x = pk2(sp[0 * 33], sp[1 * 33]); o.y = pk2(sp[2 * 33], sp[3 * 33]); o.z = pk2(sp[4 * 33], sp[5 * 33]); o.w = pk2(sp[6 * 33], sp[7 * 33]);
        const int dr = rowmap(n0 + n);
        if (dr >= 0) *(u32x4*)(WT + (size_t)dr * K + k0 + 8 * c) = o; }
    asm volatile("s_waitcnt lgkmcnt(0)" ::: "memory");
}


typedef short bf16x4s __attribute__((ext_vector_type(4)));
constexpr int S5_US = 264;
constexpr int S5_WS = 136;
__device__ __forceinline__ int s5_row0(int b, int c) { return c < 4 ? TL + b * CTXL + c * 64 : b * SEQ + (c - 4) * 64; }
template <int PASS>
__device__ __forceinline__ void s5_unit(const Frame& F, int l, int uidx) {
    const int b = uidx / 36, c = uidx % 36, r0 = s5_row0(b, c);
    LAS bf16* U = (LAS bf16*)F.lds;
    __syncthreads();
    for (int i = F.tid; i < 64 * 32; i += NTHR) { const int row = i >> 5, c8 = i & 31; *(LAS u32x4*)(U + row * S5_US + c8 * 8) = *(const u32x4*)(F.COLS + (size_t)(r0 + row) * NCOL + 2048 + c8 * 8); }
    __syncthreads();
    LAS bf16* BuS = (LAS bf16*)(F.lds + 64 * S5_US * 2 + F.wave * (2 * 16 * S5_WS * 2)); LAS bf16* Hs = BuS + 16 * S5_WS;
    const int q = F.lane >> 4, c16 = F.lane & 15, p = F.lane;
    const f32x2* AA = (const f32x2*)(F.ws + WS_S5AA); const bf16* BB = (const bf16*)(F.ws + WS_S5BB); const bf16* CM = (const bf16*)(F.ws + WS_S5CM);
    f32x2* HL = (f32x2*)(F.ws + WS_S5HL); const f32x2* HI = (const f32x2*)(F.ws + WS_S5HI);
#pragma unroll 1
    for (int gi = 0; gi < 2; ++gi) {
        const int g = F.wave * 2 + gi;
        f32x4 yacc[4];
#pragma unroll
        for (int rs = 0; rs < 4; ++rs) yacc[rs] = (f32x4){0.f, 0.f, 0.f, 0.f};
        pg8::bf16x8 cm[4];
        if (PASS == 1) {
#pragma unroll
            for (int ks = 0; ks < 4; ++ks) cm[ks] = *(const pg8::bf16x8*)(CM + ((size_t)(l * 16 + g) * 16 + c16) * 128 + 32 * ks + 8 * q);
        }
#pragma unroll
        for (int dir = 0; dir < 2; ++dir) {
            const int pidx = ((l * 2 + dir) * 16 + g);
            const f32x2 aa = AA[pidx * 64 + p]; const float ar = aa.x, ai = aa.y;
            bf16x4s bb[8];
#pragma unroll
            for (int rt = 0; rt < 8; ++rt) bb[rt] = *(const bf16x4s*)(BB + ((size_t)pidx * 128 + 16 * rt + c16) * 16 + 4 * q);
            const size_t sidx = ((size_t)(b * 36 + c) * 32 + g * 2 + dir) * 64 + p;
            float hr = 0.f, hi = 0.f;
            if (PASS == 1) { const f32x2 h0 = HI[sidx]; hr = h0.x; hi = h0.y; }
#pragma unroll
            for (int sci = 0; sci < 4; ++sci) {
                const int rs = dir ? 3 - sci : sci;
                const bf16x4s bop = *(const LAS bf16x4s*)(U + (16 * rs + c16) * S5_US + g * 16 + 4 * q);
#pragma unroll
                for (int rt = 0; rt < 8; ++rt) {
                    const f32x4 a = __builtin_amdgcn_mfma_f32_16x16x16bf16_1k(bb[rt], bop, (f32x4){0.f, 0.f, 0.f, 0.f}, 0, 0, 0);
                    u32x2 w; w.x = pk2(a[0], a[1]); w.y = pk2(a[2], a[3]);
                    *(LAS u32x2*)(BuS + c16 * S5_WS + 16 * rt + 4 * q) = w;
                }
                asm volatile("s_waitcnt lgkmcnt(0)" ::: "memory");
                unsigned bu[16];
#pragma unroll
                for (int st = 0; st < 16; ++st) bu[st] = *(const LAS unsigned*)(BuS + (dir ? 15 - st : st) * S5_WS + 2 * p);
#pragma unroll
                for (int st = 0; st < 16; ++st) {
                    const float bur = __uint_as_float(bu[st] << 16), bui = __uint_as_float(bu[st] & 0xffff0000u);
                    const float nr = fmaf(ar, hr, fmaf(-ai, hi, bur)), ni = fmaf(ar, hi, fmaf(ai, hr, bui)); hr = nr; hi = ni;
                    if (PASS == 1) *(LAS unsigned*)(Hs + (dir ? 15 - st : st) * S5_WS + 2 * p) = pk2(hr, hi);
                }
                if (PASS == 1) {
                    asm volatile("s_waitcnt lgkmcnt(0)" ::: "memory");
#pragma unroll
                    for (int ks = 0; ks < 4; ++ks) { const pg8::bf16x8 hf = *(const LAS pg8::bf16x8*)(Hs + c16 * S5_WS + 32 * ks + 8 * q);
                        yacc[rs] = __builtin_amdgcn_mfma_f32_16x16x32_bf16(cm[ks], hf, yacc[rs], 0, 0, 0); }
                }
                asm volatile("s_waitcnt lgkmcnt(0)" ::: "memory");
            }
            if (PASS == 0) HL[sidx] = (f32x2){hr, hi};
        }
        if (PASS == 1) {
            const f32x4 dsk = *(const f32x4*)(F.in[I_S5D] + l * 256 + g * 16 + 4 * q);
#pragma unroll
            for (int rs = 0; rs < 4; ++rs) {
                float u4[4]; { const u32x2 t = *(const LAS u32x2*)(U + (16 * rs + c16) * S5_US + g * 16 + 4 * q);
                    u4[0] = __uint_as_float(t.x << 16); u4[1] = __uint_as_float(t.x & 0xffff0000u); u4[2] = __uint_as_float(t.y << 16); u4[3] = __uint_as_float(t.y & 0xffff0000u); }
                float o[4];
#pragma unroll
                for (int j = 0; j < 4; ++j) o[j] = gelu_tanh(yacc[rs][j] + dsk[j] * u4[j]);
                u32x2 w; w.x = pk2(o[0], o[1]); w.y = pk2(o[2], o[3]);
                *(u32x2*)(F.YG + (size_t)(r0 + 16 * rs + c16) * 256 + g * 16 + 4 * q) = w;
            }
        }
    }
}
__device__ __forceinline__ void s5_carry(const Frame& F, int l) {
    const int gt = F.bid * NTHR + F.tid, NG = F.G * NTHR;
    const f32x2* AA = (const f32x2*)(F.ws + WS_S5AA); const f32x2* HL = (const f32x2*)(F.ws + WS_S5HL); f32x2* HI = (f32x2*)(F.ws + WS_S5HI);
    for (int i = gt; i < NB * 32 * 64; i += NG) {
        const int p = i & 63, gd = (i >> 6) & 31, b = i >> 11, g = gd >> 1, dir = gd & 1;
        f32x2 a = AA[((l * 2 + dir) * 16 + g) * 64 + p];
#pragma unroll
        for (int k = 0; k < 6; ++k) a = (f32x2){a.x * a.x - a.y * a.y, 2.f * a.x * a.y};
        float hr = 0.f, hi = 0.f;
#pragma unroll 4
        for (int j = 0; j < 36; ++j) {
            const int c = dir ? (j < 4 ? 3 - j : 39 - j) : j;
            const size_t idx = ((size_t)(b * 36 + c) * 32 + gd) * 64 + p;
            HI[idx] = (f32x2){hr, hi};
            const f32x2 hl = HL[idx];
            const float nr = a.x * hr - a.y * hi + hl.x, ni = a.x * hi + a.y * hr + hl.y; hr = nr; hi = ni;
        }
    }
}


constexpr int SSD_LD = 136;
__device__ __forceinline__ int ssd_row0(int b, int cid) { return cid < 2 ? TL + b * CTXL + cid * 128 : b * SEQ + (cid - 2) * 128; }
__device__ __forceinline__ pg8::bf16x8 mk8(u32x2 lo, u32x2 hi) { u32x4 t; t.x = lo.x; t.y = lo.y; t.z = hi.x; t.w = hi.y; return __builtin_bit_cast(pg8::bf16x8, t); }
__device__ __forceinline__ void ssd_unit_a(const Frame& F, int l, int uidx) {
    const int h = uidx & 7, uc = uidx >> 3, b = uc / 18, cid = uc % 18, g = h >> 2, r0 = ssd_row0(b, cid);
    LAS bf16* XT = (LAS bf16*)F.lds; LAS bf16* Bn = XT + 64 * SSD_LD; LAS bf16* BT = Bn + 128 * SSD_LD; LAS bf16* Cn = BT + 128 * SSD_LD;
    LAS float* cs0 = (LAS float*)(Cn + 128 * SSD_LD); LAS float* ecs1 = cs0 + 128; LAS float* dt0 = ecs1 + 128; LAS float* dt1 = dt0 + 128; LAS float* w0 = dt1 + 128; LAS float* w1 = w0 + 128;
    __syncthreads();
    if (F.wave == 0) {
        const float A0 = -expf(F.in[I_SALOG][l * 16 + h]), A1 = -expf(F.in[I_SALOG][l * 16 + 8 + h]);
        const float db0 = F.in[I_SDTB][l * 16 + h], db1 = F.in[I_SDTB][l * 16 + 8 + h];
        const int t0 = 2 * F.lane;
        const float d00 = softplusf_(F.DT[(size_t)(r0 + t0) * 16 + h] + db0), d01 = softplusf_(F.DT[(size_t)(r0 + t0 + 1) * 16 + h] + db0);
        const float d10 = softplusf_(F.DT[(size_t)(r0 + t0) * 16 + 8 + h] + db1), d11 = softplusf_(F.DT[(size_t)(r0 + t0 + 1) * 16 + 8 + h] + db1);
        const float a00 = d00 * A0, a01 = d01 * A0, a10 = d10 * A1, a11 = d11 * A1;
        float p0 = a00 + a01, p1 = a10 + a11;
#pragma unroll
        for (int o = 1; o < 64; o <<= 1) { const float u0 = __int_as_float(__builtin_amdgcn_ds_bpermute((F.lane - o) << 2, __float_as_int(p0))), u1 = __int_as_float(__builtin_amdgcn_ds_bpermute((F.lane - o) << 2, __float_as_int(p1)));
            if (F.lane >= o) { p0 += u0; p1 += u1; } }
        const float tot0 = __int_as_float(__builtin_amdgcn_readlane(__float_as_int(p0), 63)), tot1 = __int_as_float(__builtin_amdgcn_readlane(__float_as_int(p1), 63));
        const float c01 = p0, c00 = p0 - a01;
        const float e11 = p1 - a11, e10 = e11 - a10;
        cs0[t0] = c00; cs0[t0 + 1] = c01; ecs1[t0] = e10; ecs1[t0 + 1] = e11; dt0[t0] = d00; dt0[t0 + 1] = d01; dt1[t0] = d10; dt1[t0 + 1] = d11;
        w0[t0] = __expf(tot0 - c00) * d00; w0[t0 + 1] = __expf(tot0 - c01) * d01; w1[t0] = __expf(e10) * d10; w1[t0 + 1] = __expf(e11) * d11;
        float* ed = (float*)(F.ws + WS_EDEC) + ((size_t)(r0 + t0) * 8 + h) * 2;
        ed[0] = __expf(c00); ed[1] = __expf(tot1 - e10); ed[16] = __expf(c01); ed[17] = __expf(tot1 - e11);
        if (F.lane == 0) { float* tt = (float*)(F.ws + WS_TOT) + ((size_t)uc * 8 + h) * 2; tt[0] = tot0; tt[1] = tot1; }
    }
    {
        int lo, hi; seq_bounds(r0, lo, hi);
        const float* cw = F.in[I_SCW] + (size_t)l * 5 * 1024; const float* cb = F.in[I_SCB] + l * 1024;
        bf16* CC = (bf16*)(F.ws + WS_CC);
        for (int it = F.tid; it < 640; it += NTHR) {
            const int oct = it % 40, seg = it / 40, s0 = seg * 8;
            const int kind = oct < 8 ? 0 : (oct < 24 ? 1 : 2);
            const int n0 = kind == 0 ? oct * 8 : (kind == 1 ? (oct - 8) * 8 : (oct - 24) * 8);
            const int xch = kind == 0 ? h * 64 + n0 : (kind == 1 ? 512 + g * 128 + n0 : 768 + g * 128 + n0);
            u32x4 xr[12];
#pragma unroll
            for (int i = 0; i < 12; ++i) { const int rr = r0 + s0 - 2 + i; xr[i] = (rr >= lo && rr < hi) ? *(const u32x4*)(F.COLS + (size_t)rr * NCOL + 512 + xch) : (u32x4){0u, 0u, 0u, 0u}; }
#pragma unroll
            for (int hb = 0; hb < 2; ++hb) {
                float wv[5][4]; float val[8][4];
#pragma unroll
                for (int j = 0; j < 5; ++j) { const f32x4 t = *(const f32x4*)(cw + j * 1024 + xch + 4 * hb); wv[j][0] = t.x; wv[j][1] = t.y; wv[j][2] = t.z; wv[j][3] = t.w; }
                const f32x4 bias = *(const f32x4*)(cb + xch + 4 * hb);
#pragma unroll
                for (int i = 0; i < 8; ++i)
#pragma unroll
                    for (int k = 0; k < 4; ++k) val[i][k] = bias[k];
#pragma unroll
                for (int i = 0; i < 12; ++i) {
                    const unsigned wa = hb ? xr[i].z : xr[i].x, wb = hb ? xr[i].w : xr[i].y;
                    const float x4[4] = {__uint_as_float(wa << 16), __uint_as_float(wa & 0xffff0000u), __uint_as_float(wb << 16), __uint_as_float(wb & 0xffff0000u)};
#pragma unroll
                    for (int j = 0; j < 5; ++j) { const int o = i - j;
                        if (o >= 0 && o < 8) {
#pragma unroll
                            for (int k = 0; k < 4; ++k) val[o][k] = fmaf(wv[j][k], x4[k], val[o][k]); } }
                }
#pragma unroll
                for (int i = 0; i < 8; ++i)
#pragma unroll
                    for (int k = 0; k < 4; ++k) val[i][k] = siluf_(val[i][k]);
                if (kind != 0) {
                    LAS bf16* N = kind == 1 ? Bn : Cn;
#pragma unroll
                    for (int i = 0; i < 8; ++i) { u32x2 o; o.x = pk2(val[i][0], val[i][1]); o.y = pk2(val[i][2], val[i][3]); *(LAS u32x2*)(N + (s0 + i) * SSD_LD + n0 + 4 * hb) = o;
                        if (kind == 2 && (h & 3) == 0) *(u32x2*)(CC + (size_t)(r0 + s0 + i) * 256 + g * 128 + n0 + 4 * hb) = o; }
                }
                if (kind != 2) {
                    LAS bf16* T = kind == 0 ? XT : BT;
#pragma unroll
                    for (int k = 0; k < 4; ++k) { u32x4 o; o.x = pk2(val[0][k], val[1][k]); o.y = pk2(val[2][k], val[3][k]); o.z = pk2(val[4][k], val[5][k]); o.w = pk2(val[6][k], val[7][k]);
                        *(LAS u32x4*)(T + (n0 + 4 * hb + k) * SSD_LD + s0) = o; }
                }
            }
        }
    }
    __syncthreads();
    const int q = F.lane >> 4, c = F.lane & 15, w = F.wave;
    {
        pg8::bf16x8 cfr[4];
#pragma unroll
        for (int ks = 0; ks < 4; ++ks) cfr[ks] = *(const LAS pg8::bf16x8*)(Cn + (16 * w + c) * SSD_LD + 32 * ks + 8 * q);
        f32x4 gt[8];
#pragma unroll
        for (int a = 0; a < 8; ++a) { f32x4 acc = {0.f, 0.f, 0.f, 0.f};
#pragma unroll
            for (int ks = 0; ks < 4; ++ks) acc = __builtin_amdgcn_mfma_f32_16x16x32_bf16(*(const LAS pg8::bf16x8*)(Bn + (16 * a + c) * SSD_LD + 32 * ks + 8 * q), cfr[ks], acc, 0, 0, 0);
            gt[a] = acc; }
        const int t = 16 * w + c; const float cs0t = cs0[t], e1t = ecs1[t], Dh = F.in[I_SD][l * 8 + h];
#pragma unroll
        for (int a = 0; a < 8; ++a) {
            const f32x4 csv = *(const LAS f32x4*)&cs0[16 * a + 4 * q], d0v = *(const LAS f32x4*)&dt0[16 * a + 4 * q], e1v = *(const LAS f32x4*)&ecs1[16 * a + 4 * q], d1v = *(const LAS f32x4*)&dt1[16 * a + 4 * q];
#pragma unroll
            for (int j = 0; j < 4; ++j) { const int sidx = 16 * a + 4 * q + j;
                const float f0 = (sidx <= t) ? __expf(fminf(cs0t - csv[j], 0.f)) * d0v[j] : 0.f;
                const float f1 = (sidx >= t) ? __expf(fminf(e1v[j] - e1t, 0.f)) * d1v[j] : 0.f;
                gt[a][j] = gt[a][j] * (f0 + f1) + ((sidx == t) ? Dh : 0.f); }
        }
        pg8::bf16x8 mfr[4];
#pragma unroll
        for (int i = 0; i < 4; ++i) { u32x4 tq; tq.x = pk2(gt[2 * i][0], gt[2 * i][1]); tq.y = pk2(gt[2 * i][2], gt[2 * i][3]); tq.z = pk2(gt[2 * i + 1][0], gt[2 * i + 1][1]); tq.w = pk2(gt[2 * i + 1][2], gt[2 * i + 1][3]); mfr[i] = __builtin_bit_cast(pg8::bf16x8, tq); }
        bf16* YI = (bf16*)(F.ws + WS_YI);
#pragma unroll
        for (int pt = 0; pt < 4; ++pt) { f32x4 acc = {0.f, 0.f, 0.f, 0.f};
#pragma unroll
            for (int i = 0; i < 4; ++i) { const LAS bf16* xp = XT + (16 * pt + c) * SSD_LD + 32 * i + 4 * q;
                acc = __builtin_amdgcn_mfma_f32_16x16x32_bf16(mk8(*(const LAS u32x2*)xp, *(const LAS u32x2*)(xp + 16)), mfr[i], acc, 0, 0, 0); }
            u32x2 o; o.x = pk2(acc[0], acc[1]); o.y = pk2(acc[2], acc[3]);
            *(u32x2*)(YI + (((size_t)uidx * 32 + pt * 8 + w) * 64 + F.lane) * 4) = o; }
    }
    {
        pg8::bf16x8 btf[4];
#pragma unroll
        for (int ks = 0; ks < 4; ++ks) btf[ks] = *(const LAS pg8::bf16x8*)(BT + (16 * w + c) * SSD_LD + 32 * ks + 8 * q);
        bf16* SST = (bf16*)(F.ws + WS_SST);
#pragma unroll
        for (int d = 0; d < 2; ++d) { const LAS float* wd = d ? w1 : w0;
#pragma unroll
            for (int pt = 0; pt < 4; ++pt) { f32x4 acc = {0.f, 0.f, 0.f, 0.f};
#pragma unroll
                for (int ks = 0; ks < 4; ++ks) {
                    const u32x4 xq = *(const LAS u32x4*)(XT + (16 * pt + c) * SSD_LD + 32 * ks + 8 * q);
                    const f32x4 wa = *(const LAS f32x4*)&wd[32 * ks + 8 * q], wb = *(const LAS f32x4*)&wd[32 * ks + 8 * q + 4];
                    u32x4 sq;
                    sq.x = pk2(__uint_as_float(xq.x << 16) * wa[0], __uint_as_float(xq.x & 0xffff0000u) * wa[1]); sq.y = pk2(__uint_as_float(xq.y << 16) * wa[2], __uint_as_float(xq.y & 0xffff0000u) * wa[3]);
                    sq.z = pk2(__uint_as_float(xq.z << 16) * wb[0], __uint_as_float(xq.z & 0xffff0000u) * wb[1]); sq.w = pk2(__uint_as_float(xq.w << 16) * wb[2], __uint_as_float(xq.w & 0xffff0000u) * wb[3]);
                    acc = __builtin_amdgcn_mfma_f32_16x16x32_bf16(btf[ks], __builtin_bit_cast(pg8::bf16x8, sq), acc, 0, 0, 0); }
                u32x2 o; o.x = pk2(acc[0], acc[1]); o.y = pk2(acc[2], acc[3]);
                *(u32x2*)(SST + (((size_t)uidx * 2 + d) * 64 + 16 * pt + c) * 128 + 16 * w + 4 * q) = o; }
        }
    }
}
__device__ __forceinline__ void ssd_carry(const Frame& F) {
    const int gt = F.bid * NTHR + F.tid, NG = F.G * NTHR;
    const bf16* SST = (const bf16*)(F.ws + WS_SST); bf16* HIN = (bf16*)(F.ws + WS_HIN); const float* TOT = (const float*)(F.ws + WS_TOT);
    for (int i = gt; i < NB * 8 * 2 * 1024; i += NG) {
        const int e8 = i & 1023, d = (i >> 10) & 1, h = (i >> 11) & 7, b = i >> 14;
        float H[8];
#pragma unroll
        for (int k = 0; k < 8; ++k) H[k] = 0.f;
#pragma unroll 2
        for (int j = 0; j < 18; ++j) {
            const int cid = d ? (j < 2 ? 1 - j : 19 - j) : j;
            const size_t ui = (size_t)(b * 18 + cid) * 8 + h, off = ((ui * 2 + d) * 1024 + e8) * 8;
            u32x4 o; o.x = pk2(H[0], H[1]); o.y = pk2(H[2], H[3]); o.z = pk2(H[4], H[5]); o.w = pk2(H[6], H[7]);
            *(u32x4*)(HIN + off) = o;
            float sv[8]; ld8(SST + off, sv);
            const float dec = __expf(TOT[ui * 2 + d]);
#pragma unroll
            for (int k = 0; k < 8; ++k) H[k] = fmaf(H[k], dec, sv[k]);
        }
    }
}
__device__ __forceinline__ void ssd_unit_b(const Frame& F, int l, int uc) {
    const int b = uc / 18, cid = uc % 18, r0 = ssd_row0(b, cid);
    const int q = F.lane >> 4, c = F.lane & 15, w = F.wave;
    const size_t row = (size_t)(r0 + 16 * w + c);
    const bf16* CC = (const bf16*)(F.ws + WS_CC); const bf16* HIN = (const bf16*)(F.ws + WS_HIN); const bf16* YI = (const bf16*)(F.ws + WS_YI); const float* ED = (const float*)(F.ws + WS_EDEC);
    float ss = 0.f;
#pragma unroll 1
    for (int h = 0; h < 8; ++h) {
        const int g = h >> 2;
        pg8::bf16x8 cfr[4];
#pragma unroll
        for (int ks = 0; ks < 4; ++ks) cfr[ks] = *(const pg8::bf16x8*)(CC + row * 256 + g * 128 + 32 * ks + 8 * q);
        const f32x2 ed = *(const f32x2*)(ED + (row * 8 + h) * 2);
        const size_t ui = (size_t)uc * 8 + h;
#pragma unroll
        for (int pt = 0; pt < 4; ++pt) {
            f32x4 a0 = {0.f, 0.f, 0.f, 0.f}, a1 = {0.f, 0.f, 0.f, 0.f};
#pragma unroll
            for (int ks = 0; ks < 4; ++ks) {
                a0 = __builtin_amdgcn_mfma_f32_16x16x32_bf16(*(const pg8::bf16x8*)(HIN + ((ui * 2 + 0) * 64 + 16 * pt + c) * 128 + 32 * ks + 8 * q), cfr[ks], a0, 0, 0, 0);
                a1 = __builtin_amdgcn_mfma_f32_16x16x32_bf16(*(const pg8::bf16x8*)(HIN + ((ui * 2 + 1) * 64 + 16 * pt + c) * 128 + 32 * ks + 8 * q), cfr[ks], a1, 0, 0, 0);
            }
            float yi[4], z[4]; ld4(YI + ((ui * 32 + pt * 8 + w) * 64 + F.lane) * 4, yi); ld4(F.COLS + row * NCOL + h * 64 + 16 * pt + 4 * q, z);
            float v[4];
#pragma unroll
            for (int j = 0; j < 4; ++j) { v[j] = (yi[j] + ed.x * a0[j] + ed.y * a1[j]) * siluf_(z[j]); ss = fmaf(v[j], v[j], ss); }
            u32x2 o; o.x = pk2(v[0], v[1]); o.y = pk2(v[2], v[3]);
            *(u32x2*)(F.MIX + row * 1024 + h * 64 + 16 * pt + 4 * q) = o;
        }
    }
    ss += shx(ss, 16, F.lane); ss += shx(ss, 32, F.lane);
    const float rstd = rsqrtf(ss * (1.f / 512.f) + EPS);
    const float* ng = F.in[I_SNG] + l * 512;
#pragma unroll 4
    for (int k = 0; k < 32; ++k) {
        bf16* mp = F.MIX + row * 1024 + k * 16 + 4 * q;
        float v[4]; ld4(mp, v); const f32x4 gn = *(const f32x4*)(ng + k * 16 + 4 * q);
        u32x2 o; o.x = pk2(v[0] * rstd * gn[0], v[1] * rstd * gn[1]); o.y = pk2(v[2] * rstd * gn[2], v[3] * rstd * gn[3]);
        *(u32x2*)mp = o;
    }
}

__device__ __forceinline__ void phase_p0(const Frame& F0)  {
    Frame F = enter_phase(F0);
    {
        const size_t gt = (size_t)F.bid * NTHR + F.tid, NG = (size_t)F.G * NTHR;
        for (size_t i = gt; i < (size_t)TT * 256; i += NG) {
            const int r = (int)(i >> 8), c4 = (int)(i & 255) * 4;
            f32x4 v;
            if (r < TL) {
                v = *(const f32x4*)(F.in[I_X] + (size_t)r * D + c4);
                const int n = r & (SEQ - 1), rr = n >> 6, cc = n & 63, q = c4 >> 8, ii = c4 & 255;
                const float pos = (float)(q < 2 ? rr : cc);
                float pe[4];
#pragma unroll
                for (int k = 0; k < 4; ++k) {
                    const float invf = expf(-9.210340371976184f * (float)(ii + k) * (1.f / 256.f));
                    float s, c; sincos_red(pos * invf, s, c);
                    pe[k] = (q & 1) ? c : s;
                }
                v.x += pe[0]; v.y += pe[1]; v.z += pe[2]; v.w += pe[3];
            } else {
                v = *(const f32x4*)(F.in[I_CTX] + (size_t)(r - TL) * D + c4);
            }
            *(f32x4*)(F.XS + (size_t)r * D + c4) = v;
        }
    }
    {
        LAS float* scr = (LAS float*)F.lds + F.wave * (64 * 33);
        const int gw = F.bid * NWAVES + F.wave, NGW = F.G * NWAVES;
        constexpr int I_IN = 16 * 73, I_OUT = 16 * 32, I_PW = 4 * 8, I_GLU = 4 * 16, I_L = I_IN + I_OUT + I_PW + I_GLU;
        for (int it = gw; it < 2 * I_L; it += NGW) {
            const int l = it / I_L; int r = it % I_L;
            if (r < I_IN) { transpose_item(F.in[I_WIN] + (size_t)l * D * INC, D, INC, F.WIN_T + (size_t)l * NCOL * D, [](int n) { return n < 1536 ? n : (n < 1552 ? -1 : (n < INC ? n - 16 : -1)); }, scr, r, F.lane); continue; } r -= I_IN;
            if (r < I_OUT) { transpose_item(F.in[I_WOUT] + (size_t)l * D * D, D, D, F.WOUT_T + (size_t)l * D * D, [](int n) { return n; }, scr, r, F.lane); continue; } r -= I_OUT;
            if (r < I_PW) { transpose_item(F.in[I_CPW] + (size_t)l * 256 * 256, 256, 256, F.PW_T + (size_t)l * 256 * 256, [](int n) { return n; }, scr, r, F.lane); continue; } r -= I_PW;
            transpose_item(F.in[I_GLUW] + (size_t)l * 256 * 512, 256, 512, F.GLU_T + (size_t)l * 512 * 256, [](int n) { const int g = n & 255; return (g >> 7) * 256 + (n >> 8) * 128 + (g & 127); }, scr, r, F.lane);
        }
        __syncthreads();
    }
    {
        const int gt = F.bid * NTHR + F.tid, NG = F.G * NTHR;
        f32x2* AA = (f32x2*)(F.ws + WS_S5AA); bf16* BB = (bf16*)(F.ws + WS_S5BB); bf16* CM = (bf16*)(F.ws + WS_S5CM);
        for (int i = gt; i < 2 * 2 * 16 * 64; i += NG) {
            const int p = i & 63, g = (i >> 6) & 15, dir = (i >> 10) & 1, l = i >> 11;
            const float step = expf(F.in[I_LSTEP][(l * 2 + dir) * 16 + g]);
            const float lr = F.in[I_LRE][i], li = F.in[I_LIM][i];
            const float mag = expf(lr * step); float sn, cs; sincos_red(li * step, sn, cs);
            const float ar = mag * cs, ai = mag * sn, inv_den = 1.f / (lr * lr + li * li);
            const float cr = ((ar - 1.f) * lr + ai * li) * inv_den, ci = (ai * lr - (ar - 1.f) * li) * inv_den;
            AA[i] = (f32x2){ar, ai};
            const float* bre = F.in[I_BRE] + ((size_t)(l * 16 + g) * 64 + p) * 16; const float* bim = F.in[I_BIM] + ((size_t)(l * 16 + g) * 64 + p) * 16;
            bf16* o = BB + ((size_t)((l * 2 + dir) * 16 + g) * 128 + 2 * p) * 16;
            for (int h = 0; h < 16; ++h) { const float br = bre[h], bi = bim[h]; o[h] = (bf16)f2bf(cr * br - ci * bi); o[16 + h] = (bf16)f2bf(cr * bi + ci * br); }
        }
        for (int i = gt; i < 2 * 16 * 16 * 64; i += NG) {
            *(unsigned*)(CM + (size_t)i * 2) = pk2(F.in[I_CRE][i], -F.in[I_CIM][i]);
        }
    }
    LAS float* sc = (LAS float*)F.lds;
    for (int it = F.bid; it < 192; it += F.G) {
        const int l = it / 96, kc = (it / 12) % 8, jb = it % 12, j = jb * 512 + F.tid;
        __syncthreads();
        for (int t = F.tid; t < 9 * 128; t += NTHR) {
            const int r9 = t >> 7, kk = t & 127;
            const float cv = r9 < 8 ? F.in[I_C][r9 * D + kc * 128 + kk] : F.in[I_CCTX][kc * 128 + kk];
            sc[t] = siluf_(cv);
        }
        __syncthreads();
        float acc[9];
#pragma unroll
        for (int r9 = 0; r9 < 9; ++r9) acc[r9] = 0.f;
        const float* wp = F.in[I_WADA] + ((size_t)l * D + kc * 128) * 6144 + j;
        for (int kk = 0; kk < 128; ++kk) {
            const float w = wp[(size_t)kk * 6144];
#pragma unroll
            for (int r9 = 0; r9 < 9; ++r9) acc[r9] = fmaf(sc[r9 * 128 + kk], w, acc[r9]);
        }
#pragma unroll
        for (int r9 = 0; r9 < 9; ++r9) F.MODP[((size_t)(kc * 2 + l) * 9 + r9) * 6144 + j] = acc[r9];
    }
}
__device__ __forceinline__ void phase_p1(const Frame& F0)  {
    Frame F = enter_phase(F0);
    const int gt = F.bid * NTHR + F.tid, NG = F.G * NTHR;
    for (int i = gt; i < 2 * 9 * 6144; i += NG) {
        const int j = i % 6144, l = i / (9 * 6144);
        float s = F.in[I_BADA][l * 6144 + j];
#pragma unroll
        for (int kc = 0; kc < 8; ++kc) s += F.MODP[(size_t)kc * 2 * 9 * 6144 + i];
        F.MOD[i] = s;
    }
}
__device__ __forceinline__ LAS int* moe_tables(const Frame& F, int l) {
    LAS int* tab = (LAS int*)(F.lds + TAB_OFF);
    __syncthreads();
    if (F.tid == 0) {
        int bs = 0;
        for (int e = 0; e < NEXP; ++e) { const int c = (int)F.ctl[CW_CNT + l * 64 + e]; tab[e] = bs; tab[40 + e] = c; bs += ((c + 255) / 256) * 256; }
        tab[16] = bs;
    }
    __syncthreads();
    return tab;
}
__device__ __forceinline__ void phase_rowA(const Frame& F0, int l)  {
    Frame F = enter_phase(F0);
    LAS int* tab = (LAS int*)(F.lds + TAB_OFF);
    if (l > 0) tab = moe_tables(F, l - 1);
    LAS float* WDT = (LAS float*)F.lds;
    if (l < DEPTH) {
        __syncthreads();
        for (int i = F.tid; i < 4096; i += NTHR) { const int k = i >> 2, j4 = (i & 3) * 4; *(LAS f32x4*)&WDT[k * 16 + j4] = *(const f32x4*)(F.in[I_WIN] + ((size_t)l * D + k) * INC + 1536 + j4); }
        __syncthreads();
    }
    const int gw = F.bid * NWAVES + F.wave, NGW = F.G * NWAVES;
    const int RL = (l == DEPTH) ? TL : TT;
    const float* gvec = (l == DEPTH) ? F.in[I_GFIN] : F.in[I_GMIX] + l * D;
    for (int r = gw; r < RL; r += NGW) {
        const int mr = modrow(r);
        f32x4 v[4];
#pragma unroll
        for (int j = 0; j < 4; ++j) v[j] = *(const f32x4*)(F.XS + (size_t)r * D + 4 * F.lane + 256 * j);
        if (l > 0) {
            const int4 ti = *(const int4*)(F.TOKI + (size_t)r * 4);
            const f32x2 tw = *(const f32x2*)(F.TOKW + (size_t)r * 2);
            const size_t ra = (size_t)(tab[ti.x] + ti.y), rb = (size_t)(tab[ti.z] + ti.w);
            const float* g2 = F.MOD + ((size_t)(l - 1) * 9 + mr) * 6144 + 5120;
#pragma unroll
            for (int j = 0; j < 4; ++j) {
                const int c = 4 * F.lane + 256 * j;
                float ya[4], yb[4]; ld4(F.YDN + ra * D + c, ya); ld4(F.YDN + rb * D + c, yb);
                const f32x4 g = *(const f32x4*)(g2 + c);
#pragma unroll
                for (int e = 0; e < 4; ++e) v[j][e] += g[e] * (ya[e] * tw.x + yb[e] * tw.y);
            }
            if (l < DEPTH) {
#pragma unroll
                for (int j = 0; j < 4; ++j) *(f32x4*)(F.XS + (size_t)r * D + 4 * F.lane + 256 * j) = v[j];
            }
        }
        float ss = 0.f;
#pragma unroll
        for (int j = 0; j < 4; ++j) ss += (v[j].x * v[j].x + v[j].y * v[j].y) + (v[j].z * v[j].z + v[j].w * v[j].w);
        const float rstd = rsqrtf(wave_sum(ss, F.lane) * (1.f / D) + EPS);
        if (l == DEPTH) {
#pragma unroll
            for (int j = 0; j < 4; ++j) { const int c = 4 * F.lane + 256 * j; const f32x4 g = *(const f32x4*)(gvec + c); *(f32x4*)(F.out + (size_t)r * D + c) = v[j] * rstd * g; }
        } else {
            const float* md = F.MOD + ((size_t)l * 9 + mr) * 6144;
            float dtp[16];
#pragma unroll
            for (int e = 0; e < 16; ++e) dtp[e] = 0.f;
#pragma unroll
            for (int j = 0; j < 4; ++j) {
                const int c = 4 * F.lane + 256 * j;
                const f32x4 g = *(const f32x4*)(gvec + c), sh = *(const f32x4*)(md + c), scl = *(const f32x4*)(md + 1024 + c);
                const f32x4 h = v[j] * rstd * g * (scl + 1.f) + sh;
                u32x2 o; o.x = pk2(h.x, h.y); o.y = pk2(h.z, h.w);
                *(u32x2*)(F.HN + (size_t)r * D + c) = o;
#pragma unroll
                for (int k = 0; k < 4; ++k) {
#pragma unroll
                    for (int e4 = 0; e4 < 4; ++e4) {
                        const f32x4 w = *(const LAS f32x4*)&WDT[(c + k) * 16 + e4 * 4];
#pragma unroll
                        for (int e = 0; e < 4; ++e) dtp[e4 * 4 + e] = fmaf(h[k], w[e], dtp[e4 * 4 + e]);
                    }
                    asm volatile("" ::: "memory");
                }
            }
#pragma unroll
            for (int e = 0; e < 16; ++e) dtp[e] = wave_sum(dtp[e], F.lane);
            if (F.lane == 0) {
#pragma unroll
                for (int e4 = 0; e4 < 4; ++e4) *(f32x4*)(F.DT + (size_t)r * 16 + e4 * 4) = (f32x4){dtp[e4 * 4], dtp[e4 * 4 + 1], dtp[e4 * 4 + 2], dtp[e4 * 4 + 3]};
            }
        }
    }
}
__device__ __forceinline__ void phase_inproj(const Frame& F0, int l)  {
    Frame F = enter_phase(F0);
    pg8::PlainSched S; S.T.init(TT / 256, NCOL / 256, F.G, F.bid); S.Bt = (const char*)(F.WIN_T + (size_t)l * NCOL * D); S.K = D;
    pg8::EpiStoreBf16 E{F.COLS, NCOL, 0, nullptr};
    pg8::gemm_phase<pg8::EpiStoreBf16, pg8::PlainSched, true>(F.lds, F.HN, D, S, E, F.tid);
}
__device__ __forceinline__ void phase_elem(const Frame& F0, int l)  {
    Frame F = enter_phase(F0);
    const size_t gt = (size_t)F.bid * NTHR + F.tid, NG = (size_t)F.G * NTHR;
    {
        LAS float* scr = (LAS float*)F.lds + F.wave * (64 * 33);
        const int gw = F.bid * NWAVES + F.wave, NGW = F.G * NWAVES;
        for (int it = gw; it < 48 * 512; it += NGW) {
            const int mtx = it >> 9, r = it & 511, e = mtx / 3, kind = mtx % 3;
            const size_t wofs = ((size_t)l * NEXP + e) * D * D;
            if (kind == 0) transpose_item(F.in[I_WG] + wofs, D, D, F.WGU_T + (size_t)e * 2048 * D, [](int n) { return (n >> 7) * 256 + (n & 127); }, scr, r, F.lane);
            else if (kind == 1) transpose_item(F.in[I_WU] + wofs, D, D, F.WGU_T + (size_t)e * 2048 * D, [](int n) { return (n >> 7) * 256 + 128 + (n & 127); }, scr, r, F.lane);
            else transpose_item(F.in[I_WD] + wofs, D, D, F.WD_T + (size_t)e * D * D, [](int n) { return n; }, scr, r, F.lane);
        }
    }
    for (size_t i = gt; i < (size_t)TT * 64; i += NG) {
        const int r = (int)(i >> 6), c = (int)(i & 63) * 4;
        float a[4], g[4]; ld4(F.COLS + (size_t)r * NCOL + 1536 + c, a); ld4(F.COLS + (size_t)r * NCOL + 1792 + c, g);
        *(f32x4*)(F.CU + (size_t)r * 256 + c) = (f32x4){a[0] * sigmoidf_(g[0]), a[1] * sigmoidf_(g[1]), a[2] * sigmoidf_(g[2]), a[3] * sigmoidf_(g[3])};
    }
}
__device__ __forceinline__ void phase_scan(const Frame& F0, int l)  {
    Frame F = enter_phase(F0);
    const int RLc = (l == 0) ? TT : TL;
    const int NU = 1152 + 288 + RLc / 64;
    for (int u = F.bid; u < NU; u += F.G) {
        if (u < 1152) {
            ssd_unit_a(F, l, u);
        } else if (u < 1152 + 288) {
            s5_unit<0>(F, l, u - 1152);
        } else {
            const int rbase = (u - 1440) * 64 + F.wave * 8, ch = 4 * F.lane;
            const float* dw = F.in[I_CDW] + (size_t)l * 31 * 256;
            const f32x4 db = *(const f32x4*)(F.in[I_CDB] + l * 256 + ch), lg = *(const f32x4*)(F.in[I_CLG] + l * 256 + ch), lb = *(const f32x4*)(F.in[I_CLB] + l * 256 + ch);
            for (int i = 0; i < 8; ++i) {
                const int r = rbase + i; int lo, hi; seq_bounds(r, lo, hi);
                f32x4 acc = db;
#pragma unroll 1
                for (int j = 0; j < 31; ++j) {
                    const int rr = r + j - 15;
                    if (rr >= lo && rr < hi) acc += *(const f32x4*)(dw + j * 256 + ch) * *(const f32x4*)(F.CU + (size_t)rr * 256 + ch);
                }
                const float mean = wave_sum((acc.x + acc.y) + (acc.z + acc.w), F.lane) * (1.f / 256.f);
                const f32x4 d = acc - mean;
                const float var = wave_sum((d.x * d.x + d.y * d.y) + (d.z * d.z + d.w * d.w), F.lane) * (1.f / 256.f);
                const f32x4 y = d * rsqrtf(var + EPS) * lg + lb;
                u32x2 o; o.x = pk2(siluf_(y.x), siluf_(y.y)); o.y = pk2(siluf_(y.z), siluf_(y.w));
                *(u32x2*)(F.CV + (size_t)r * 256 + ch) = o;
            }
        }
    }
}
__device__ __forceinline__ void phase_carry(const Frame& F0, int l)  {
    Frame F = enter_phase(F0);
    s5_carry(F, l);
    ssd_carry(F);
}
__device__ __forceinline__ void phase_mix1(const Frame& F0, int l)  {
    Frame F = enter_phase(F0);
    const int RL = (l == 0) ? TT : TL;
    for (int u = F.bid; u < 144 + 288; u += F.G) {
        if (u < 144) { if (l == 0 || (u % 18) >= 2) ssd_unit_b(F, l, u); }
        else { const int v = u - 144; if (l == 0 || (v % 36) >= 4) s5_unit<1>(F, l, v); }
    }
    {
        __syncthreads();
        pg8::PlainSched S; S.T.init(RL / 256, 1, F.G, F.bid); S.Bt = (const char*)(F.PW_T + (size_t)l * 256 * 256); S.K = 256;
        pg8::EpiStoreBf16 E{F.MIX, 1024, 512, F.in[I_CPB] + l * 256};
        pg8::gemm_phase<pg8::EpiStoreBf16, pg8::PlainSched, true>(F.lds, F.CV, 256, S, E, F.tid);
    }
}
__device__ __forceinline__ void phase_s5glu(const Frame& F0, int l)  {
    Frame F = enter_phase(F0);
    const int RL = (l == 0) ? TT : TL;
    pg8::PlainSched S; S.T.init(RL / 256, 2, F.G, F.bid); S.Bt = (const char*)(F.GLU_T + (size_t)l * 512 * 256); S.K = 256;
    pg8::EpiPairBf16<1> E{F.MIX, 1024, 768, F.in[I_GLUB] + l * 512, 256};
    pg8::gemm_phase<pg8::EpiPairBf16<1>, pg8::PlainSched, true>(F.lds, F.YG, 256, S, E, F.tid);
}
__device__ __forceinline__ void phase_wout(const Frame& F0, int l)  {
    Frame F = enter_phase(F0);
    const int RL = (l == 0) ? TT : TL;
    pg8::PlainSched S; S.T.init(RL / 256, D / 256, F.G, F.bid); S.Bt = (const char*)(F.WOUT_T + (size_t)l * D * D); S.K = D;
    pg8::EpiResidual E{F.XS, F.MOD + (size_t)l * 9 * 6144 + 2048};
    pg8::gemm_phase<pg8::EpiResidual, pg8::PlainSched, true>(F.lds, F.MIX, D, S, E, F.tid);
}
__device__ __forceinline__ void phase_norm2(const Frame& F0, int l)  {
    Frame F = enter_phase(F0);
    const int RL = (l == 0) ? TT : TL;
    LAS float* RW = (LAS float*)F.lds;
    __syncthreads();
    for (int i = F.tid; i < 1024 * 16 / 4; i += NTHR) *(LAS f32x4*)&RW[i * 4] = *(const f32x4*)(F.in[I_RW] + i * 4);
    __syncthreads();
    const int gw = F.bid * NWAVES + F.wave, NGW = F.G * NWAVES;
    const float* gvec = F.in[I_GFFN] + l * D;
    for (int r = gw; r < RL; r += NGW) {
        const int mr = modrow(r);
        f32x4 v[4]; float ss = 0.f;
#pragma unroll
        for (int j = 0; j < 4; ++j) { v[j] = *(const f32x4*)(F.XS + (size_t)r * D + 4 * F.lane + 256 * j); ss += (v[j].x * v[j].x + v[j].y * v[j].y) + (v[j].z * v[j].z + v[j].w * v[j].w); }
        const float rstd = rsqrtf(wave_sum(ss, F.lane) * (1.f / D) + EPS);
        const float* md = F.MOD + ((size_t)l * 9 + mr) * 6144;
        float lg[16];
#pragma unroll
        for (int e = 0; e < 16; ++e) lg[e] = 0.f;
#pragma unroll
        for (int j = 0; j < 4; ++j) {
            const int c = 4 * F.lane + 256 * j;
            const f32x4 g = *(const f32x4*)(gvec + c), sh = *(const f32x4*)(md + 3072 + c), scl = *(const f32x4*)(md + 4096 + c);
            const f32x4 h = v[j] * rstd * g * (scl + 1.f) + sh;
            u32x2 o; o.x = pk2(h.x, h.y); o.y = pk2(h.z, h.w);
            *(u32x2*)(F.HN + (size_t)r * D + c) = o;
#pragma unroll
            for (int k = 0; k < 4; ++k) {
#pragma unroll
                for (int e4 = 0; e4 < 4; ++e4) {
                    const f32x4 w = *(const LAS f32x4*)&RW[(c + k) * 16 + e4 * 4];
#pragma unroll
                    for (int e = 0; e < 4; ++e) lg[e4 * 4 + e] = fmaf(h[k], w[e], lg[e4 * 4 + e]);
                }
                asm volatile("" ::: "memory");
            }
        }
        float mx = -3.0e38f;
#pragma unroll
        for (int e = 0; e < 16; ++e) { lg[e] = wave_sum(lg[e], F.lane) + F.in[I_RB][e]; mx = fmaxf(mx, lg[e]); }
        float den = 0.f;
#pragma unroll
        for (int e = 0; e < 16; ++e) { lg[e] = expf(lg[e] - mx); den += lg[e]; }
        const float inv = 1.f / den;
#pragma unroll
        for (int e = 0; e < 16; ++e) lg[e] *= inv;
        float gs[4];
#pragma unroll
        for (int gI = 0; gI < 4; ++gI) {
            const float p0 = lg[gI * 4], p1 = lg[gI * 4 + 1], p2 = lg[gI * 4 + 2], p3 = lg[gI * 4 + 3];
            const float h01 = fmaxf(p0, p1), l01 = fminf(p0, p1), h23 = fmaxf(p2, p3), l23 = fminf(p2, p3);
            gs[gI] = fmaxf(h01, h23) + fmaxf(fminf(h01, h23), fmaxf(l01, l23));
        }
        int best = 0; float bsv = gs[0];
#pragma unroll
        for (int gI = 1; gI < 4; ++gI) if (gs[gI] > bsv) { bsv = gs[gI]; best = gI; }
        float q[4];
#pragma unroll
        for (int i = 0; i < 4; ++i) q[i] = best == 0 ? lg[i] : (best == 1 ? lg[4 + i] : (best == 2 ? lg[8 + i] : lg[12 + i]));
        int i0 = 0; float v0 = q[0];
#pragma unroll
        for (int i = 1; i < 4; ++i) if (q[i] > v0) { v0 = q[i]; i0 = i; }
        int i1 = -1; float v1 = -1.f;
#pragma unroll
        for (int i = 0; i < 4; ++i) if (i != i0 && q[i] > v1) { v1 = q[i]; i1 = i; }
        const float ginv = 1.f / (v0 + v1);
        if (F.lane == 0) {
            const int e0 = best * 4 + i0, e1 = best * 4 + i1;
            const int p0 = (int)atomicAdd(&F.ctl[CW_CNT + l * 64 + e0], 1u), p1 = (int)atomicAdd(&F.ctl[CW_CNT + l * 64 + e1], 1u);
            F.LIST[(size_t)e0 * TT + p0] = r; F.LIST[(size_t)e1 * TT + p1] = r;
            *(int4*)(F.TOKI + (size_t)r * 4) = make_int4(e0, p0, e1, p1);
            *(f32x2*)(F.TOKW + (size_t)r * 2) = (f32x2){v0 * ginv, v1 * ginv};
        }
    }
}
__device__ __forceinline__ void phase_gateup(const Frame& F0, int l)  {
    Frame F = enter_phase(F0);
    LAS int* tab = moe_tables(F, l);
    LAS int* rows = (LAS int*)(F.lds + ROWS_OFF);
    pg8::MoeSched<true> S; S.T.init(tab[16] / 256, 8, F.G, F.bid); S.Bt = (const char*)F.WGU_T; S.K = D; S.NE = 2048; S.tab = tab; S.rows = rows;
    {
        pg8::Unit u;
        for (int i = 0; i < 15 && S.next(i, u); ++i) {
            if (F.tid < 256) { const int sr = u.pm * 256 + F.tid, e = S.expert(u.pm), pos = sr - tab[e], cnt = tab[40 + e];
                rows[i * 256 + F.tid] = F.LIST[(size_t)e * TT + (pos < cnt ? pos : 0)]; }
        }
        __syncthreads();
    }
    pg8::EpiPairBf16<0> E{F.HMID, 1024, 0, nullptr, 0};
    pg8::gemm_phase<pg8::EpiPairBf16<0>, pg8::MoeSched<true>, true>(F.lds, F.HN, D, S, E, F.tid);
}
__device__ __forceinline__ void phase_down(const Frame& F0, int l)  {
    Frame F = enter_phase(F0);
    LAS int* tab = moe_tables(F, l);
    pg8::MoeSched<false> S; S.T.init(tab[16] / 256, 4, F.G, F.bid); S.Bt = (const char*)F.WD_T; S.K = D; S.NE = 1024; S.tab = tab; S.rows = nullptr;
    pg8::EpiStoreBf16 E{F.YDN, 1024, 0, nullptr};
    pg8::gemm_phase<pg8::EpiStoreBf16, pg8::MoeSched<false>, true>(F.lds, F.HMID, D, S, E, F.tid);
}

constexpr int PH_PER_LAYER = 11, N_PHASES = 2 + DEPTH * PH_PER_LAYER + 1;

__global__ void __launch_bounds__(NTHR, 2) fwd_kernel(Args args) {
    extern __shared__ __attribute__((aligned(16))) unsigned char lds_raw[];
    Frame F;
    F.lds = (LAS unsigned char*)lds_raw;
    F.tid = threadIdx.x; F.lane = F.tid & 63; F.wave = __builtin_amdgcn_readfirstlane(F.tid >> 6);
    F.G = gridDim.x; F.bid = blockIdx.x;
    F.in = (const CAS cfp_t*)__builtin_amdgcn_kernarg_segment_ptr(); F.out = args.out; F.ws = args.ws;
    frame_ptrs(F, args.ws);
    volatile LAS unsigned* MISC = (volatile LAS unsigned*)(F.lds + MISC_OFF);
    if (F.tid < 32) MISC[F.tid] = 0u;
    __syncthreads();
    const int lo = args.ph_lo, hi = args.ph_hi;
    const bool multi = (hi - lo) > 1;
    XcdBarrier bar; bar.bar = F.ctl + CW_BAR; bar.x = 0; bar.st = MISC + 8;
    if (multi) bar = xcd_barrier_post(F.ctl + CW_BAR, MISC + 8);
#define IN(k) (lo <= (k) && (k) < hi)
#define SEAM(k) do { if (IN(k) && IN((k) + 1)) { XcdBarrier bb_ = bar; asm volatile("" : "+s"(bb_.bar)); xcd_barrier(bb_); } } while (0)
    if (IN(0)) phase_p0(F);
    SEAM(0);
    if (IN(1)) phase_p1(F);
    SEAM(1);
    for (int l = 0; l < DEPTH; ++l) {
        const int pb = 2 + l * PH_PER_LAYER;
        if (IN(pb + 0)) phase_rowA(F, l);
        SEAM(pb + 0);
        if (IN(pb + 1)) phase_inproj(F, l);
        SEAM(pb + 1);
        if (IN(pb + 2)) phase_elem(F, l);
        SEAM(pb + 2);
        if (IN(pb + 3)) phase_scan(F, l);
        SEAM(pb + 3);
        if (IN(pb + 4)) phase_carry(F, l);
        SEAM(pb + 4);
        if (IN(pb + 5)) phase_mix1(F, l);
        SEAM(pb + 5);
        if (IN(pb + 6)) phase_s5glu(F, l);
        SEAM(pb + 6);
        if (IN(pb + 7)) phase_wout(F, l);
        SEAM(pb + 7);
        if (IN(pb + 8)) phase_norm2(F, l);
        SEAM(pb + 8);
        if (IN(pb + 9)) phase_gateup(F, l);
        SEAM(pb + 9);
        if (IN(pb + 10)) phase_down(F, l);
        SEAM(pb + 10);
    }
    if (IN(N_PHASES - 1)) phase_rowA(F, DEPTH);
#undef IN
#undef SEAM
}

extern "C" void kernel_launch(void* const* d_in, const int* in_sizes, int n_in, void* d_out, int out_size, void* d_ws, size_t ws_size, hipStream_t stream) {
    static int grid = 0;
    if (grid == 0) {
        if (n_in != N_IN || out_size != TL * D || ws_size < WS_END) { fprintf(stderr, "kernel_launch: unexpected shapes (n_in %d out %d ws %zu)\n", n_in, out_size, ws_size); grid = -1; return; }
        int dev = 0, cus = 0, per_cu = 0;
        if (hipGetDevice(&dev) != hipSuccess || hipDeviceGetAttribute(&cus, hipDeviceAttributeMultiprocessorCount, dev) != hipSuccess) { grid = -1; return; }
        if (hipFuncSetAttribute((const void*)fwd_kernel, hipFuncAttributeMaxDynamicSharedMemorySize, LDS_BYTES) != hipSuccess) { fprintf(stderr, "kernel_launch: hipFuncSetAttribute failed\n"); grid = -1; return; }
        if (hipOccupancyMaxActiveBlocksPerMultiprocessor(&per_cu, (const void*)fwd_kernel, NTHR, LDS_BYTES) != hipSuccess || per_cu < 1) { fprintf(stderr, "kernel_launch: occupancy query says %d\n", per_cu); }
        (void)hipGetLastError();
        grid = cus;
    }
    if (grid < 0) return;
    if (hipMemsetAsync((char*)d_ws + WS_CTL, 0, CTL_ZERO_BYTES, stream) != hipSuccess) return;
    Args a{};
    for (int i = 0; i < N_IN; ++i) a.in[i] = (const float*)d_in[i];
    a.out = (float*)d_out; a.ws = (unsigned char*)d_ws;
#if MK_ONE_LAUNCH
    a.ph_lo = 0; a.ph_hi = N_PHASES;
    hipLaunchKernelGGL(fwd_kernel, dim3(grid), dim3(NTHR), LDS_BYTES, stream, a);
#else
    for (int p = 0; p < N_PHASES; ++p) { a.ph_lo = p; a.ph_hi = p + 1; hipLaunchKernelGGL(fwd_kernel, dim3(grid), dim3(NTHR), LDS_BYTES, stream, a); }
#endif
}
```

```cpp
#include <hip/hip_runtime.h>
#include <cstdio>
#include <cstdint>

#ifndef MK_ONE_LAUNCH
#define MK_ONE_LAUNCH 1
#endif

#define GAS __attribute__((address_space(1)))
#define LAS __attribute__((address_space(3)))
#define CAS __attribute__((address_space(4)))
typedef const float* cfp_t;
typedef unsigned short bf16;
typedef float f32x4 __attribute__((ext_vector_type(4)));
typedef float f32x2 __attribute__((ext_vector_type(2)));
typedef unsigned u32x4 __attribute__((ext_vector_type(4)));
typedef unsigned u32x2 __attribute__((ext_vector_type(2)));

constexpr int D = 1024, NB = 8, SEQ = 2048, CTXL = 256, DEPTH = 2;
constexpr int TL = NB * SEQ, TC = NB * CTXL, TT = TL + TC;
constexpr int INC = 2320;
constexpr int NCOL = 2304;
constexpr int VSEQ = CTXL + SEQ;
constexpr int NEXP = 16;
constexpr float EPS = 1e-6f;

enum { I_X = 0, I_C, I_CTX, I_CCTX, I_WADA, I_BADA, I_GMIX, I_WIN, I_SCW, I_SCB, I_SDTB, I_SALOG, I_SD, I_SNG,
       I_CDW, I_CDB, I_CLG, I_CLB, I_CPW, I_CPB, I_LRE, I_LIM, I_LSTEP, I_BRE, I_BIM, I_CRE, I_CIM, I_S5D, I_GLUW, I_GLUB,
       I_WOUT, I_GFFN, I_RW, I_RB, I_WG, I_WU, I_WD, I_GFIN, N_IN };

constexpr size_t MiB = 1u << 20;
constexpr size_t WS_CTL = 0, CTL_ZERO_BYTES = 64 * 1024;
constexpr size_t WS_MOD = 1 * MiB;
constexpr size_t WS_MODP = 2 * MiB;
constexpr size_t WS_DT = 6 * MiB;
constexpr size_t WS_S5AA = 5 * MiB + 512 * 1024;
constexpr size_t WS_S5BB = WS_S5AA + 32 * 1024;
constexpr size_t WS_S5CM = WS_S5BB + 256 * 1024;
constexpr size_t WS_TOKI = 7 * MiB + 512 * 1024;
constexpr size_t WS_TOKW = WS_TOKI + (size_t)TT * 16;
constexpr size_t WS_XS = 8 * MiB;
constexpr size_t WS_HN = 80 * MiB;
constexpr size_t WS_COLS = 116 * MiB;
constexpr size_t WS_XBCC = 197 * MiB;
constexpr size_t WS_CC = 197 * MiB;
constexpr size_t WS_YI = 207 * MiB;
constexpr size_t WS_SST = 226 * MiB;
constexpr size_t WS_HIN = 264 * MiB;
constexpr size_t WS_EDEC = 302 * MiB;
constexpr size_t WS_TOT = 304 * MiB;
constexpr size_t WS_YSSD = 233 * MiB;
constexpr size_t WS_MIX = 305 * MiB;
constexpr size_t WS_YS5 = 341 * MiB;
constexpr size_t WS_S5HL = 341 * MiB;
constexpr size_t WS_S5HI = 346 * MiB;
constexpr size_t WS_CU = 377 * MiB;
constexpr size_t WS_CV = 395 * MiB;
constexpr size_t WS_LIST = 413 * MiB;
constexpr size_t WS_WIN_T = 415 * MiB;
constexpr size_t WS_WOUT_T = 424 * MiB;
constexpr size_t WS_PW_T = 428 * MiB;
constexpr size_t WS_GLU_T = 428 * MiB + 512 * 1024;
constexpr size_t WS_WGU_T = 429 * MiB;
constexpr size_t WS_WD_T = 493 * MiB;
constexpr size_t WS_END = 525 * MiB;
constexpr int MOE_ROWS = 2 * TT + NEXP * 256;
constexpr size_t WS_HMID = WS_COLS;
constexpr size_t WS_YDN = WS_XBCC;
constexpr size_t WS_YG = WS_CU;
static_assert(WS_HMID + (size_t)MOE_ROWS * 1024 * 2 <= WS_XBCC, "HMID overlay");
static_assert(WS_YDN + (size_t)MOE_ROWS * 1024 * 2 <= WS_MIX, "YDN overlay");
constexpr int CW_CNT = 64;
constexpr int CW_BAR = 1024;

constexpr int NWAVES = 8, NTHR = 512;
constexpr int LDS_BYTES = 147456;
constexpr int MISC_OFF = 131072 + 320;
constexpr int TAB_OFF = 131072 + 512, ROWS_OFF = TAB_OFF + 256;

__device__ __forceinline__ float bf2f(bf16 v) { return __uint_as_float((unsigned)v << 16); }
__device__ __forceinline__ unsigned f2bf(float f) { unsigned u = __float_as_uint(f); return (u + 0x7fffu + ((u >> 16) & 1u)) >> 16; }
__device__ __forceinline__ unsigned pk2(float lo, float hi) { return f2bf(lo) | (f2bf(hi) << 16); }
__device__ __forceinline__ float shx(float v, int m, int lane) { return __int_as_float(__builtin_amdgcn_ds_bpermute((lane ^ m) << 2, __float_as_int(v))); }
__device__ __forceinline__ float wave_sum(float v, int lane) {
#pragma unroll
    for (int o = 1; o < 64; o <<= 1) v += shx(v, o, lane);
    return v;
}
__device__ __forceinline__ float sigmoidf_(float x) { return 1.f / (1.f + __expf(-x)); }
__device__ __forceinline__ float siluf_(float x) { return x / (1.f + __expf(-x)); }
__device__ __forceinline__ float softplusf_(float x) { return fmaxf(x, 0.f) + log1pf(__expf(-fabsf(x))); }
__device__ __forceinline__ float gelu_tanh(float x) { const float u = 0.7978845608028654f * (x + 0.044715f * x * x * x); return 0.5f * x * (1.f + tanhf(u)); }
__device__ __forceinline__ void sincos_red(float x, float& s, float& c) {
    const float k = rintf(x * 0.15915494309189535f);
    float r = fmaf(-k, 6.2831854820251465f, x); r = fmaf(-k, -1.7484555e-7f, r);
    s = __sinf(r); c = __cosf(r);
}
__device__ __forceinline__ int opaque_v(int v) { asm volatile("" : "+v"(v)); return v; }
__device__ __forceinline__ int modrow(int r) { return r < TL ? (r >> 11) : 8; }
__device__ __forceinline__ void seq_bounds(int r, int& lo, int& hi) {
    if (r < TL) { lo = r & ~(SEQ - 1); hi = lo + SEQ; } else { lo = TL + ((r - TL) & ~(CTXL - 1)); hi = lo + CTXL; }
}
__device__ __forceinline__ int vrow(int b, int dir, int s) {
    if (s < CTXL) return TL + b * CTXL + (dir ? CTXL - 1 - s : s);
    const int t = s - CTXL; return b * SEQ + (dir ? SEQ - 1 - t : t);
}

#define XB_TMO      128
#define XB_XCNT(j)  (256  + 64 * (j))
#define XB_XSUB(j)  (1280 + 64 * (j))
#define XB_XGEN(j)  (2304 + 64 * (j))
#define XB_TOP      3328
#define XB_TOPGEN   3392
#define XCD_BAR_WORDS 3456
#define XB_SPIN_CAP (1u << 18)
__device__ __forceinline__ unsigned xb_ld(unsigned* p)              { return __hip_atomic_load(p, __ATOMIC_RELAXED, __HIP_MEMORY_SCOPE_AGENT); }
__device__ __forceinline__ unsigned xb_add(unsigned* p, unsigned v) { return __hip_atomic_fetch_add(p, v, __ATOMIC_RELAXED, __HIP_MEMORY_SCOPE_AGENT); }
__device__ __forceinline__ unsigned xb_xcc_id() { return (unsigned)__builtin_amdgcn_s_getreg((3 << 11) | 20) & 0xFu; }
#define XB_SPIN(cond, bar) do { unsigned _sp = 0; while (cond) { __builtin_amdgcn_s_sleep(1); \
    if ((++_sp & 255u) == 0u) { if (xb_ld(&(bar)[XB_TMO])) break; if (_sp > XB_SPIN_CAP) { atomicAdd(&(bar)[XB_TMO], 1u); break; } } } } while (0)
struct XcdBarrier { unsigned* bar; unsigned x; volatile LAS unsigned* st; };
__device__ __forceinline__ XcdBarrier xcd_barrier_post(unsigned* bar, volatile LAS unsigned* st) {
    XcdBarrier b; b.bar = bar; b.x = xb_xcc_id(); b.st = st;
    if (threadIdx.x == 0) (void)xb_add(&bar[XB_XCNT(b.x)], 1u);
    return b;
}
__device__ __forceinline__ void xcd_barrier_complete(unsigned* bar, unsigned x, unsigned& nloc, unsigned& nx) {
    const unsigned G = gridDim.x * gridDim.y * gridDim.z;
    unsigned sum, cnt, mine, sp = 0u;
    for (;;) {
        sum = 0u; cnt = 0u; mine = 0u;
#pragma unroll
        for (unsigned j = 0; j < 16; ++j) { const unsigned c = xb_ld(&bar[XB_XCNT(j)]); sum += c; cnt += (c > 0u) ? 1u : 0u; mine = (j == x) ? c : mine; }
        if (sum == G) break;
        __builtin_amdgcn_s_sleep(1);
        if ((++sp & 255u) == 0u) { if (xb_ld(&bar[XB_TMO])) break; if (sp > XB_SPIN_CAP) { atomicAdd(&bar[XB_TMO], 1u); break; } }
    }
    nloc = mine > 0u ? mine : 1u; nx = cnt > 0u ? cnt : 1u;
}
__device__ __forceinline__ void xcd_barrier(const XcdBarrier& b) {
    asm volatile("s_waitcnt vmcnt(0)" ::: "memory");
    __syncthreads();
    if (threadIdx.x == 0) {
        unsigned* bar = b.bar;
        const unsigned bx = xb_xcc_id();
        __builtin_amdgcn_s_waitcnt(0);
        unsigned nloc = b.st[0], nx = b.st[1];
        if (nloc == 0u) { xcd_barrier_complete(bar, bx, nloc, nx); b.st[0] = nloc; b.st[1] = nx; }
        const unsigned old = xb_add(&bar[XB_XSUB(bx)], 1u);
        const unsigned gen = old / nloc;
        if (old + 1u == (gen + 1u) * nloc) {
            __builtin_amdgcn_fence(__ATOMIC_RELEASE, "agent");
            asm volatile("s_waitcnt vmcnt(0)" ::: "memory");
            const unsigned og = xb_add(&bar[XB_TOP], 1u);
            const unsigned tg = og / nx;
            if (og + 1u == (tg + 1u) * nx) xb_add(&bar[XB_TOPGEN], 1u);
            else XB_SPIN(xb_ld(&bar[XB_TOPGEN]) == tg, bar);
            __builtin_amdgcn_fence(__ATOMIC_ACQUIRE, "agent");
            xb_add(&bar[XB_XGEN(bx)], 1u);
            asm volatile("s_waitcnt vmcnt(0)" ::: "memory");
        } else {
            XB_SPIN(xb_ld(&bar[XB_XGEN(bx)]) == gen, bar);
            __builtin_amdgcn_fence(__ATOMIC_ACQUIRE, "agent");
            asm volatile("s_waitcnt vmcnt(0)" ::: "memory");
        }
    }
    __syncthreads();
}

struct Args { const float* in[N_IN]; float* out; unsigned char* ws; int ph_lo, ph_hi; };
struct Frame {
    LAS unsigned char* lds;
    int tid, lane, wave, G, bid;
    const CAS cfp_t* in;
    float* out; unsigned char* ws;
    unsigned* ctl;
    float *MOD, *MODP, *DT, *XS, *YSSD, *YS5, *CU;
    bf16 *HN, *COLS, *XBCC, *MIX, *HMID, *CV, *YG, *YDN, *WIN_T, *WOUT_T, *PW_T, *GLU_T, *WGU_T, *WD_T;
    int* LIST; int* TOKI; float* TOKW;
};
__device__ __forceinline__ void frame_ptrs(Frame& F, unsigned char* ws) {
    F.ws = ws; F.ctl = (unsigned*)(ws + WS_CTL);
    F.MOD = (float*)(ws + WS_MOD); F.MODP = (float*)(ws + WS_MODP); F.DT = (float*)(ws + WS_DT); F.XS = (float*)(ws + WS_XS);
    F.YSSD = (float*)(ws + WS_YSSD); F.YS5 = (float*)(ws + WS_YS5); F.CU = (float*)(ws + WS_CU); F.CV = (bf16*)(ws + WS_CV); F.YDN = (bf16*)(ws + WS_YDN); F.YG = (bf16*)(ws + WS_YG);
    F.WIN_T = (bf16*)(ws + WS_WIN_T); F.WOUT_T = (bf16*)(ws + WS_WOUT_T); F.PW_T = (bf16*)(ws + WS_PW_T); F.GLU_T = (bf16*)(ws + WS_GLU_T); F.WGU_T = (bf16*)(ws + WS_WGU_T); F.WD_T = (bf16*)(ws + WS_WD_T);
    F.HN = (bf16*)(ws + WS_HN); F.COLS = (bf16*)(ws + WS_COLS); F.XBCC = (bf16*)(ws + WS_XBCC); F.MIX = (bf16*)(ws + WS_MIX); F.HMID = (bf16*)(ws + WS_HMID);
    F.LIST = (int*)(ws + WS_LIST); F.TOKI = (int*)(ws + WS_TOKI); F.TOKW = (float*)(ws + WS_TOKW);
}
__device__ __forceinline__ Frame enter_phase(const Frame& F0) {
    Frame F = F0; unsigned om = ~0u; asm volatile("" : "+s"(om)); int ln = (int)__builtin_amdgcn_mbcnt_hi(om, __builtin_amdgcn_mbcnt_lo(om, 0u)); asm volatile("" : "+v"(ln));
    int wv_ = F0.wave, bid_ = F0.bid, g_ = F0.G; asm volatile("" : "+s"(wv_), "+s"(bid_), "+s"(g_));
    F.wave = wv_; F.bid = bid_; F.G = g_; F.lane = ln; F.tid = wv_ * 64 + ln;
    unsigned char* ws = F0.ws; asm volatile("" : "+s"(ws)); frame_ptrs(F, ws);
    const CAS cfp_t* ka = (const CAS cfp_t*)__builtin_amdgcn_kernarg_segment_ptr(); asm volatile("" : "+s"(ka)); F.in = ka;
    return F;
}

__device__ __forceinline__ void ld4(const float* p, float (&v)[4]) { const f32x4 t = *(const f32x4*)p; v[0] = t.x; v[1] = t.y; v[2] = t.z; v[3] = t.w; }
__device__ __forceinline__ void ld4(const bf16* p, float (&v)[4]) { const u32x2 t = *(const u32x2*)p; v[0] = __uint_as_float(t.x << 16); v[1] = __uint_as_float(t.x & 0xffff0000u); v[2] = __uint_as_float(t.y << 16); v[3] = __uint_as_float(t.y & 0xffff0000u); }

__device__ __forceinline__ void ld8(const bf16* p, float (&v)[8]) { const u32x4 t = *(const u32x4*)p;
    v[0] = __uint_as_float(t.x << 16); v[1] = __uint_as_float(t.x & 0xffff0000u); v[2] = __uint_as_float(t.y << 16); v[3] = __uint_as_float(t.y & 0xffff0000u);
    v[4] = __uint_as_float(t.z << 16); v[5] = __uint_as_float(t.z & 0xffff0000u); v[6] = __uint_as_float(t.w << 16); v[7] = __uint_as_float(t.w & 0xffff0000u); }

namespace pg8 {
typedef short bf16x8 __attribute__((ext_vector_type(8)));
constexpr int BM = 256, BK = 64, HALF = 128, HTB = HALF * BK * 2, STAGE_BYTES = 8 * HTB, NXCD = 8, WGM = 8;
__device__ __forceinline__ int lds_byte(int r, int c) { const int st = (r >> 4) * 2 + (c >> 5), rr = r & 15, cc = c & 31, ob = rr * 64 + cc * 2; return st * 1024 + (ob ^ (((ob >> 9) & 1) << 5)); }
__device__ __forceinline__ void stage_rc(int b, int& R, int& C) { const int st = b / 1024, sb = b % 1024, swz = sb ^ (((sb >> 9) & 1) << 5); R = (st >> 1) * 16 + swz / 64; C = (st & 1) * 32 + (swz % 64) / 2; }
__device__ __forceinline__ int perm32(int rho) { const int n = rho >> 4, i = rho & 15; return 8 * (i >> 2) + 4 * n + (i & 3); }
struct Unit { int pm, pn, idx; };
struct TileOrder {
    int nM, nN, nwg, G, c;
    __device__ __forceinline__ void init(int nM_, int nN_, int G_, int c_) { nM = nM_; nN = nN_; nwg = nM * nN; G = G_; c = c_; }
    __device__ __forceinline__ bool next(int i, Unit& u) const {
        const long L = (long)i * G + c; if (L >= nwg) return false;
        int wgid = (int)L; { const int q = nwg / NXCD, r = nwg % NXCD, xcd = wgid % NXCD, off = wgid / NXCD; wgid = (xcd < r ? xcd * (q + 1) : r * (q + 1) + (xcd - r) * q) + off; }
        const int nig = WGM * nN, gid = wgid / nig, fm = gid * WGM, gsz = (nM - fm) < WGM ? (nM - fm) : WGM;
        u.pm = fm + ((wgid % nig) % gsz); u.pn = (wgid % nig) / gsz; u.idx = i; return true;
    }
};
__device__ __forceinline__ unsigned cvt_pk_bf16(float lo, float hi) { unsigned r; asm volatile("v_cvt_pk_bf16_f32 %0, %1, %2" : "=v"(r) : "v"(lo), "v"(hi)); return r; }

template <class Epi, class Sched, bool ALIGN_EPI>
__device__ __forceinline__ void gemm_phase(LAS unsigned char* lds, const bf16* Abase, int K, const Sched& S, const Epi& E, int tid) {
    const int wid = __builtin_amdgcn_readfirstlane(tid >> 6), lane = tid & 63, wr = wid >> 2, wc = wid & 3, fr = lane & 15, fq = lane >> 4;
    const int nt = K / BK;
    unsigned voffB[2];
#pragma unroll
    for (int i = 0; i < 2; ++i) { int R, C; stage_rc(tid * 16 + i * 8192, R, C); const int Rb = Epi::PERM ? ((R & ~31) + perm32(R & 31)) : R; voffB[i] = (unsigned)(Rb * K + C) * 2u; }
    const size_t kstep = (size_t)(BK * 2);
    const size_t hstep = (size_t)HALF * K * 2;
    const unsigned ldsw = (unsigned)wid * 1024u;
    const int aoff = lds_byte(wr * 64 + fr, fq * 8), boff = lds_byte(wc * 32 + fr, fq * 8);
#define PG8_SA(b, h) (((b) * 2 + (h)) * HTB)
#define PG8_SB(b, h) ((4 + (b) * 2 + (h)) * HTB)
#define PG8_STAGE(bufoff, gbase, voff) do { _Pragma("unroll") for (int _i = 0; _i < 2; ++_i) \
        __builtin_amdgcn_global_load_lds((const unsigned*)((const char*)(gbase) + (voff)[_i]), (LAS unsigned*)(lds + (bufoff) + ldsw + _i * 8192), 16, 0, 0); } while (0)
#define PG8_LDA(dst, b, h) do { _Pragma("unroll") for (int m = 0; m < 4; ++m) _Pragma("unroll") for (int k = 0; k < 2; ++k) dst[m][k] = *(const LAS bf16x8*)(lds + PG8_SA(b, h) + aoff + m * 2048 + k * 1024); } while (0)
#define PG8_LDB(dst, b, h) do { _Pragma("unroll") for (int n = 0; n < 2; ++n) _Pragma("unroll") for (int k = 0; k < 2; ++k) dst[n][k] = *(const LAS bf16x8*)(lds + PG8_SB(b, h) + boff + n * 2048 + k * 1024); } while (0)
#define PG8_MMA(ai, bj, At, Bt) do { __builtin_amdgcn_s_setprio(1); _Pragma("unroll") for (int m = 0; m < 4; ++m) _Pragma("unroll") for (int n = 0; n < 2; ++n) _Pragma("unroll") for (int k = 0; k < 2; ++k) \
        acc[ai][bj][m][n] = __builtin_amdgcn_mfma_f32_16x16x32_bf16(Bt[n][k], At[m][k], acc[ai][bj][m][n], 0, 0, 0); __builtin_amdgcn_s_setprio(0); } while (0)
#define PG8_WAIT_V(n) asm volatile("s_waitcnt vmcnt(" #n ")" ::: "memory")
#define PG8_WAIT_L(n) asm volatile("s_waitcnt lgkmcnt(" #n ")" ::: "memory")
#define PG8_BAR __builtin_amdgcn_s_barrier()
#define PG8_SCHED __builtin_amdgcn_sched_barrier(0)
#define PG8_SETV(v, u) do { _Pragma("unroll") for (int _i = 0; _i < 2; ++_i) { int _R, _C; stage_rc(tid * 16 + _i * 8192, _R, _C); _Pragma("unroll") for (int _h = 0; _h < 2; ++_h) v[_h][_i] = (unsigned)(S.arow(u, _h * HALF + _R) * K + _C) * 2u; } } while (0)
    Unit cur, nxt; int ui = 0;
    if (!S.next(0, cur)) return;
    f32x4 acc[2][2][4][2];
#pragma unroll
    for (int a = 0; a < 2; ++a)
#pragma unroll
        for (int b = 0; b < 2; ++b)
#pragma unroll
            for (int m = 0; m < 4; ++m)
#pragma unroll
                for (int n = 0; n < 2; ++n) acc[a][b][m][n] = (f32x4){0.f, 0.f, 0.f, 0.f};
    bf16x8 At[4][2], B0[2][2], B1[2][2];
    unsigned vC[2][2], vN[2][2];
    PG8_SETV(vC, cur);
    const char* cA = (const char*)Abase; const char* cB = S.bbase(cur);
    PG8_WAIT_L(0);
    PG8_STAGE(PG8_SB(0, 0), cB, voffB); PG8_STAGE(PG8_SB(0, 1), cB + hstep, voffB); PG8_STAGE(PG8_SA(0, 0), cA, vC[0]); PG8_STAGE(PG8_SA(0, 1), cA, vC[1]);
    if (wr == 1) PG8_BAR;
    PG8_WAIT_V(2); PG8_BAR;
    PG8_STAGE(PG8_SB(1, 0), cB + kstep, voffB); PG8_STAGE(PG8_SA(1, 0), cA + kstep, vC[0]); PG8_STAGE(PG8_SB(1, 1), cB + hstep + kstep, voffB);
    PG8_WAIT_V(6); PG8_BAR;
    for (;;) {
        const bool has_next = S.next(ui + 1, nxt);
        const char* nB = cB;
        if (has_next) { PG8_SETV(vN, nxt); nB = S.bbase(nxt); }
        else {
#pragma unroll
            for (int _h = 0; _h < 2; ++_h)
#pragma unroll
                for (int _i = 0; _i < 2; ++_i) vN[_h][_i] = vC[_h][_i];
        }
        PG8_WAIT_L(0);
#pragma unroll 1
        for (int t = 0; t < nt; t += 2) {
            const bool last = (t == nt - 2);
            const char* a1 = cA + (size_t)(t + 1) * kstep;
            const char* a2 = last ? cA : cA + (size_t)(t + 2) * kstep; const char* b2 = last ? nB : cB + (size_t)(t + 2) * kstep;
            const char* a3 = a2 + kstep; const char* b3 = b2 + kstep;
            PG8_LDB(B0, 0, 0); PG8_LDB(B1, 0, 1); PG8_SCHED; PG8_LDA(At, 0, 0); PG8_STAGE(PG8_SA(1, 1), a1, vC[1]);
            if (last) {
#pragma unroll
                for (int _h = 0; _h < 2; ++_h)
#pragma unroll
                    for (int _i = 0; _i < 2; ++_i) vC[_h][_i] = vN[_h][_i];
            }
            PG8_WAIT_V(8); PG8_WAIT_L(0); PG8_BAR; PG8_MMA(0, 0, At, B0); PG8_MMA(0, 1, At, B1); PG8_BAR; PG8_SCHED;
            PG8_LDA(At, 0, 1); PG8_STAGE(PG8_SB(0, 0), b2, voffB); PG8_STAGE(PG8_SB(0, 1), b2 + hstep, voffB); PG8_STAGE(PG8_SA(0, 0), a2, vC[0]);
            PG8_WAIT_V(8); PG8_WAIT_L(0); PG8_BAR; PG8_MMA(1, 0, At, B0); PG8_MMA(1, 1, At, B1); PG8_BAR; PG8_SCHED;
            PG8_LDB(B0, 1, 0); PG8_LDB(B1, 1, 1); PG8_SCHED; PG8_LDA(At, 1, 0); PG8_STAGE(PG8_SA(0, 1), a2, vC[1]);
            PG8_WAIT_V(8); PG8_WAIT_L(0); PG8_BAR; PG8_MMA(0, 0, At, B0); PG8_MMA(0, 1, At, B1); PG8_BAR; PG8_SCHED;
            PG8_LDA(At, 1, 1); PG8_STAGE(PG8_SB(1, 0), b3, voffB); PG8_STAGE(PG8_SB(1, 1), b3 + hstep, voffB); PG8_STAGE(PG8_SA(1, 0), a3, vC[0]);
            PG8_WAIT_V(8); PG8_WAIT_L(0); PG8_BAR; PG8_MMA(1, 0, At, B0); PG8_MMA(1, 1, At, B1); PG8_BAR; PG8_SCHED;
        }
        if constexpr (ALIGN_EPI) { if (wr == 0) PG8_BAR; }
        E(acc, cur, wr, wc, fr, fq);
        if (!has_next) break;
#pragma unroll
        for (int a = 0; a < 2; ++a)
#pragma unroll
            for (int b = 0; b < 2; ++b)
#pragma unroll
                for (int m = 0; m < 4; ++m)
#pragma unroll
                    for (int n = 0; n < 2; ++n) acc[a][b][m][n] = (f32x4){0.f, 0.f, 0.f, 0.f};
        cur = nxt; cB = nB; ++ui;
        if constexpr (ALIGN_EPI) { if (wr == 1) PG8_BAR; }
    }
    PG8_WAIT_V(0);
    if constexpr (!ALIGN_EPI) { if (wr == 0) PG8_BAR; }
    PG8_BAR;
#undef PG8_SA
#undef PG8_SB
#undef PG8_STAGE
#undef PG8_LDA
#undef PG8_LDB
#undef PG8_MMA
#undef PG8_WAIT_V
#undef PG8_WAIT_L
#undef PG8_BAR
#undef PG8_SCHED
#undef PG8_SETV
}

struct PlainSched {
    TileOrder T; const char* Bt; int K;
    __device__ __forceinline__ bool next(int i, Unit& u) const { return T.next(i, u); }
    __device__ __forceinline__ int arow(const Unit& u, int r) const { return u.pm * BM + r; }
    __device__ __forceinline__ const char* bbase(const Unit& u) const { return Bt + (size_t)u.pn * BM * K * 2; }
};
template <bool GATHER> struct MoeSched {
    TileOrder T; const char* Bt; int K, NE; const LAS int* tab; const LAS int* rows;
    __device__ __forceinline__ bool next(int i, Unit& u) const { return T.next(i, u); }
    __device__ __forceinline__ int expert(int pm) const { const int s = pm * BM; int e = 0;
#pragma unroll
        for (int k = 1; k < NEXP; ++k) if (s >= tab[k]) e = k;
        return e; }
    __device__ __forceinline__ int arow(const Unit& u, int r) const { return GATHER ? rows[u.idx * BM + r] : u.pm * BM + r; }
    __device__ __forceinline__ const char* bbase(const Unit& u) const { return Bt + ((size_t)expert(u.pm) * NE + (size_t)u.pn * BM) * K * 2; }
};
struct EpiStoreBf16 {
    static constexpr bool PERM = true;
    bf16* O; int ldc, col0; const float* bias;
    __device__ __forceinline__ void operator()(const f32x4 (&acc)[2][2][4][2], const Unit& u, int wr, int wc, int fr, int fq) const {
        const int row0 = u.pm * BM + wr * 64 + fr, ct0 = u.pn * BM + wc * 32 + 8 * fq;
        f32x4 bv[2][2];
#pragma unroll
        for (int bj = 0; bj < 2; ++bj)
#pragma unroll
            for (int n = 0; n < 2; ++n) bv[bj][n] = bias ? *(const f32x4*)(bias + ct0 + bj * HALF + 4 * n) : (f32x4){0.f, 0.f, 0.f, 0.f};
#pragma unroll
        for (int ai = 0; ai < 2; ++ai)
#pragma unroll
            for (int m = 0; m < 4; ++m) { bf16* rowp = O + (size_t)(row0 + ai * HALF + m * 16) * ldc + col0 + ct0;
#pragma unroll
                for (int bj = 0; bj < 2; ++bj) { const f32x4 v0 = acc[ai][bj][m][0] + bv[bj][0], v1 = acc[ai][bj][m][1] + bv[bj][1];
                    u32x4 w; w.x = cvt_pk_bf16(v0[0], v0[1]); w.y = cvt_pk_bf16(v0[2], v0[3]); w.z = cvt_pk_bf16(v1[0], v1[1]); w.w = cvt_pk_bf16(v1[2], v1[3]);
                    *(u32x4*)(rowp + bj * HALF) = w; } }
    }
};
template <int ACT>
struct EpiPairBf16 {
    static constexpr bool PERM = true;
    bf16* O; int ldc, col0; const float* bias; int nb;
    __device__ __forceinline__ void operator()(const f32x4 (&acc)[2][2][4][2], const Unit& u, int wr, int wc, int fr, int fq) const {
        const int row0 = u.pm * BM + wr * 64 + fr, ct0 = u.pn * HALF + wc * 32 + 8 * fq;
        f32x4 ba[2], bb[2];
#pragma unroll
        for (int n = 0; n < 2; ++n) { ba[n] = (ACT == 1) ? *(const f32x4*)(bias + ct0 + 4 * n) : (f32x4){0.f, 0.f, 0.f, 0.f}; bb[n] = (ACT == 1) ? *(const f32x4*)(bias + nb + ct0 + 4 * n) : (f32x4){0.f, 0.f, 0.f, 0.f}; }
#pragma unroll
        for (int ai = 0; ai < 2; ++ai)
#pragma unroll
            for (int m = 0; m < 4; ++m) {
                float o[8];
#pragma unroll
                for (int n = 0; n < 2; ++n)
#pragma unroll
                    for (int j = 0; j < 4; ++j) { const float a = acc[ai][0][m][n][j] + ba[n][j], b = acc[ai][1][m][n][j] + bb[n][j];
                        o[n * 4 + j] = (ACT == 0) ? (a / (1.f + __expf(-a))) * b : a / (1.f + __expf(-b)); }
                u32x4 w; w.x = cvt_pk_bf16(o[0], o[1]); w.y = cvt_pk_bf16(o[2], o[3]); w.z = cvt_pk_bf16(o[4], o[5]); w.w = cvt_pk_bf16(o[6], o[7]);
                *(u32x4*)(O + (size_t)(row0 + ai * HALF + m * 16) * ldc + col0 + ct0) = w; }
    }
};
struct EpiResidual {
    static constexpr bool PERM = false;
    float* XS; const float* g1;
    __device__ __forceinline__ void operator()(const f32x4 (&acc)[2][2][4][2], const Unit& u, int wr, int wc, int fr, int fq) const {
        const int row0 = u.pm * BM + wr * 64 + fr, ct0 = u.pn * BM + wc * 32 + 4 * fq;
#pragma unroll
        for (int ai = 0; ai < 2; ++ai)
#pragma unroll
            for (int m = 0; m < 4; ++m) { const int row = row0 + ai * HALF + m * 16; float* xp = XS + (size_t)row * D + ct0; const float* gp = g1 + (size_t)modrow(row) * 6144 + ct0;
#pragma unroll
                for (int bj = 0; bj < 2; ++bj)
#pragma unroll
                    for (int n = 0; n < 2; ++n) { const int o = bj * HALF + n * 16; const f32x4 g = *(const f32x4*)(gp + o); f32x4 x = *(const f32x4*)(xp + o); x += g * acc[ai][bj][m][n]; *(f32x4*)(xp + o) = x; }
                if (m & 1) asm volatile("" ::: "memory"); }
    }
};
}

template <class RowMap>
__device__ __forceinline__ void transpose_item(const float* W, int K, int N, bf16* WT, const RowMap& rowmap, LAS float* scr, int item, int lane) {
    const int nblk = (N + 31) / 32, kb = item / nblk, nb = item % nblk, k0 = 64 * kb, n0 = 32 * nb;
    const bool cok = n0 + (lane & 31) < N;
#pragma unroll 8
    for (int i = 0; i < 32; ++i) { const int kk = 2 * i + (lane >> 5); scr[kk * 33 + (lane & 31)] = cok ? W[(size_t)(k0 + kk) * N + n0 + (lane & 31)] : 0.f; }
    asm volatile("s_waitcnt lgkmcnt(0)" ::: "memory");
    const int c = lane & 7;
#pragma unroll
    for (int j = 0; j < 4; ++j) { const int n = (lane >> 3) + 8 * j; const LAS float* sp = scr + (8 * c) * 33 + n;
        u32x4 o; o.x = pk2(sp[0 * 33], sp[1 * 33]); o.y = pk2(sp[2 * 33], sp[3 * 33]); o.z = pk2(sp[4 * 33], sp[5 * 33]); o.w = pk2(sp[6 * 33], sp[7 * 33]);
        const int dr = rowmap(n0 + n);
        if (dr >= 0) *(u32x4*)(WT + (size_t)dr * K + k0 + 8 * c) = o; }
    asm volatile("s_waitcnt lgkmcnt(0)" ::: "memory");
}


typedef short bf16x4s __attribute__((ext_vector_type(4)));
constexpr int S5_US = 264;
constexpr int S5_WS = 136;
__device__ __forceinline__ int s5_row0(int b, int c) { return c < 4 ? TL + b * CTXL + c * 64 : b * SEQ + (c - 4) * 64; }
template <int PASS>
__device__ __forceinline__ void s5_unit(const Frame& F, int l, int uidx) {
    const int b = uidx / 36, c = uidx % 36, r0 = s5_row0(b, c);
    LAS bf16* U = (LAS bf16*)F.lds;
    __syncthreads();
    for (int i = F.tid; i < 64 * 32; i += NTHR) { const int row = i >> 5, c8 = i & 31; *(LAS u32x4*)(U + row * S5_US + c8 * 8) = *(const u32x4*)(F.COLS + (size_t)(r0 + row) * NCOL + 2048 + c8 * 8); }
    __syncthreads();
    LAS bf16* BuS = (LAS bf16*)(F.lds + 64 * S5_US * 2 + F.wave * (2 * 16 * S5_WS * 2)); LAS bf16* Hs = BuS + 16 * S5_WS;
    int lane_ = F.lane; asm volatile("" : "+v"(lane_));
    const int q = lane_ >> 4, c16 = lane_ & 15, p = lane_;
    const f32x2* AA = (const f32x2*)(F.ws + WS_S5AA); const bf16* BB = (const bf16*)(F.ws + WS_S5BB); const bf16* CM = (const bf16*)(F.ws + WS_S5CM);
    f32x2* HL = (f32x2*)(F.ws + WS_S5HL); const f32x2* HI = (const f32x2*)(F.ws + WS_S5HI);
#pragma unroll 1
    for (int gi = 0; gi < 2; ++gi) {
        const int g = F.wave * 2 + gi;
        f32x4 yacc[4];
#pragma unroll
        for (int rs = 0; rs < 4; ++rs) yacc[rs] = (f32x4){0.f, 0.f, 0.f, 0.f};
        pg8::bf16x8 cm[4];
        if (PASS == 1) {
#pragma unroll
            for (int ks = 0; ks < 4; ++ks) cm[ks] = *(const pg8::bf16x8*)(CM + ((size_t)(l * 16 + g) * 16 + c16) * 128 + 32 * ks + 8 * q);
        }
#pragma unroll
        for (int dir = 0; dir < 2; ++dir) {
            const int pidx = ((l * 2 + dir) * 16 + g);
            const f32x2 aa = AA[pidx * 64 + p]; const float ar = aa.x, ai = aa.y;
            bf16x4s bb[8];
#pragma unroll
            for (int rt = 0; rt < 8; ++rt) bb[rt] = *(const bf16x4s*)(BB + ((size_t)pidx * 128 + 16 * rt + c16) * 16 + 4 * q);
            const size_t sidx = ((size_t)(b * 36 + c) * 32 + g * 2 + dir) * 64 + p;
            float hr = 0.f, hi = 0.f;
            if (PASS == 1) { const f32x2 h0 = HI[sidx]; hr = h0.x; hi = h0.y; }
#pragma unroll
            for (int sci = 0; sci < 4; ++sci) {
                const int rs = dir ? 3 - sci : sci;
                const bf16x4s bop = *(const LAS bf16x4s*)(U + (16 * rs + c16) * S5_US + g * 16 + 4 * q);
#pragma unroll
                for (int rt = 0; rt < 8; ++rt) {
                    const f32x4 a = __builtin_amdgcn_mfma_f32_16x16x16bf16_1k(bb[rt], bop, (f32x4){0.f, 0.f, 0.f, 0.f}, 0, 0, 0);
                    u32x2 w; w.x = pk2(a[0], a[1]); w.y = pk2(a[2], a[3]);
                    *(LAS u32x2*)(BuS + c16 * S5_WS + 16 * rt + 4 * q) = w;
                }
                asm volatile("s_waitcnt lgkmcnt(0)" ::: "memory");
                unsigned bu[16];
#pragma unroll
                for (int st = 0; st < 16; ++st) bu[st] = *(const LAS unsigned*)(BuS + (dir ? 15 - st : st) * S5_WS + 2 * p);
#pragma unroll
                for (int st = 0; st < 16; ++st) {
                    const float bur = __uint_as_float(bu[st] << 16), bui = __uint_as_float(bu[st] & 0xffff0000u);
                    const float nr = fmaf(ar, hr, fmaf(-ai, hi, bur)), ni = fmaf(ar, hi, fmaf(ai, hr, bui)); hr = nr; hi = ni;
                    if (PASS == 1) *(LAS unsigned*)(Hs + (dir ? 15 - st : st) * S5_WS + 2 * p) = pk2(hr, hi);
                }
                if (PASS == 1) {
                    asm volatile("s_waitcnt lgkmcnt(0)" ::: "memory");
#pragma unroll
                    for (int ks = 0; ks < 4; ++ks) { const pg8::bf16x8 hf = *(const LAS pg8::bf16x8*)(Hs + c16 * S5_WS + 32 * ks + 8 * q);
                        yacc[rs] = __builtin_amdgcn_mfma_f32_16x16x32_bf16(cm[ks], hf, yacc[rs], 0, 0, 0); }
                }
                asm volatile("s_waitcnt lgkmcnt(0)" ::: "memory");
            }
            if (PASS == 0) HL[sidx] = (f32x2){hr, hi};
        }
        if (PASS == 1) {
            const f32x4 dsk = *(const f32x4*)(F.in[I_S5D] + l * 256 + g * 16 + 4 * q);
#pragma unroll
            for (int rs = 0; rs < 4; ++rs) {
                float u4[4]; { const u32x2 t = *(const LAS u32x2*)(U + (16 * rs + c16) * S5_US + g * 16 + 4 * q);
                    u4[0] = __uint_as_float(t.x << 16); u4[1] = __uint_as_float(t.x & 0xffff0000u); u4[2] = __uint_as_float(t.y << 16); u4[3] = __uint_as_float(t.y & 0xffff0000u); }
                float o[4];
#pragma unroll
                for (int j = 0; j < 4; ++j) o[j] = gelu_tanh(yacc[rs][j] + dsk[j] * u4[j]);
                u32x2 w; w.x = pk2(o[0], o[1]); w.y = pk2(o[2], o[3]);
                *(u32x2*)(F.YG + (size_t)(r0 + 16 * rs + c16) * 256 + g * 16 + 4 * q) = w;
            }
        }
    }
}
__device__ __forceinline__ void s5_carry(const Frame& F, int l) {
    const int gt = F.bid * NTHR + F.tid, NG = F.G * NTHR;
    const f32x2* AA = (const f32x2*)(F.ws + WS_S5AA); const f32x2* HL = (const f32x2*)(F.ws + WS_S5HL); f32x2* HI = (f32x2*)(F.ws + WS_S5HI);
    for (int i = gt; i < NB * 32 * 64; i += NG) {
        const int p = i & 63, gd = (i >> 6) & 31, b = i >> 11, g = gd >> 1, dir = gd & 1;
        f32x2 a = AA[((l * 2 + dir) * 16 + g) * 64 + p];
#pragma unroll
        for (int k = 0; k < 6; ++k) a = (f32x2){a.x * a.x - a.y * a.y, 2.f * a.x * a.y};
        float hr = 0.f, hi = 0.f;
#pragma unroll 4
        for (int j = 0; j < 36; ++j) {
            const int c = dir ? (j < 4 ? 3 - j : 39 - j) : j;
            const size_t idx = ((size_t)(b * 36 + c) * 32 + gd) * 64 + p;
            HI[idx] = (f32x2){hr, hi};
            const f32x2 hl = HL[idx];
            const float nr = a.x * hr - a.y * hi + hl.x, ni = a.x * hi + a.y * hr + hl.y; hr = nr; hi = ni;
        }
    }
}


constexpr int SSD_LD = 136;
__device__ __forceinline__ int ssd_row0(int b, int cid) { return cid < 2 ? TL + b * CTXL + cid * 128 : b * SEQ + (cid - 2) * 128; }
__device__ __forceinline__ pg8::bf16x8 mk8(u32x2 lo, u32x2 hi) { u32x4 t; t.x = lo.x; t.y = lo.y; t.z = hi.x; t.w = hi.y; return __builtin_bit_cast(pg8::bf16x8, t); }
__device__ __forceinline__ void ssd_unit_a(const Frame& F, int l, int uidx) {
    const int h = uidx & 7, uc = uidx >> 3, b = uc / 18, cid = uc % 18, g = h >> 2, r0 = ssd_row0(b, cid);
    LAS bf16* XT = (LAS bf16*)F.lds; LAS bf16* Bn = XT + 64 * SSD_LD; LAS bf16* BT = Bn + 128 * SSD_LD; LAS bf16* Cn = BT + 128 * SSD_LD;
    LAS float* cs0 = (LAS float*)(Cn + 128 * SSD_LD); LAS float* ecs1 = cs0 + 128; LAS float* dt0 = ecs1 + 128; LAS float* dt1 = dt0 + 128; LAS float* w0 = dt1 + 128; LAS float* w1 = w0 + 128;
    __syncthreads();
    if (F.wave == 0) {
        const float A0 = -expf(F.in[I_SALOG][l * 16 + h]), A1 = -expf(F.in[I_SALOG][l * 16 + 8 + h]);
        const float db0 = F.in[I_SDTB][l * 16 + h], db1 = F.in[I_SDTB][l * 16 + 8 + h];
        const int t0 = 2 * F.lane;
        const float d00 = softplusf_(F.DT[(size_t)(r0 + t0) * 16 + h] + db0), d01 = softplusf_(F.DT[(size_t)(r0 + t0 + 1) * 16 + h] + db0);
        const float d10 = softplusf_(F.DT[(size_t)(r0 + t0) * 16 + 8 + h] + db1), d11 = softplusf_(F.DT[(size_t)(r0 + t0 + 1) * 16 + 8 + h] + db1);
        const float a00 = d00 * A0, a01 = d01 * A0, a10 = d10 * A1, a11 = d11 * A1;
        float p0 = a00 + a01, p1 = a10 + a11;
#pragma unroll
        for (int o = 1; o < 64; o <<= 1) { const float u0 = __int_as_float(__builtin_amdgcn_ds_bpermute((F.lane - o) << 2, __float_as_int(p0))), u1 = __int_as_float(__builtin_amdgcn_ds_bpermute((F.lane - o) << 2, __float_as_int(p1)));
            if (F.lane >= o) { p0 += u0; p1 += u1; } }
        const float tot0 = __int_as_float(__builtin_amdgcn_readlane(__float_as_int(p0), 63)), tot1 = __int_as_float(__builtin_amdgcn_readlane(__float_as_int(p1), 63));
        const float c01 = p0, c00 = p0 - a01;
        const float e11 = p1 - a11, e10 = e11 - a10;
        cs0[t0] = c00; cs0[t0 + 1] = c01; ecs1[t0] = e10; ecs1[t0 + 1] = e11; dt0[t0] = d00; dt0[t0 + 1] = d01; dt1[t0] = d10; dt1[t0 + 1] = d11;
        w0[t0] = __expf(tot0 - c00) * d00; w0[t0 + 1] = __expf(tot0 - c01) * d01; w1[t0] = __expf(e10) * d10; w1[t0 + 1] = __expf(e11) * d11;
        float* ed = (float*)(F.ws + WS_EDEC) + ((size_t)(r0 + t0) * 8 + h) * 2;
        ed[0] = __expf(c00); ed[1] = __expf(tot1 - e10); ed[16] = __expf(c01); ed[17] = __expf(tot1 - e11);
        if (F.lane == 0) { float* tt = (float*)(F.ws + WS_TOT) + ((size_t)uc * 8 + h) * 2; tt[0] = tot0; tt[1] = tot1; }
    }
    {
        int lo, hi; seq_bounds(r0, lo, hi);
        const float* cw = F.in[I_SCW] + (size_t)l * 5 * 1024; const float* cb = F.in[I_SCB] + l * 1024;
        bf16* CC = (bf16*)(F.ws + WS_CC);
        for (int it = F.tid; it < 640; it += NTHR) {
            const int oct = it % 40, seg = it / 40, s0 = seg * 8;
            const int kind = oct < 8 ? 0 : (oct < 24 ? 1 : 2);
            const int n0 = kind == 0 ? oct * 8 : (kind == 1 ? (oct - 8) * 8 : (oct - 24) * 8);
            const int xch = kind == 0 ? h * 64 + n0 : (kind == 1 ? 512 + g * 128 + n0 : 768 + g * 128 + n0);
            u32x4 xr[12];
            const bool lo_ok = (r0 + s0 - 2) >= lo, hi_ok = (r0 + s0 + 9) < hi;
            const bf16* xp = F.COLS + (size_t)(r0 + s0) * NCOL + 512 + xch;
#pragma unroll
            for (int i = 2; i < 10; ++i) xr[i] = *(const u32x4*)(xp + (i - 2) * NCOL);
            xr[0] = xr[2]; xr[1] = xr[2]; xr[10] = xr[9]; xr[11] = xr[9];
            if (lo_ok) { xr[0] = *(const u32x4*)(xp - 2 * NCOL); xr[1] = *(const u32x4*)(xp - NCOL); } else { xr[0] = (u32x4){0u, 0u, 0u, 0u}; xr[1] = xr[0]; }
            if (hi_ok) { xr[10] = *(const u32x4*)(xp + 8 * NCOL); xr[11] = *(const u32x4*)(xp + 9 * NCOL); } else { xr[10] = (u32x4){0u, 0u, 0u, 0u}; xr[11] = xr[10]; }
#pragma unroll
            for (int hb = 0; hb < 2; ++hb) {
                float wv[5][4]; float val[8][4];
#pragma unroll
                for (int j = 0; j < 5; ++j) { const f32x4 t = *(const f32x4*)(cw + j * 1024 + xch + 4 * hb); wv[j][0] = t.x; wv[j][1] = t.y; wv[j][2] = t.z; wv[j][3] = t.w; }
                const f32x4 bias = *(const f32x4*)(cb + xch + 4 * hb);
#pragma unroll
                for (int i = 0; i < 8; ++i)
#pragma unroll
                    for (int k = 0; k < 4; ++k) val[i][k] = bias[k];
#pragma unroll
                for (int i = 0; i < 12; ++i) {
                    const unsigned wa = hb ? xr[i].z : xr[i].x, wb = hb ? xr[i].w : xr[i].y;
                    const float x4[4] = {__uint_as_float(wa << 16), __uint_as_float(wa & 0xffff0000u), __uint_as_float(wb << 16), __uint_as_float(wb & 0xffff0000u)};
#pragma unroll
                    for (int j = 0; j < 5; ++j) { const int o = i - j;
                        if (o >= 0 && o < 8) {
#pragma unroll
                            for (int k = 0; k < 4; ++k) val[o][k] = fmaf(wv[j][k], x4[k], val[o][k]); } }
                }
#pragma unroll
                for (int i = 0; i < 8; ++i)
#pragma unroll
                    for (int k = 0; k < 4; ++k) val[i][k] = siluf_(val[i][k]);
                if (kind != 0) {
                    LAS bf16* N = kind == 1 ? Bn : Cn;
#pragma unroll
                    for (int i = 0; i < 8; ++i) { u32x2 o; o.x = pk2(val[i][0], val[i][1]); o.y = pk2(val[i][2], val[i][3]); *(LAS u32x2*)(N + (s0 + i) * SSD_LD + n0 + 4 * hb) = o;
                        if (kind == 2 && (h & 3) == 0) *(u32x2*)(CC + (size_t)(r0 + s0 + i) * 256 + g * 128 + n0 + 4 * hb) = o; }
                }
                if (kind != 2) {
                    LAS bf16* T = kind == 0 ? XT : BT;
#pragma unroll
                    for (int k = 0; k < 4; ++k) { u32x4 o; o.x = pk2(val[0][k], val[1][k]); o.y = pk2(val[2][k], val[3][k]); o.z = pk2(val[4][k], val[5][k]); o.w = pk2(val[6][k], val[7][k]);
                        *(LAS u32x4*)(T + (n0 + 4 * hb + k) * SSD_LD + s0) = o; }
                }
            }
        }
    }
    __syncthreads();
    int lane_ = F.lane; asm volatile("" : "+v"(lane_));
    const int q = lane_ >> 4, c = lane_ & 15, w = F.wave;
    {
        pg8::bf16x8 cfr[4];
#pragma unroll
        for (int ks = 0; ks < 4; ++ks) cfr[ks] = *(const LAS pg8::bf16x8*)(Cn + (16 * w + c) * SSD_LD + 32 * ks + 8 * q);
        f32x4 gt[8];
#pragma unroll
        for (int a = 0; a < 8; ++a) { f32x4 acc = {0.f, 0.f, 0.f, 0.f};
#pragma unroll
            for (int ks = 0; ks < 4; ++ks) acc = __builtin_amdgcn_mfma_f32_16x16x32_bf16(*(const LAS pg8::bf16x8*)(Bn + (16 * a + c) * SSD_LD + 32 * ks + 8 * q), cfr[ks], acc, 0, 0, 0);
            gt[a] = acc; }
        const int t = 16 * w + c; const float cs0t = cs0[t], e1t = ecs1[t], Dh = F.in[I_SD][l * 8 + h];
#pragma unroll
        for (int a = 0; a < 8; ++a) {
            const f32x4 csv = *(const LAS f32x4*)&cs0[16 * a + 4 * q], d0v = *(const LAS f32x4*)&dt0[16 * a + 4 * q], e1v = *(const LAS f32x4*)&ecs1[16 * a + 4 * q], d1v = *(const LAS f32x4*)&dt1[16 * a + 4 * q];
#pragma unroll
            for (int j = 0; j < 4; ++j) { const int sidx = 16 * a + 4 * q + j;
                const float f0 = (sidx <= t) ? __expf(fminf(cs0t - csv[j], 0.f)) * d0v[j] : 0.f;
                const float f1 = (sidx >= t) ? __expf(fminf(e1v[j] - e1t, 0.f)) * d1v[j] : 0.f;
                gt[a][j] = gt[a][j] * (f0 + f1) + ((sidx == t) ? Dh : 0.f); }
        }
        pg8::bf16x8 mfr[4];
#pragma unroll
        for (int i = 0; i < 4; ++i) { u32x4 tq; tq.x = pk2(gt[2 * i][0], gt[2 * i][1]); tq.y = pk2(gt[2 * i][2], gt[2 * i][3]); tq.z = pk2(gt[2 * i + 1][0], gt[2 * i + 1][1]); tq.w = pk2(gt[2 * i + 1][2], gt[2 * i + 1][3]); mfr[i] = __builtin_bit_cast(pg8::bf16x8, tq); }
        bf16* YI = (bf16*)(F.ws + WS_YI);
#pragma unroll
        for (int pt = 0; pt < 4; ++pt) { f32x4 acc = {0.f, 0.f, 0.f, 0.f};
#pragma unroll
            for (int i = 0; i < 4; ++i) { const LAS bf16* xp = XT + (16 * pt + c) * SSD_LD + 32 * i + 4 * q;
                acc = __builtin_amdgcn_mfma_f32_16x16x32_bf16(mk8(*(const LAS u32x2*)xp, *(const LAS u32x2*)(xp + 16)), mfr[i], acc, 0, 0, 0); }
            u32x2 o; o.x = pk2(acc[0], acc[1]); o.y = pk2(acc[2], acc[3]);
            *(u32x2*)(YI + (((size_t)uidx * 32 + pt * 8 + w) * 64 + F.lane) * 4) = o; }
    }
    {
        pg8::bf16x8 btf[4];
#pragma unroll
        for (int ks = 0; ks < 4; ++ks) btf[ks] = *(const LAS pg8::bf16x8*)(BT + (16 * w + c) * SSD_LD + 32 * ks + 8 * q);
        bf16* SST = (bf16*)(F.ws + WS_SST);
#pragma unroll
        for (int d = 0; d < 2; ++d) { const LAS float* wd = d ? w1 : w0;
#pragma unroll
            for (int pt = 0; pt < 4; ++pt) { f32x4 acc = {0.f, 0.f, 0.f, 0.f};
#pragma unroll
                for (int ks = 0; ks < 4; ++ks) {
                    const u32x4 xq = *(const LAS u32x4*)(XT + (16 * pt + c) * SSD_LD + 32 * ks + 8 * q);
                    const f32x4 wa = *(const LAS f32x4*)&wd[32 * ks + 8 * q], wb = *(const LAS f32x4*)&wd[32 * ks + 8 * q + 4];
                    u32x4 sq;
                    sq.x = pk2(__uint_as_float(xq.x << 16) * wa[0], __uint_as_float(xq.x & 0xffff0000u) * wa[1]); sq.y = pk2(__uint_as_float(xq.y << 16) * wa[2], __uint_as_float(xq.y & 0xffff0000u) * wa[3]);
                    sq.z = pk2(__uint_as_float(xq.z << 16) * wb[0], __uint_as_float(xq.z & 0xffff0000u) * wb[1]); sq.w = pk2(__uint_as_float(xq.w << 16) * wb[2], __uint_as_float(xq.w & 0xffff0000u) * wb[3]);
                    acc = __builtin_amdgcn_mfma_f32_16x16x32_bf16(btf[ks], __builtin_bit_cast(pg8::bf16x8, sq), acc, 0, 0, 0); }
                u32x2 o; o.x = pk2(acc[0], acc[1]); o.y = pk2(acc[2], acc[3]);
                *(u32x2*)(SST + (((size_t)uidx * 2 + d) * 64 + 16 * pt + c) * 128 + 16 * w + 4 * q) = o; }
        }
    }
}
__device__ __forceinline__ void ssd_carry(const Frame& F) {
    const int gt = F.bid * NTHR + F.tid, NG = F.G * NTHR;
    const bf16* SST = (const bf16*)(F.ws + WS_SST); bf16* HIN = (bf16*)(F.ws + WS_HIN); const float* TOT = (const float*)(F.ws + WS_TOT);
    for (int i = gt; i < NB * 8 * 2 * 1024; i += NG) {
        const int e8 = i & 1023, d = (i >> 10) & 1, h = (i >> 11) & 7, b = i >> 14;
        float H[8];
#pragma unroll
        for (int k = 0; k < 8; ++k) H[k] = 0.f;
#pragma unroll 2
        for (int j = 0; j < 18; ++j) {
            const int cid = d ? (j < 2 ? 1 - j : 19 - j) : j;
            const size_t ui = (size_t)(b * 18 + cid) * 8 + h, off = ((ui * 2 + d) * 1024 + e8) * 8;
            u32x4 o; o.x = pk2(H[0], H[1]); o.y = pk2(H[2], H[3]); o.z = pk2(H[4], H[5]); o.w = pk2(H[6], H[7]);
            *(u32x4*)(HIN + off) = o;
            float sv[8]; ld8(SST + off, sv);
            const float dec = __expf(TOT[ui * 2 + d]);
#pragma unroll
            for (int k = 0; k < 8; ++k) H[k] = fmaf(H[k], dec, sv[k]);
        }
    }
}
__device__ __forceinline__ void ssd_unit_b(const Frame& F, int l, int uc) {
    const int b = uc / 18, cid = uc % 18, r0 = ssd_row0(b, cid);
    int lane_ = F.lane; asm volatile("" : "+v"(lane_));
    const int q = lane_ >> 4, c = lane_ & 15, w = F.wave;
    const size_t row = (size_t)(r0 + 16 * w + c);
    const bf16* CC = (const bf16*)(F.ws + WS_CC); const bf16* HIN = (const bf16*)(F.ws + WS_HIN); const bf16* YI = (const bf16*)(F.ws + WS_YI); const float* ED = (const float*)(F.ws + WS_EDEC);
    float ss = 0.f;
#pragma unroll 1
    for (int h = 0; h < 8; ++h) {
        const int g = h >> 2;
        pg8::bf16x8 cfr[4];
#pragma unroll
        for (int ks = 0; ks < 4; ++ks) cfr[ks] = *(const pg8::bf16x8*)(CC + row * 256 + g * 128 + 32 * ks + 8 * q);
        const f32x2 ed = *(const f32x2*)(ED + (row * 8 + h) * 2);
        const size_t ui = (size_t)uc * 8 + h;
#pragma unroll
        for (int pt = 0; pt < 4; ++pt) {
            f32x4 a0 = {0.f, 0.f, 0.f, 0.f}, a1 = {0.f, 0.f, 0.f, 0.f};
#pragma unroll
            for (int ks = 0; ks < 4; ++ks) {
                a0 = __builtin_amdgcn_mfma_f32_16x16x32_bf16(*(const pg8::bf16x8*)(HIN + ((ui * 2 + 0) * 64 + 16 * pt + c) * 128 + 32 * ks + 8 * q), cfr[ks], a0, 0, 0, 0);
                a1 = __builtin_amdgcn_mfma_f32_16x16x32_bf16(*(const pg8::bf16x8*)(HIN + ((ui * 2 + 1) * 64 + 16 * pt + c) * 128 + 32 * ks + 8 * q), cfr[ks], a1, 0, 0, 0);
            }
            float yi[4], z[4]; ld4(YI + ((ui * 32 + pt * 8 + w) * 64 + F.lane) * 4, yi); ld4(F.COLS + row * NCOL + h * 64 + 16 * pt + 4 * q, z);
            float v[4];
#pragma unroll
            for (int j = 0; j < 4; ++j) { v[j] = (yi[j] + ed.x * a0[j] + ed.y * a1[j]) * siluf_(z[j]); ss = fmaf(v[j], v[j], ss); }
            u32x2 o; o.x = pk2(v[0], v[1]); o.y = pk2(v[2], v[3]);
            *(u32x2*)(F.MIX + row * 1024 + h * 64 + 16 * pt + 4 * q) = o;
        }
    }
    ss += shx(ss, 16, F.lane); ss += shx(ss, 32, F.lane);
    const float rstd = rsqrtf(ss * (1.f / 512.f) + EPS);
    const float* ng = F.in[I_SNG] + l * 512;
#pragma unroll 4
    for (int k = 0; k < 32; ++k) {
        bf16* mp = F.MIX + row * 1024 + k * 16 + 4 * q;
        float v[4]; ld4(mp, v); const f32x4 gn = *(const f32x4*)(ng + k * 16 + 4 * q);
        u32x2 o; o.x = pk2(v[0] * rstd * gn[0], v[1] * rstd * gn[1]); o.y = pk2(v[2] * rstd * gn[2], v[3] * rstd * gn[3]);
        *(u32x2*)mp = o;
    }
}


__device__ __forceinline__ void stage_wt16(LAS float* WT, const float* src, int stride, int tid) {
    for (int i = tid; i < 4096; i += NTHR) { const int k = i >> 2, e4 = (i & 3) * 4; const f32x4 v = *(const f32x4*)(src + (size_t)k * stride + e4);
        WT[(e4 + 0) * 1024 + k] = v.x; WT[(e4 + 1) * 1024 + k] = v.y; WT[(e4 + 2) * 1024 + k] = v.z; WT[(e4 + 3) * 1024 + k] = v.w; }
}
__device__ __forceinline__ void dot16_acc(const LAS float* WT, const f32x4& h, int j, int lane, float (&acc)[16]) {
#pragma unroll
    for (int e = 0; e < 16; ++e) { const f32x4 w = *(const LAS f32x4*)&WT[e * 1024 + 4 * lane + 256 * j]; acc[e] = fmaf(h.x, w.x, fmaf(h.y, w.y, fmaf(h.z, w.z, fmaf(h.w, w.w, acc[e])))); }
    asm volatile("" ::: "memory");
}

__device__ __forceinline__ void phase_p0(const Frame& F0)  {
    Frame F = enter_phase(F0);
    {
        const size_t gt = (size_t)F.bid * NTHR + F.tid, NG = (size_t)F.G * NTHR;
        for (size_t i = gt; i < (size_t)TT * 256; i += NG) {
            const int r = (int)(i >> 8), c4 = (int)(i & 255) * 4;
            f32x4 v;
            if (r < TL) {
                v = *(const f32x4*)(F.in[I_X] + (size_t)r * D + c4);
                const int n = r & (SEQ - 1), rr = n >> 6, cc = n & 63, q = c4 >> 8, ii = c4 & 255;
                const float pos = (float)(q < 2 ? rr : cc);
                float pe[4];
#pragma unroll
                for (int k = 0; k < 4; ++k) {
                    const float invf = expf(-9.210340371976184f * (float)(ii + k) * (1.f / 256.f));
                    float s, c; sincos_red(pos * invf, s, c);
                    pe[k] = (q & 1) ? c : s;
                }
                v.x += pe[0]; v.y += pe[1]; v.z += pe[2]; v.w += pe[3];
            } else {
                v = *(const f32x4*)(F.in[I_CTX] + (size_t)(r - TL) * D + c4);
            }
            *(f32x4*)(F.XS + (size_t)r * D + c4) = v;
        }
    }
    {
        LAS float* scr = (LAS float*)F.lds + F.wave * (64 * 33);
        const int gw = F.bid * NWAVES + F.wave, NGW = F.G * NWAVES;
        constexpr int I_IN = 16 * 73, I_OUT = 16 * 32, I_PW = 4 * 8, I_GLU = 4 * 16, I_L = I_IN + I_OUT + I_PW + I_GLU;
        for (int it = gw; it < 2 * I_L; it += NGW) {
            const int l = it / I_L; int r = it % I_L;
            if (r < I_IN) { transpose_item(F.in[I_WIN] + (size_t)l * D * INC, D, INC, F.WIN_T + (size_t)l * NCOL * D, [](int n) { return n < 1536 ? n : (n < 1552 ? -1 : (n < INC ? n - 16 : -1)); }, scr, r, F.lane); continue; } r -= I_IN;
            if (r < I_OUT) { transpose_item(F.in[I_WOUT] + (size_t)l * D * D, D, D, F.WOUT_T + (size_t)l * D * D, [](int n) { return n; }, scr, r, F.lane); continue; } r -= I_OUT;
            if (r < I_PW) { transpose_item(F.in[I_CPW] + (size_t)l * 256 * 256, 256, 256, F.PW_T + (size_t)l * 256 * 256, [](int n) { return n; }, scr, r, F.lane); continue; } r -= I_PW;
            transpose_item(F.in[I_GLUW] + (size_t)l * 256 * 512, 256, 512, F.GLU_T + (size_t)l * 512 * 256, [](int n) { const int g = n & 255; return (g >> 7) * 256 + (n >> 8) * 128 + (g & 127); }, scr, r, F.lane);
        }
        __syncthreads();
    }
    {
        const int gt = F.bid * NTHR + F.tid, NG = F.G * NTHR;
        f32x2* AA = (f32x2*)(F.ws + WS_S5AA); bf16* BB = (bf16*)(F.ws + WS_S5BB); bf16* CM = (bf16*)(F.ws + WS_S5CM);
        for (int i = gt; i < 2 * 2 * 16 * 64; i += NG) {
            const int p = i & 63, g = (i >> 6) & 15, dir = (i >> 10) & 1, l = i >> 11;
            const float step = expf(F.in[I_LSTEP][(l * 2 + dir) * 16 + g]);
            const float lr = F.in[I_LRE][i], li = F.in[I_LIM][i];
            const float mag = expf(lr * step); float sn, cs; sincos_red(li * step, sn, cs);
            const float ar = mag * cs, ai = mag * sn, inv_den = 1.f / (lr * lr + li * li);
            const float cr = ((ar - 1.f) * lr + ai * li) * inv_den, ci = (ai * lr - (ar - 1.f) * li) * inv_den;
            AA[i] = (f32x2){ar, ai};
            const float* bre = F.in[I_BRE] + ((size_t)(l * 16 + g) * 64 + p) * 16; const float* bim = F.in[I_BIM] + ((size_t)(l * 16 + g) * 64 + p) * 16;
            bf16* o = BB + ((size_t)((l * 2 + dir) * 16 + g) * 128 + 2 * p) * 16;
            for (int h = 0; h < 16; ++h) { const float br = bre[h], bi = bim[h]; o[h] = (bf16)f2bf(cr * br - ci * bi); o[16 + h] = (bf16)f2bf(cr * bi + ci * br); }
        }
        for (int i = gt; i < 2 * 16 * 16 * 64; i += NG) {
            *(unsigned*)(CM + (size_t)i * 2) = pk2(F.in[I_CRE][i], -F.in[I_CIM][i]);
        }
    }
    {
        LAS float* sc = (LAS float*)F.lds;
        LAS float* part = sc + 9 * 1024;
        __syncthreads();
        if (F.bid < 192) { for (int t = F.tid; t < 9 * 1024; t += NTHR) { const int r9 = t >> 10, k = t & 1023; sc[t] = siluf_(r9 < 8 ? F.in[I_C][r9 * D + k] : F.in[I_CCTX][k]); } }
        __syncthreads();
        for (int it = F.bid; it < 192; it += F.G) {
            const int l = it / 96, cb = it % 96, col = F.tid & 63, kg = F.tid >> 6;
            float acc[9];
#pragma unroll
            for (int r9 = 0; r9 < 9; ++r9) acc[r9] = 0.f;
            const float* wp = F.in[I_WADA] + ((size_t)l * D + kg * 128) * 6144 + cb * 64 + col;
#pragma unroll 4
            for (int kk = 0; kk < 128; ++kk) {
                const float w = wp[(size_t)kk * 6144];
#pragma unroll
                for (int r9 = 0; r9 < 9; ++r9) acc[r9] = fmaf(sc[r9 * 1024 + kg * 128 + kk], w, acc[r9]);
            }
#pragma unroll
            for (int r9 = 0; r9 < 9; ++r9) part[(kg * 9 + r9) * 64 + col] = acc[r9];
            __syncthreads();
            for (int t = F.tid; t < 9 * 64; t += NTHR) { const int r9 = t >> 6, cc = t & 63; float sm = F.in[I_BADA][l * 6144 + cb * 64 + cc];
#pragma unroll
                for (int k8 = 0; k8 < 8; ++k8) sm += part[(k8 * 9 + r9) * 64 + cc];
                F.MOD[((size_t)l * 9 + r9) * 6144 + cb * 64 + cc] = sm; }
            __syncthreads();
        }
    }
}
__device__ __forceinline__ LAS int* moe_tables(const Frame& F, int l) {
    LAS int* tab = (LAS int*)(F.lds + TAB_OFF);
    __syncthreads();
    if (F.tid == 0) {
        int bs = 0;
        for (int e = 0; e < NEXP; ++e) { const int c = (int)F.ctl[CW_CNT + l * 64 + e]; tab[e] = bs; tab[40 + e] = c; bs += ((c + 255) / 256) * 256; }
        tab[16] = bs;
    }
    __syncthreads();
    return tab;
}
__device__ __forceinline__ void phase_rowA(const Frame& F0, int l)  {
    Frame F = enter_phase(F0);
    LAS int* tab = (LAS int*)(F.lds + TAB_OFF);
    if (l > 0) tab = moe_tables(F, l - 1);
    LAS float* WDT = (LAS float*)F.lds;
    if (l < DEPTH) {
        __syncthreads();
        stage_wt16(WDT, F.in[I_WIN] + (size_t)l * D * INC + 1536, INC, F.tid);
        __syncthreads();
    }
    const int gw = F.bid * NWAVES + F.wave, NGW = F.G * NWAVES;
    const int RL = (l == DEPTH) ? TL : TT;
    const float* gvec = (l == DEPTH) ? F.in[I_GFIN] : F.in[I_GMIX] + l * D;
    for (int r = gw; r < RL; r += NGW) {
        const int mr = modrow(r);
        f32x4 v[4];
#pragma unroll
        for (int j = 0; j < 4; ++j) v[j] = *(const f32x4*)(F.XS + (size_t)r * D + 4 * F.lane + 256 * j);
        if (l > 0) {
            const int4 ti = *(const int4*)(F.TOKI + (size_t)r * 4);
            const f32x2 tw = *(const f32x2*)(F.TOKW + (size_t)r * 2);
            const size_t ra = (size_t)(tab[ti.x] + ti.y), rb = (size_t)(tab[ti.z] + ti.w);
            const float* g2 = F.MOD + ((size_t)(l - 1) * 9 + mr) * 6144 + 5120;
#pragma unroll
            for (int j = 0; j < 4; ++j) {
                const int c = 4 * F.lane + 256 * j;
                float ya[4], yb[4]; ld4(F.YDN + ra * D + c, ya); ld4(F.YDN + rb * D + c, yb);
                const f32x4 g = *(const f32x4*)(g2 + c);
#pragma unroll
                for (int e = 0; e < 4; ++e) v[j][e] += g[e] * (ya[e] * tw.x + yb[e] * tw.y);
            }
            if (l < DEPTH) {
#pragma unroll
                for (int j = 0; j < 4; ++j) *(f32x4*)(F.XS + (size_t)r * D + 4 * F.lane + 256 * j) = v[j];
            }
        }
        float ss = 0.f;
#pragma unroll
        for (int j = 0; j < 4; ++j) ss += (v[j].x * v[j].x + v[j].y * v[j].y) + (v[j].z * v[j].z + v[j].w * v[j].w);
        const float rstd = rsqrtf(wave_sum(ss, F.lane) * (1.f / D) + EPS);
        if (l == DEPTH) {
#pragma unroll
            for (int j = 0; j < 4; ++j) { const int c = 4 * F.lane + 256 * j; const f32x4 g = *(const f32x4*)(gvec + c); *(f32x4*)(F.out + (size_t)r * D + c) = v[j] * rstd * g; }
        } else {
            const float* md = F.MOD + ((size_t)l * 9 + mr) * 6144;
            float dtp[16];
#pragma unroll
            for (int e = 0; e < 16; ++e) dtp[e] = 0.f;
#pragma unroll
            for (int j = 0; j < 4; ++j) {
                const int c = 4 * F.lane + 256 * j;
                const f32x4 g = *(const f32x4*)(gvec + c), sh = *(const f32x4*)(md + c), scl = *(const f32x4*)(md + 1024 + c);
                const f32x4 h = v[j] * rstd * g * (scl + 1.f) + sh;
                u32x2 o; o.x = pk2(h.x, h.y); o.y = pk2(h.z, h.w);
                *(u32x2*)(F.HN + (size_t)r * D + c) = o;
                dot16_acc(WDT, h, j, F.lane, dtp);
            }
#pragma unroll
            for (int e = 0; e < 16; ++e) dtp[e] = wave_sum(dtp[e], F.lane);
            if (F.lane == 0) {
#pragma unroll
                for (int e4 = 0; e4 < 4; ++e4) *(f32x4*)(F.DT + (size_t)r * 16 + e4 * 4) = (f32x4){dtp[e4 * 4], dtp[e4 * 4 + 1], dtp[e4 * 4 + 2], dtp[e4 * 4 + 3]};
            }
        }
    }
}
__device__ __forceinline__ void phase_inproj(const Frame& F0, int l)  {
    Frame F = enter_phase(F0);
    pg8::PlainSched S; S.T.init(TT / 256, NCOL / 256, F.G, F.bid); S.Bt = (const char*)(F.WIN_T + (size_t)l * NCOL * D); S.K = D;
    pg8::EpiStoreBf16 E{F.COLS, NCOL, 0, nullptr};
    pg8::gemm_phase<pg8::EpiStoreBf16, pg8::PlainSched, true>(F.lds, F.HN, D, S, E, F.tid);
}
__device__ __forceinline__ void phase_elem(const Frame& F0, int l)  {
    Frame F = enter_phase(F0);
    const size_t gt = (size_t)F.bid * NTHR + F.tid, NG = (size_t)F.G * NTHR;
    {
        LAS float* scr = (LAS float*)F.lds + F.wave * (64 * 33);
        const int gw = F.bid * NWAVES + F.wave, NGW = F.G * NWAVES;
        for (int it = gw; it < 48 * 512; it += NGW) {
            const int mtx = it >> 9, r = it & 511, e = mtx / 3, kind = mtx % 3;
            const size_t wofs = ((size_t)l * NEXP + e) * D * D;
            if (kind == 0) transpose_item(F.in[I_WG] + wofs, D, D, F.WGU_T + (size_t)e * 2048 * D, [](int n) { return (n >> 7) * 256 + (n & 127); }, scr, r, F.lane);
            else if (kind == 1) transpose_item(F.in[I_WU] + wofs, D, D, F.WGU_T + (size_t)e * 2048 * D, [](int n) { return (n >> 7) * 256 + 128 + (n & 127); }, scr, r, F.lane);
            else transpose_item(F.in[I_WD] + wofs, D, D, F.WD_T + (size_t)e * D * D, [](int n) { return n; }, scr, r, F.lane);
        }
    }
    for (size_t i = gt; i < (size_t)TT * 64; i += NG) {
        const int r = (int)(i >> 6), c = (int)(i & 63) * 4;
        float a[4], g[4]; ld4(F.COLS + (size_t)r * NCOL + 1536 + c, a); ld4(F.COLS + (size_t)r * NCOL + 1792 + c, g);
        *(f32x4*)(F.CU + (size_t)r * 256 + c) = (f32x4){a[0] * sigmoidf_(g[0]), a[1] * sigmoidf_(g[1]), a[2] * sigmoidf_(g[2]), a[3] * sigmoidf_(g[3])};
    }
}
__device__ __forceinline__ void phase_scan(const Frame& F0, int l)  {
    Frame F = enter_phase(F0);
    const int RLc = (l == 0) ? TT : TL;
    const int NU = 1152 + 288 + RLc / 64;
    for (int u = F.bid; u < NU; u += F.G) {
        if (u < 1152) {
            ssd_unit_a(F, l, u);
        } else if (u < 1152 + 288) {
            s5_unit<0>(F, l, u - 1152);
        } else {
            const int rbase = (u - 1440) * 64 + F.wave * 8, ch = 4 * F.lane;
            const float* dw = F.in[I_CDW] + (size_t)l * 31 * 256;
            const f32x4 db = *(const f32x4*)(F.in[I_CDB] + l * 256 + ch), lg = *(const f32x4*)(F.in[I_CLG] + l * 256 + ch), lb = *(const f32x4*)(F.in[I_CLB] + l * 256 + ch);
            for (int i = 0; i < 8; ++i) {
                const int r = rbase + i; int lo, hi; seq_bounds(r, lo, hi);
                f32x4 acc = db;
#pragma unroll 1
                for (int j = 0; j < 31; ++j) {
                    const int rr = r + j - 15;
                    if (rr >= lo && rr < hi) acc += *(const f32x4*)(dw + j * 256 + ch) * *(const f32x4*)(F.CU + (size_t)rr * 256 + ch);
                }
                const float mean = wave_sum((acc.x + acc.y) + (acc.z + acc.w), F.lane) * (1.f / 256.f);
                const f32x4 d = acc - mean;
                const float var = wave_sum((d.x * d.x + d.y * d.y) + (d.z * d.z + d.w * d.w), F.lane) * (1.f / 256.f);
                const f32x4 y = d * rsqrtf(var + EPS) * lg + lb;
                u32x2 o; o.x = pk2(siluf_(y.x), siluf_(y.y)); o.y = pk2(siluf_(y.z), siluf_(y.w));
                *(u32x2*)(F.CV + (size_t)r * 256 + ch) = o;
            }
        }
    }
}
__device__ __forceinline__ void phase_carry(const Frame& F0, int l)  {
    Frame F = enter_phase(F0);
    s5_carry(F, l);
    ssd_carry(F);
}
__device__ __forceinline__ void phase_mix1(const Frame& F0, int l)  {
    Frame F = enter_phase(F0);
    const int RL = (l == 0) ? TT : TL;
    for (int u = F.bid; u < 144 + 288; u += F.G) {
        if (u < 144) { if (l == 0 || (u % 18) >= 2) ssd_unit_b(F, l, u); }
        else { const int v = u - 144; if (l == 0 || (v % 36) >= 4) s5_unit<1>(F, l, v); }
    }
    {
        __syncthreads();
        pg8::PlainSched S; S.T.init(RL / 256, 1, F.G, F.bid); S.Bt = (const char*)(F.PW_T + (size_t)l * 256 * 256); S.K = 256;
        pg8::EpiStoreBf16 E{F.MIX, 1024, 512, F.in[I_CPB] + l * 256};
        pg8::gemm_phase<pg8::EpiStoreBf16, pg8::PlainSched, true>(F.lds, F.CV, 256, S, E, F.tid);
    }
}
__device__ __forceinline__ void phase_s5glu(const Frame& F0, int l)  {
    Frame F = enter_phase(F0);
    const int RL = (l == 0) ? TT : TL;
    pg8::PlainSched S; S.T.init(RL / 256, 2, F.G, F.bid); S.Bt = (const char*)(F.GLU_T + (size_t)l * 512 * 256); S.K = 256;
    pg8::EpiPairBf16<1> E{F.MIX, 1024, 768, F.in[I_GLUB] + l * 512, 256};
    pg8::gemm_phase<pg8::EpiPairBf16<1>, pg8::PlainSched, true>(F.lds, F.YG, 256, S, E, F.tid);
}
__device__ __forceinline__ void phase_wout(const Frame& F0, int l)  {
    Frame F = enter_phase(F0);
    const int RL = (l == 0) ? TT : TL;
    pg8::PlainSched S; S.T.init(RL / 256, D / 256, F.G, F.bid); S.Bt = (const char*)(F.WOUT_T + (size_t)l * D * D); S.K = D;
    pg8::EpiResidual E{F.XS, F.MOD + (size_t)l * 9 * 6144 + 2048};
    pg8::gemm_phase<pg8::EpiResidual, pg8::PlainSched, true>(F.lds, F.MIX, D, S, E, F.tid);
}
__device__ __forceinline__ void phase_norm2(const Frame& F0, int l)  {
    Frame F = enter_phase(F0);
    const int RL = (l == 0) ? TT : TL;
    LAS float* RW = (LAS float*)F.lds;
    __syncthreads();
    stage_wt16(RW, F.in[I_RW], 16, F.tid);
    LAS int* lcnt = (LAS int*)(F.lds + 65536);
    if (F.tid < 32) lcnt[F.tid] = 0;
    __syncthreads();
    const int gw = F.bid * NWAVES + F.wave, NGW = F.G * NWAVES;
    const float* gvec = F.in[I_GFFN] + l * D;
    for (int r = gw; r < RL; r += NGW) {
        const int mr = modrow(r);
        f32x4 v[4]; float ss = 0.f;
#pragma unroll
        for (int j = 0; j < 4; ++j) { v[j] = *(const f32x4*)(F.XS + (size_t)r * D + 4 * F.lane + 256 * j); ss += (v[j].x * v[j].x + v[j].y * v[j].y) + (v[j].z * v[j].z + v[j].w * v[j].w); }
        const float rstd = rsqrtf(wave_sum(ss, F.lane) * (1.f / D) + EPS);
        const float* md = F.MOD + ((size_t)l * 9 + mr) * 6144;
        float lg[16];
#pragma unroll
        for (int e = 0; e < 16; ++e) lg[e] = 0.f;
#pragma unroll
        for (int j = 0; j < 4; ++j) {
            const int c = 4 * F.lane + 256 * j;
            const f32x4 g = *(const f32x4*)(gvec + c), sh = *(const f32x4*)(md + 3072 + c), scl = *(const f32x4*)(md + 4096 + c);
            const f32x4 h = v[j] * rstd * g * (scl + 1.f) + sh;
            u32x2 o; o.x = pk2(h.x, h.y); o.y = pk2(h.z, h.w);
            *(u32x2*)(F.HN + (size_t)r * D + c) = o;
            dot16_acc(RW, h, j, F.lane, lg);
        }
        float mx = -3.0e38f;
#pragma unroll
        for (int e = 0; e < 16; ++e) { lg[e] = wave_sum(lg[e], F.lane) + F.in[I_RB][e]; mx = fmaxf(mx, lg[e]); }
        float den = 0.f;
#pragma unroll
        for (int e = 0; e < 16; ++e) { lg[e] = expf(lg[e] - mx); den += lg[e]; }
        const float inv = 1.f / den;
#pragma unroll
        for (int e = 0; e < 16; ++e) lg[e] *= inv;
        float gs[4];
#pragma unroll
        for (int gI = 0; gI < 4; ++gI) {
            const float p0 = lg[gI * 4], p1 = lg[gI * 4 + 1], p2 = lg[gI * 4 + 2], p3 = lg[gI * 4 + 3];
            const float h01 = fmaxf(p0, p1), l01 = fminf(p0, p1), h23 = fmaxf(p2, p3), l23 = fminf(p2, p3);
            gs[gI] = fmaxf(h01, h23) + fmaxf(fminf(h01, h23), fmaxf(l01, l23));
        }
        int best = 0; float bsv = gs[0];
#pragma unroll
        for (int gI = 1; gI < 4; ++gI) if (gs[gI] > bsv) { bsv = gs[gI]; best = gI; }
        float q[4];
#pragma unroll
        for (int i = 0; i < 4; ++i) q[i] = best == 0 ? lg[i] : (best == 1 ? lg[4 + i] : (best == 2 ? lg[8 + i] : lg[12 + i]));
        int i0 = 0; float v0 = q[0];
#pragma unroll
        for (int i = 1; i < 4; ++i) if (q[i] > v0) { v0 = q[i]; i0 = i; }
        int i1 = -1; float v1 = -1.f;
#pragma unroll
        for (int i = 0; i < 4; ++i) if (i != i0 && q[i] > v1) { v1 = q[i]; i1 = i; }
        const float ginv = 1.f / (v0 + v1);
        if (F.lane == 0) {
            const int e0 = best * 4 + i0, e1 = best * 4 + i1;
            const int p0 = __hip_atomic_fetch_add(&lcnt[e0], 1, __ATOMIC_RELAXED, __HIP_MEMORY_SCOPE_WORKGROUP), p1 = __hip_atomic_fetch_add(&lcnt[e1], 1, __ATOMIC_RELAXED, __HIP_MEMORY_SCOPE_WORKGROUP);
            *(int4*)(F.TOKI + (size_t)r * 4) = make_int4(e0, p0, e1, p1);
            *(f32x2*)(F.TOKW + (size_t)r * 2) = (f32x2){v0 * ginv, v1 * ginv};
        }
    }
    __syncthreads();
    if (F.tid < 16) lcnt[16 + F.tid] = (int)atomicAdd(&F.ctl[CW_CNT + l * 64 + F.tid], (unsigned)lcnt[F.tid]);
    __syncthreads();
    if (F.lane == 0) {
        for (int r = gw; r < RL; r += NGW) {
            int4 ti = *(const int4*)(F.TOKI + (size_t)r * 4);
            ti.y += lcnt[16 + ti.x]; ti.w += lcnt[16 + ti.z];
            *(int4*)(F.TOKI + (size_t)r * 4) = ti;
            F.LIST[(size_t)ti.x * TT + ti.y] = r; F.LIST[(size_t)ti.z * TT + ti.w] = r;
        }
    }
}
__device__ __forceinline__ void phase_gateup(const Frame& F0, int l)  {
    Frame F = enter_phase(F0);
    LAS int* tab = moe_tables(F, l);
    LAS int* rows = (LAS int*)(F.lds + ROWS_OFF);
    pg8::MoeSched<true> S; S.T.init(tab[16] / 256, 8, F.G, F.bid); S.Bt = (const char*)F.WGU_T; S.K = D; S.NE = 2048; S.tab = tab; S.rows = rows;
    {
        pg8::Unit u;
        for (int i = 0; i < 15 && S.next(i, u); ++i) {
            if (F.tid < 256) { const int sr = u.pm * 256 + F.tid, e = S.expert(u.pm), pos = sr - tab[e], cnt = tab[40 + e];
                rows[i * 256 + F.tid] = F.LIST[(size_t)e * TT + (pos < cnt ? pos : 0)]; }
        }
        __syncthreads();
    }
    pg8::EpiPairBf16<0> E{F.HMID, 1024, 0, nullptr, 0};
    pg8::gemm_phase<pg8::EpiPairBf16<0>, pg8::MoeSched<true>, true>(F.lds, F.HN, D, S, E, F.tid);
}
__device__ __forceinline__ void phase_down(const Frame& F0, int l)  {
    Frame F = enter_phase(F0);
    LAS int* tab = moe_tables(F, l);
    pg8::MoeSched<false> S; S.T.init(tab[16] / 256, 4, F.G, F.bid); S.Bt = (const char*)F.WD_T; S.K = D; S.NE = 1024; S.tab = tab; S.rows = nullptr;
    pg8::EpiStoreBf16 E{F.YDN, 1024, 0, nullptr};
    pg8::gemm_phase<pg8::EpiStoreBf16, pg8::MoeSched<false>, true>(F.lds, F.HMID, D, S, E, F.tid);
}

constexpr int PH_PER_LAYER = 11, N_PHASES = 1 + DEPTH * PH_PER_LAYER + 1;

__global__ void __launch_bounds__(NTHR, 2) fwd_kernel(Args args) {
    extern __shared__ __attribute__((aligned(16))) unsigned char lds_raw[];
    Frame F;
    F.lds = (LAS unsigned char*)lds_raw;
    F.tid = threadIdx.x; F.lane = F.tid & 63; F.wave = __builtin_amdgcn_readfirstlane(F.tid >> 6);
    F.G = gridDim.x; F.bid = blockIdx.x;
    F.in = (const CAS cfp_t*)__builtin_amdgcn_kernarg_segment_ptr(); F.out = args.out; F.ws = args.ws;
    frame_ptrs(F, args.ws);
    volatile LAS unsigned* MISC = (volatile LAS unsigned*)(F.lds + MISC_OFF);
    if (F.tid < 32) MISC[F.tid] = 0u;
    __syncthreads();
    const int lo = args.ph_lo, hi = args.ph_hi;
    const bool multi = (hi - lo) > 1;
    XcdBarrier bar; bar.bar = F.ctl + CW_BAR; bar.x = 0; bar.st = MISC + 8;
    if (multi) bar = xcd_barrier_post(F.ctl + CW_BAR, MISC + 8);
#define IN(k) (lo <= (k) && (k) < hi)
#define SEAM(k) do { if (IN(k) && IN((k) + 1)) { XcdBarrier bb_ = bar; asm volatile("" : "+s"(bb_.bar)); xcd_barrier(bb_); } } while (0)
    if (IN(0)) phase_p0(F);
    SEAM(0);
    for (int l = 0; l < DEPTH; ++l) {
        const int pb = 1 + l * PH_PER_LAYER;
        if (IN(pb + 0)) phase_rowA(F, l);
        SEAM(pb + 0);
        if (IN(pb + 1)) phase_inproj(F, l);
        SEAM(pb + 1);
        if (IN(pb + 2)) phase_elem(F, l);
        SEAM(pb + 2);
        if (IN(pb + 3)) phase_scan(F, l);
        SEAM(pb + 3);
        if (IN(pb + 4)) phase_carry(F, l);
        SEAM(pb + 4);
        if (IN(pb + 5)) phase_mix1(F, l);
        SEAM(pb + 5);
        if (IN(pb + 6)) phase_s5glu(F, l);
        SEAM(pb + 6);
        if (IN(pb + 7)) phase_wout(F, l);
        SEAM(pb + 7);
        if (IN(pb + 8)) phase_norm2(F, l);
        SEAM(pb + 8);
        if (IN(pb + 9)) phase_gateup(F, l);
        SEAM(pb + 9);
        if (IN(pb + 10)) phase_down(F, l);
        SEAM(pb + 10);
    }
    if (IN(N_PHASES - 1)) phase_rowA(F, DEPTH);
#undef IN
#undef SEAM
}

extern "C" void kernel_launch(void* const* d_in, const int* in_sizes, int n_in, void* d_out, int out_size, void* d_ws, size_t ws_size, hipStream_t stream) {
    static int grid = 0;
    if (grid == 0) {
        if (n_in != N_IN || out_size != TL * D || ws_size < WS_END) { fprintf(stderr, "kernel_launch: unexpected shapes (n_in %d out %d ws %zu)\n", n_in, out_size, ws_size); grid = -1; return; }
        int dev = 0, cus = 0, per_cu = 0;
        if (hipGetDevice(&dev) != hipSuccess || hipDeviceGetAttribute(&cus, hipDeviceAttributeMultiprocessorCount, dev) != hipSuccess) { grid = -1; return; }
        if (hipFuncSetAttribute((const void*)fwd_kernel, hipFuncAttributeMaxDynamicSharedMemorySize, LDS_BYTES) != hipSuccess) { fprintf(stderr, "kernel_launch: hipFuncSetAttribute failed\n"); grid = -1; return; }
        if (hipOccupancyMaxActiveBlocksPerMultiprocessor(&per_cu, (const void*)fwd_kernel, NTHR, LDS_BYTES) != hipSuccess || per_cu < 1) { fprintf(stderr, "kernel_launch: occupancy query says %d\n", per_cu); }
        (void)hipGetLastError();
        grid = cus;
    }
    if (grid < 0) return;
    if (hipMemsetAsync((char*)d_ws + WS_CTL, 0, CTL_ZERO_BYTES, stream) != hipSuccess) return;
    Args a{};
    for (int i = 0; i < N_IN; ++i) a.in[i] = (const float*)d_in[i];
    a.out = (float*)d_out; a.ws = (unsigned char*)d_ws;
#if MK_ONE_LAUNCH
    a.ph_lo = 0; a.ph_hi = N_PHASES;
    hipLaunchKernelGGL(fwd_kernel, dim3(grid), dim3(NTHR), LDS_BYTES, stream, a);
#else
    for (int p = 0; p < N_PHASES; ++p) { a.ph_lo = p; a.ph_hi = p + 1; hipLaunchKernelGGL(fwd_kernel, dim3(grid), dim3(NTHR), LDS_BYTES, stream, a); }
#endif
}
```

```cpp
#include <hip/hip_runtime.h>
#include <cstdio>
#include <cstdint>

#ifndef MK_ONE_LAUNCH
#define MK_ONE_LAUNCH 1
#endif

#define GAS __attribute__((address_space(1)))
#define LAS __attribute__((address_space(3)))
#define CAS __attribute__((address_space(4)))
typedef const float* cfp_t;
typedef unsigned short bf16;
typedef float f32x4 __attribute__((ext_vector_type(4)));
typedef float f32x2 __attribute__((ext_vector_type(2)));
typedef unsigned u32x4 __attribute__((ext_vector_type(4)));
typedef unsigned u32x2 __attribute__((ext_vector_type(2)));

constexpr int D = 1024, NB = 8, SEQ = 2048, CTXL = 256, DEPTH = 2;
constexpr int TL = NB * SEQ, TC = NB * CTXL, TT = TL + TC;
constexpr int INC = 2320;
constexpr int NCOL = 2304;
constexpr int VSEQ = CTXL + SEQ;
constexpr int NEXP = 16;
constexpr float EPS = 1e-6f;

enum { I_X = 0, I_C, I_CTX, I_CCTX, I_WADA, I_BADA, I_GMIX, I_WIN, I_SCW, I_SCB, I_SDTB, I_SALOG, I_SD, I_SNG,
       I_CDW, I_CDB, I_CLG, I_CLB, I_CPW, I_CPB, I_LRE, I_LIM, I_LSTEP, I_BRE, I_BIM, I_CRE, I_CIM, I_S5D, I_GLUW, I_GLUB,
       I_WOUT, I_GFFN, I_RW, I_RB, I_WG, I_WU, I_WD, I_GFIN, N_IN };

constexpr size_t MiB = 1u << 20;
constexpr size_t WS_CTL = 0, CTL_ZERO_BYTES = 64 * 1024;
constexpr size_t WS_MOD = 1 * MiB;
constexpr size_t WS_MODP = 2 * MiB;
constexpr size_t WS_DT = 6 * MiB;
constexpr size_t WS_S5AA = 5 * MiB + 512 * 1024;
constexpr size_t WS_S5BB = WS_S5AA + 32 * 1024;
constexpr size_t WS_S5CM = WS_S5BB + 256 * 1024;
constexpr size_t WS_TOKI = 7 * MiB + 512 * 1024;
constexpr size_t WS_TOKW = WS_TOKI + (size_t)TT * 16;
constexpr size_t WS_XS = 8 * MiB;
constexpr size_t WS_HN = 80 * MiB;
constexpr size_t WS_COLS = 116 * MiB;
constexpr size_t WS_XBCC = 197 * MiB;
constexpr size_t WS_CC = 197 * MiB;
constexpr size_t WS_YI = 207 * MiB;
constexpr size_t WS_SST = 226 * MiB;
constexpr size_t WS_HIN = 264 * MiB;
constexpr size_t WS_EDEC = 302 * MiB;
constexpr size_t WS_TOT = 304 * MiB;
constexpr size_t WS_YSSD = 233 * MiB;
constexpr size_t WS_MIX = 305 * MiB;
constexpr size_t WS_YS5 = 341 * MiB;
constexpr size_t WS_S5HL = 341 * MiB;
constexpr size_t WS_S5HI = 346 * MiB;
constexpr size_t WS_CU = 377 * MiB;
constexpr size_t WS_CV = 395 * MiB;
constexpr size_t WS_LIST = 413 * MiB;
constexpr size_t WS_WIN_T = 415 * MiB;
constexpr size_t WS_WOUT_T = 424 * MiB;
constexpr size_t WS_PW_T = 428 * MiB;
constexpr size_t WS_GLU_T = 428 * MiB + 512 * 1024;
constexpr size_t WS_WGU_T = 429 * MiB;
constexpr size_t WS_WD_T = 493 * MiB;
constexpr size_t WS_END = 525 * MiB;
constexpr int MOE_ROWS = 2 * TT + NEXP * 256;
constexpr size_t WS_HMID = WS_COLS;
constexpr size_t WS_YDN = WS_XBCC;
constexpr size_t WS_YG = WS_CU;
static_assert(WS_HMID + (size_t)MOE_ROWS * 1024 * 2 <= WS_XBCC, "HMID overlay");
static_assert(WS_YDN + (size_t)MOE_ROWS * 1024 * 2 <= WS_MIX, "YDN overlay");
constexpr int CW_CNT = 64;
constexpr int CW_BAR = 1024;

constexpr int NWAVES = 8, NTHR = 512;
constexpr int LDS_BYTES = 147456;
constexpr int MISC_OFF = 131072 + 320;
constexpr int TAB_OFF = 131072 + 512, ROWS_OFF = TAB_OFF + 256;

__device__ __forceinline__ float bf2f(bf16 v) { return __uint_as_float((unsigned)v << 16); }
__device__ __forceinline__ unsigned f2bf(float f) { unsigned u = __float_as_uint(f); return (u + 0x7fffu + ((u >> 16) & 1u)) >> 16; }
__device__ __forceinline__ unsigned pk2(float lo, float hi) { return f2bf(lo) | (f2bf(hi) << 16); }
__device__ __forceinline__ float shx(float v, int m, int lane) { return __int_as_float(__builtin_amdgcn_ds_bpermute((lane ^ m) << 2, __float_as_int(v))); }
__device__ __forceinline__ float wave_sum(float v, int lane) {
#pragma unroll
    for (int o = 1; o < 64; o <<= 1) v += shx(v, o, lane);
    return v;
}
__device__ __forceinline__ float sigmoidf_(float x) { return 1.f / (1.f + __expf(-x)); }
__device__ __forceinline__ float siluf_(float x) { return x / (1.f + __expf(-x)); }
__device__ __forceinline__ float softplusf_(float x) { return fmaxf(x, 0.f) + log1pf(__expf(-fabsf(x))); }
__device__ __forceinline__ float gelu_tanh(float x) { const float u = 0.7978845608028654f * (x + 0.044715f * x * x * x); return 0.5f * x * (1.f + tanhf(u)); }
__device__ __forceinline__ void sincos_red(float x, float& s, float& c) {
    const float k = rintf(x * 0.15915494309189535f);
    float r = fmaf(-k, 6.2831854820251465f, x); r = fmaf(-k, -1.7484555e-7f, r);
    s = __sinf(r); c = __cosf(r);
}
__device__ __forceinline__ int opaque_v(int v) { asm volatile("" : "+v"(v)); return v; }
__device__ __forceinline__ int modrow(int r) { return r < TL ? (r >> 11) : 8; }
__device__ __forceinline__ void seq_bounds(int r, int& lo, int& hi) {
    if (r < TL) { lo = r & ~(SEQ - 1); hi = lo + SEQ; } else { lo = TL + ((r - TL) & ~(CTXL - 1)); hi = lo + CTXL; }
}
__device__ __forceinline__ int vrow(int b, int dir, int s) {
    if (s < CTXL) return TL + b * CTXL + (dir ? CTXL - 1 - s : s);
    const int t = s - CTXL; return b * SEQ + (dir ? SEQ - 1 - t : t);
}

#define XB_TMO      128
#define XB_XCNT(j)  (256  + 64 * (j))
#define XB_XSUB(j)  (1280 + 64 * (j))
#define XB_XGEN(j)  (2304 + 64 * (j))
#define XB_TOP      3328
#define XB_TOPGEN   3392
#define XCD_BAR_WORDS 3456
#define XB_SPIN_CAP (1u << 18)
__device__ __forceinline__ unsigned xb_ld(unsigned* p)              { return __hip_atomic_load(p, __ATOMIC_RELAXED, __HIP_MEMORY_SCOPE_AGENT); }
__device__ __forceinline__ unsigned xb_add(unsigned* p, unsigned v) { return __hip_atomic_fetch_add(p, v, __ATOMIC_RELAXED, __HIP_MEMORY_SCOPE_AGENT); }
__device__ __forceinline__ unsigned xb_xcc_id() { return (unsigned)__builtin_amdgcn_s_getreg((3 << 11) | 20) & 0xFu; }
#define XB_SPIN(cond, bar) do { unsigned _sp = 0; while (cond) { __builtin_amdgcn_s_sleep(1); \
    if ((++_sp & 255u) == 0u) { if (xb_ld(&(bar)[XB_TMO])) break; if (_sp > XB_SPIN_CAP) { atomicAdd(&(bar)[XB_TMO], 1u); break; } } } } while (0)
struct XcdBarrier { unsigned* bar; unsigned x; volatile LAS unsigned* st; };
__device__ __forceinline__ XcdBarrier xcd_barrier_post(unsigned* bar, volatile LAS unsigned* st) {
    XcdBarrier b; b.bar = bar; b.x = xb_xcc_id(); b.st = st;
    if (threadIdx.x == 0) (void)xb_add(&bar[XB_XCNT(b.x)], 1u);
    return b;
}
__device__ __forceinline__ void xcd_barrier_complete(unsigned* bar, unsigned x, unsigned& nloc, unsigned& nx) {
    const unsigned G = gridDim.x * gridDim.y * gridDim.z;
    unsigned sum, cnt, mine, sp = 0u;
    for (;;) {
        sum = 0u; cnt = 0u; mine = 0u;
#pragma unroll
        for (unsigned j = 0; j < 16; ++j) { const unsigned c = xb_ld(&bar[XB_XCNT(j)]); sum += c; cnt += (c > 0u) ? 1u : 0u; mine = (j == x) ? c : mine; }
        if (sum == G) break;
        __builtin_amdgcn_s_sleep(1);
        if ((++sp & 255u) == 0u) { if (xb_ld(&bar[XB_TMO])) break; if (sp > XB_SPIN_CAP) { atomicAdd(&bar[XB_TMO], 1u); break; } }
    }
    nloc = mine > 0u ? mine : 1u; nx = cnt > 0u ? cnt : 1u;
}
__device__ __forceinline__ void xcd_barrier(const XcdBarrier& b) {
    asm volatile("s_waitcnt vmcnt(0)" ::: "memory");
    __syncthreads();
    if (threadIdx.x == 0) {
        unsigned* bar = b.bar;
        const unsigned bx = xb_xcc_id();
        __builtin_amdgcn_s_waitcnt(0);
        unsigned nloc = b.st[0], nx = b.st[1];
        if (nloc == 0u) { xcd_barrier_complete(bar, bx, nloc, nx); b.st[0] = nloc; b.st[1] = nx; }
        const unsigned old = xb_add(&bar[XB_XSUB(bx)], 1u);
        const unsigned gen = old / nloc;
        if (old + 1u == (gen + 1u) * nloc) {
            __builtin_amdgcn_fence(__ATOMIC_RELEASE, "agent");
            asm volatile("s_waitcnt vmcnt(0)" ::: "memory");
            const unsigned og = xb_add(&bar[XB_TOP], 1u);
            const unsigned tg = og / nx;
            if (og + 1u == (tg + 1u) * nx) xb_add(&bar[XB_TOPGEN], 1u);
            else XB_SPIN(xb_ld(&bar[XB_TOPGEN]) == tg, bar);
            __builtin_amdgcn_fence(__ATOMIC_ACQUIRE, "agent");
            xb_add(&bar[XB_XGEN(bx)], 1u);
            asm volatile("s_waitcnt vmcnt(0)" ::: "memory");
        } else {
            XB_SPIN(xb_ld(&bar[XB_XGEN(bx)]) == gen, bar);
            __builtin_amdgcn_fence(__ATOMIC_ACQUIRE, "agent");
            asm volatile("s_waitcnt vmcnt(0)" ::: "memory");
        }
    }
    __syncthreads();
}

struct Args { const float* in[N_IN]; float* out; unsigned char* ws; int ph_lo, ph_hi; };
struct Frame {
    LAS unsigned char* lds;
    int tid, lane, wave, G, bid;
    const CAS cfp_t* in;
    float* out; unsigned char* ws;
    unsigned* ctl;
    float *MOD, *MODP, *DT, *XS, *YSSD, *YS5, *CU;
    bf16 *HN, *COLS, *XBCC, *MIX, *HMID, *CV, *YG, *YDN, *WIN_T, *WOUT_T, *PW_T, *GLU_T, *WGU_T, *WD_T;
    int* LIST; int* TOKI; float* TOKW;
};
__device__ __forceinline__ void frame_ptrs(Frame& F, unsigned char* ws) {
    F.ws = ws; F.ctl = (unsigned*)(ws + WS_CTL);
    F.MOD = (float*)(ws + WS_MOD); F.MODP = (float*)(ws + WS_MODP); F.DT = (float*)(ws + WS_DT); F.XS = (float*)(ws + WS_XS);
    F.YSSD = (float*)(ws + WS_YSSD); F.YS5 = (float*)(ws + WS_YS5); F.CU = (float*)(ws + WS_CU); F.CV = (bf16*)(ws + WS_CV); F.YDN = (bf16*)(ws + WS_YDN); F.YG = (bf16*)(ws + WS_YG);
    F.WIN_T = (bf16*)(ws + WS_WIN_T); F.WOUT_T = (bf16*)(ws + WS_WOUT_T); F.PW_T = (bf16*)(ws + WS_PW_T); F.GLU_T = (bf16*)(ws + WS_GLU_T); F.WGU_T = (bf16*)(ws + WS_WGU_T); F.WD_T = (bf16*)(ws + WS_WD_T);
    F.HN = (bf16*)(ws + WS_HN); F.COLS = (bf16*)(ws + WS_COLS); F.XBCC = (bf16*)(ws + WS_XBCC); F.MIX = (bf16*)(ws + WS_MIX); F.HMID = (bf16*)(ws + WS_HMID);
    F.LIST = (int*)(ws + WS_LIST); F.TOKI = (int*)(ws + WS_TOKI); F.TOKW = (float*)(ws + WS_TOKW);
}
__device__ __forceinline__ Frame enter_phase(const Frame& F0) {
    Frame F = F0; unsigned om = ~0u; asm volatile("" : "+s"(om)); int ln = (int)__builtin_amdgcn_mbcnt_hi(om, __builtin_amdgcn_mbcnt_lo(om, 0u)); asm volatile("" : "+v"(ln));
    int wv_ = F0.wave, bid_ = F0.bid, g_ = F0.G; asm volatile("" : "+s"(wv_), "+s"(bid_), "+s"(g_));
    F.wave = wv_; F.bid = bid_; F.G = g_; F.lane = ln; F.tid = wv_ * 64 + ln;
    unsigned char* ws = F0.ws; asm volatile("" : "+s"(ws)); frame_ptrs(F, ws);
    const CAS cfp_t* ka = (const CAS cfp_t*)__builtin_amdgcn_kernarg_segment_ptr(); asm volatile("" : "+s"(ka)); F.in = ka;
    return F;
}

__device__ __forceinline__ void ld4(const float* p, float (&v)[4]) { const f32x4 t = *(const f32x4*)p; v[0] = t.x; v[1] = t.y; v[2] = t.z; v[3] = t.w; }
__device__ __forceinline__ void ld4(const bf16* p, float (&v)[4]) { const u32x2 t = *(const u32x2*)p; v[0] = __uint_as_float(t.x << 16); v[1] = __uint_as_float(t.x & 0xffff0000u); v[2] = __uint_as_float(t.y << 16); v[3] = __uint_as_float(t.y & 0xffff0000u); }

__device__ __forceinline__ void ld8(const bf16* p, float (&v)[8]) { const u32x4 t = *(const u32x4*)p;
    v[0] = __uint_as_float(t.x << 16); v[1] = __uint_as_float(t.x & 0xffff0000u); v[2] = __uint_as_float(t.y << 16); v[3] = __uint_as_float(t.y & 0xffff0000u);
    v[4] = __uint_as_float(t.z << 16); v[5] = __uint_as_float(t.z & 0xffff0000u); v[6] = __uint_as_float(t.w << 16); v[7] = __uint_as_float(t.w & 0xffff0000u); }

namespace pg8 {
typedef short bf16x8 __attribute__((ext_vector_type(8)));
constexpr int BM = 256, BK = 64, HALF = 128, HTB = HALF * BK * 2, STAGE_BYTES = 8 * HTB, NXCD = 8, WGM = 8;
__device__ __forceinline__ int lds_byte(int r, int c) { const int st = (r >> 4) * 2 + (c >> 5), rr = r & 15, cc = c & 31, ob = rr * 64 + cc * 2; return st * 1024 + (ob ^ (((ob >> 9) & 1) << 5)); }
__device__ __forceinline__ void stage_rc(int b, int& R, int& C) { const int st = b / 1024, sb = b % 1024, swz = sb ^ (((sb >> 9) & 1) << 5); R = (st >> 1) * 16 + swz / 64; C = (st & 1) * 32 + (swz % 64) / 2; }
__device__ __forceinline__ int perm32(int rho) { const int n = rho >> 4, i = rho & 15; return 8 * (i >> 2) + 4 * n + (i & 3); }
struct Unit { int pm, pn, idx; };
struct TileOrder {
    int nM, nN, nwg, G, c;
    __device__ __forceinline__ void init(int nM_, int nN_, int G_, int c_) { nM = nM_; nN = nN_; nwg = nM * nN; G = G_; c = c_; }
    __device__ __forceinline__ bool next(int i, Unit& u) const {
        const long L = (long)i * G + c; if (L >= nwg) return false;
        int wgid = (int)L; { const int q = nwg / NXCD, r = nwg % NXCD, xcd = wgid % NXCD, off = wgid / NXCD; wgid = (xcd < r ? xcd * (q + 1) : r * (q + 1) + (xcd - r) * q) + off; }
        const int nig = WGM * nN, gid = wgid / nig, fm = gid * WGM, gsz = (nM - fm) < WGM ? (nM - fm) : WGM;
        u.pm = fm + ((wgid % nig) % gsz); u.pn = (wgid % nig) / gsz; u.idx = i; return true;
    }
};
__device__ __forceinline__ unsigned cvt_pk_bf16(float lo, float hi) { unsigned r; asm volatile("v_cvt_pk_bf16_f32 %0, %1, %2" : "=v"(r) : "v"(lo), "v"(hi)); return r; }

template <class Epi, class Sched, bool ALIGN_EPI>
__device__ __forceinline__ void gemm_phase(LAS unsigned char* lds, const bf16* Abase, int K, const Sched& S, const Epi& E, int tid) {
    const int wid = __builtin_amdgcn_readfirstlane(tid >> 6), lane = tid & 63, wr = wid >> 2, wc = wid & 3, fr = lane & 15, fq = lane >> 4;
    const int nt = K / BK;
    unsigned voffB[2];
#pragma unroll
    for (int i = 0; i < 2; ++i) { int R, C; stage_rc(tid * 16 + i * 8192, R, C); const int Rb = Epi::PERM ? ((R & ~31) + perm32(R & 31)) : R; voffB[i] = (unsigned)(Rb * K + C) * 2u; }
    const size_t kstep = (size_t)(BK * 2);
    const size_t hstep = (size_t)HALF * K * 2;
    const unsigned ldsw = (unsigned)wid * 1024u;
    const int aoff = lds_byte(wr * 64 + fr, fq * 8), boff = lds_byte(wc * 32 + fr, fq * 8);
#define PG8_SA(b, h) (((b) * 2 + (h)) * HTB)
#define PG8_SB(b, h) ((4 + (b) * 2 + (h)) * HTB)
#define PG8_STAGE(bufoff, gbase, voff) do { _Pragma("unroll") for (int _i = 0; _i < 2; ++_i) \
        __builtin_amdgcn_global_load_lds((const unsigned*)((const char*)(gbase) + (voff)[_i]), (LAS unsigned*)(lds + (bufoff) + ldsw + _i * 8192), 16, 0, 0); } while (0)
#define PG8_LDA(dst, b, h) do { _Pragma("unroll") for (int m = 0; m < 4; ++m) _Pragma("unroll") for (int k = 0; k < 2; ++k) dst[m][k] = *(const LAS bf16x8*)(lds + PG8_SA(b, h) + aoff + m * 2048 + k * 1024); } while (0)
#define PG8_LDB(dst, b, h) do { _Pragma("unroll") for (int n = 0; n < 2; ++n) _Pragma("unroll") for (int k = 0; k < 2; ++k) dst[n][k] = *(const LAS bf16x8*)(lds + PG8_SB(b, h) + boff + n * 2048 + k * 1024); } while (0)
#define PG8_MMA(ai, bj, At, Bt) do { __builtin_amdgcn_s_setprio(1); _Pragma("unroll") for (int m = 0; m < 4; ++m) _Pragma("unroll") for (int n = 0; n < 2; ++n) _Pragma("unroll") for (int k = 0; k < 2; ++k) \
        acc[ai][bj][m][n] = __builtin_amdgcn_mfma_f32_16x16x32_bf16(Bt[n][k], At[m][k], acc[ai][bj][m][n], 0, 0, 0); __builtin_amdgcn_s_setprio(0); } while (0)
#define PG8_WAIT_V(n) asm volatile("s_waitcnt vmcnt(" #n ")" ::: "memory")
#define PG8_WAIT_L(n) asm volatile("s_waitcnt lgkmcnt(" #n ")" ::: "memory")
#define PG8_BAR __builtin_amdgcn_s_barrier()
#define PG8_SCHED __builtin_amdgcn_sched_barrier(0)
#define PG8_SETV(v, u) do { _Pragma("unroll") for (int _i = 0; _i < 2; ++_i) { int _R, _C; stage_rc(tid * 16 + _i * 8192, _R, _C); _Pragma("unroll") for (int _h = 0; _h < 2; ++_h) v[_h][_i] = (unsigned)(S.arow(u, _h * HALF + _R) * K + _C) * 2u; } } while (0)
    Unit cur, nxt; int ui = 0;
    if (!S.next(0, cur)) return;
    f32x4 acc[2][2][4][2];
#pragma unroll
    for (int a = 0; a < 2; ++a)
#pragma unroll
        for (int b = 0; b < 2; ++b)
#pragma unroll
            for (int m = 0; m < 4; ++m)
#pragma unroll
                for (int n = 0; n < 2; ++n) acc[a][b][m][n] = (f32x4){0.f, 0.f, 0.f, 0.f};
    bf16x8 At[4][2], B0[2][2], B1[2][2];
    unsigned vC[2][2], vN[2][2];
    PG8_SETV(vC, cur);
    const char* cA = (const char*)Abase; const char* cB = S.bbase(cur);
    PG8_WAIT_L(0);
    PG8_STAGE(PG8_SB(0, 0), cB, voffB); PG8_STAGE(PG8_SB(0, 1), cB + hstep, voffB); PG8_STAGE(PG8_SA(0, 0), cA, vC[0]); PG8_STAGE(PG8_SA(0, 1), cA, vC[1]);
    if (wr == 1) PG8_BAR;
    PG8_WAIT_V(2); PG8_BAR;
    PG8_STAGE(PG8_SB(1, 0), cB + kstep, voffB); PG8_STAGE(PG8_SA(1, 0), cA + kstep, vC[0]); PG8_STAGE(PG8_SB(1, 1), cB + hstep + kstep, voffB);
    PG8_WAIT_V(6); PG8_BAR;
    for (;;) {
        const bool has_next = S.next(ui + 1, nxt);
        const char* nB = cB;
        if (has_next) { PG8_SETV(vN, nxt); nB = S.bbase(nxt); }
        else {
#pragma unroll
            for (int _h = 0; _h < 2; ++_h)
#pragma unroll
                for (int _i = 0; _i < 2; ++_i) vN[_h][_i] = vC[_h][_i];
        }
        PG8_WAIT_L(0);
#pragma unroll 1
        for (int t = 0; t < nt; t += 2) {
            const bool last = (t == nt - 2);
            const char* a1 = cA + (size_t)(t + 1) * kstep;
            const char* a2 = last ? cA : cA + (size_t)(t + 2) * kstep; const char* b2 = last ? nB : cB + (size_t)(t + 2) * kstep;
            const char* a3 = a2 + kstep; const char* b3 = b2 + kstep;
            PG8_LDB(B0, 0, 0); PG8_LDB(B1, 0, 1); PG8_SCHED; PG8_LDA(At, 0, 0); PG8_STAGE(PG8_SA(1, 1), a1, vC[1]);
            if (last) {
#pragma unroll
                for (int _h = 0; _h < 2; ++_h)
#pragma unroll
                    for (int _i = 0; _i < 2; ++_i) vC[_h][_i] = vN[_h][_i];
            }
            PG8_WAIT_V(8); PG8_WAIT_L(0); PG8_BAR; PG8_MMA(0, 0, At, B0); PG8_MMA(0, 1, At, B1); PG8_BAR; PG8_SCHED;
            PG8_LDA(At, 0, 1); PG8_STAGE(PG8_SB(0, 0), b2, voffB); PG8_STAGE(PG8_SB(0, 1), b2 + hstep, voffB); PG8_STAGE(PG8_SA(0, 0), a2, vC[0]);
            PG8_WAIT_V(8); PG8_WAIT_L(0); PG8_BAR; PG8_MMA(1, 0, At, B0); PG8_MMA(1, 1, At, B1); PG8_BAR; PG8_SCHED;
            PG8_LDB(B0, 1, 0); PG8_LDB(B1, 1, 1); PG8_SCHED; PG8_LDA(At, 1, 0); PG8_STAGE(PG8_SA(0, 1), a2, vC[1]);
            PG8_WAIT_V(8); PG8_WAIT_L(0); PG8_BAR; PG8_MMA(0, 0, At, B0); PG8_MMA(0, 1, At, B1); PG8_BAR; PG8_SCHED;
            PG8_LDA(At, 1, 1); PG8_STAGE(PG8_SB(1, 0), b3, voffB); PG8_STAGE(PG8_SB(1, 1), b3 + hstep, voffB); PG8_STAGE(PG8_SA(1, 0), a3, vC[0]);
            PG8_WAIT_V(8); PG8_WAIT_L(0); PG8_BAR; PG8_MMA(1, 0, At, B0); PG8_MMA(1, 1, At, B1); PG8_BAR; PG8_SCHED;
        }
        if constexpr (ALIGN_EPI) { if (wr == 0) PG8_BAR; }
        E(acc, cur, wr, wc, fr, fq);
        if (!has_next) break;
#pragma unroll
        for (int a = 0; a < 2; ++a)
#pragma unroll
            for (int b = 0; b < 2; ++b)
#pragma unroll
                for (int m = 0; m < 4; ++m)
#pragma unroll
                    for (int n = 0; n < 2; ++n) acc[a][b][m][n] = (f32x4){0.f, 0.f, 0.f, 0.f};
        cur = nxt; cB = nB; ++ui;
        if constexpr (ALIGN_EPI) { if (wr == 1) PG8_BAR; }
    }
    PG8_WAIT_V(0);
    if constexpr (!ALIGN_EPI) { if (wr == 0) PG8_BAR; }
    PG8_BAR;
#undef PG8_SA
#undef PG8_SB
#undef PG8_STAGE
#undef PG8_LDA
#undef PG8_LDB
#undef PG8_MMA
#undef PG8_WAIT_V
#undef PG8_WAIT_L
#undef PG8_BAR
#undef PG8_SCHED
#undef PG8_SETV
}

struct PlainSched {
    TileOrder T; const char* Bt; int K;
    __device__ __forceinline__ bool next(int i, Unit& u) const { return T.next(i, u); }
    __device__ __forceinline__ int arow(const Unit& u, int r) const { return u.pm * BM + r; }
    __device__ __forceinline__ const char* bbase(const Unit& u) const { return Bt + (size_t)u.pn * BM * K * 2; }
};
template <bool GATHER> struct MoeSched {
    TileOrder T; const char* Bt; int K, NE; const LAS int* tab; const LAS int* rows;
    __device__ __forceinline__ bool next(int i, Unit& u) const { return T.next(i, u); }
    __device__ __forceinline__ int expert(int pm) const { const int s = pm * BM; int e = 0;
#pragma unroll
        for (int k = 1; k < NEXP; ++k) if (s >= tab[k]) e = k;
        return e; }
    __device__ __forceinline__ int arow(const Unit& u, int r) const { return GATHER ? rows[u.idx * BM + r] : u.pm * BM + r; }
    __device__ __forceinline__ const char* bbase(const Unit& u) const { return Bt + ((size_t)expert(u.pm) * NE + (size_t)u.pn * BM) * K * 2; }
};
struct EpiStoreBf16 {
    static constexpr bool PERM = true;
    bf16* O; int ldc, col0; const float* bias;
    __device__ __forceinline__ void operator()(const f32x4 (&acc)[2][2][4][2], const Unit& u, int wr, int wc, int fr, int fq) const {
        const int row0 = u.pm * BM + wr * 64 + fr, ct0 = u.pn * BM + wc * 32 + 8 * fq;
        f32x4 bv[2][2];
#pragma unroll
        for (int bj = 0; bj < 2; ++bj)
#pragma unroll
            for (int n = 0; n < 2; ++n) bv[bj][n] = bias ? *(const f32x4*)(bias + ct0 + bj * HALF + 4 * n) : (f32x4){0.f, 0.f, 0.f, 0.f};
#pragma unroll
        for (int ai = 0; ai < 2; ++ai)
#pragma unroll
            for (int m = 0; m < 4; ++m) { bf16* rowp = O + (size_t)(row0 + ai * HALF + m * 16) * ldc + col0 + ct0;
#pragma unroll
                for (int bj = 0; bj < 2; ++bj) { const f32x4 v0 = acc[ai][bj][m][0] + bv[bj][0], v1 = acc[ai][bj][m][1] + bv[bj][1];
                    u32x4 w; w.x = cvt_pk_bf16(v0[0], v0[1]); w.y = cvt_pk_bf16(v0[2], v0[3]); w.z = cvt_pk_bf16(v1[0], v1[1]); w.w = cvt_pk_bf16(v1[2], v1[3]);
                    *(u32x4*)(rowp + bj * HALF) = w; } }
    }
};
template <int ACT>
struct EpiPairBf16 {
    static constexpr bool PERM = true;
    bf16* O; int ldc, col0; const float* bias; int nb;
    __device__ __forceinline__ void operator()(const f32x4 (&acc)[2][2][4][2], const Unit& u, int wr, int wc, int fr, int fq) const {
        const int row0 = u.pm * BM + wr * 64 + fr, ct0 = u.pn * HALF + wc * 32 + 8 * fq;
        f32x4 ba[2], bb[2];
#pragma unroll
        for (int n = 0; n < 2; ++n) { ba[n] = (ACT == 1) ? *(const f32x4*)(bias + ct0 + 4 * n) : (f32x4){0.f, 0.f, 0.f, 0.f}; bb[n] = (ACT == 1) ? *(const f32x4*)(bias + nb + ct0 + 4 * n) : (f32x4){0.f, 0.f, 0.f, 0.f}; }
#pragma unroll
        for (int ai = 0; ai < 2; ++ai)
#pragma unroll
            for (int m = 0; m < 4; ++m) {
                float o[8];
#pragma unroll
                for (int n = 0; n < 2; ++n)
#pragma unroll
                    for (int j = 0; j < 4; ++j) { const float a = acc[ai][0][m][n][j] + ba[n][j], b = acc[ai][1][m][n][j] + bb[n][j];
                        o[n * 4 + j] = (ACT == 0) ? (a / (1.f + __expf(-a))) * b : a / (1.f + __expf(-b)); }
                u32x4 w; w.x = cvt_pk_bf16(o[0], o[1]); w.y = cvt_pk_bf16(o[2], o[3]); w.z = cvt_pk_bf16(o[4], o[5]); w.w = cvt_pk_bf16(o[6], o[7]);
                *(u32x4*)(O + (size_t)(row0 + ai * HALF + m * 16) * ldc + col0 + ct0) = w; }
    }
};
struct EpiResidual {
    static constexpr bool PERM = false;
    float* XS; const float* g1;
    __device__ __forceinline__ void operator()(const f32x4 (&acc)[2][2][4][2], const Unit& u, int wr, int wc, int fr, int fq) const {
        const int row0 = u.pm * BM + wr * 64 + fr, ct0 = u.pn * BM + wc * 32 + 4 * fq;
#pragma unroll
        for (int ai = 0; ai < 2; ++ai)
#pragma unroll
            for (int m = 0; m < 4; ++m) { const int row = row0 + ai * HALF + m * 16; float* xp = XS + (size_t)row * D + ct0; const float* gp = g1 + (size_t)modrow(row) * 6144 + ct0;
#pragma unroll
                for (int bj = 0; bj < 2; ++bj)
#pragma unroll
                    for (int n = 0; n < 2; ++n) { const int o = bj * HALF + n * 16; const f32x4 g = *(const f32x4*)(gp + o); f32x4 x = *(const f32x4*)(xp + o); x += g * acc[ai][bj][m][n]; *(f32x4*)(xp + o) = x; }
                if (m & 1) asm volatile("" ::: "memory"); }
    }
};
}

template <class RowMap>
__device__ __forceinline__ void transpose_item(const float* W, int K, int N, bf16* WT, const RowMap& rowmap, LAS float* scr, int item, int lane) {
    const int nblk = (N + 31) / 32, kb = item / nblk, nb = item % nblk, k0 = 64 * kb, n0 = 32 * nb;
    const bool cok = n0 + (lane & 31) < N;
#pragma unroll 8
    for (int i = 0; i < 32; ++i) { const int kk = 2 * i + (lane >> 5); scr[kk * 33 + (lane & 31)] = cok ? W[(size_t)(k0 + kk) * N + n0 + (lane & 31)] : 0.f; }
    asm volatile("s_waitcnt lgkmcnt(0)" ::: "memory");
    const int c = lane & 7;
#pragma unroll
    for (int j = 0; j < 4; ++j) { const int n = (lane >> 3) + 8 * j; const LAS float* sp = scr + (8 * c) * 33 + n;
        u32x4 o; o.x = pk2(sp[0 * 33], sp[1 * 33]); o.y = pk2(sp[2 * 33], sp[3 * 33]); o.z = pk2(sp[4 * 33], sp[5 * 33]); o.w = pk2(sp[6 * 33], sp[7 * 33]);
        const int dr = rowmap(n0 + n);
        if (dr >= 0) *(u32x4*)(WT + (size_t)dr * K + k0 + 8 * c) = o; }
    asm volatile("s_waitcnt lgkmcnt(0)" ::: "memory");
}


typedef short bf16x4s __attribute__((ext_vector_type(4)));
constexpr int S5_US = 264;
constexpr int S5_WS = 136;
__device__ __forceinline__ int s5_row0(int b, int c) { return c < 4 ? TL + b * CTXL + c * 64 : b * SEQ + (c - 4) * 64; }
template <int PASS>
__device__ __forceinline__ void s5_unit(const Frame& F, int l, int uidx) {
    const int b = uidx / 36, c = uidx % 36, r0 = s5_row0(b, c);
    LAS bf16* U = (LAS bf16*)F.lds;
    __syncthreads();
    for (int i = F.tid; i < 64 * 32; i += NTHR) { const int row = i >> 5, c8 = i & 31; *(LAS u32x4*)(U + row * S5_US + c8 * 8) = *(const u32x4*)(F.COLS + (size_t)(r0 + row) * NCOL + 2048 + c8 * 8); }
    __syncthreads();
    LAS bf16* BuS = (LAS bf16*)(F.lds + 64 * S5_US * 2 + F.wave * (2 * 16 * S5_WS * 2)); LAS bf16* Hs = BuS + 16 * S5_WS;
    int lane_ = F.lane; asm volatile("" : "+v"(lane_));
    const int q = lane_ >> 4, c16 = lane_ & 15, p = lane_;
    const f32x2* AA = (const f32x2*)(F.ws + WS_S5AA); const bf16* BB = (const bf16*)(F.ws + WS_S5BB); const bf16* CM = (const bf16*)(F.ws + WS_S5CM);
    f32x2* HL = (f32x2*)(F.ws + WS_S5HL); const f32x2* HI = (const f32x2*)(F.ws + WS_S5HI);
    u32x2 yout[2][4];
#pragma unroll
    for (int gi = 0; gi < 2; ++gi) {
        const int g = F.wave * 2 + gi;
        f32x4 yacc[4];
#pragma unroll
        for (int rs = 0; rs < 4; ++rs) yacc[rs] = (f32x4){0.f, 0.f, 0.f, 0.f};
        pg8::bf16x8 cm[4];
        if (PASS == 1) {
#pragma unroll
            for (int ks = 0; ks < 4; ++ks) cm[ks] = *(const pg8::bf16x8*)(CM + ((size_t)(l * 16 + g) * 16 + c16) * 128 + 32 * ks + 8 * q);
        }
#pragma unroll
        for (int dir = 0; dir < 2; ++dir) {
            const int pidx = ((l * 2 + dir) * 16 + g);
            const f32x2 aa = AA[pidx * 64 + p]; const float ar = aa.x, ai = aa.y;
            bf16x4s bb[8];
#pragma unroll
            for (int rt = 0; rt < 8; ++rt) bb[rt] = *(const bf16x4s*)(BB + ((size_t)pidx * 128 + 16 * rt + c16) * 16 + 4 * q);
            const size_t sidx = ((size_t)(b * 36 + c) * 32 + g * 2 + dir) * 64 + p;
            float hr = 0.f, hi = 0.f;
            if (PASS == 1) { const f32x2 h0 = HI[sidx]; hr = h0.x; hi = h0.y; }
#pragma unroll
            for (int sci = 0; sci < 4; ++sci) {
                const int rs = dir ? 3 - sci : sci;
                const bf16x4s bop = *(const LAS bf16x4s*)(U + (16 * rs + c16) * S5_US + g * 16 + 4 * q);
#pragma unroll
                for (int rt = 0; rt < 8; ++rt) {
                    const f32x4 a = __builtin_amdgcn_mfma_f32_16x16x16bf16_1k(bb[rt], bop, (f32x4){0.f, 0.f, 0.f, 0.f}, 0, 0, 0);
                    u32x2 w; w.x = pk2(a[0], a[1]); w.y = pk2(a[2], a[3]);
                    *(LAS u32x2*)(BuS + c16 * S5_WS + 16 * rt + 4 * q) = w;
                }
                asm volatile("s_waitcnt lgkmcnt(0)" ::: "memory");
                unsigned bu[16];
#pragma unroll
                for (int st = 0; st < 16; ++st) bu[st] = *(const LAS unsigned*)(BuS + (dir ? 15 - st : st) * S5_WS + 2 * p);
#pragma unroll
                for (int st = 0; st < 16; ++st) {
                    const float bur = __uint_as_float(bu[st] << 16), bui = __uint_as_float(bu[st] & 0xffff0000u);
                    const float nr = fmaf(ar, hr, fmaf(-ai, hi, bur)), ni = fmaf(ar, hi, fmaf(ai, hr, bui)); hr = nr; hi = ni;
                    if (PASS == 1) *(LAS unsigned*)(Hs + (dir ? 15 - st : st) * S5_WS + 2 * p) = pk2(hr, hi);
                }
                if (PASS == 1) {
                    asm volatile("s_waitcnt lgkmcnt(0)" ::: "memory");
#pragma unroll
                    for (int ks = 0; ks < 4; ++ks) { const pg8::bf16x8 hf = *(const LAS pg8::bf16x8*)(Hs + c16 * S5_WS + 32 * ks + 8 * q);
                        yacc[rs] = __builtin_amdgcn_mfma_f32_16x16x32_bf16(cm[ks], hf, yacc[rs], 0, 0, 0); }
                }
                asm volatile("s_waitcnt lgkmcnt(0)" ::: "memory");
            }
            if (PASS == 0) HL[sidx] = (f32x2){hr, hi};
        }
        if (PASS == 1) {
            const f32x4 dsk = *(const f32x4*)(F.in[I_S5D] + l * 256 + g * 16 + 4 * q);
#pragma unroll
            for (int rs = 0; rs < 4; ++rs) {
                float u4[4]; { const u32x2 t = *(const LAS u32x2*)(U + (16 * rs + c16) * S5_US + g * 16 + 4 * q);
                    u4[0] = __uint_as_float(t.x << 16); u4[1] = __uint_as_float(t.x & 0xffff0000u); u4[2] = __uint_as_float(t.y << 16); u4[3] = __uint_as_float(t.y & 0xffff0000u); }
                float o[4];
#pragma unroll
                for (int j = 0; j < 4; ++j) o[j] = gelu_tanh(yacc[rs][j] + dsk[j] * u4[j]);
                yout[gi][rs].x = pk2(o[0], o[1]); yout[gi][rs].y = pk2(o[2], o[3]);
            }
        }
    }
    if (PASS == 1) {
        __syncthreads();
#pragma unroll
        for (int gi = 0; gi < 2; ++gi)
#pragma unroll
            for (int rs = 0; rs < 4; ++rs) *(LAS u32x2*)(U + (16 * rs + c16) * S5_US + (F.wave * 2 + gi) * 16 + 4 * q) = yout[gi][rs];
        __syncthreads();
        const bf16* GW = F.GLU_T + (size_t)l * 512 * 256;
        f32x4 av[2][4], ag[2][4];
#pragma unroll
        for (int nt = 0; nt < 2; ++nt)
#pragma unroll
            for (int rt = 0; rt < 4; ++rt) { av[nt][rt] = (f32x4){0.f, 0.f, 0.f, 0.f}; ag[nt][rt] = (f32x4){0.f, 0.f, 0.f, 0.f}; }
#pragma unroll 2
        for (int ks = 0; ks < 8; ++ks) {
            pg8::bf16x8 wv[2], wg[2], yf[4];
#pragma unroll
            for (int nt = 0; nt < 2; ++nt) { wv[nt] = *(const pg8::bf16x8*)(GW + (size_t)(32 * F.wave + 16 * nt + c16) * 256 + 32 * ks + 8 * q); wg[nt] = *(const pg8::bf16x8*)(GW + (size_t)(256 + 32 * F.wave + 16 * nt + c16) * 256 + 32 * ks + 8 * q); }
#pragma unroll
            for (int rt = 0; rt < 4; ++rt) yf[rt] = *(const LAS pg8::bf16x8*)(U + (16 * rt + c16) * S5_US + 32 * ks + 8 * q);
#pragma unroll
            for (int nt = 0; nt < 2; ++nt)
#pragma unroll
                for (int rt = 0; rt < 4; ++rt) { av[nt][rt] = __builtin_amdgcn_mfma_f32_16x16x32_bf16(wv[nt], yf[rt], av[nt][rt], 0, 0, 0); ag[nt][rt] = __builtin_amdgcn_mfma_f32_16x16x32_bf16(wg[nt], yf[rt], ag[nt][rt], 0, 0, 0); }
        }
        const float* gb = F.in[I_GLUB] + l * 512;
#pragma unroll
        for (int nt = 0; nt < 2; ++nt) { const int n0 = 32 * F.wave + 16 * nt + 4 * q; const f32x4 bv = *(const f32x4*)(gb + n0), bg = *(const f32x4*)(gb + 256 + n0);
#pragma unroll
            for (int rt = 0; rt < 4; ++rt) { float o[4];
#pragma unroll
                for (int j = 0; j < 4; ++j) o[j] = (av[nt][rt][j] + bv[j]) * sigmoidf_(ag[nt][rt][j] + bg[j]);
                u32x2 w; w.x = pk2(o[0], o[1]); w.y = pk2(o[2], o[3]);
                *(u32x2*)(F.MIX + (size_t)(r0 + 16 * rt + c16) * 1024 + 768 + n0) = w; } }
    }
}
__device__ __forceinline__ void s5_carry(const Frame& F, int l) {
    const int gt = F.bid * NTHR + F.tid, NG = F.G * NTHR;
    const f32x2* AA = (const f32x2*)(F.ws + WS_S5AA); const f32x2* HL = (const f32x2*)(F.ws + WS_S5HL); f32x2* HI = (f32x2*)(F.ws + WS_S5HI);
    for (int i = gt; i < NB * 32 * 64; i += NG) {
        const int p = i & 63, gd = (i >> 6) & 31, b = i >> 11, g = gd >> 1, dir = gd & 1;
        f32x2 a = AA[((l * 2 + dir) * 16 + g) * 64 + p];
#pragma unroll
        for (int k = 0; k < 6; ++k) a = (f32x2){a.x * a.x - a.y * a.y, 2.f * a.x * a.y};
        float hr = 0.f, hi = 0.f;
#pragma unroll 4
        for (int j = 0; j < 36; ++j) {
            const int c = dir ? (j < 4 ? 3 - j : 39 - j) : j;
            const size_t idx = ((size_t)(b * 36 + c) * 32 + gd) * 64 + p;
            HI[idx] = (f32x2){hr, hi};
            const f32x2 hl = HL[idx];
            const float nr = a.x * hr - a.y * hi + hl.x, ni = a.x * hi + a.y * hr + hl.y; hr = nr; hi = ni;
        }
    }
}


constexpr int SSD_LD = 136;
__device__ __forceinline__ int ssd_row0(int b, int cid) { return cid < 2 ? TL + b * CTXL + cid * 128 : b * SEQ + (cid - 2) * 128; }
__device__ __forceinline__ pg8::bf16x8 mk8(u32x2 lo, u32x2 hi) { u32x4 t; t.x = lo.x; t.y = lo.y; t.z = hi.x; t.w = hi.y; return __builtin_bit_cast(pg8::bf16x8, t); }
__device__ __forceinline__ void ssd_unit_a(const Frame& F, int l, int uidx) {
    const int h = uidx & 7, uc = uidx >> 3, b = uc / 18, cid = uc % 18, g = h >> 2, r0 = ssd_row0(b, cid);
    LAS bf16* XT = (LAS bf16*)F.lds; LAS bf16* Bn = XT + 64 * SSD_LD; LAS bf16* BT = Bn + 128 * SSD_LD; LAS bf16* Cn = BT + 128 * SSD_LD;
    LAS float* cs0 = (LAS float*)(Cn + 128 * SSD_LD); LAS float* ecs1 = cs0 + 128; LAS float* dt0 = ecs1 + 128; LAS float* dt1 = dt0 + 128; LAS float* w0 = dt1 + 128; LAS float* w1 = w0 + 128;
    __syncthreads();
    if (F.wave == 0) {
        const float A0 = -expf(F.in[I_SALOG][l * 16 + h]), A1 = -expf(F.in[I_SALOG][l * 16 + 8 + h]);
        const float db0 = F.in[I_SDTB][l * 16 + h], db1 = F.in[I_SDTB][l * 16 + 8 + h];
        const int t0 = 2 * F.lane;
        const float d00 = softplusf_(F.DT[(size_t)(r0 + t0) * 16 + h] + db0), d01 = softplusf_(F.DT[(size_t)(r0 + t0 + 1) * 16 + h] + db0);
        const float d10 = softplusf_(F.DT[(size_t)(r0 + t0) * 16 + 8 + h] + db1), d11 = softplusf_(F.DT[(size_t)(r0 + t0 + 1) * 16 + 8 + h] + db1);
        const float a00 = d00 * A0, a01 = d01 * A0, a10 = d10 * A1, a11 = d11 * A1;
        float p0 = a00 + a01, p1 = a10 + a11;
#pragma unroll
        for (int o = 1; o < 64; o <<= 1) { const float u0 = __int_as_float(__builtin_amdgcn_ds_bpermute((F.lane - o) << 2, __float_as_int(p0))), u1 = __int_as_float(__builtin_amdgcn_ds_bpermute((F.lane - o) << 2, __float_as_int(p1)));
            if (F.lane >= o) { p0 += u0; p1 += u1; } }
        const float tot0 = __int_as_float(__builtin_amdgcn_readlane(__float_as_int(p0), 63)), tot1 = __int_as_float(__builtin_amdgcn_readlane(__float_as_int(p1), 63));
        const float c01 = p0, c00 = p0 - a01;
        const float e11 = p1 - a11, e10 = e11 - a10;
        cs0[t0] = c00; cs0[t0 + 1] = c01; ecs1[t0] = e10; ecs1[t0 + 1] = e11; dt0[t0] = d00; dt0[t0 + 1] = d01; dt1[t0] = d10; dt1[t0 + 1] = d11;
        w0[t0] = __expf(tot0 - c00) * d00; w0[t0 + 1] = __expf(tot0 - c01) * d01; w1[t0] = __expf(e10) * d10; w1[t0 + 1] = __expf(e11) * d11;
        float* ed = (float*)(F.ws + WS_EDEC) + ((size_t)(r0 + t0) * 8 + h) * 2;
        ed[0] = __expf(c00); ed[1] = __expf(tot1 - e10); ed[16] = __expf(c01); ed[17] = __expf(tot1 - e11);
        if (F.lane == 0) { float* tt = (float*)(F.ws + WS_TOT) + ((size_t)uc * 8 + h) * 2; tt[0] = tot0; tt[1] = tot1; }
    }
    {
        int lo, hi; seq_bounds(r0, lo, hi);
        const float* cw = F.in[I_SCW] + (size_t)l * 5 * 1024; const float* cb = F.in[I_SCB] + l * 1024;
        bf16* CC = (bf16*)(F.ws + WS_CC);
        for (int it = F.tid; it < 640; it += NTHR) {
            const int oct = it % 40, seg = it / 40, s0 = seg * 8;
            const int kind = oct < 8 ? 0 : (oct < 24 ? 1 : 2);
            const int n0 = kind == 0 ? oct * 8 : (kind == 1 ? (oct - 8) * 8 : (oct - 24) * 8);
            const int xch = kind == 0 ? h * 64 + n0 : (kind == 1 ? 512 + g * 128 + n0 : 768 + g * 128 + n0);
            u32x4 xr[12];
            const bool lo_ok = (r0 + s0 - 2) >= lo, hi_ok = (r0 + s0 + 9) < hi;
            const bf16* xp = F.COLS + (size_t)(r0 + s0) * NCOL + 512 + xch;
#pragma unroll
            for (int i = 2; i < 10; ++i) xr[i] = *(const u32x4*)(xp + (i - 2) * NCOL);
            xr[0] = xr[2]; xr[1] = xr[2]; xr[10] = xr[9]; xr[11] = xr[9];
            if (lo_ok) { xr[0] = *(const u32x4*)(xp - 2 * NCOL); xr[1] = *(const u32x4*)(xp - NCOL); } else { xr[0] = (u32x4){0u, 0u, 0u, 0u}; xr[1] = xr[0]; }
            if (hi_ok) { xr[10] = *(const u32x4*)(xp + 8 * NCOL); xr[11] = *(const u32x4*)(xp + 9 * NCOL); } else { xr[10] = (u32x4){0u, 0u, 0u, 0u}; xr[11] = xr[10]; }
#pragma unroll
            for (int hb = 0; hb < 2; ++hb) {
                float wv[5][4]; float val[8][4];
#pragma unroll
                for (int j = 0; j < 5; ++j) { const f32x4 t = *(const f32x4*)(cw + j * 1024 + xch + 4 * hb); wv[j][0] = t.x; wv[j][1] = t.y; wv[j][2] = t.z; wv[j][3] = t.w; }
                const f32x4 bias = *(const f32x4*)(cb + xch + 4 * hb);
#pragma unroll
                for (int i = 0; i < 8; ++i)
#pragma unroll
                    for (int k = 0; k < 4; ++k) val[i][k] = bias[k];
#pragma unroll
                for (int i = 0; i < 12; ++i) {
                    const unsigned wa = hb ? xr[i].z : xr[i].x, wb = hb ? xr[i].w : xr[i].y;
                    const float x4[4] = {__uint_as_float(wa << 16), __uint_as_float(wa & 0xffff0000u), __uint_as_float(wb << 16), __uint_as_float(wb & 0xffff0000u)};
#pragma unroll
                    for (int j = 0; j < 5; ++j) { const int o = i - j;
                        if (o >= 0 && o < 8) {
#pragma unroll
                            for (int k = 0; k < 4; ++k) val[o][k] = fmaf(wv[j][k], x4[k], val[o][k]); } }
                }
#pragma unroll
                for (int i = 0; i < 8; ++i)
#pragma unroll
                    for (int k = 0; k < 4; ++k) val[i][k] = siluf_(val[i][k]);
                if (kind != 0) {
                    LAS bf16* N = kind == 1 ? Bn : Cn;
#pragma unroll
                    for (int i = 0; i < 8; ++i) { u32x2 o; o.x = pk2(val[i][0], val[i][1]); o.y = pk2(val[i][2], val[i][3]); *(LAS u32x2*)(N + (s0 + i) * SSD_LD + n0 + 4 * hb) = o;
                        if (kind == 2 && (h & 3) == 0) *(u32x2*)(CC + (size_t)(r0 + s0 + i) * 256 + g * 128 + n0 + 4 * hb) = o; }
                }
                if (kind != 2) {
                    LAS bf16* T = kind == 0 ? XT : BT;
#pragma unroll
                    for (int k = 0; k < 4; ++k) { u32x4 o; o.x = pk2(val[0][k], val[1][k]); o.y = pk2(val[2][k], val[3][k]); o.z = pk2(val[4][k], val[5][k]); o.w = pk2(val[6][k], val[7][k]);
                        *(LAS u32x4*)(T + (n0 + 4 * hb + k) * SSD_LD + s0) = o; }
                }
            }
        }
    }
    __syncthreads();
    int lane_ = F.lane; asm volatile("" : "+v"(lane_));
    const int q = lane_ >> 4, c = lane_ & 15, w = F.wave;
    {
        pg8::bf16x8 cfr[4];
#pragma unroll
        for (int ks = 0; ks < 4; ++ks) cfr[ks] = *(const LAS pg8::bf16x8*)(Cn + (16 * w + c) * SSD_LD + 32 * ks + 8 * q);
        f32x4 gt[8];
#pragma unroll
        for (int a = 0; a < 8; ++a) { f32x4 acc = {0.f, 0.f, 0.f, 0.f};
#pragma unroll
            for (int ks = 0; ks < 4; ++ks) acc = __builtin_amdgcn_mfma_f32_16x16x32_bf16(*(const LAS pg8::bf16x8*)(Bn + (16 * a + c) * SSD_LD + 32 * ks + 8 * q), cfr[ks], acc, 0, 0, 0);
            gt[a] = acc; }
        const int t = 16 * w + c; const float cs0t = cs0[t], e1t = ecs1[t], Dh = F.in[I_SD][l * 8 + h];
#pragma unroll
        for (int a = 0; a < 8; ++a) {
            const f32x4 csv = *(const LAS f32x4*)&cs0[16 * a + 4 * q], d0v = *(const LAS f32x4*)&dt0[16 * a + 4 * q], e1v = *(const LAS f32x4*)&ecs1[16 * a + 4 * q], d1v = *(const LAS f32x4*)&dt1[16 * a + 4 * q];
#pragma unroll
            for (int j = 0; j < 4; ++j) { const int sidx = 16 * a + 4 * q + j;
                const float f0 = (sidx <= t) ? __expf(fminf(cs0t - csv[j], 0.f)) * d0v[j] : 0.f;
                const float f1 = (sidx >= t) ? __expf(fminf(e1v[j] - e1t, 0.f)) * d1v[j] : 0.f;
                gt[a][j] = gt[a][j] * (f0 + f1) + ((sidx == t) ? Dh : 0.f); }
        }
        pg8::bf16x8 mfr[4];
#pragma unroll
        for (int i = 0; i < 4; ++i) { u32x4 tq; tq.x = pk2(gt[2 * i][0], gt[2 * i][1]); tq.y = pk2(gt[2 * i][2], gt[2 * i][3]); tq.z = pk2(gt[2 * i + 1][0], gt[2 * i + 1][1]); tq.w = pk2(gt[2 * i + 1][2], gt[2 * i + 1][3]); mfr[i] = __builtin_bit_cast(pg8::bf16x8, tq); }
        bf16* YI = (bf16*)(F.ws + WS_YI);
#pragma unroll
        for (int pt = 0; pt < 4; ++pt) { f32x4 acc = {0.f, 0.f, 0.f, 0.f};
#pragma unroll
            for (int i = 0; i < 4; ++i) { const LAS bf16* xp = XT + (16 * pt + c) * SSD_LD + 32 * i + 4 * q;
                acc = __builtin_amdgcn_mfma_f32_16x16x32_bf16(mk8(*(const LAS u32x2*)xp, *(const LAS u32x2*)(xp + 16)), mfr[i], acc, 0, 0, 0); }
            u32x2 o; o.x = pk2(acc[0], acc[1]); o.y = pk2(acc[2], acc[3]);
            *(u32x2*)(YI + (((size_t)uidx * 32 + pt * 8 + w) * 64 + F.lane) * 4) = o; }
    }
    {
        pg8::bf16x8 btf[4];
#pragma unroll
        for (int ks = 0; ks < 4; ++ks) btf[ks] = *(const LAS pg8::bf16x8*)(BT + (16 * w + c) * SSD_LD + 32 * ks + 8 * q);
        bf16* SST = (bf16*)(F.ws + WS_SST);
#pragma unroll
        for (int d = 0; d < 2; ++d) { const LAS float* wd = d ? w1 : w0;
#pragma unroll
            for (int pt = 0; pt < 4; ++pt) { f32x4 acc = {0.f, 0.f, 0.f, 0.f};
#pragma unroll
                for (int ks = 0; ks < 4; ++ks) {
                    const u32x4 xq = *(const LAS u32x4*)(XT + (16 * pt + c) * SSD_LD + 32 * ks + 8 * q);
                    const f32x4 wa = *(const LAS f32x4*)&wd[32 * ks + 8 * q], wb = *(const LAS f32x4*)&wd[32 * ks + 8 * q + 4];
                    u32x4 sq;
                    sq.x = pk2(__uint_as_float(xq.x << 16) * wa[0], __uint_as_float(xq.x & 0xffff0000u) * wa[1]); sq.y = pk2(__uint_as_float(xq.y << 16) * wa[2], __uint_as_float(xq.y & 0xffff0000u) * wa[3]);
                    sq.z = pk2(__uint_as_float(xq.z << 16) * wb[0], __uint_as_float(xq.z & 0xffff0000u) * wb[1]); sq.w = pk2(__uint_as_float(xq.w << 16) * wb[2], __uint_as_float(xq.w & 0xffff0000u) * wb[3]);
                    acc = __builtin_amdgcn_mfma_f32_16x16x32_bf16(btf[ks], __builtin_bit_cast(pg8::bf16x8, sq), acc, 0, 0, 0); }
                u32x2 o; o.x = pk2(acc[0], acc[1]); o.y = pk2(acc[2], acc[3]);
                *(u32x2*)(SST + (((size_t)uidx * 2 + d) * 64 + 16 * pt + c) * 128 + 16 * w + 4 * q) = o; }
        }
    }
}
__device__ __forceinline__ void ssd_carry(const Frame& F) {
    const int gt = F.bid * NTHR + F.tid, NG = F.G * NTHR;
    const bf16* SST = (const bf16*)(F.ws + WS_SST); bf16* HIN = (bf16*)(F.ws + WS_HIN); const float* TOT = (const float*)(F.ws + WS_TOT);
    for (int i = gt; i < NB * 8 * 2 * 1024; i += NG) {
        const int e8 = i & 1023, d = (i >> 10) & 1, h = (i >> 11) & 7, b = i >> 14;
        float H[8];
#pragma unroll
        for (int k = 0; k < 8; ++k) H[k] = 0.f;
#pragma unroll 2
        for (int j = 0; j < 18; ++j) {
            const int cid = d ? (j < 2 ? 1 - j : 19 - j) : j;
            const size_t ui = (size_t)(b * 18 + cid) * 8 + h, off = ((ui * 2 + d) * 1024 + e8) * 8;
            u32x4 o; o.x = pk2(H[0], H[1]); o.y = pk2(H[2], H[3]); o.z = pk2(H[4], H[5]); o.w = pk2(H[6], H[7]);
            *(u32x4*)(HIN + off) = o;
            float sv[8]; ld8(SST + off, sv);
            const float dec = __expf(TOT[ui * 2 + d]);
#pragma unroll
            for (int k = 0; k < 8; ++k) H[k] = fmaf(H[k], dec, sv[k]);
        }
    }
}
__device__ __forceinline__ void ssd_unit_b(const Frame& F, int l, int uc) {
    const int b = uc / 18, cid = uc % 18, r0 = ssd_row0(b, cid);
    int lane_ = F.lane; asm volatile("" : "+v"(lane_));
    const int q = lane_ >> 4, c = lane_ & 15, w = F.wave;
    const size_t row = (size_t)(r0 + 16 * w + c);
    const bf16* CC = (const bf16*)(F.ws + WS_CC); const bf16* HIN = (const bf16*)(F.ws + WS_HIN); const bf16* YI = (const bf16*)(F.ws + WS_YI); const float* ED = (const float*)(F.ws + WS_EDEC);
    float ss = 0.f;
#pragma unroll 1
    for (int h = 0; h < 8; ++h) {
        const int g = h >> 2;
        pg8::bf16x8 cfr[4];
#pragma unroll
        for (int ks = 0; ks < 4; ++ks) cfr[ks] = *(const pg8::bf16x8*)(CC + row * 256 + g * 128 + 32 * ks + 8 * q);
        const f32x2 ed = *(const f32x2*)(ED + (row * 8 + h) * 2);
        const size_t ui = (size_t)uc * 8 + h;
#pragma unroll
        for (int pt = 0; pt < 4; ++pt) {
            f32x4 a0 = {0.f, 0.f, 0.f, 0.f}, a1 = {0.f, 0.f, 0.f, 0.f};
#pragma unroll
            for (int ks = 0; ks < 4; ++ks) {
                a0 = __builtin_amdgcn_mfma_f32_16x16x32_bf16(*(const pg8::bf16x8*)(HIN + ((ui * 2 + 0) * 64 + 16 * pt + c) * 128 + 32 * ks + 8 * q), cfr[ks], a0, 0, 0, 0);
                a1 = __builtin_amdgcn_mfma_f32_16x16x32_bf16(*(const pg8::bf16x8*)(HIN + ((ui * 2 + 1) * 64 + 16 * pt + c) * 128 + 32 * ks + 8 * q), cfr[ks], a1, 0, 0, 0);
            }
            float yi[4], z[4]; ld4(YI + ((ui * 32 + pt * 8 + w) * 64 + F.lane) * 4, yi); ld4(F.COLS + row * NCOL + h * 64 + 16 * pt + 4 * q, z);
            float v[4];
#pragma unroll
            for (int j = 0; j < 4; ++j) { v[j] = (yi[j] + ed.x * a0[j] + ed.y * a1[j]) * siluf_(z[j]); ss = fmaf(v[j], v[j], ss); }
            u32x2 o; o.x = pk2(v[0], v[1]); o.y = pk2(v[2], v[3]);
            *(u32x2*)(F.MIX + row * 1024 + h * 64 + 16 * pt + 4 * q) = o;
        }
    }
    ss += shx(ss, 16, F.lane); ss += shx(ss, 32, F.lane);
    const float rstd = rsqrtf(ss * (1.f / 512.f) + EPS);
    const float* ng = F.in[I_SNG] + l * 512;
#pragma unroll 4
    for (int k = 0; k < 32; ++k) {
        bf16* mp = F.MIX + row * 1024 + k * 16 + 4 * q;
        float v[4]; ld4(mp, v); const f32x4 gn = *(const f32x4*)(ng + k * 16 + 4 * q);
        u32x2 o; o.x = pk2(v[0] * rstd * gn[0], v[1] * rstd * gn[1]); o.y = pk2(v[2] * rstd * gn[2], v[3] * rstd * gn[3]);
        *(u32x2*)mp = o;
    }
}


__device__ __forceinline__ void stage_wt16(LAS float* WT, const float* src, int stride, int tid) {
    for (int i = tid; i < 4096; i += NTHR) { const int k = i >> 2, e4 = (i & 3) * 4; const f32x4 v = *(const f32x4*)(src + (size_t)k * stride + e4);
        WT[(e4 + 0) * 1024 + k] = v.x; WT[(e4 + 1) * 1024 + k] = v.y; WT[(e4 + 2) * 1024 + k] = v.z; WT[(e4 + 3) * 1024 + k] = v.w; }
}
__device__ __forceinline__ void dot16_acc(const LAS float* WT, const f32x4& h, int j, int lane, float (&acc)[16]) {
#pragma unroll
    for (int e = 0; e < 16; ++e) { const f32x4 w = *(const LAS f32x4*)&WT[e * 1024 + 4 * lane + 256 * j]; acc[e] = fmaf(h.x, w.x, fmaf(h.y, w.y, fmaf(h.z, w.z, fmaf(h.w, w.w, acc[e])))); }
    asm volatile("" ::: "memory");
}

__device__ __forceinline__ void phase_p0(const Frame& F0)  {
    Frame F = enter_phase(F0);
    {
        const size_t gt = (size_t)F.bid * NTHR + F.tid, NG = (size_t)F.G * NTHR;
        for (size_t i = gt; i < (size_t)TT * 256; i += NG) {
            const int r = (int)(i >> 8), c4 = (int)(i & 255) * 4;
            f32x4 v;
            if (r < TL) {
                v = *(const f32x4*)(F.in[I_X] + (size_t)r * D + c4);
                const int n = r & (SEQ - 1), rr = n >> 6, cc = n & 63, q = c4 >> 8, ii = c4 & 255;
                const float pos = (float)(q < 2 ? rr : cc);
                float pe[4];
#pragma unroll
                for (int k = 0; k < 4; ++k) {
                    const float invf = expf(-9.210340371976184f * (float)(ii + k) * (1.f / 256.f));
                    float s, c; sincos_red(pos * invf, s, c);
                    pe[k] = (q & 1) ? c : s;
                }
                v.x += pe[0]; v.y += pe[1]; v.z += pe[2]; v.w += pe[3];
            } else {
                v = *(const f32x4*)(F.in[I_CTX] + (size_t)(r - TL) * D + c4);
            }
            *(f32x4*)(F.XS + (size_t)r * D + c4) = v;
        }
    }
    {
        LAS float* scr = (LAS float*)F.lds + F.wave * (64 * 33);
        const int gw = F.bid * NWAVES + F.wave, NGW = F.G * NWAVES;
        constexpr int I_IN = 16 * 73, I_OUT = 16 * 32, I_PW = 4 * 8, I_GLU = 4 * 16, I_L = I_IN + I_OUT + I_PW + I_GLU;
        for (int it = gw; it < 2 * I_L; it += NGW) {
            const int l = it / I_L; int r = it % I_L;
            if (r < I_IN) { transpose_item(F.in[I_WIN] + (size_t)l * D * INC, D, INC, F.WIN_T + (size_t)l * NCOL * D, [](int n) { return n < 1536 ? n : (n < 1552 ? -1 : (n < INC ? n - 16 : -1)); }, scr, r, F.lane); continue; } r -= I_IN;
            if (r < I_OUT) { transpose_item(F.in[I_WOUT] + (size_t)l * D * D, D, D, F.WOUT_T + (size_t)l * D * D, [](int n) { return n; }, scr, r, F.lane); continue; } r -= I_OUT;
            if (r < I_PW) { transpose_item(F.in[I_CPW] + (size_t)l * 256 * 256, 256, 256, F.PW_T + (size_t)l * 256 * 256, [](int n) { return n; }, scr, r, F.lane); continue; } r -= I_PW;
            transpose_item(F.in[I_GLUW] + (size_t)l * 256 * 512, 256, 512, F.GLU_T + (size_t)l * 512 * 256, [](int n) { return n; }, scr, r, F.lane);
        }
        __syncthreads();
    }
    {
        const int gt = F.bid * NTHR + F.tid, NG = F.G * NTHR;
        f32x2* AA = (f32x2*)(F.ws + WS_S5AA); bf16* BB = (bf16*)(F.ws + WS_S5BB); bf16* CM = (bf16*)(F.ws + WS_S5CM);
        for (int i = gt; i < 2 * 2 * 16 * 64; i += NG) {
            const int p = i & 63, g = (i >> 6) & 15, dir = (i >> 10) & 1, l = i >> 11;
            const float step = expf(F.in[I_LSTEP][(l * 2 + dir) * 16 + g]);
            const float lr = F.in[I_LRE][i], li = F.in[I_LIM][i];
            const float mag = expf(lr * step); float sn, cs; sincos_red(li * step, sn, cs);
            const float ar = mag * cs, ai = mag * sn, inv_den = 1.f / (lr * lr + li * li);
            const float cr = ((ar - 1.f) * lr + ai * li) * inv_den, ci = (ai * lr - (ar - 1.f) * li) * inv_den;
            AA[i] = (f32x2){ar, ai};
            const float* bre = F.in[I_BRE] + ((size_t)(l * 16 + g) * 64 + p) * 16; const float* bim = F.in[I_BIM] + ((size_t)(l * 16 + g) * 64 + p) * 16;
            bf16* o = BB + ((size_t)((l * 2 + dir) * 16 + g) * 128 + 2 * p) * 16;
            for (int h = 0; h < 16; ++h) { const float br = bre[h], bi = bim[h]; o[h] = (bf16)f2bf(cr * br - ci * bi); o[16 + h] = (bf16)f2bf(cr * bi + ci * br); }
        }
        for (int i = gt; i < 2 * 16 * 16 * 64; i += NG) {
            *(unsigned*)(CM + (size_t)i * 2) = pk2(F.in[I_CRE][i], -F.in[I_CIM][i]);
        }
    }
    {
        LAS float* sc = (LAS float*)F.lds;
        LAS float* part = sc + 9 * 1024;
        __syncthreads();
        if (F.bid < 192) { for (int t = F.tid; t < 9 * 1024; t += NTHR) { const int r9 = t >> 10, k = t & 1023; sc[t] = siluf_(r9 < 8 ? F.in[I_C][r9 * D + k] : F.in[I_CCTX][k]); } }
        __syncthreads();
        for (int it = F.bid; it < 192; it += F.G) {
            const int l = it / 96, cb = it % 96, col = F.tid & 63, kg = F.tid >> 6;
            float acc[9];
#pragma unroll
            for (int r9 = 0; r9 < 9; ++r9) acc[r9] = 0.f;
            const float* wp = F.in[I_WADA] + ((size_t)l * D + kg * 128) * 6144 + cb * 64 + col;
#pragma unroll 4
            for (int kk = 0; kk < 128; ++kk) {
                const float w = wp[(size_t)kk * 6144];
#pragma unroll
                for (int r9 = 0; r9 < 9; ++r9) acc[r9] = fmaf(sc[r9 * 1024 + kg * 128 + kk], w, acc[r9]);
            }
#pragma unroll
            for (int r9 = 0; r9 < 9; ++r9) part[(kg * 9 + r9) * 64 + col] = acc[r9];
            __syncthreads();
            for (int t = F.tid; t < 9 * 64; t += NTHR) { const int r9 = t >> 6, cc = t & 63; float sm = F.in[I_BADA][l * 6144 + cb * 64 + cc];
#pragma unroll
                for (int k8 = 0; k8 < 8; ++k8) sm += part[(k8 * 9 + r9) * 64 + cc];
                F.MOD[((size_t)l * 9 + r9) * 6144 + cb * 64 + cc] = sm; }
            __syncthreads();
        }
    }
}
__device__ __forceinline__ LAS int* moe_tables(const Frame& F, int l) {
    LAS int* tab = (LAS int*)(F.lds + TAB_OFF);
    __syncthreads();
    if (F.tid == 0) {
        int bs = 0;
        for (int e = 0; e < NEXP; ++e) { const int c = (int)F.ctl[CW_CNT + l * 64 + e]; tab[e] = bs; tab[40 + e] = c; bs += ((c + 255) / 256) * 256; }
        tab[16] = bs;
    }
    __syncthreads();
    return tab;
}
__device__ __forceinline__ void phase_rowA(const Frame& F0, int l)  {
    Frame F = enter_phase(F0);
    LAS int* tab = (LAS int*)(F.lds + TAB_OFF);
    if (l > 0) tab = moe_tables(F, l - 1);
    LAS float* WDT = (LAS float*)F.lds;
    if (l < DEPTH) {
        __syncthreads();
        stage_wt16(WDT, F.in[I_WIN] + (size_t)l * D * INC + 1536, INC, F.tid);
        __syncthreads();
    }
    const int gw = F.bid * NWAVES + F.wave, NGW = F.G * NWAVES;
    const int RL = (l == DEPTH) ? TL : TT;
    const float* gvec = (l == DEPTH) ? F.in[I_GFIN] : F.in[I_GMIX] + l * D;
    for (int r = gw; r < RL; r += NGW) {
        const int mr = modrow(r);
        f32x4 v[4];
#pragma unroll
        for (int j = 0; j < 4; ++j) v[j] = *(const f32x4*)(F.XS + (size_t)r * D + 4 * F.lane + 256 * j);
        if (l > 0) {
            const int4 ti = *(const int4*)(F.TOKI + (size_t)r * 4);
            const f32x2 tw = *(const f32x2*)(F.TOKW + (size_t)r * 2);
            const size_t ra = (size_t)(tab[ti.x] + ti.y), rb = (size_t)(tab[ti.z] + ti.w);
            const float* g2 = F.MOD + ((size_t)(l - 1) * 9 + mr) * 6144 + 5120;
#pragma unroll
            for (int j = 0; j < 4; ++j) {
                const int c = 4 * F.lane + 256 * j;
                float ya[4], yb[4]; ld4(F.YDN + ra * D + c, ya); ld4(F.YDN + rb * D + c, yb);
                const f32x4 g = *(const f32x4*)(g2 + c);
#pragma unroll
                for (int e = 0; e < 4; ++e) v[j][e] += g[e] * (ya[e] * tw.x + yb[e] * tw.y);
            }
            if (l < DEPTH) {
#pragma unroll
                for (int j = 0; j < 4; ++j) *(f32x4*)(F.XS + (size_t)r * D + 4 * F.lane + 256 * j) = v[j];
            }
        }
        float ss = 0.f;
#pragma unroll
        for (int j = 0; j < 4; ++j) ss += (v[j].x * v[j].x + v[j].y * v[j].y) + (v[j].z * v[j].z + v[j].w * v[j].w);
        const float rstd = rsqrtf(wave_sum(ss, F.lane) * (1.f / D) + EPS);
        if (l == DEPTH) {
#pragma unroll
            for (int j = 0; j < 4; ++j) { const int c = 4 * F.lane + 256 * j; const f32x4 g = *(const f32x4*)(gvec + c); *(f32x4*)(F.out + (size_t)r * D + c) = v[j] * rstd * g; }
        } else {
            const float* md = F.MOD + ((size_t)l * 9 + mr) * 6144;
            float dtp[16];
#pragma unroll
            for (int e = 0; e < 16; ++e) dtp[e] = 0.f;
#pragma unroll
            for (int j = 0; j < 4; ++j) {
                const int c = 4 * F.lane + 256 * j;
                const f32x4 g = *(const f32x4*)(gvec + c), sh = *(const f32x4*)(md + c), scl = *(const f32x4*)(md + 1024 + c);
                const f32x4 h = v[j] * rstd * g * (scl + 1.f) + sh;
                u32x2 o; o.x = pk2(h.x, h.y); o.y = pk2(h.z, h.w);
                *(u32x2*)(F.HN + (size_t)r * D + c) = o;
                dot16_acc(WDT, h, j, F.lane, dtp);
            }
#pragma unroll
            for (int e = 0; e < 16; ++e) dtp[e] = wave_sum(dtp[e], F.lane);
            if (F.lane == 0) {
#pragma unroll
                for (int e4 = 0; e4 < 4; ++e4) *(f32x4*)(F.DT + (size_t)r * 16 + e4 * 4) = (f32x4){dtp[e4 * 4], dtp[e4 * 4 + 1], dtp[e4 * 4 + 2], dtp[e4 * 4 + 3]};
            }
        }
    }
}
__device__ __forceinline__ void phase_inproj(const Frame& F0, int l)  {
    Frame F = enter_phase(F0);
    pg8::PlainSched S; S.T.init(TT / 256, NCOL / 256, F.G, F.bid); S.Bt = (const char*)(F.WIN_T + (size_t)l * NCOL * D); S.K = D;
    pg8::EpiStoreBf16 E{F.COLS, NCOL, 0, nullptr};
    pg8::gemm_phase<pg8::EpiStoreBf16, pg8::PlainSched, true>(F.lds, F.HN, D, S, E, F.tid);
}
__device__ __forceinline__ void conf_unit(const Frame& F, int l, int uidx) {
    const int r0 = uidx * 64;
    LAS bf16* XU = (LAS bf16*)F.lds;
    LAS float* WD = (LAS float*)(F.lds + 94 * 512);
    LAS bf16* CVL = (LAS bf16*)(F.lds + 94 * 512 + 31 * 1024);
    int lo, hi; seq_bounds(r0, lo, hi);
    __syncthreads();
    for (int i = F.tid; i < 94 * 64; i += NTHR) {
        const int rr = r0 - 15 + (i >> 6), c = (i & 63) * 4;
        u32x2 o = {0u, 0u};
        if (rr >= lo && rr < hi) { float a[4], g[4]; ld4(F.COLS + (size_t)rr * NCOL + 1536 + c, a); ld4(F.COLS + (size_t)rr * NCOL + 1792 + c, g);
            o.x = pk2(a[0] * sigmoidf_(g[0]), a[1] * sigmoidf_(g[1])); o.y = pk2(a[2] * sigmoidf_(g[2]), a[3] * sigmoidf_(g[3])); }
        *(LAS u32x2*)(XU + (i >> 6) * 256 + c) = o;
    }
    for (int i = F.tid; i < 31 * 64; i += NTHR) *(LAS f32x4*)&WD[i * 4] = *(const f32x4*)(F.in[I_CDW] + (size_t)l * 31 * 256 + i * 4);
    __syncthreads();
    const int ch = 4 * F.lane;
    const f32x4 db = *(const f32x4*)(F.in[I_CDB] + l * 256 + ch), lg = *(const f32x4*)(F.in[I_CLG] + l * 256 + ch), lb = *(const f32x4*)(F.in[I_CLB] + l * 256 + ch);
#pragma unroll 1
    for (int i = 0; i < 8; ++i) {
        const int lr = F.wave * 8 + i;
        f32x4 acc = db;
#pragma unroll
        for (int j = 0; j < 31; ++j) {
            const u32x2 xv = *(const LAS u32x2*)(XU + (lr + j) * 256 + ch); const f32x4 w = *(const LAS f32x4*)&WD[j * 256 + ch];
            acc.x = fmaf(w.x, __uint_as_float(xv.x << 16), acc.x); acc.y = fmaf(w.y, __uint_as_float(xv.x & 0xffff0000u), acc.y);
            acc.z = fmaf(w.z, __uint_as_float(xv.y << 16), acc.z); acc.w = fmaf(w.w, __uint_as_float(xv.y & 0xffff0000u), acc.w);
        }
        const float mean = wave_sum((acc.x + acc.y) + (acc.z + acc.w), F.lane) * (1.f / 256.f);
        const f32x4 d = acc - mean;
        const float var = wave_sum((d.x * d.x + d.y * d.y) + (d.z * d.z + d.w * d.w), F.lane) * (1.f / 256.f);
        const f32x4 y = d * rsqrtf(var + EPS) * lg + lb;
        u32x2 o; o.x = pk2(siluf_(y.x), siluf_(y.y)); o.y = pk2(siluf_(y.z), siluf_(y.w));
        *(LAS u32x2*)(CVL + lr * S5_US + ch) = o;
    }
    __syncthreads();
    {
        int lane_ = F.lane; asm volatile("" : "+v"(lane_));
        const int q = lane_ >> 4, c16 = lane_ & 15;
        const bf16* PW = F.PW_T + (size_t)l * 256 * 256;
        f32x4 acc[2][4];
#pragma unroll
        for (int nt = 0; nt < 2; ++nt)
#pragma unroll
            for (int rt = 0; rt < 4; ++rt) acc[nt][rt] = (f32x4){0.f, 0.f, 0.f, 0.f};
#pragma unroll 2
        for (int ks = 0; ks < 8; ++ks) {
            pg8::bf16x8 wf[2], vf[4];
#pragma unroll
            for (int nt = 0; nt < 2; ++nt) wf[nt] = *(const pg8::bf16x8*)(PW + (size_t)(32 * F.wave + 16 * nt + c16) * 256 + 32 * ks + 8 * q);
#pragma unroll
            for (int rt = 0; rt < 4; ++rt) vf[rt] = *(const LAS pg8::bf16x8*)(CVL + (16 * rt + c16) * S5_US + 32 * ks + 8 * q);
#pragma unroll
            for (int nt = 0; nt < 2; ++nt)
#pragma unroll
                for (int rt = 0; rt < 4; ++rt) acc[nt][rt] = __builtin_amdgcn_mfma_f32_16x16x32_bf16(wf[nt], vf[rt], acc[nt][rt], 0, 0, 0);
        }
        const float* pb = F.in[I_CPB] + l * 256;
#pragma unroll
        for (int nt = 0; nt < 2; ++nt) { const int n0 = 32 * F.wave + 16 * nt + 4 * q; const f32x4 bv = *(const f32x4*)(pb + n0);
#pragma unroll
            for (int rt = 0; rt < 4; ++rt) { u32x2 w; w.x = pk2(acc[nt][rt][0] + bv[0], acc[nt][rt][1] + bv[1]); w.y = pk2(acc[nt][rt][2] + bv[2], acc[nt][rt][3] + bv[3]);
                *(u32x2*)(F.MIX + (size_t)(r0 + 16 * rt + c16) * 1024 + 512 + n0) = w; } }
    }
}
__device__ __forceinline__ void expert_cvt_item(const Frame& F, int l, int it, LAS float* scr) {
    const int mtx = it >> 9, r = it & 511, e = mtx / 3, kind = mtx % 3;
    const size_t wofs = ((size_t)l * NEXP + e) * D * D;
    if (kind == 0) transpose_item(F.in[I_WG] + wofs, D, D, F.WGU_T + (size_t)e * 2048 * D, [](int n) { return (n >> 7) * 256 + (n & 127); }, scr, r, F.lane);
    else if (kind == 1) transpose_item(F.in[I_WU] + wofs, D, D, F.WGU_T + (size_t)e * 2048 * D, [](int n) { return (n >> 7) * 256 + 128 + (n & 127); }, scr, r, F.lane);
    else transpose_item(F.in[I_WD] + wofs, D, D, F.WD_T + (size_t)e * D * D, [](int n) { return n; }, scr, r, F.lane);
}
__device__ __forceinline__ void phase_scan(const Frame& F0, int l)  {
    Frame F = enter_phase(F0);
    const int RLc = (l == 0) ? TT : TL;
    const int NU = 1152 + 288 + RLc / 64;
    const int gw = F.bid * NWAVES + F.wave, NGW = F.G * NWAVES;
    LAS float* scr = (LAS float*)(F.lds + 131072 - NWAVES * 8448) + F.wave * (64 * 33);
    int cv = gw;
    for (int u = F.bid; u < NU; u += F.G) {
        if (u < 1152) ssd_unit_a(F, l, u);
        else if (u < 1152 + 288) s5_unit<0>(F, l, u - 1152);
        else conf_unit(F, l, u - 1440);
        __syncthreads();
#pragma unroll 1
        for (int k = 0; k < 2 && cv < 48 * 512; ++k, cv += NGW) expert_cvt_item(F, l, cv, scr);
    }
    __syncthreads();
    for (; cv < 48 * 512; cv += NGW) expert_cvt_item(F, l, cv, scr);
}
__device__ __forceinline__ void phase_carry(const Frame& F0, int l)  {
    Frame F = enter_phase(F0);
    s5_carry(F, l);
    ssd_carry(F);
}
__device__ __forceinline__ void phase_mix1(const Frame& F0, int l)  {
    Frame F = enter_phase(F0);
    const int RL = (l == 0) ? TT : TL;
    for (int u = F.bid; u < 144 + 288; u += F.G) {
        if (u < 144) { if (l == 0 || (u % 18) >= 2) ssd_unit_b(F, l, u); }
        else { const int v = u - 144; if (l == 0 || (v % 36) >= 4) s5_unit<1>(F, l, v); }
    }
}
__device__ __forceinline__ void phase_wout(const Frame& F0, int l)  {
    Frame F = enter_phase(F0);
    const int RL = (l == 0) ? TT : TL;
    pg8::PlainSched S; S.T.init(RL / 256, D / 256, F.G, F.bid); S.Bt = (const char*)(F.WOUT_T + (size_t)l * D * D); S.K = D;
    pg8::EpiResidual E{F.XS, F.MOD + (size_t)l * 9 * 6144 + 2048};
    pg8::gemm_phase<pg8::EpiResidual, pg8::PlainSched, true>(F.lds, F.MIX, D, S, E, F.tid);
}
__device__ __forceinline__ void phase_norm2(const Frame& F0, int l)  {
    Frame F = enter_phase(F0);
    const int RL = (l == 0) ? TT : TL;
    LAS float* RW = (LAS float*)F.lds;
    __syncthreads();
    stage_wt16(RW, F.in[I_RW], 16, F.tid);
    LAS int* lcnt = (LAS int*)(F.lds + 65536);
    if (F.tid < 32) lcnt[F.tid] = 0;
    __syncthreads();
    const int gw = F.bid * NWAVES + F.wave, NGW = F.G * NWAVES;
    const float* gvec = F.in[I_GFFN] + l * D;
    for (int r = gw; r < RL; r += NGW) {
        const int mr = modrow(r);
        f32x4 v[4]; float ss = 0.f;
#pragma unroll
        for (int j = 0; j < 4; ++j) { v[j] = *(const f32x4*)(F.XS + (size_t)r * D + 4 * F.lane + 256 * j); ss += (v[j].x * v[j].x + v[j].y * v[j].y) + (v[j].z * v[j].z + v[j].w * v[j].w); }
        const float rstd = rsqrtf(wave_sum(ss, F.lane) * (1.f / D) + EPS);
        const float* md = F.MOD + ((size_t)l * 9 + mr) * 6144;
        float lg[16];
#pragma unroll
        for (int e = 0; e < 16; ++e) lg[e] = 0.f;
#pragma unroll
        for (int j = 0; j < 4; ++j) {
            const int c = 4 * F.lane + 256 * j;
            const f32x4 g = *(const f32x4*)(gvec + c), sh = *(const f32x4*)(md + 3072 + c), scl = *(const f32x4*)(md + 4096 + c);
            const f32x4 h = v[j] * rstd * g * (scl + 1.f) + sh;
            u32x2 o; o.x = pk2(h.x, h.y); o.y = pk2(h.z, h.w);
            *(u32x2*)(F.HN + (size_t)r * D + c) = o;
            dot16_acc(RW, h, j, F.lane, lg);
        }
        float mx = -3.0e38f;
#pragma unroll
        for (int e = 0; e < 16; ++e) { lg[e] = wave_sum(lg[e], F.lane) + F.in[I_RB][e]; mx = fmaxf(mx, lg[e]); }
        float den = 0.f;
#pragma unroll
        for (int e = 0; e < 16; ++e) { lg[e] = expf(lg[e] - mx); den += lg[e]; }
        const float inv = 1.f / den;
#pragma unroll
        for (int e = 0; e < 16; ++e) lg[e] *= inv;
        float gs[4];
#pragma unroll
        for (int gI = 0; gI < 4; ++gI) {
            const float p0 = lg[gI * 4], p1 = lg[gI * 4 + 1], p2 = lg[gI * 4 + 2], p3 = lg[gI * 4 + 3];
            const float h01 = fmaxf(p0, p1), l01 = fminf(p0, p1), h23 = fmaxf(p2, p3), l23 = fminf(p2, p3);
            gs[gI] = fmaxf(h01, h23) + fmaxf(fminf(h01, h23), fmaxf(l01, l23));
        }
        int best = 0; float bsv = gs[0];
#pragma unroll
        for (int gI = 1; gI < 4; ++gI) if (gs[gI] > bsv) { bsv = gs[gI]; best = gI; }
        float q[4];
#pragma unroll
        for (int i = 0; i < 4; ++i) q[i] = best == 0 ? lg[i] : (best == 1 ? lg[4 + i] : (best == 2 ? lg[8 + i] : lg[12 + i]));
        int i0 = 0; float v0 = q[0];
#pragma unroll
        for (int i = 1; i < 4; ++i) if (q[i] > v0) { v0 = q[i]; i0 = i; }
        int i1 = -1; float v1 = -1.f;
#pragma unroll
        for (int i = 0; i < 4; ++i) if (i != i0 && q[i] > v1) { v1 = q[i]; i1 = i; }
        const float ginv = 1.f / (v0 + v1);
        if (F.lane == 0) {
            const int e0 = best * 4 + i0, e1 = best * 4 + i1;
            const int p0 = __hip_atomic_fetch_add(&lcnt[e0], 1, __ATOMIC_RELAXED, __HIP_MEMORY_SCOPE_WORKGROUP), p1 = __hip_atomic_fetch_add(&lcnt[e1], 1, __ATOMIC_RELAXED, __HIP_MEMORY_SCOPE_WORKGROUP);
            *(int4*)(F.TOKI + (size_t)r * 4) = make_int4(e0, p0, e1, p1);
            *(f32x2*)(F.TOKW + (size_t)r * 2) = (f32x2){v0 * ginv, v1 * ginv};
        }
    }
    __syncthreads();
    if (F.tid < 16) lcnt[16 + F.tid] = (int)atomicAdd(&F.ctl[CW_CNT + l * 64 + F.tid], (unsigned)lcnt[F.tid]);
    __syncthreads();
    if (F.lane == 0) {
        for (int r = gw; r < RL; r += NGW) {
            int4 ti = *(const int4*)(F.TOKI + (size_t)r * 4);
            ti.y += lcnt[16 + ti.x]; ti.w += lcnt[16 + ti.z];
            *(int4*)(F.TOKI + (size_t)r * 4) = ti;
            F.LIST[(size_t)ti.x * TT + ti.y] = r; F.LIST[(size_t)ti.z * TT + ti.w] = r;
        }
    }
}
__device__ __forceinline__ void phase_gateup(const Frame& F0, int l)  {
    Frame F = enter_phase(F0);
    LAS int* tab = moe_tables(F, l);
    LAS int* rows = (LAS int*)(F.lds + ROWS_OFF);
    pg8::MoeSched<true> S; S.T.init(tab[16] / 256, 8, F.G, F.bid); S.Bt = (const char*)F.WGU_T; S.K = D; S.NE = 2048; S.tab = tab; S.rows = rows;
    {
        pg8::Unit u;
        for (int i = 0; i < 15 && S.next(i, u); ++i) {
            if (F.tid < 256) { const int sr = u.pm * 256 + F.tid, e = S.expert(u.pm), pos = sr - tab[e], cnt = tab[40 + e];
                rows[i * 256 + F.tid] = F.LIST[(size_t)e * TT + (pos < cnt ? pos : 0)]; }
        }
        __syncthreads();
    }
    pg8::EpiPairBf16<0> E{F.HMID, 1024, 0, nullptr, 0};
    pg8::gemm_phase<pg8::EpiPairBf16<0>, pg8::MoeSched<true>, true>(F.lds, F.HN, D, S, E, F.tid);
}
__device__ __forceinline__ void phase_down(const Frame& F0, int l)  {
    Frame F = enter_phase(F0);
    LAS int* tab = moe_tables(F, l);
    pg8::MoeSched<false> S; S.T.init(tab[16] / 256, 4, F.G, F.bid); S.Bt = (const char*)F.WD_T; S.K = D; S.NE = 1024; S.tab = tab; S.rows = nullptr;
    pg8::EpiStoreBf16 E{F.YDN, 1024, 0, nullptr};
    pg8::gemm_phase<pg8::EpiStoreBf16, pg8::MoeSched<false>, true>(F.lds, F.HMID, D, S, E, F.tid);
}

constexpr int PH_PER_LAYER = 9, N_PHASES = 1 + DEPTH * PH_PER_LAYER + 1;

__global__ void __launch_bounds__(NTHR, 2) fwd_kernel(Args args) {
    extern __shared__ __attribute__((aligned(16))) unsigned char lds_raw[];
    Frame F;
    F.lds = (LAS unsigned char*)lds_raw;
    F.tid = threadIdx.x; F.lane = F.tid & 63; F.wave = __builtin_amdgcn_readfirstlane(F.tid >> 6);
    F.G = gridDim.x; F.bid = blockIdx.x;
    F.in = (const CAS cfp_t*)__builtin_amdgcn_kernarg_segment_ptr(); F.out = args.out; F.ws = args.ws;
    frame_ptrs(F, args.ws);
    volatile LAS unsigned* MISC = (volatile LAS unsigned*)(F.lds + MISC_OFF);
    if (F.tid < 32) MISC[F.tid] = 0u;
    __syncthreads();
    const int lo = args.ph_lo, hi = args.ph_hi;
    const bool multi = (hi - lo) > 1;
    XcdBarrier bar; bar.bar = F.ctl + CW_BAR; bar.x = 0; bar.st = MISC + 8;
    if (multi) bar = xcd_barrier_post(F.ctl + CW_BAR, MISC + 8);
#define IN(k) (lo <= (k) && (k) < hi)
#define SEAM(k) do { if (IN(k) && IN((k) + 1)) { XcdBarrier bb_ = bar; asm volatile("" : "+s"(bb_.bar)); xcd_barrier(bb_); } } while (0)
    if (IN(0)) phase_p0(F);
    SEAM(0);
    for (int l = 0; l < DEPTH; ++l) {
        const int pb = 1 + l * PH_PER_LAYER;
        if (IN(pb + 0)) phase_rowA(F, l);
        SEAM(pb + 0);
        if (IN(pb + 1)) phase_inproj(F, l);
        SEAM(pb + 1);
        if (IN(pb + 2)) phase_scan(F, l);
        SEAM(pb + 2);
        if (IN(pb + 3)) phase_carry(F, l);
        SEAM(pb + 3);
        if (IN(pb + 4)) phase_mix1(F, l);
        SEAM(pb + 4);
        if (IN(pb + 5)) phase_wout(F, l);
        SEAM(pb + 5);
        if (IN(pb + 6)) phase_norm2(F, l);
        SEAM(pb + 6);
        if (IN(pb + 7)) phase_gateup(F, l);
        SEAM(pb + 7);
        if (IN(pb + 8)) phase_down(F, l);
        SEAM(pb + 8);
    }
    if (IN(N_PHASES - 1)) phase_rowA(F, DEPTH);
#undef IN
#undef SEAM
}

extern "C" void kernel_launch(void* const* d_in, const int* in_sizes, int n_in, void* d_out, int out_size, void* d_ws, size_t ws_size, hipStream_t stream) {
    static int grid = 0;
    if (grid == 0) {
        if (n_in != N_IN || out_size != TL * D || ws_size < WS_END) { fprintf(stderr, "kernel_launch: unexpected shapes (n_in %d out %d ws %zu)\n", n_in, out_size, ws_size); grid = -1; return; }
        int dev = 0, cus = 0, per_cu = 0;
        if (hipGetDevice(&dev) != hipSuccess || hipDeviceGetAttribute(&cus, hipDeviceAttributeMultiprocessorCount, dev) != hipSuccess) { grid = -1; return; }
        if (hipFuncSetAttribute((const void*)fwd_kernel, hipFuncAttributeMaxDynamicSharedMemorySize, LDS_BYTES) != hipSuccess) { fprintf(stderr, "kernel_launch: hipFuncSetAttribute failed\n"); grid = -1; return; }
        if (hipOccupancyMaxActiveBlocksPerMultiprocessor(&per_cu, (const void*)fwd_kernel, NTHR, LDS_BYTES) != hipSuccess || per_cu < 1) { fprintf(stderr, "kernel_launch: occupancy query says %d\n", per_cu); }
        (void)hipGetLastError();
        grid = cus;
    }
    if (grid < 0) return;
    if (hipMemsetAsync((char*)d_ws + WS_CTL, 0, CTL_ZERO_BYTES, stream) != hipSuccess) return;
    Args a{};
    for (int i = 0; i < N_IN; ++i) a.in[i] = (const float*)d_in[i];
    a.out = (float*)d_out; a.ws = (unsigned char*)d_ws;
#if MK_ONE_LAUNCH
    a.ph_lo = 0; a.ph_hi = N_PHASES;
    hipLaunchKernelGGL(fwd_kernel, dim3(grid), dim3(NTHR), LDS_BYTES, stream, a);
#else
    for (int p = 0; p < N_PHASES; ++p) { a.ph_lo = p; a.ph_hi = p + 1; hipLaunchKernelGGL(fwd_kernel, dim3(grid), dim3(NTHR), LDS_BYTES, stream, a); }
#endif
}
```

```cpp
#include <hip/hip_runtime.h>
#include <cstdio>
#include <cstdint>

#ifndef MK_ONE_LAUNCH
#define MK_ONE_LAUNCH 1
#endif

#define GAS __attribute__((address_space(1)))
#define LAS __attribute__((address_space(3)))
#define CAS __attribute__((address_space(4)))
typedef const float* cfp_t;
typedef unsigned short bf16;
typedef float f32x4 __attribute__((ext_vector_type(4)));
typedef float f32x2 __attribute__((ext_vector_type(2)));
typedef unsigned u32x4 __attribute__((ext_vector_type(4)));
typedef unsigned u32x2 __attribute__((ext_vector_type(2)));

constexpr int D = 1024, NB = 8, SEQ = 2048, CTXL = 256, DEPTH = 2;
constexpr int TL = NB * SEQ, TC = NB * CTXL, TT = TL + TC;
constexpr int INC = 2320;
constexpr int NCOL = 2304;
constexpr int VSEQ = CTXL + SEQ;
constexpr int NEXP = 16;
constexpr float EPS = 1e-6f;

enum { I_X = 0, I_C, I_CTX, I_CCTX, I_WADA, I_BADA, I_GMIX, I_WIN, I_SCW, I_SCB, I_SDTB, I_SALOG, I_SD, I_SNG,
       I_CDW, I_CDB, I_CLG, I_CLB, I_CPW, I_CPB, I_LRE, I_LIM, I_LSTEP, I_BRE, I_BIM, I_CRE, I_CIM, I_S5D, I_GLUW, I_GLUB,
       I_WOUT, I_GFFN, I_RW, I_RB, I_WG, I_WU, I_WD, I_GFIN, N_IN };

constexpr size_t MiB = 1u << 20;
constexpr size_t WS_CTL = 0, CTL_ZERO_BYTES = 64 * 1024;
constexpr size_t WS_MOD = 1 * MiB;
constexpr size_t WS_MODP = 2 * MiB;
constexpr size_t WS_DT = 6 * MiB;
constexpr size_t WS_S5AA = 5 * MiB + 512 * 1024;
constexpr size_t WS_S5BB = WS_S5AA + 32 * 1024;
constexpr size_t WS_S5CM = WS_S5BB + 256 * 1024;
constexpr size_t WS_TOKI = 7 * MiB + 512 * 1024;
constexpr size_t WS_TOKW = WS_TOKI + (size_t)TT * 16;
constexpr size_t WS_XS = 8 * MiB;
constexpr size_t WS_HN = 80 * MiB;
constexpr size_t WS_COLS = 116 * MiB;
constexpr size_t WS_XBCC = 197 * MiB;
constexpr size_t WS_CC = 197 * MiB;
constexpr size_t WS_YI = 207 * MiB;
constexpr size_t WS_SST = 226 * MiB;
constexpr size_t WS_HIN = 264 * MiB;
constexpr size_t WS_EDEC = 302 * MiB;
constexpr size_t WS_TOT = 304 * MiB;
constexpr size_t WS_YSSD = 233 * MiB;
constexpr size_t WS_MIX = 305 * MiB;
constexpr size_t WS_YS5 = 341 * MiB;
constexpr size_t WS_S5HL = 341 * MiB;
constexpr size_t WS_S5HI = 346 * MiB;
constexpr size_t WS_CU = 377 * MiB;
constexpr size_t WS_CV = 395 * MiB;
constexpr size_t WS_LIST = 413 * MiB;
constexpr size_t WS_WIN_T = 415 * MiB;
constexpr size_t WS_WOUT_T = 424 * MiB;
constexpr size_t WS_PW_T = 428 * MiB;
constexpr size_t WS_GLU_T = 428 * MiB + 512 * 1024;
constexpr size_t WS_WGU_T = 429 * MiB;
constexpr size_t WS_WD_T = 493 * MiB;
constexpr size_t WS_END = 525 * MiB;
constexpr int MOE_ROWS = 2 * TT + NEXP * 256;
constexpr size_t WS_HMID = WS_COLS;
constexpr size_t WS_YDN = WS_XBCC;
constexpr size_t WS_YG = WS_CU;
static_assert(WS_HMID + (size_t)MOE_ROWS * 1024 * 2 <= WS_XBCC, "HMID overlay");
static_assert(WS_YDN + (size_t)MOE_ROWS * 1024 * 2 <= WS_MIX, "YDN overlay");
constexpr int CW_CNT = 64;
constexpr int CW_BAR = 1024;

constexpr int NWAVES = 8, NTHR = 512;
constexpr int LDS_BYTES = 147456;
constexpr int MISC_OFF = 131072 + 320;
constexpr int TAB_OFF = 131072 + 512, ROWS_OFF = TAB_OFF + 256;

__device__ __forceinline__ float bf2f(bf16 v) { return __uint_as_float((unsigned)v << 16); }
__device__ __forceinline__ unsigned f2bf(float f) { unsigned u = __float_as_uint(f); return (u + 0x7fffu + ((u >> 16) & 1u)) >> 16; }
typedef __bf16 bf16x2_t __attribute__((ext_vector_type(2)));
__device__ __forceinline__ unsigned pk2(float lo, float hi) { f32x2 v = {lo, hi}; return __builtin_bit_cast(unsigned, __builtin_convertvector(v, bf16x2_t)); }
__device__ __forceinline__ float shx(float v, int m, int lane) { return __int_as_float(__builtin_amdgcn_ds_bpermute((lane ^ m) << 2, __float_as_int(v))); }
__device__ __forceinline__ float wave_sum(float v, int lane) {
#pragma unroll
    for (int o = 1; o < 64; o <<= 1) v += shx(v, o, lane);
    return v;
}
__device__ __forceinline__ float sigmoidf_(float x) { return 1.f / (1.f + __expf(-x)); }
__device__ __forceinline__ float siluf_(float x) { return x / (1.f + __expf(-x)); }
__device__ __forceinline__ float softplusf_(float x) { return fmaxf(x, 0.f) + log1pf(__expf(-fabsf(x))); }
__device__ __forceinline__ float gelu_tanh(float x) { const float u = 0.7978845608028654f * (x + 0.044715f * x * x * x); return 0.5f * x * (1.f + tanhf(u)); }
__device__ __forceinline__ void sincos_red(float x, float& s, float& c) {
    const float k = rintf(x * 0.15915494309189535f);
    float r = fmaf(-k, 6.2831854820251465f, x); r = fmaf(-k, -1.7484555e-7f, r);
    s = __sinf(r); c = __cosf(r);
}
__device__ __forceinline__ int opaque_v(int v) { asm volatile("" : "+v"(v)); return v; }
__device__ __forceinline__ int modrow(int r) { return r < TL ? (r >> 11) : 8; }
__device__ __forceinline__ void seq_bounds(int r, int& lo, int& hi) {
    if (r < TL) { lo = r & ~(SEQ - 1); hi = lo + SEQ; } else { lo = TL + ((r - TL) & ~(CTXL - 1)); hi = lo + CTXL; }
}
__device__ __forceinline__ int vrow(int b, int dir, int s) {
    if (s < CTXL) return TL + b * CTXL + (dir ? CTXL - 1 - s : s);
    const int t = s - CTXL; return b * SEQ + (dir ? SEQ - 1 - t : t);
}

#define XB_TMO      128
#define XB_XCNT(j)  (256  + 64 * (j))
#define XB_XSUB(j)  (1280 + 64 * (j))
#define XB_XGEN(j)  (2304 + 64 * (j))
#define XB_TOP      3328
#define XB_TOPGEN   3392
#define XCD_BAR_WORDS 3456
#define XB_SPIN_CAP (1u << 18)
__device__ __forceinline__ unsigned xb_ld(unsigned* p)              { return __hip_atomic_load(p, __ATOMIC_RELAXED, __HIP_MEMORY_SCOPE_AGENT); }
__device__ __forceinline__ unsigned xb_add(unsigned* p, unsigned v) { return __hip_atomic_fetch_add(p, v, __ATOMIC_RELAXED, __HIP_MEMORY_SCOPE_AGENT); }
__device__ __forceinline__ unsigned xb_xcc_id() { return (unsigned)__builtin_amdgcn_s_getreg((3 << 11) | 20) & 0xFu; }
#define XB_SPIN(cond, bar) do { unsigned _sp = 0; while (cond) { __builtin_amdgcn_s_sleep(1); \
    if ((++_sp & 255u) == 0u) { if (xb_ld(&(bar)[XB_TMO])) break; if (_sp > XB_SPIN_CAP) { atomicAdd(&(bar)[XB_TMO], 1u); break; } } } } while (0)
struct XcdBarrier { unsigned* bar; unsigned x; volatile LAS unsigned* st; };
__device__ __forceinline__ XcdBarrier xcd_barrier_post(unsigned* bar, volatile LAS unsigned* st) {
    XcdBarrier b; b.bar = bar; b.x = xb_xcc_id(); b.st = st;
    if (threadIdx.x == 0) (void)xb_add(&bar[XB_XCNT(b.x)], 1u);
    return b;
}
__device__ __forceinline__ void xcd_barrier_complete(unsigned* bar, unsigned x, unsigned& nloc, unsigned& nx) {
    const unsigned G = gridDim.x * gridDim.y * gridDim.z;
    unsigned sum, cnt, mine, sp = 0u;
    for (;;) {
        sum = 0u; cnt = 0u; mine = 0u;
#pragma unroll
        for (unsigned j = 0; j < 16; ++j) { const unsigned c = xb_ld(&bar[XB_XCNT(j)]); sum += c; cnt += (c > 0u) ? 1u : 0u; mine = (j == x) ? c : mine; }
        if (sum == G) break;
        __builtin_amdgcn_s_sleep(1);
        if ((++sp & 255u) == 0u) { if (xb_ld(&bar[XB_TMO])) break; if (sp > XB_SPIN_CAP) { atomicAdd(&bar[XB_TMO], 1u); break; } }
    }
    nloc = mine > 0u ? mine : 1u; nx = cnt > 0u ? cnt : 1u;
}
__device__ __forceinline__ void xcd_barrier(const XcdBarrier& b) {
    asm volatile("s_waitcnt vmcnt(0)" ::: "memory");
    __syncthreads();
    if (threadIdx.x == 0) {
        unsigned* bar = b.bar;
        const unsigned bx = xb_xcc_id();
        __builtin_amdgcn_s_waitcnt(0);
        unsigned nloc = b.st[0], nx = b.st[1];
        if (nloc == 0u) { xcd_barrier_complete(bar, bx, nloc, nx); b.st[0] = nloc; b.st[1] = nx; }
        const unsigned old = xb_add(&bar[XB_XSUB(bx)], 1u);
        const unsigned gen = old / nloc;
        if (old + 1u == (gen + 1u) * nloc) {
            __builtin_amdgcn_fence(__ATOMIC_RELEASE, "agent");
            asm volatile("s_waitcnt vmcnt(0)" ::: "memory");
            const unsigned og = xb_add(&bar[XB_TOP], 1u);
            const unsigned tg = og / nx;
            if (og + 1u == (tg + 1u) * nx) xb_add(&bar[XB_TOPGEN], 1u);
            else XB_SPIN(xb_ld(&bar[XB_TOPGEN]) == tg, bar);
            __builtin_amdgcn_fence(__ATOMIC_ACQUIRE, "agent");
            xb_add(&bar[XB_XGEN(bx)], 1u);
            asm volatile("s_waitcnt vmcnt(0)" ::: "memory");
        } else {
            XB_SPIN(xb_ld(&bar[XB_XGEN(bx)]) == gen, bar);
            __builtin_amdgcn_fence(__ATOMIC_ACQUIRE, "agent");
            asm volatile("s_waitcnt vmcnt(0)" ::: "memory");
        }
    }
    __syncthreads();
}

struct Args { const float* in[N_IN]; float* out; unsigned char* ws; int ph_lo, ph_hi; };
struct Frame {
    LAS unsigned char* lds;
    int tid, lane, wave, G, bid;
    const CAS cfp_t* in;
    float* out; unsigned char* ws;
    unsigned* ctl;
    float *MOD, *MODP, *DT, *XS, *YSSD, *YS5, *CU;
    bf16 *HN, *COLS, *XBCC, *MIX, *HMID, *CV, *YG, *YDN, *WIN_T, *WOUT_T, *PW_T, *GLU_T, *WGU_T, *WD_T;
    int* LIST; int* TOKI; float* TOKW;
};
__device__ __forceinline__ void frame_ptrs(Frame& F, unsigned char* ws) {
    F.ws = ws; F.ctl = (unsigned*)(ws + WS_CTL);
    F.MOD = (float*)(ws + WS_MOD); F.MODP = (float*)(ws + WS_MODP); F.DT = (float*)(ws + WS_DT); F.XS = (float*)(ws + WS_XS);
    F.YSSD = (float*)(ws + WS_YSSD); F.YS5 = (float*)(ws + WS_YS5); F.CU = (float*)(ws + WS_CU); F.CV = (bf16*)(ws + WS_CV); F.YDN = (bf16*)(ws + WS_YDN); F.YG = (bf16*)(ws + WS_YG);
    F.WIN_T = (bf16*)(ws + WS_WIN_T); F.WOUT_T = (bf16*)(ws + WS_WOUT_T); F.PW_T = (bf16*)(ws + WS_PW_T); F.GLU_T = (bf16*)(ws + WS_GLU_T); F.WGU_T = (bf16*)(ws + WS_WGU_T); F.WD_T = (bf16*)(ws + WS_WD_T);
    F.HN = (bf16*)(ws + WS_HN); F.COLS = (bf16*)(ws + WS_COLS); F.XBCC = (bf16*)(ws + WS_XBCC); F.MIX = (bf16*)(ws + WS_MIX); F.HMID = (bf16*)(ws + WS_HMID);
    F.LIST = (int*)(ws + WS_LIST); F.TOKI = (int*)(ws + WS_TOKI); F.TOKW = (float*)(ws + WS_TOKW);
}
__device__ __forceinline__ int fresh_lane() { unsigned om = ~0u; asm volatile("" : "+s"(om)); int ln = (int)__builtin_amdgcn_mbcnt_hi(om, __builtin_amdgcn_mbcnt_lo(om, 0u)); asm volatile("" : "+v"(ln)); return ln; }
__device__ __forceinline__ Frame enter_phase(const Frame& F0) {
    Frame F = F0; unsigned om = ~0u; asm volatile("" : "+s"(om)); int ln = (int)__builtin_amdgcn_mbcnt_hi(om, __builtin_amdgcn_mbcnt_lo(om, 0u)); asm volatile("" : "+v"(ln));
    int wv_ = F0.wave, bid_ = F0.bid, g_ = F0.G; asm volatile("" : "+s"(wv_), "+s"(bid_), "+s"(g_));
    F.wave = wv_; F.bid = bid_; F.G = g_; F.lane = ln; F.tid = wv_ * 64 + ln;
    unsigned char* ws = F0.ws; asm volatile("" : "+s"(ws)); frame_ptrs(F, ws);
    const CAS cfp_t* ka = (const CAS cfp_t*)__builtin_amdgcn_kernarg_segment_ptr(); asm volatile("" : "+s"(ka)); F.in = ka;
    return F;
}

__device__ __forceinline__ void ld4(const float* p, float (&v)[4]) { const f32x4 t = *(const f32x4*)p; v[0] = t.x; v[1] = t.y; v[2] = t.z; v[3] = t.w; }
__device__ __forceinline__ void ld4(const bf16* p, float (&v)[4]) { const u32x2 t = *(const u32x2*)p; v[0] = __uint_as_float(t.x << 16); v[1] = __uint_as_float(t.x & 0xffff0000u); v[2] = __uint_as_float(t.y << 16); v[3] = __uint_as_float(t.y & 0xffff0000u); }

__device__ __forceinline__ void ld8(const bf16* p, float (&v)[8]) { const u32x4 t = *(const u32x4*)p;
    v[0] = __uint_as_float(t.x << 16); v[1] = __uint_as_float(t.x & 0xffff0000u); v[2] = __uint_as_float(t.y << 16); v[3] = __uint_as_float(t.y & 0xffff0000u);
    v[4] = __uint_as_float(t.z << 16); v[5] = __uint_as_float(t.z & 0xffff0000u); v[6] = __uint_as_float(t.w << 16); v[7] = __uint_as_float(t.w & 0xffff0000u); }

namespace pg8 {
typedef short bf16x8 __attribute__((ext_vector_type(8)));
constexpr int BM = 256, BK = 64, HALF = 128, HTB = HALF * BK * 2, STAGE_BYTES = 8 * HTB, NXCD = 8, WGM = 8;
__device__ __forceinline__ int lds_byte(int r, int c) { const int st = (r >> 4) * 2 + (c >> 5), rr = r & 15, cc = c & 31, ob = rr * 64 + cc * 2; return st * 1024 + (ob ^ (((ob >> 9) & 1) << 5)); }
__device__ __forceinline__ void stage_rc(int b, int& R, int& C) { const int st = b / 1024, sb = b % 1024, swz = sb ^ (((sb >> 9) & 1) << 5); R = (st >> 1) * 16 + swz / 64; C = (st & 1) * 32 + (swz % 64) / 2; }
__device__ __forceinline__ int perm32(int rho) { const int n = rho >> 4, i = rho & 15; return 8 * (i >> 2) + 4 * n + (i & 3); }
struct Unit { int pm, pn, idx; };
struct TileOrder {
    int nM, nN, nwg, G, c;
    __device__ __forceinline__ void init(int nM_, int nN_, int G_, int c_) { nM = nM_; nN = nN_; nwg = nM * nN; G = G_; c = c_; }
    __device__ __forceinline__ bool next(int i, Unit& u) const {
        const long L = (long)i * G + c; if (L >= nwg) return false;
        int wgid = (int)L; { const int q = nwg / NXCD, r = nwg % NXCD, xcd = wgid % NXCD, off = wgid / NXCD; wgid = (xcd < r ? xcd * (q + 1) : r * (q + 1) + (xcd - r) * q) + off; }
        const int nig = WGM * nN, gid = wgid / nig, fm = gid * WGM, gsz = (nM - fm) < WGM ? (nM - fm) : WGM;
        u.pm = fm + ((wgid % nig) % gsz); u.pn = (wgid % nig) / gsz; u.idx = i; return true;
    }
};
__device__ __forceinline__ unsigned cvt_pk_bf16(float lo, float hi) { return pk2(lo, hi); }

template <class Epi, class Sched, bool ALIGN_EPI>
__device__ __forceinline__ void gemm_phase(LAS unsigned char* lds, const bf16* Abase, int K, const Sched& S, const Epi& E, int tid) {
    const int wid = __builtin_amdgcn_readfirstlane(tid >> 6), lane = tid & 63, wr = wid >> 2, wc = wid & 3, fr = lane & 15, fq = lane >> 4;
    const int nt = K / BK;
    unsigned voffB[2];
#pragma unroll
    for (int i = 0; i < 2; ++i) { int R, C; stage_rc(tid * 16 + i * 8192, R, C); const int Rb = Epi::PERM ? ((R & ~31) + perm32(R & 31)) : R; voffB[i] = (unsigned)(Rb * K + C) * 2u; }
    const size_t kstep = (size_t)(BK * 2);
    const size_t hstep = (size_t)HALF * K * 2;
    const unsigned ldsw = (unsigned)wid * 1024u;
    const int aoff = lds_byte(wr * 64 + fr, fq * 8), boff = lds_byte(wc * 32 + fr, fq * 8);
#define PG8_SA(b, h) (((b) * 2 + (h)) * HTB)
#define PG8_SB(b, h) ((4 + (b) * 2 + (h)) * HTB)
#define PG8_STAGE(bufoff, gbase, voff) do { _Pragma("unroll") for (int _i = 0; _i < 2; ++_i) \
        __builtin_amdgcn_global_load_lds((const unsigned*)((const char*)(gbase) + (voff)[_i]), (LAS unsigned*)(lds + (bufoff) + ldsw + _i * 8192), 16, 0, 0); } while (0)
#define PG8_LDA(dst, b, h) do { _Pragma("unroll") for (int m = 0; m < 4; ++m) _Pragma("unroll") for (int k = 0; k < 2; ++k) dst[m][k] = *(const LAS bf16x8*)(lds + PG8_SA(b, h) + aoff + m * 2048 + k * 1024); } while (0)
#define PG8_LDB(dst, b, h) do { _Pragma("unroll") for (int n = 0; n < 2; ++n) _Pragma("unroll") for (int k = 0; k < 2; ++k) dst[n][k] = *(const LAS bf16x8*)(lds + PG8_SB(b, h) + boff + n * 2048 + k * 1024); } while (0)
#define PG8_MMA(ai, bj, At, Bt) do { __builtin_amdgcn_s_setprio(1); _Pragma("unroll") for (int m = 0; m < 4; ++m) _Pragma("unroll") for (int n = 0; n < 2; ++n) _Pragma("unroll") for (int k = 0; k < 2; ++k) \
        acc[ai][bj][m][n] = __builtin_amdgcn_mfma_f32_16x16x32_bf16(Bt[n][k], At[m][k], acc[ai][bj][m][n], 0, 0, 0); __builtin_amdgcn_s_setprio(0); } while (0)
#define PG8_WAIT_V(n) asm volatile("s_waitcnt vmcnt(" #n ")" ::: "memory")
#define PG8_WAIT_L(n) asm volatile("s_waitcnt lgkmcnt(" #n ")" ::: "memory")
#define PG8_BAR __builtin_amdgcn_s_barrier()
#define PG8_SCHED __builtin_amdgcn_sched_barrier(0)
#define PG8_SETV(v, u) do { _Pragma("unroll") for (int _i = 0; _i < 2; ++_i) { int _R, _C; stage_rc(tid * 16 + _i * 8192, _R, _C); _Pragma("unroll") for (int _h = 0; _h < 2; ++_h) v[_h][_i] = (unsigned)(S.arow(u, _h * HALF + _R) * K + _C) * 2u; } } while (0)
    Unit cur, nxt; int ui = 0;
    if (!S.next(0, cur)) return;
    f32x4 acc[2][2][4][2];
#pragma unroll
    for (int a = 0; a < 2; ++a)
#pragma unroll
        for (int b = 0; b < 2; ++b)
#pragma unroll
            for (int m = 0; m < 4; ++m)
#pragma unroll
                for (int n = 0; n < 2; ++n) acc[a][b][m][n] = (f32x4){0.f, 0.f, 0.f, 0.f};
    bf16x8 At[4][2], B0[2][2], B1[2][2];
    unsigned vC[2][2], vN[2][2];
    PG8_SETV(vC, cur);
    const char* cA = (const char*)Abase; const char* cB = S.bbase(cur);
    PG8_WAIT_L(0);
    PG8_STAGE(PG8_SB(0, 0), cB, voffB); PG8_STAGE(PG8_SB(0, 1), cB + hstep, voffB); PG8_STAGE(PG8_SA(0, 0), cA, vC[0]); PG8_STAGE(PG8_SA(0, 1), cA, vC[1]);
    if (wr == 1) PG8_BAR;
    PG8_WAIT_V(2); PG8_BAR;
    PG8_STAGE(PG8_SB(1, 0), cB + kstep, voffB); PG8_STAGE(PG8_SA(1, 0), cA + kstep, vC[0]); PG8_STAGE(PG8_SB(1, 1), cB + hstep + kstep, voffB);
    PG8_WAIT_V(6); PG8_BAR;
    for (;;) {
        const bool has_next = S.next(ui + 1, nxt);
        const char* nB = cB;
        if (has_next) { PG8_SETV(vN, nxt); nB = S.bbase(nxt); }
        else {
#pragma unroll
            for (int _h = 0; _h < 2; ++_h)
#pragma unroll
                for (int _i = 0; _i < 2; ++_i) vN[_h][_i] = vC[_h][_i];
        }
        PG8_WAIT_L(0);
#pragma unroll 1
        for (int t = 0; t < nt; t += 2) {
            const bool last = (t == nt - 2);
            const char* a1 = cA + (size_t)(t + 1) * kstep;
            const char* a2 = last ? cA : cA + (size_t)(t + 2) * kstep; const char* b2 = last ? nB : cB + (size_t)(t + 2) * kstep;
            const char* a3 = a2 + kstep; const char* b3 = b2 + kstep;
            PG8_LDB(B0, 0, 0); PG8_LDB(B1, 0, 1); PG8_SCHED; PG8_LDA(At, 0, 0); PG8_STAGE(PG8_SA(1, 1), a1, vC[1]);
            if (last) {
#pragma unroll
                for (int _h = 0; _h < 2; ++_h)
#pragma unroll
                    for (int _i = 0; _i < 2; ++_i) vC[_h][_i] = vN[_h][_i];
            }
            PG8_WAIT_V(8); PG8_WAIT_L(0); PG8_BAR; PG8_MMA(0, 0, At, B0); PG8_MMA(0, 1, At, B1); PG8_BAR; PG8_SCHED;
            PG8_LDA(At, 0, 1); PG8_STAGE(PG8_SB(0, 0), b2, voffB); PG8_STAGE(PG8_SB(0, 1), b2 + hstep, voffB); PG8_STAGE(PG8_SA(0, 0), a2, vC[0]);
            PG8_WAIT_V(8); PG8_WAIT_L(0); PG8_BAR; PG8_MMA(1, 0, At, B0); PG8_MMA(1, 1, At, B1); PG8_BAR; PG8_SCHED;
            PG8_LDB(B0, 1, 0); PG8_LDB(B1, 1, 1); PG8_SCHED; PG8_LDA(At, 1, 0); PG8_STAGE(PG8_SA(0, 1), a2, vC[1]);
            PG8_WAIT_V(8); PG8_WAIT_L(0); PG8_BAR; PG8_MMA(0, 0, At, B0); PG8_MMA(0, 1, At, B1); PG8_BAR; PG8_SCHED;
            PG8_LDA(At, 1, 1); PG8_STAGE(PG8_SB(1, 0), b3, voffB); PG8_STAGE(PG8_SB(1, 1), b3 + hstep, voffB); PG8_STAGE(PG8_SA(1, 0), a3, vC[0]);
            PG8_WAIT_V(8); PG8_WAIT_L(0); PG8_BAR; PG8_MMA(1, 0, At, B0); PG8_MMA(1, 1, At, B1); PG8_BAR; PG8_SCHED;
        }
        if constexpr (ALIGN_EPI) { if (wr == 0) PG8_BAR; }
        E(acc, cur, wr, wc, fr, fq);
        if (!has_next) break;
#pragma unroll
        for (int a = 0; a < 2; ++a)
#pragma unroll
            for (int b = 0; b < 2; ++b)
#pragma unroll
                for (int m = 0; m < 4; ++m)
#pragma unroll
                    for (int n = 0; n < 2; ++n) acc[a][b][m][n] = (f32x4){0.f, 0.f, 0.f, 0.f};
        cur = nxt; cB = nB; ++ui;
        if constexpr (ALIGN_EPI) { if (wr == 1) PG8_BAR; }
    }
    PG8_WAIT_V(0);
    if constexpr (!ALIGN_EPI) { if (wr == 0) PG8_BAR; }
    PG8_BAR;
#undef PG8_SA
#undef PG8_SB
#undef PG8_STAGE
#undef PG8_LDA
#undef PG8_LDB
#undef PG8_MMA
#undef PG8_WAIT_V
#undef PG8_WAIT_L
#undef PG8_BAR
#undef PG8_SCHED
#undef PG8_SETV
}

struct PlainSched {
    TileOrder T; const char* Bt; int K;
    __device__ __forceinline__ bool next(int i, Unit& u) const { return T.next(i, u); }
    __device__ __forceinline__ int arow(const Unit& u, int r) const { return u.pm * BM + r; }
    __device__ __forceinline__ const char* bbase(const Unit& u) const { return Bt + (size_t)u.pn * BM * K * 2; }
};
template <bool GATHER> struct MoeSched {
    TileOrder T; const char* Bt; int K, NE; const LAS int* tab; const LAS int* rows;
    __device__ __forceinline__ bool next(int i, Unit& u) const { return T.next(i, u); }
    __device__ __forceinline__ int expert(int pm) const { const int s = pm * BM; int e = 0;
#pragma unroll
        for (int k = 1; k < NEXP; ++k) if (s >= tab[k]) e = k;
        return e; }
    __device__ __forceinline__ int arow(const Unit& u, int r) const { return GATHER ? rows[u.idx * BM + r] : u.pm * BM + r; }
    __device__ __forceinline__ const char* bbase(const Unit& u) const { return Bt + ((size_t)expert(u.pm) * NE + (size_t)u.pn * BM) * K * 2; }
};
struct EpiStoreBf16 {
    static constexpr bool PERM = true;
    bf16* O; int ldc, col0; const float* bias;
    __device__ __forceinline__ void operator()(const f32x4 (&acc)[2][2][4][2], const Unit& u, int wr, int wc, int fr, int fq) const {
        const int row0 = u.pm * BM + wr * 64 + fr, ct0 = u.pn * BM + wc * 32 + 8 * fq;
        f32x4 bv[2][2];
#pragma unroll
        for (int bj = 0; bj < 2; ++bj)
#pragma unroll
            for (int n = 0; n < 2; ++n) bv[bj][n] = bias ? *(const f32x4*)(bias + ct0 + bj * HALF + 4 * n) : (f32x4){0.f, 0.f, 0.f, 0.f};
#pragma unroll
        for (int ai = 0; ai < 2; ++ai)
#pragma unroll
            for (int m = 0; m < 4; ++m) { bf16* rowp = O + (size_t)(row0 + ai * HALF + m * 16) * ldc + col0 + ct0;
#pragma unroll
                for (int bj = 0; bj < 2; ++bj) { const f32x4 v0 = acc[ai][bj][m][0] + bv[bj][0], v1 = acc[ai][bj][m][1] + bv[bj][1];
                    u32x4 w; w.x = cvt_pk_bf16(v0[0], v0[1]); w.y = cvt_pk_bf16(v0[2], v0[3]); w.z = cvt_pk_bf16(v1[0], v1[1]); w.w = cvt_pk_bf16(v1[2], v1[3]);
                    *(u32x4*)(rowp + bj * HALF) = w; } }
    }
};
template <int ACT>
struct EpiPairBf16 {
    static constexpr bool PERM = true;
    bf16* O; int ldc, col0; const float* bias; int nb;
    __device__ __forceinline__ void operator()(const f32x4 (&acc)[2][2][4][2], const Unit& u, int wr, int wc, int fr, int fq) const {
        const int row0 = u.pm * BM + wr * 64 + fr, ct0 = u.pn * HALF + wc * 32 + 8 * fq;
        f32x4 ba[2], bb[2];
#pragma unroll
        for (int n = 0; n < 2; ++n) { ba[n] = (ACT == 1) ? *(const f32x4*)(bias + ct0 + 4 * n) : (f32x4){0.f, 0.f, 0.f, 0.f}; bb[n] = (ACT == 1) ? *(const f32x4*)(bias + nb + ct0 + 4 * n) : (f32x4){0.f, 0.f, 0.f, 0.f}; }
#pragma unroll
        for (int ai = 0; ai < 2; ++ai)
#pragma unroll
            for (int m = 0; m < 4; ++m) {
                float o[8];
#pragma unroll
                for (int n = 0; n < 2; ++n)
#pragma unroll
                    for (int j = 0; j < 4; ++j) { const float a = acc[ai][0][m][n][j] + ba[n][j], b = acc[ai][1][m][n][j] + bb[n][j];
                        o[n * 4 + j] = (ACT == 0) ? (a / (1.f + __expf(-a))) * b : a / (1.f + __expf(-b)); }
                u32x4 w; w.x = cvt_pk_bf16(o[0], o[1]); w.y = cvt_pk_bf16(o[2], o[3]); w.z = cvt_pk_bf16(o[4], o[5]); w.w = cvt_pk_bf16(o[6], o[7]);
                *(u32x4*)(O + (size_t)(row0 + ai * HALF + m * 16) * ldc + col0 + ct0) = w; }
    }
};
struct EpiResidual {
    static constexpr bool PERM = false;
    float* XS; const float* g1;
    __device__ __forceinline__ void operator()(const f32x4 (&acc)[2][2][4][2], const Unit& u, int wr, int wc, int fr, int fq) const {
        const int row0 = u.pm * BM + wr * 64 + fr, ct0 = u.pn * BM + wc * 32 + 4 * fq;
#pragma unroll
        for (int ai = 0; ai < 2; ++ai)
#pragma unroll
            for (int m = 0; m < 4; ++m) { const int row = row0 + ai * HALF + m * 16; float* xp = XS + (size_t)row * D + ct0; const float* gp = g1 + (size_t)modrow(row) * 6144 + ct0;
#pragma unroll
                for (int bj = 0; bj < 2; ++bj)
#pragma unroll
                    for (int n = 0; n < 2; ++n) { const int o = bj * HALF + n * 16; const f32x4 g = *(const f32x4*)(gp + o); f32x4 x = *(const f32x4*)(xp + o); x += g * acc[ai][bj][m][n]; *(f32x4*)(xp + o) = x; }
                if (m & 1) asm volatile("" ::: "memory"); }
    }
};
}

template <class RowMap>
__device__ __forceinline__ void transpose_item(const float* W, int K, int N, bf16* WT, const RowMap& rowmap, LAS float* scr, int item, int lane) {
    const int nblk = (N + 31) / 32, kb = item / nblk, nb = item % nblk, k0 = 64 * kb, n0 = 32 * nb;
    const bool cok = n0 + (lane & 31) < N;
    float tv[32];
#pragma unroll
    for (int i = 0; i < 32; ++i) { const int kk = 2 * i + (lane >> 5); tv[i] = cok ? W[(size_t)(k0 + kk) * N + n0 + (lane & 31)] : 0.f; }
#pragma unroll
    for (int i = 0; i < 32; ++i) { const int kk = 2 * i + (lane >> 5); scr[kk * 33 + (lane & 31)] = tv[i]; }
    if (false) for (int i = 0; i < 32; ++i) { const int kk = 2 * i + (lane >> 5); scr[kk * 33 + (lane & 31)] = cok ? W[(size_t)(k0 + kk) * N + n0 + (lane & 31)] : 0.f; }
    asm volatile("s_waitcnt lgkmcnt(0)" ::: "memory");
    const int c = lane & 7;
#pragma unroll
    for (int j = 0; j < 4; ++j) { const int n = (lane >> 3) + 8 * j; const LAS float* sp = scr + (8 * c) * 33 + n;
        u32x4 o; o.x = pk2(sp[0 * 33], sp[1 * 33]); o.y = pk2(sp[2 * 33], sp[3 * 33]); o.z = pk2(sp[4 * 33], sp[5 * 33]); o.w = pk2(sp[6 * 33], sp[7 * 33]);
        const int dr = rowmap(n0 + n);
        if (dr >= 0) *(u32x4*)(WT + (size_t)dr * K + k0 + 8 * c) = o; }
    asm volatile("s_waitcnt lgkmcnt(0)" ::: "memory");
}


typedef short bf16x4s __attribute__((ext_vector_type(4)));
constexpr int S5_US = 264;
constexpr int S5_WS = 136;
__device__ __forceinline__ int s5_row0(int b, int c) { return c < 4 ? TL + b * CTXL + c * 64 : b * SEQ + (c - 4) * 64; }
template <int PASS>
__device__ __forceinline__ void s5_unit(const Frame& Fu, int l, int uidx) {
    Frame F = Fu; F.lane = fresh_lane(); F.tid = F.wave * 64 + F.lane;
    const int b = uidx / 36, c = uidx % 36, r0 = s5_row0(b, c);
    LAS bf16* U = (LAS bf16*)F.lds;
    __syncthreads();
    for (int i = F.tid; i < 64 * 32; i += NTHR) { const int row = i >> 5, c8 = i & 31; *(LAS u32x4*)(U + row * S5_US + c8 * 8) = *(const u32x4*)(F.COLS + (size_t)(r0 + row) * NCOL + 2048 + c8 * 8); }
    __syncthreads();
    LAS bf16* BuS = (LAS bf16*)(F.lds + 64 * S5_US * 2 + F.wave * (2 * 16 * S5_WS * 2)); LAS bf16* Hs = BuS + 16 * S5_WS;
    const int lane_ = F.lane;
    const int q = lane_ >> 4, c16 = lane_ & 15, p = lane_;
    const f32x2* AA = (const f32x2*)(F.ws + WS_S5AA); const bf16* BB = (const bf16*)(F.ws + WS_S5BB); const bf16* CM = (const bf16*)(F.ws + WS_S5CM);
    f32x2* HL = (f32x2*)(F.ws + WS_S5HL); const f32x2* HI = (const f32x2*)(F.ws + WS_S5HI);
    u32x2 yout[2][4];
    f32x2 aa_[2][2], h0_[2][2]; bf16x4s bb_[2][2][8]; pg8::bf16x8 cm_[2][4];
#pragma unroll
    for (int gi = 0; gi < 2; ++gi) {
        const int g = F.wave * 2 + gi;
        if (PASS == 1) {
#pragma unroll
            for (int ks = 0; ks < 4; ++ks) cm_[gi][ks] = *(const pg8::bf16x8*)(CM + ((size_t)(l * 16 + g) * 16 + c16) * 128 + 32 * ks + 8 * q);
        }
#pragma unroll
        for (int dir = 0; dir < 2; ++dir) {
            const int pidx = ((l * 2 + dir) * 16 + g);
            aa_[gi][dir] = AA[pidx * 64 + p];
#pragma unroll
            for (int rt = 0; rt < 8; ++rt) bb_[gi][dir][rt] = *(const bf16x4s*)(BB + ((size_t)pidx * 128 + 16 * rt + c16) * 16 + 4 * q);
            if (PASS == 1) h0_[gi][dir] = HI[((size_t)(b * 36 + c) * 32 + g * 2 + dir) * 64 + p];
        }
    }
#pragma unroll
    for (int gi = 0; gi < 2; ++gi) {
        const int g = F.wave * 2 + gi;
        f32x4 yacc[4];
#pragma unroll
        for (int rs = 0; rs < 4; ++rs) yacc[rs] = (f32x4){0.f, 0.f, 0.f, 0.f};
#pragma unroll
        for (int dir = 0; dir < 2; ++dir) {
            const float ar = aa_[gi][dir].x, ai = aa_[gi][dir].y;
            const size_t sidx = ((size_t)(b * 36 + c) * 32 + g * 2 + dir) * 64 + p;
            float hr = 0.f, hi = 0.f;
            if (PASS == 1) { hr = h0_[gi][dir].x; hi = h0_[gi][dir].y; }
#pragma unroll
            for (int sci = 0; sci < 4; ++sci) {
                const int rs = dir ? 3 - sci : sci;
                const bf16x4s bop = *(const LAS bf16x4s*)(U + (16 * rs + c16) * S5_US + g * 16 + 4 * q);
#pragma unroll
                for (int rt = 0; rt < 8; ++rt) {
                    const f32x4 a = __builtin_amdgcn_mfma_f32_16x16x16bf16_1k(bb_[gi][dir][rt], bop, (f32x4){0.f, 0.f, 0.f, 0.f}, 0, 0, 0);
                    u32x2 w; w.x = pk2(a[0], a[1]); w.y = pk2(a[2], a[3]);
                    *(LAS u32x2*)(BuS + c16 * S5_WS + 16 * rt + 4 * q) = w;
                }
                asm volatile("s_waitcnt lgkmcnt(0)" ::: "memory");
                unsigned bu[16];
#pragma unroll
                for (int st = 0; st < 16; ++st) bu[st] = *(const LAS unsigned*)(BuS + (dir ? 15 - st : st) * S5_WS + 2 * p);
#pragma unroll
                for (int st = 0; st < 16; ++st) {
                    const float bur = __uint_as_float(bu[st] << 16), bui = __uint_as_float(bu[st] & 0xffff0000u);
                    const float nr = fmaf(ar, hr, fmaf(-ai, hi, bur)), ni = fmaf(ar, hi, fmaf(ai, hr, bui)); hr = nr; hi = ni;
                    if (PASS == 1) *(LAS unsigned*)(Hs + (dir ? 15 - st : st) * S5_WS + 2 * p) = pk2(hr, hi);
                }
                if (PASS == 1) {
                    asm volatile("s_waitcnt lgkmcnt(0)" ::: "memory");
#pragma unroll
                    for (int ks = 0; ks < 4; ++ks) { const pg8::bf16x8 hf = *(const LAS pg8::bf16x8*)(Hs + c16 * S5_WS + 32 * ks + 8 * q);
                        yacc[rs] = __builtin_amdgcn_mfma_f32_16x16x32_bf16(cm_[gi][ks], hf, yacc[rs], 0, 0, 0); }
                }
                asm volatile("s_waitcnt lgkmcnt(0)" ::: "memory");
            }
            if (PASS == 0) HL[sidx] = (f32x2){hr, hi};
        }
        if (PASS == 1) {
            const f32x4 dsk = *(const f32x4*)(F.in[I_S5D] + l * 256 + g * 16 + 4 * q);
#pragma unroll
            for (int rs = 0; rs < 4; ++rs) {
                float u4[4]; { const u32x2 t = *(const LAS u32x2*)(U + (16 * rs + c16) * S5_US + g * 16 + 4 * q);
                    u4[0] = __uint_as_float(t.x << 16); u4[1] = __uint_as_float(t.x & 0xffff0000u); u4[2] = __uint_as_float(t.y << 16); u4[3] = __uint_as_float(t.y & 0xffff0000u); }
                float o[4];
#pragma unroll
                for (int j = 0; j < 4; ++j) o[j] = gelu_tanh(yacc[rs][j] + dsk[j] * u4[j]);
                yout[gi][rs].x = pk2(o[0], o[1]); yout[gi][rs].y = pk2(o[2], o[3]);
            }
        }
    }
    if (PASS == 1) {
        const bf16* GW = F.GLU_T + (size_t)l * 512 * 256;
        pg8::bf16x8 wv[8][2], wg[8][2];
#pragma unroll
        for (int ks = 0; ks < 8; ++ks)
#pragma unroll
            for (int nt = 0; nt < 2; ++nt) { wv[ks][nt] = *(const pg8::bf16x8*)(GW + (size_t)(32 * F.wave + 16 * nt + c16) * 256 + 32 * ks + 8 * q); wg[ks][nt] = *(const pg8::bf16x8*)(GW + (size_t)(256 + 32 * F.wave + 16 * nt + c16) * 256 + 32 * ks + 8 * q); }
        __syncthreads();
#pragma unroll
        for (int gi = 0; gi < 2; ++gi)
#pragma unroll
            for (int rs = 0; rs < 4; ++rs) *(LAS u32x2*)(U + (16 * rs + c16) * S5_US + (F.wave * 2 + gi) * 16 + 4 * q) = yout[gi][rs];
        __syncthreads();
        f32x4 av[2][4], ag[2][4];
#pragma unroll
        for (int nt = 0; nt < 2; ++nt)
#pragma unroll
            for (int rt = 0; rt < 4; ++rt) { av[nt][rt] = (f32x4){0.f, 0.f, 0.f, 0.f}; ag[nt][rt] = (f32x4){0.f, 0.f, 0.f, 0.f}; }
#pragma unroll
        for (int ks = 0; ks < 8; ++ks) {
            pg8::bf16x8 yf[4];
#pragma unroll
            for (int rt = 0; rt < 4; ++rt) yf[rt] = *(const LAS pg8::bf16x8*)(U + (16 * rt + c16) * S5_US + 32 * ks + 8 * q);
#pragma unroll
            for (int nt = 0; nt < 2; ++nt)
#pragma unroll
                for (int rt = 0; rt < 4; ++rt) { av[nt][rt] = __builtin_amdgcn_mfma_f32_16x16x32_bf16(wv[ks][nt], yf[rt], av[nt][rt], 0, 0, 0); ag[nt][rt] = __builtin_amdgcn_mfma_f32_16x16x32_bf16(wg[ks][nt], yf[rt], ag[nt][rt], 0, 0, 0); }
        }
        const float* gb = F.in[I_GLUB] + l * 512;
#pragma unroll
        for (int nt = 0; nt < 2; ++nt) { const int n0 = 32 * F.wave + 16 * nt + 4 * q; const f32x4 bv = *(const f32x4*)(gb + n0), bg = *(const f32x4*)(gb + 256 + n0);
#pragma unroll
            for (int rt = 0; rt < 4; ++rt) { float o[4];
#pragma unroll
                for (int j = 0; j < 4; ++j) o[j] = (av[nt][rt][j] + bv[j]) * sigmoidf_(ag[nt][rt][j] + bg[j]);
                u32x2 w; w.x = pk2(o[0], o[1]); w.y = pk2(o[2], o[3]);
                *(u32x2*)(F.MIX + (size_t)(r0 + 16 * rt + c16) * 1024 + 768 + n0) = w; } }
    }
}
__device__ __forceinline__ void s5_carry(const Frame& F, int l) {
    const int gt = F.bid * NTHR + F.tid, NG = F.G * NTHR;
    const f32x2* AA = (const f32x2*)(F.ws + WS_S5AA); const f32x2* HL = (const f32x2*)(F.ws + WS_S5HL); f32x2* HI = (f32x2*)(F.ws + WS_S5HI);
    for (int i = gt; i < NB * 32 * 64; i += NG) {
        const int p = i & 63, gd = (i >> 6) & 31, b = i >> 11, g = gd >> 1, dir = gd & 1;
        f32x2 a = AA[((l * 2 + dir) * 16 + g) * 64 + p];
#pragma unroll
        for (int k = 0; k < 6; ++k) a = (f32x2){a.x * a.x - a.y * a.y, 2.f * a.x * a.y};
        float hr = 0.f, hi = 0.f;
#pragma unroll 4
        for (int j = 0; j < 36; ++j) {
            const int c = dir ? (j < 4 ? 3 - j : 39 - j) : j;
            const size_t idx = ((size_t)(b * 36 + c) * 32 + gd) * 64 + p;
            HI[idx] = (f32x2){hr, hi};
            const f32x2 hl = HL[idx];
            const float nr = a.x * hr - a.y * hi + hl.x, ni = a.x * hi + a.y * hr + hl.y; hr = nr; hi = ni;
        }
    }
}


constexpr int SSD_LD = 136;
__device__ __forceinline__ int ssd_row0(int b, int cid) { return cid < 2 ? TL + b * CTXL + cid * 128 : b * SEQ + (cid - 2) * 128; }
__device__ __forceinline__ pg8::bf16x8 mk8(u32x2 lo, u32x2 hi) { u32x4 t; t.x = lo.x; t.y = lo.y; t.z = hi.x; t.w = hi.y; return __builtin_bit_cast(pg8::bf16x8, t); }
__device__ __forceinline__ void ssd_unit_a(const Frame& Fu, int l, int uidx) {
    Frame F = Fu; F.lane = fresh_lane(); F.tid = F.wave * 64 + F.lane;
    const int h = uidx & 7, uc = uidx >> 3, b = uc / 18, cid = uc % 18, g = h >> 2, r0 = ssd_row0(b, cid);
    LAS bf16* XT = (LAS bf16*)F.lds; LAS bf16* Bn = XT + 64 * SSD_LD; LAS bf16* BT = Bn + 128 * SSD_LD; LAS bf16* Cn = BT + 128 * SSD_LD;
    LAS float* cs0 = (LAS float*)(Cn + 128 * SSD_LD); LAS float* ecs1 = cs0 + 128; LAS float* dt0 = ecs1 + 128; LAS float* dt1 = dt0 + 128; LAS float* w0 = dt1 + 128; LAS float* w1 = w0 + 128;
    __syncthreads();
    if (F.wave == 0) {
        const float A0 = -expf(F.in[I_SALOG][l * 16 + h]), A1 = -expf(F.in[I_SALOG][l * 16 + 8 + h]);
        const float db0 = F.in[I_SDTB][l * 16 + h], db1 = F.in[I_SDTB][l * 16 + 8 + h];
        const int t0 = 2 * F.lane;
        const float d00 = softplusf_(F.DT[(size_t)(r0 + t0) * 16 + h] + db0), d01 = softplusf_(F.DT[(size_t)(r0 + t0 + 1) * 16 + h] + db0);
        const float d10 = softplusf_(F.DT[(size_t)(r0 + t0) * 16 + 8 + h] + db1), d11 = softplusf_(F.DT[(size_t)(r0 + t0 + 1) * 16 + 8 + h] + db1);
        const float a00 = d00 * A0, a01 = d01 * A0, a10 = d10 * A1, a11 = d11 * A1;
        float p0 = a00 + a01, p1 = a10 + a11;
#pragma unroll
        for (int o = 1; o < 64; o <<= 1) { const float u0 = __int_as_float(__builtin_amdgcn_ds_bpermute((F.lane - o) << 2, __float_as_int(p0))), u1 = __int_as_float(__builtin_amdgcn_ds_bpermute((F.lane - o) << 2, __float_as_int(p1)));
            if (F.lane >= o) { p0 += u0; p1 += u1; } }
        const float tot0 = __int_as_float(__builtin_amdgcn_readlane(__float_as_int(p0), 63)), tot1 = __int_as_float(__builtin_amdgcn_readlane(__float_as_int(p1), 63));
        const float c01 = p0, c00 = p0 - a01;
        const float e11 = p1 - a11, e10 = e11 - a10;
        cs0[t0] = c00; cs0[t0 + 1] = c01; ecs1[t0] = e10; ecs1[t0 + 1] = e11; dt0[t0] = d00; dt0[t0 + 1] = d01; dt1[t0] = d10; dt1[t0 + 1] = d11;
        w0[t0] = __expf(tot0 - c00) * d00; w0[t0 + 1] = __expf(tot0 - c01) * d01; w1[t0] = __expf(e10) * d10; w1[t0 + 1] = __expf(e11) * d11;
        float* ed = (float*)(F.ws + WS_EDEC) + ((size_t)(r0 + t0) * 8 + h) * 2;
        ed[0] = __expf(c00); ed[1] = __expf(tot1 - e10); ed[16] = __expf(c01); ed[17] = __expf(tot1 - e11);
        if (F.lane == 0) { float* tt = (float*)(F.ws + WS_TOT) + ((size_t)uc * 8 + h) * 2; tt[0] = tot0; tt[1] = tot1; }
    }
    {
        int lo, hi; seq_bounds(r0, lo, hi);
        const float* cw = F.in[I_SCW] + (size_t)l * 5 * 1024; const float* cb = F.in[I_SCB] + l * 1024;
        bf16* CC = (bf16*)(F.ws + WS_CC);
        for (int it = F.tid; it < 640; it += NTHR) {
            const int oct = it % 40, seg = it / 40, s0 = seg * 8;
            const int kind = oct < 8 ? 0 : (oct < 24 ? 1 : 2);
            const int n0 = kind == 0 ? oct * 8 : (kind == 1 ? (oct - 8) * 8 : (oct - 24) * 8);
            const int xch = kind == 0 ? h * 64 + n0 : (kind == 1 ? 512 + g * 128 + n0 : 768 + g * 128 + n0);
            u32x4 xr[12];
            const bool lo_ok = (r0 + s0 - 2) >= lo, hi_ok = (r0 + s0 + 9) < hi;
            const bf16* xp = F.COLS + (size_t)(r0 + s0) * NCOL + 512 + xch;
#pragma unroll
            for (int i = 2; i < 10; ++i) xr[i] = *(const u32x4*)(xp + (i - 2) * NCOL);
            xr[0] = xr[2]; xr[1] = xr[2]; xr[10] = xr[9]; xr[11] = xr[9];
            if (lo_ok) { xr[0] = *(const u32x4*)(xp - 2 * NCOL); xr[1] = *(const u32x4*)(xp - NCOL); } else { xr[0] = (u32x4){0u, 0u, 0u, 0u}; xr[1] = xr[0]; }
            if (hi_ok) { xr[10] = *(const u32x4*)(xp + 8 * NCOL); xr[11] = *(const u32x4*)(xp + 9 * NCOL); } else { xr[10] = (u32x4){0u, 0u, 0u, 0u}; xr[11] = xr[10]; }
#pragma unroll
            for (int hb = 0; hb < 2; ++hb) {
                float wv[5][4]; float val[8][4];
#pragma unroll
                for (int j = 0; j < 5; ++j) { const f32x4 t = *(const f32x4*)(cw + j * 1024 + xch + 4 * hb); wv[j][0] = t.x; wv[j][1] = t.y; wv[j][2] = t.z; wv[j][3] = t.w; }
                const f32x4 bias = *(const f32x4*)(cb + xch + 4 * hb);
#pragma unroll
                for (int i = 0; i < 8; ++i)
#pragma unroll
                    for (int k = 0; k < 4; ++k) val[i][k] = bias[k];
#pragma unroll
                for (int i = 0; i < 12; ++i) {
                    const unsigned wa = hb ? xr[i].z : xr[i].x, wb = hb ? xr[i].w : xr[i].y;
                    const float x4[4] = {__uint_as_float(wa << 16), __uint_as_float(wa & 0xffff0000u), __uint_as_float(wb << 16), __uint_as_float(wb & 0xffff0000u)};
#pragma unroll
                    for (int j = 0; j < 5; ++j) { const int o = i - j;
                        if (o >= 0 && o < 8) {
#pragma unroll
                            for (int k = 0; k < 4; ++k) val[o][k] = fmaf(wv[j][k], x4[k], val[o][k]); } }
                }
#pragma unroll
                for (int i = 0; i < 8; ++i)
#pragma unroll
                    for (int k = 0; k < 4; ++k) val[i][k] = siluf_(val[i][k]);
                if (kind != 0) {
                    LAS bf16* N = kind == 1 ? Bn : Cn;
#pragma unroll
                    for (int i = 0; i < 8; ++i) { u32x2 o; o.x = pk2(val[i][0], val[i][1]); o.y = pk2(val[i][2], val[i][3]); *(LAS u32x2*)(N + (s0 + i) * SSD_LD + n0 + 4 * hb) = o;
                        if (kind == 2 && (h & 3) == 0) *(u32x2*)(CC + (size_t)(r0 + s0 + i) * 256 + g * 128 + n0 + 4 * hb) = o; }
                }
                if (kind != 2) {
                    LAS bf16* T = kind == 0 ? XT : BT;
#pragma unroll
                    for (int k = 0; k < 4; ++k) { u32x4 o; o.x = pk2(val[0][k], val[1][k]); o.y = pk2(val[2][k], val[3][k]); o.z = pk2(val[4][k], val[5][k]); o.w = pk2(val[6][k], val[7][k]);
                        *(LAS u32x4*)(T + (n0 + 4 * hb + k) * SSD_LD + s0) = o; }
                }
            }
        }
    }
    __syncthreads();
    int lane_ = F.lane; asm volatile("" : "+v"(lane_));
    const int q = lane_ >> 4, c = lane_ & 15, w = F.wave;
    {
        pg8::bf16x8 cfr[4];
#pragma unroll
        for (int ks = 0; ks < 4; ++ks) cfr[ks] = *(const LAS pg8::bf16x8*)(Cn + (16 * w + c) * SSD_LD + 32 * ks + 8 * q);
        f32x4 gt[8];
#pragma unroll
        for (int a = 0; a < 8; ++a) { f32x4 acc = {0.f, 0.f, 0.f, 0.f};
#pragma unroll
            for (int ks = 0; ks < 4; ++ks) acc = __builtin_amdgcn_mfma_f32_16x16x32_bf16(*(const LAS pg8::bf16x8*)(Bn + (16 * a + c) * SSD_LD + 32 * ks + 8 * q), cfr[ks], acc, 0, 0, 0);
            gt[a] = acc; }
        const int t = 16 * w + c; const float cs0t = cs0[t], e1t = ecs1[t], Dh = F.in[I_SD][l * 8 + h];
#pragma unroll
        for (int a = 0; a < 8; ++a) {
            const f32x4 csv = *(const LAS f32x4*)&cs0[16 * a + 4 * q], d0v = *(const LAS f32x4*)&dt0[16 * a + 4 * q], e1v = *(const LAS f32x4*)&ecs1[16 * a + 4 * q], d1v = *(const LAS f32x4*)&dt1[16 * a + 4 * q];
#pragma unroll
            for (int j = 0; j < 4; ++j) { const int sidx = 16 * a + 4 * q + j;
                const float f0 = (sidx <= t) ? __expf(fminf(cs0t - csv[j], 0.f)) * d0v[j] : 0.f;
                const float f1 = (sidx >= t) ? __expf(fminf(e1v[j] - e1t, 0.f)) * d1v[j] : 0.f;
                gt[a][j] = gt[a][j] * (f0 + f1) + ((sidx == t) ? Dh : 0.f); }
        }
        pg8::bf16x8 mfr[4];
#pragma unroll
        for (int i = 0; i < 4; ++i) { u32x4 tq; tq.x = pk2(gt[2 * i][0], gt[2 * i][1]); tq.y = pk2(gt[2 * i][2], gt[2 * i][3]); tq.z = pk2(gt[2 * i + 1][0], gt[2 * i + 1][1]); tq.w = pk2(gt[2 * i + 1][2], gt[2 * i + 1][3]); mfr[i] = __builtin_bit_cast(pg8::bf16x8, tq); }
        bf16* YI = (bf16*)(F.ws + WS_YI);
#pragma unroll
        for (int pt = 0; pt < 4; ++pt) { f32x4 acc = {0.f, 0.f, 0.f, 0.f};
#pragma unroll
            for (int i = 0; i < 4; ++i) { const LAS bf16* xp = XT + (16 * pt + c) * SSD_LD + 32 * i + 4 * q;
                acc = __builtin_amdgcn_mfma_f32_16x16x32_bf16(mk8(*(const LAS u32x2*)xp, *(const LAS u32x2*)(xp + 16)), mfr[i], acc, 0, 0, 0); }
            u32x2 o; o.x = pk2(acc[0], acc[1]); o.y = pk2(acc[2], acc[3]);
            *(u32x2*)(YI + (((size_t)uidx * 32 + pt * 8 + w) * 64 + F.lane) * 4) = o; }
    }
    {
        pg8::bf16x8 btf[4];
#pragma unroll
        for (int ks = 0; ks < 4; ++ks) btf[ks] = *(const LAS pg8::bf16x8*)(BT + (16 * w + c) * SSD_LD + 32 * ks + 8 * q);
        bf16* SST = (bf16*)(F.ws + WS_SST);
#pragma unroll
        for (int d = 0; d < 2; ++d) { const LAS float* wd = d ? w1 : w0;
#pragma unroll
            for (int pt = 0; pt < 4; ++pt) { f32x4 acc = {0.f, 0.f, 0.f, 0.f};
#pragma unroll
                for (int ks = 0; ks < 4; ++ks) {
                    const u32x4 xq = *(const LAS u32x4*)(XT + (16 * pt + c) * SSD_LD + 32 * ks + 8 * q);
                    const f32x4 wa = *(const LAS f32x4*)&wd[32 * ks + 8 * q], wb = *(const LAS f32x4*)&wd[32 * ks + 8 * q + 4];
                    u32x4 sq;
                    sq.x = pk2(__uint_as_float(xq.x << 16) * wa[0], __uint_as_float(xq.x & 0xffff0000u) * wa[1]); sq.y = pk2(__uint_as_float(xq.y << 16) * wa[2], __uint_as_float(xq.y & 0xffff0000u) * wa[3]);
                    sq.z = pk2(__uint_as_float(xq.z << 16) * wb[0], __uint_as_float(xq.z & 0xffff0000u) * wb[1]); sq.w = pk2(__uint_as_float(xq.w << 16) * wb[2], __uint_as_float(xq.w & 0xffff0000u) * wb[3]);
                    acc = __builtin_amdgcn_mfma_f32_16x16x32_bf16(btf[ks], __builtin_bit_cast(pg8::bf16x8, sq), acc, 0, 0, 0); }
                u32x2 o; o.x = pk2(acc[0], acc[1]); o.y = pk2(acc[2], acc[3]);
                *(u32x2*)(SST + (((size_t)uidx * 2 + d) * 64 + 16 * pt + c) * 128 + 16 * w + 4 * q) = o; }
        }
    }
}
__device__ __forceinline__ void ssd_carry(const Frame& F) {
    const int gt = F.bid * NTHR + F.tid, NG = F.G * NTHR;
    const bf16* SST = (const bf16*)(F.ws + WS_SST); bf16* HIN = (bf16*)(F.ws + WS_HIN); const float* TOT = (const float*)(F.ws + WS_TOT);
    for (int i = gt; i < NB * 8 * 2 * 1024; i += NG) {
        const int e8 = i & 1023, d = (i >> 10) & 1, h = (i >> 11) & 7, b = i >> 14;
        float H[8];
#pragma unroll
        for (int k = 0; k < 8; ++k) H[k] = 0.f;
#pragma unroll 2
        for (int j = 0; j < 18; ++j) {
            const int cid = d ? (j < 2 ? 1 - j : 19 - j) : j;
            const size_t ui = (size_t)(b * 18 + cid) * 8 + h, off = ((ui * 2 + d) * 1024 + e8) * 8;
            u32x4 o; o.x = pk2(H[0], H[1]); o.y = pk2(H[2], H[3]); o.z = pk2(H[4], H[5]); o.w = pk2(H[6], H[7]);
            *(u32x4*)(HIN + off) = o;
            float sv[8]; ld8(SST + off, sv);
            const float dec = __expf(TOT[ui * 2 + d]);
#pragma unroll
            for (int k = 0; k < 8; ++k) H[k] = fmaf(H[k], dec, sv[k]);
        }
    }
}
__device__ __forceinline__ void ssd_unit_b(const Frame& F, int l, int u2) {
    const int uc = u2 >> 1, rh = u2 & 1, b = uc / 18, cid = uc % 18, r0 = ssd_row0(b, cid) + 64 * rh;
    const int lane_ = fresh_lane();
    const int q = lane_ >> 4, c = lane_ & 15, h = F.wave, g = h >> 2;
    const bf16* CC = (const bf16*)(F.ws + WS_CC); const bf16* HIN = (const bf16*)(F.ws + WS_HIN); const bf16* YI = (const bf16*)(F.ws + WS_YI); const float* ED = (const float*)(F.ws + WS_EDEC);
    LAS float* SSX = (LAS float*)F.lds;
    const size_t ui = (size_t)uc * 8 + h;
    pg8::bf16x8 hin[2][4][4], cfr[4][4];
#pragma unroll
    for (int d = 0; d < 2; ++d)
#pragma unroll
        for (int pt = 0; pt < 4; ++pt)
#pragma unroll
            for (int ks = 0; ks < 4; ++ks) hin[d][pt][ks] = *(const pg8::bf16x8*)(HIN + ((ui * 2 + d) * 64 + 16 * pt + c) * 128 + 32 * ks + 8 * q);
#pragma unroll
    for (int tt = 0; tt < 4; ++tt)
#pragma unroll
        for (int ks = 0; ks < 4; ++ks) cfr[tt][ks] = *(const pg8::bf16x8*)(CC + (size_t)(r0 + 16 * tt + c) * 256 + g * 128 + 32 * ks + 8 * q);
    float ssv[4];
#pragma unroll
    for (int tt = 0; tt < 4; ++tt) {
        const size_t row = (size_t)(r0 + 16 * tt + c); const int w = rh * 4 + tt;
        const f32x2 ed = *(const f32x2*)(ED + (row * 8 + h) * 2);
        u32x2 yiq[4], zq[4];
#pragma unroll
        for (int pt = 0; pt < 4; ++pt) { yiq[pt] = *(const u32x2*)(YI + ((ui * 32 + pt * 8 + w) * 64 + lane_) * 4); zq[pt] = *(const u32x2*)(F.COLS + row * NCOL + h * 64 + 16 * pt + 4 * q); }
        float ss = 0.f;
#pragma unroll
        for (int pt = 0; pt < 4; ++pt) {
            f32x4 a0 = {0.f, 0.f, 0.f, 0.f}, a1 = {0.f, 0.f, 0.f, 0.f};
#pragma unroll
            for (int ks = 0; ks < 4; ++ks) { a0 = __builtin_amdgcn_mfma_f32_16x16x32_bf16(hin[0][pt][ks], cfr[tt][ks], a0, 0, 0, 0); a1 = __builtin_amdgcn_mfma_f32_16x16x32_bf16(hin[1][pt][ks], cfr[tt][ks], a1, 0, 0, 0); }
            const float yi[4] = {__uint_as_float(yiq[pt].x << 16), __uint_as_float(yiq[pt].x & 0xffff0000u), __uint_as_float(yiq[pt].y << 16), __uint_as_float(yiq[pt].y & 0xffff0000u)};
            const float z[4] = {__uint_as_float(zq[pt].x << 16), __uint_as_float(zq[pt].x & 0xffff0000u), __uint_as_float(zq[pt].y << 16), __uint_as_float(zq[pt].y & 0xffff0000u)};
            float v[4];
#pragma unroll
            for (int j = 0; j < 4; ++j) { v[j] = (yi[j] + ed.x * a0[j] + ed.y * a1[j]) * siluf_(z[j]); ss = fmaf(v[j], v[j], ss); }
            u32x2 o; o.x = pk2(v[0], v[1]); o.y = pk2(v[2], v[3]);
            *(u32x2*)(F.MIX + row * 1024 + h * 64 + 16 * pt + 4 * q) = o;
        }
        ss += shx(ss, 16, lane_); ss += shx(ss, 32, lane_);
        ssv[tt] = ss;
    }
    __syncthreads();
    if (q == 0) {
#pragma unroll
        for (int tt = 0; tt < 4; ++tt) SSX[h * 64 + 16 * tt + c] = ssv[tt];
    }
    __syncthreads();
    const float* ng = F.in[I_SNG] + l * 512 + h * 64;
    u32x2 mv[4][4];
#pragma unroll
    for (int tt = 0; tt < 4; ++tt)
#pragma unroll
        for (int pt = 0; pt < 4; ++pt) mv[tt][pt] = *(const u32x2*)(F.MIX + (size_t)(r0 + 16 * tt + c) * 1024 + h * 64 + 16 * pt + 4 * q);
#pragma unroll
    for (int tt = 0; tt < 4; ++tt) {
        float tot = 0.f;
#pragma unroll
        for (int k = 0; k < 8; ++k) tot += SSX[k * 64 + 16 * tt + c];
        const float rstd = rsqrtf(tot * (1.f / 512.f) + EPS);
#pragma unroll
        for (int pt = 0; pt < 4; ++pt) { const f32x4 gn = *(const f32x4*)(ng + 16 * pt + 4 * q);
            u32x2 o; o.x = pk2(__uint_as_float(mv[tt][pt].x << 16) * rstd * gn[0], __uint_as_float(mv[tt][pt].x & 0xffff0000u) * rstd * gn[1]);
            o.y = pk2(__uint_as_float(mv[tt][pt].y << 16) * rstd * gn[2], __uint_as_float(mv[tt][pt].y & 0xffff0000u) * rstd * gn[3]);
            *(u32x2*)(F.MIX + (size_t)(r0 + 16 * tt + c) * 1024 + h * 64 + 16 * pt + 4 * q) = o; }
    }
}

__device__ __forceinline__ void stage_wt16(LAS float* WT, const float* src, int stride, int tid) {
    for (int i = tid; i < 4096; i += NTHR) { const int k = i >> 2, e4 = (i & 3) * 4; const f32x4 v = *(const f32x4*)(src + (size_t)k * stride + e4);
        WT[(e4 + 0) * 1024 + k] = v.x; WT[(e4 + 1) * 1024 + k] = v.y; WT[(e4 + 2) * 1024 + k] = v.z; WT[(e4 + 3) * 1024 + k] = v.w; }
}
__device__ __forceinline__ void dot16_acc(const LAS float* WT, const f32x4& h, int j, int lane, float (&acc)[16]) {
#pragma unroll
    for (int e = 0; e < 16; ++e) { const f32x4 w = *(const LAS f32x4*)&WT[e * 1024 + 4 * lane + 256 * j]; acc[e] = fmaf(h.x, w.x, fmaf(h.y, w.y, fmaf(h.z, w.z, fmaf(h.w, w.w, acc[e])))); }
    asm volatile("" ::: "memory");
}

__device__ __forceinline__ void phase_p0(const Frame& F0)  {
    Frame F = enter_phase(F0);
    {
        const size_t gt = (size_t)F.bid * NTHR + F.tid, NG = (size_t)F.G * NTHR;
        for (size_t i = gt; i < (size_t)TT * 256; i += NG) {
            const int r = (int)(i >> 8), c4 = (int)(i & 255) * 4;
            f32x4 v;
            if (r < TL) {
                v = *(const f32x4*)(F.in[I_X] + (size_t)r * D + c4);
                const int n = r & (SEQ - 1), rr = n >> 6, cc = n & 63, q = c4 >> 8, ii = c4 & 255;
                const float pos = (float)(q < 2 ? rr : cc);
                float pe[4];
#pragma unroll
                for (int k = 0; k < 4; ++k) {
                    const float invf = expf(-9.210340371976184f * (float)(ii + k) * (1.f / 256.f));
                    float s, c; sincos_red(pos * invf, s, c);
                    pe[k] = (q & 1) ? c : s;
                }
                v.x += pe[0]; v.y += pe[1]; v.z += pe[2]; v.w += pe[3];
            } else {
                v = *(const f32x4*)(F.in[I_CTX] + (size_t)(r - TL) * D + c4);
            }
            *(f32x4*)(F.XS + (size_t)r * D + c4) = v;
        }
    }
    {
        LAS float* scr = (LAS float*)F.lds + F.wave * (64 * 33);
        const int gw = F.bid * NWAVES + F.wave, NGW = F.G * NWAVES;
        constexpr int I_IN = 16 * 73, I_OUT = 16 * 32, I_PW = 4 * 8, I_GLU = 4 * 16, I_L = I_IN + I_OUT + I_PW + I_GLU;
        for (int it = gw; it < 2 * I_L; it += NGW) {
            const int l = it / I_L; int r = it % I_L;
            if (r < I_IN) { transpose_item(F.in[I_WIN] + (size_t)l * D * INC, D, INC, F.WIN_T + (size_t)l * NCOL * D, [](int n) { return n < 1536 ? n : (n < 1552 ? -1 : (n < INC ? n - 16 : -1)); }, scr, r, F.lane); continue; } r -= I_IN;
            if (r < I_OUT) { transpose_item(F.in[I_WOUT] + (size_t)l * D * D, D, D, F.WOUT_T + (size_t)l * D * D, [](int n) { return n; }, scr, r, F.lane); continue; } r -= I_OUT;
            if (r < I_PW) { transpose_item(F.in[I_CPW] + (size_t)l * 256 * 256, 256, 256, F.PW_T + (size_t)l * 256 * 256, [](int n) { return n; }, scr, r, F.lane); continue; } r -= I_PW;
            transpose_item(F.in[I_GLUW] + (size_t)l * 256 * 512, 256, 512, F.GLU_T + (size_t)l * 512 * 256, [](int n) { return n; }, scr, r, F.lane);
        }
        __syncthreads();
    }
    {
        const int gt = F.bid * NTHR + F.tid, NG = F.G * NTHR;
        f32x2* AA = (f32x2*)(F.ws + WS_S5AA); bf16* BB = (bf16*)(F.ws + WS_S5BB); bf16* CM = (bf16*)(F.ws + WS_S5CM);
        for (int i = gt; i < 2 * 2 * 16 * 64; i += NG) {
            const int p = i & 63, g = (i >> 6) & 15, dir = (i >> 10) & 1, l = i >> 11;
            const float step = expf(F.in[I_LSTEP][(l * 2 + dir) * 16 + g]);
            const float lr = F.in[I_LRE][i], li = F.in[I_LIM][i];
            const float mag = expf(lr * step); float sn, cs; sincos_red(li * step, sn, cs);
            const float ar = mag * cs, ai = mag * sn, inv_den = 1.f / (lr * lr + li * li);
            const float cr = ((ar - 1.f) * lr + ai * li) * inv_den, ci = (ai * lr - (ar - 1.f) * li) * inv_den;
            AA[i] = (f32x2){ar, ai};
            const float* bre = F.in[I_BRE] + ((size_t)(l * 16 + g) * 64 + p) * 16; const float* bim = F.in[I_BIM] + ((size_t)(l * 16 + g) * 64 + p) * 16;
            bf16* o = BB + ((size_t)((l * 2 + dir) * 16 + g) * 128 + 2 * p) * 16;
            for (int h = 0; h < 16; ++h) { const float br = bre[h], bi = bim[h]; o[h] = (bf16)f2bf(cr * br - ci * bi); o[16 + h] = (bf16)f2bf(cr * bi + ci * br); }
        }
        for (int i = gt; i < 2 * 16 * 16 * 64; i += NG) {
            *(unsigned*)(CM + (size_t)i * 2) = pk2(F.in[I_CRE][i], -F.in[I_CIM][i]);
        }
    }
    {
        LAS float* sc = (LAS float*)F.lds;
        LAS float* part = sc + 9 * 1024;
        __syncthreads();
        if (F.bid < 192) { for (int t = F.tid; t < 9 * 1024; t += NTHR) { const int r9 = t >> 10, k = t & 1023; sc[t] = siluf_(r9 < 8 ? F.in[I_C][r9 * D + k] : F.in[I_CCTX][k]); } }
        __syncthreads();
        for (int it = F.bid; it < 192; it += F.G) {
            const int l = it / 96, cb = it % 96, col = F.tid & 63, kg = F.tid >> 6;
            float acc[9];
#pragma unroll
            for (int r9 = 0; r9 < 9; ++r9) acc[r9] = 0.f;
            const float* wp = F.in[I_WADA] + ((size_t)l * D + kg * 128) * 6144 + cb * 64 + col;
#pragma unroll 4
            for (int kk = 0; kk < 128; ++kk) {
                const float w = wp[(size_t)kk * 6144];
#pragma unroll
                for (int r9 = 0; r9 < 9; ++r9) acc[r9] = fmaf(sc[r9 * 1024 + kg * 128 + kk], w, acc[r9]);
            }
#pragma unroll
            for (int r9 = 0; r9 < 9; ++r9) part[(kg * 9 + r9) * 64 + col] = acc[r9];
            __syncthreads();
            for (int t = F.tid; t < 9 * 64; t += NTHR) { const int r9 = t >> 6, cc = t & 63; float sm = F.in[I_BADA][l * 6144 + cb * 64 + cc];
#pragma unroll
                for (int k8 = 0; k8 < 8; ++k8) sm += part[(k8 * 9 + r9) * 64 + cc];
                F.MOD[((size_t)l * 9 + r9) * 6144 + cb * 64 + cc] = sm; }
            __syncthreads();
        }
    }
}
__device__ __forceinline__ LAS int* moe_tables(const Frame& F, int l) {
    LAS int* tab = (LAS int*)(F.lds + TAB_OFF);
    __syncthreads();
    if (F.tid == 0) {
        int bs = 0;
        for (int e = 0; e < NEXP; ++e) { const int c = (int)F.ctl[CW_CNT + l * 64 + e]; tab[e] = bs; tab[40 + e] = c; bs += ((c + 255) / 256) * 256; }
        tab[16] = bs;
    }
    __syncthreads();
    return tab;
}
__device__ __forceinline__ void phase_rowA(const Frame& F0, int l)  {
    Frame F = enter_phase(F0);
    LAS int* tab = (LAS int*)(F.lds + TAB_OFF);
    if (l > 0) tab = moe_tables(F, l - 1);
    LAS float* WDT = (LAS float*)F.lds;
    if (l < DEPTH) {
        __syncthreads();
        stage_wt16(WDT, F.in[I_WIN] + (size_t)l * D * INC + 1536, INC, F.tid);
        __syncthreads();
    }
    const int gw = F.bid * NWAVES + F.wave, NGW = F.G * NWAVES;
    const int RL = (l == DEPTH) ? TL : TT;
    const float* gvec = (l == DEPTH) ? F.in[I_GFIN] : F.in[I_GMIX] + l * D;
    for (int r = gw; r < RL; r += NGW) {
        const int mr = modrow(r);
        f32x4 v[4];
#pragma unroll
        for (int j = 0; j < 4; ++j) v[j] = *(const f32x4*)(F.XS + (size_t)r * D + 4 * F.lane + 256 * j);
        if (l > 0) {
            const int4 ti = *(const int4*)(F.TOKI + (size_t)r * 4);
            const f32x2 tw = *(const f32x2*)(F.TOKW + (size_t)r * 2);
            const size_t ra = (size_t)(tab[ti.x] + ti.y), rb = (size_t)(tab[ti.z] + ti.w);
            const float* g2 = F.MOD + ((size_t)(l - 1) * 9 + mr) * 6144 + 5120;
#pragma unroll
            for (int j = 0; j < 4; ++j) {
                const int c = 4 * F.lane + 256 * j;
                float ya[4], yb[4]; ld4(F.YDN + ra * D + c, ya); ld4(F.YDN + rb * D + c, yb);
                const f32x4 g = *(const f32x4*)(g2 + c);
#pragma unroll
                for (int e = 0; e < 4; ++e) v[j][e] += g[e] * (ya[e] * tw.x + yb[e] * tw.y);
            }
            if (l < DEPTH) {
#pragma unroll
                for (int j = 0; j < 4; ++j) *(f32x4*)(F.XS + (size_t)r * D + 4 * F.lane + 256 * j) = v[j];
            }
        }
        float ss = 0.f;
#pragma unroll
        for (int j = 0; j < 4; ++j) ss += (v[j].x * v[j].x + v[j].y * v[j].y) + (v[j].z * v[j].z + v[j].w * v[j].w);
        const float rstd = rsqrtf(wave_sum(ss, F.lane) * (1.f / D) + EPS);
        if (l == DEPTH) {
#pragma unroll
            for (int j = 0; j < 4; ++j) { const int c = 4 * F.lane + 256 * j; const f32x4 g = *(const f32x4*)(gvec + c); *(f32x4*)(F.out + (size_t)r * D + c) = v[j] * rstd * g; }
        } else {
            const float* md = F.MOD + ((size_t)l * 9 + mr) * 6144;
            float dtp[16];
#pragma unroll
            for (int e = 0; e < 16; ++e) dtp[e] = 0.f;
#pragma unroll
            for (int j = 0; j < 4; ++j) {
                const int c = 4 * F.lane + 256 * j;
                const f32x4 g = *(const f32x4*)(gvec + c), sh = *(const f32x4*)(md + c), scl = *(const f32x4*)(md + 1024 + c);
                const f32x4 h = v[j] * rstd * g * (scl + 1.f) + sh;
                u32x2 o; o.x = pk2(h.x, h.y); o.y = pk2(h.z, h.w);
                *(u32x2*)(F.HN + (size_t)r * D + c) = o;
                dot16_acc(WDT, h, j, F.lane, dtp);
            }
#pragma unroll
            for (int e = 0; e < 16; ++e) dtp[e] = wave_sum(dtp[e], F.lane);
            if (F.lane == 0) {
#pragma unroll
                for (int e4 = 0; e4 < 4; ++e4) *(f32x4*)(F.DT + (size_t)r * 16 + e4 * 4) = (f32x4){dtp[e4 * 4], dtp[e4 * 4 + 1], dtp[e4 * 4 + 2], dtp[e4 * 4 + 3]};
            }
        }
    }
}
__device__ __forceinline__ void phase_inproj(const Frame& F0, int l)  {
    Frame F = enter_phase(F0);
    pg8::PlainSched S; S.T.init(TT / 256, NCOL / 256, F.G, F.bid); S.Bt = (const char*)(F.WIN_T + (size_t)l * NCOL * D); S.K = D;
    pg8::EpiStoreBf16 E{F.COLS, NCOL, 0, nullptr};
    pg8::gemm_phase<pg8::EpiStoreBf16, pg8::PlainSched, true>(F.lds, F.HN, D, S, E, F.tid);
}
__device__ __forceinline__ void conf_unit(const Frame& Fu, int l, int uidx) {
    Frame F = Fu; F.lane = fresh_lane(); F.tid = F.wave * 64 + F.lane;
    const int r0 = uidx * 64;
    LAS bf16* XU = (LAS bf16*)F.lds;
    LAS float* WD = (LAS float*)(F.lds + 94 * 512);
    LAS bf16* CVL = (LAS bf16*)(F.lds + 94 * 512 + 31 * 1024);
    int lo, hi; seq_bounds(r0, lo, hi);
    __syncthreads();
    for (int i = F.tid; i < 94 * 64; i += NTHR) {
        const int rr = r0 - 15 + (i >> 6), c = (i & 63) * 4;
        u32x2 o = {0u, 0u};
        if (rr >= lo && rr < hi) { float a[4], g[4]; ld4(F.COLS + (size_t)rr * NCOL + 1536 + c, a); ld4(F.COLS + (size_t)rr * NCOL + 1792 + c, g);
            o.x = pk2(a[0] * sigmoidf_(g[0]), a[1] * sigmoidf_(g[1])); o.y = pk2(a[2] * sigmoidf_(g[2]), a[3] * sigmoidf_(g[3])); }
        *(LAS u32x2*)(XU + (i >> 6) * 256 + c) = o;
    }
    for (int i = F.tid; i < 31 * 64; i += NTHR) *(LAS f32x4*)&WD[i * 4] = *(const f32x4*)(F.in[I_CDW] + (size_t)l * 31 * 256 + i * 4);
    __syncthreads();
    const int ch = 4 * F.lane;
    const f32x4 db = *(const f32x4*)(F.in[I_CDB] + l * 256 + ch), lg = *(const f32x4*)(F.in[I_CLG] + l * 256 + ch), lb = *(const f32x4*)(F.in[I_CLB] + l * 256 + ch);
#pragma unroll 1
    for (int i = 0; i < 8; ++i) {
        const int lr = F.wave * 8 + i;
        f32x4 acc = db;
#pragma unroll
        for (int j = 0; j < 31; ++j) {
            const u32x2 xv = *(const LAS u32x2*)(XU + (lr + j) * 256 + ch); const f32x4 w = *(const LAS f32x4*)&WD[j * 256 + ch];
            acc.x = fmaf(w.x, __uint_as_float(xv.x << 16), acc.x); acc.y = fmaf(w.y, __uint_as_float(xv.x & 0xffff0000u), acc.y);
            acc.z = fmaf(w.z, __uint_as_float(xv.y << 16), acc.z); acc.w = fmaf(w.w, __uint_as_float(xv.y & 0xffff0000u), acc.w);
        }
        const float mean = wave_sum((acc.x + acc.y) + (acc.z + acc.w), F.lane) * (1.f / 256.f);
        const f32x4 d = acc - mean;
        const float var = wave_sum((d.x * d.x + d.y * d.y) + (d.z * d.z + d.w * d.w), F.lane) * (1.f / 256.f);
        const f32x4 y = d * rsqrtf(var + EPS) * lg + lb;
        u32x2 o; o.x = pk2(siluf_(y.x), siluf_(y.y)); o.y = pk2(siluf_(y.z), siluf_(y.w));
        *(LAS u32x2*)(CVL + lr * S5_US + ch) = o;
    }
    __syncthreads();
    {
        int lane_ = F.lane; asm volatile("" : "+v"(lane_));
        const int q = lane_ >> 4, c16 = lane_ & 15;
        const bf16* PW = F.PW_T + (size_t)l * 256 * 256;
        f32x4 acc[2][4];
#pragma unroll
        for (int nt = 0; nt < 2; ++nt)
#pragma unroll
            for (int rt = 0; rt < 4; ++rt) acc[nt][rt] = (f32x4){0.f, 0.f, 0.f, 0.f};
#pragma unroll 2
        for (int ks = 0; ks < 8; ++ks) {
            pg8::bf16x8 wf[2], vf[4];
#pragma unroll
            for (int nt = 0; nt < 2; ++nt) wf[nt] = *(const pg8::bf16x8*)(PW + (size_t)(32 * F.wave + 16 * nt + c16) * 256 + 32 * ks + 8 * q);
#pragma unroll
            for (int rt = 0; rt < 4; ++rt) vf[rt] = *(const LAS pg8::bf16x8*)(CVL + (16 * rt + c16) * S5_US + 32 * ks + 8 * q);
#pragma unroll
            for (int nt = 0; nt < 2; ++nt)
#pragma unroll
                for (int rt = 0; rt < 4; ++rt) acc[nt][rt] = __builtin_amdgcn_mfma_f32_16x16x32_bf16(wf[nt], vf[rt], acc[nt][rt], 0, 0, 0);
        }
        const float* pb = F.in[I_CPB] + l * 256;
#pragma unroll
        for (int nt = 0; nt < 2; ++nt) { const int n0 = 32 * F.wave + 16 * nt + 4 * q; const f32x4 bv = *(const f32x4*)(pb + n0);
#pragma unroll
            for (int rt = 0; rt < 4; ++rt) { u32x2 w; w.x = pk2(acc[nt][rt][0] + bv[0], acc[nt][rt][1] + bv[1]); w.y = pk2(acc[nt][rt][2] + bv[2], acc[nt][rt][3] + bv[3]);
                *(u32x2*)(F.MIX + (size_t)(r0 + 16 * rt + c16) * 1024 + 512 + n0) = w; } }
    }
}
__device__ __forceinline__ void expert_cvt_item(const Frame& F, int l, int it, LAS float* scr) {
    const int mtx = it >> 9, r = it & 511, e = mtx / 3, kind = mtx % 3;
    const size_t wofs = ((size_t)l * NEXP + e) * D * D;
    if (kind == 0) transpose_item(F.in[I_WG] + wofs, D, D, F.WGU_T + (size_t)e * 2048 * D, [](int n) { return (n >> 7) * 256 + (n & 127); }, scr, r, F.lane);
    else if (kind == 1) transpose_item(F.in[I_WU] + wofs, D, D, F.WGU_T + (size_t)e * 2048 * D, [](int n) { return (n >> 7) * 256 + 128 + (n & 127); }, scr, r, F.lane);
    else transpose_item(F.in[I_WD] + wofs, D, D, F.WD_T + (size_t)e * D * D, [](int n) { return n; }, scr, r, F.lane);
}
__device__ __forceinline__ void phase_scan(const Frame& F0, int l)  {
    Frame F = enter_phase(F0);
    const int RLc = (l == 0) ? TT : TL;
    const int NU = 1152 + 288 + RLc / 64;
    const int gw = F.bid * NWAVES + F.wave, NGW = F.G * NWAVES;
    LAS float* scr = (LAS float*)(F.lds + 131072 - NWAVES * 8448) + F.wave * (64 * 33);
    int cv = gw;
    for (int u = F.bid; u < NU; u += F.G) {
        if (u < 1152) ssd_unit_a(F, l, u);
        else if (u < 1152 + 288) s5_unit<0>(F, l, u - 1152);
        else conf_unit(F, l, u - 1440);
        __syncthreads();
#pragma unroll 1
        for (int k = 0; k < 2 && cv < 48 * 512; ++k, cv += NGW) expert_cvt_item(F, l, cv, scr);
    }
    __syncthreads();
    for (; cv < 48 * 512; cv += NGW) expert_cvt_item(F, l, cv, scr);
}
__device__ __forceinline__ void phase_carry(const Frame& F0, int l)  {
    Frame F = enter_phase(F0);
    s5_carry(F, l);
    ssd_carry(F);
}
__device__ __forceinline__ void phase_mix1(const Frame& F0, int l)  {
    Frame F = enter_phase(F0);
    const int RL = (l == 0) ? TT : TL;
    for (int u = F.bid; u < 288 + 288; u += F.G) {
        if (u < 288) { if (l == 0 || ((u >> 1) % 18) >= 2) ssd_unit_b(F, l, u); }
        else { const int v = u - 288; if (l == 0 || (v % 36) >= 4) s5_unit<1>(F, l, v); }
    }
}
__device__ __forceinline__ void phase_wout(const Frame& F0, int l)  {
    Frame F = enter_phase(F0);
    const int RL = (l == 0) ? TT : TL;
    pg8::PlainSched S; S.T.init(RL / 256, D / 256, F.G, F.bid); S.Bt = (const char*)(F.WOUT_T + (size_t)l * D * D); S.K = D;
    pg8::EpiResidual E{F.XS, F.MOD + (size_t)l * 9 * 6144 + 2048};
    pg8::gemm_phase<pg8::EpiResidual, pg8::PlainSched, true>(F.lds, F.MIX, D, S, E, F.tid);
}
__device__ __forceinline__ void phase_norm2(const Frame& F0, int l)  {
    Frame F = enter_phase(F0);
    const int RL = (l == 0) ? TT : TL;
    LAS float* RW = (LAS float*)F.lds;
    __syncthreads();
    stage_wt16(RW, F.in[I_RW], 16, F.tid);
    LAS int* lcnt = (LAS int*)(F.lds + 65536);
    if (F.tid < 32) lcnt[F.tid] = 0;
    __syncthreads();
    const int gw = F.bid * NWAVES + F.wave, NGW = F.G * NWAVES;
    const float* gvec = F.in[I_GFFN] + l * D;
    for (int r = gw; r < RL; r += NGW) {
        const int mr = modrow(r);
        f32x4 v[4]; float ss = 0.f;
#pragma unroll
        for (int j = 0; j < 4; ++j) { v[j] = *(const f32x4*)(F.XS + (size_t)r * D + 4 * F.lane + 256 * j); ss += (v[j].x * v[j].x + v[j].y * v[j].y) + (v[j].z * v[j].z + v[j].w * v[j].w); }
        const float rstd = rsqrtf(wave_sum(ss, F.lane) * (1.f / D) + EPS);
        const float* md = F.MOD + ((size_t)l * 9 + mr) * 6144;
        float lg[16];
#pragma unroll
        for (int e = 0; e < 16; ++e) lg[e] = 0.f;
#pragma unroll
        for (int j = 0; j < 4; ++j) {
            const int c = 4 * F.lane + 256 * j;
            const f32x4 g = *(const f32x4*)(gvec + c), sh = *(const f32x4*)(md + 3072 + c), scl = *(const f32x4*)(md + 4096 + c);
            const f32x4 h = v[j] * rstd * g * (scl + 1.f) + sh;
            u32x2 o; o.x = pk2(h.x, h.y); o.y = pk2(h.z, h.w);
            *(u32x2*)(F.HN + (size_t)r * D + c) = o;
            dot16_acc(RW, h, j, F.lane, lg);
        }
        float mx = -3.0e38f;
#pragma unroll
        for (int e = 0; e < 16; ++e) { lg[e] = wave_sum(lg[e], F.lane) + F.in[I_RB][e]; mx = fmaxf(mx, lg[e]); }
        float den = 0.f;
#pragma unroll
        for (int e = 0; e < 16; ++e) { lg[e] = expf(lg[e] - mx); den += lg[e]; }
        const float inv = 1.f / den;
#pragma unroll
        for (int e = 0; e < 16; ++e) lg[e] *= inv;
        float gs[4];
#pragma unroll
        for (int gI = 0; gI < 4; ++gI) {
            const float p0 = lg[gI * 4], p1 = lg[gI * 4 + 1], p2 = lg[gI * 4 + 2], p3 = lg[gI * 4 + 3];
            const float h01 = fmaxf(p0, p1), l01 = fminf(p0, p1), h23 = fmaxf(p2, p3), l23 = fminf(p2, p3);
            gs[gI] = fmaxf(h01, h23) + fmaxf(fminf(h01, h23), fmaxf(l01, l23));
        }
        int best = 0; float bsv = gs[0];
#pragma unroll
        for (int gI = 1; gI < 4; ++gI) if (gs[gI] > bsv) { bsv = gs[gI]; best = gI; }
        float q[4];
#pragma unroll
        for (int i = 0; i < 4; ++i) q[i] = best == 0 ? lg[i] : (best == 1 ? lg[4 + i] : (best == 2 ? lg[8 + i] : lg[12 + i]));
        int i0 = 0; float v0 = q[0];
#pragma unroll
        for (int i = 1; i < 4; ++i) if (q[i] > v0) { v0 = q[i]; i0 = i; }
        int i1 = -1; float v1 = -1.f;
#pragma unroll
        for (int i = 0; i < 4; ++i) if (i != i0 && q[i] > v1) { v1 = q[i]; i1 = i; }
        const float ginv = 1.f / (v0 + v1);
        if (F.lane == 0) {
            const int e0 = best * 4 + i0, e1 = best * 4 + i1;
            const int p0 = __hip_atomic_fetch_add(&lcnt[e0], 1, __ATOMIC_RELAXED, __HIP_MEMORY_SCOPE_WORKGROUP), p1 = __hip_atomic_fetch_add(&lcnt[e1], 1, __ATOMIC_RELAXED, __HIP_MEMORY_SCOPE_WORKGROUP);
            *(int4*)(F.TOKI + (size_t)r * 4) = make_int4(e0, p0, e1, p1);
            *(f32x2*)(F.TOKW + (size_t)r * 2) = (f32x2){v0 * ginv, v1 * ginv};
        }
    }
    __syncthreads();
    if (F.tid < 16) lcnt[16 + F.tid] = (int)atomicAdd(&F.ctl[CW_CNT + l * 64 + F.tid], (unsigned)lcnt[F.tid]);
    __syncthreads();
    if (F.lane == 0) {
        for (int r = gw; r < RL; r += NGW) {
            int4 ti = *(const int4*)(F.TOKI + (size_t)r * 4);
            ti.y += lcnt[16 + ti.x]; ti.w += lcnt[16 + ti.z];
            *(int4*)(F.TOKI + (size_t)r * 4) = ti;
            F.LIST[(size_t)ti.x * TT + ti.y] = r; F.LIST[(size_t)ti.z * TT + ti.w] = r;
        }
    }
}
__device__ __forceinline__ void phase_gateup(const Frame& F0, int l)  {
    Frame F = enter_phase(F0);
    LAS int* tab = moe_tables(F, l);
    LAS int* rows = (LAS int*)(F.lds + ROWS_OFF);
    pg8::MoeSched<true> S; S.T.init(tab[16] / 256, 8, F.G, F.bid); S.Bt = (const char*)F.WGU_T; S.K = D; S.NE = 2048; S.tab = tab; S.rows = rows;
    {
        pg8::Unit u;
        for (int i = 0; i < 15 && S.next(i, u); ++i) {
            if (F.tid < 256) { const int sr = u.pm * 256 + F.tid, e = S.expert(u.pm), pos = sr - tab[e], cnt = tab[40 + e];
                rows[i * 256 + F.tid] = F.LIST[(size_t)e * TT + (pos < cnt ? pos : 0)]; }
        }
        __syncthreads();
    }
    pg8::EpiPairBf16<0> E{F.HMID, 1024, 0, nullptr, 0};
    pg8::gemm_phase<pg8::EpiPairBf16<0>, pg8::MoeSched<true>, true>(F.lds, F.HN, D, S, E, F.tid);
}
__device__ __forceinline__ void phase_down(const Frame& F0, int l)  {
    Frame F = enter_phase(F0);
    LAS int* tab = moe_tables(F, l);
    pg8::MoeSched<false> S; S.T.init(tab[16] / 256, 4, F.G, F.bid); S.Bt = (const char*)F.WD_T; S.K = D; S.NE = 1024; S.tab = tab; S.rows = nullptr;
    pg8::EpiStoreBf16 E{F.YDN, 1024, 0, nullptr};
    pg8::gemm_phase<pg8::EpiStoreBf16, pg8::MoeSched<false>, true>(F.lds, F.HMID, D, S, E, F.tid);
}

constexpr int PH_PER_LAYER = 9, N_PHASES = 1 + DEPTH * PH_PER_LAYER + 1;

__global__ void __launch_bounds__(NTHR, 2) fwd_kernel(Args args) {
    extern __shared__ __attribute__((aligned(16))) unsigned char lds_raw[];
    Frame F;
    F.lds = (LAS unsigned char*)lds_raw;
    F.tid = threadIdx.x; F.lane = F.tid & 63; F.wave = __builtin_amdgcn_readfirstlane(F.tid >> 6);
    F.G = gridDim.x; F.bid = blockIdx.x;
    F.in = (const CAS cfp_t*)__builtin_amdgcn_kernarg_segment_ptr(); F.out = args.out; F.ws = args.ws;
    frame_ptrs(F, args.ws);
    volatile LAS unsigned* MISC = (volatile LAS unsigned*)(F.lds + MISC_OFF);
    if (F.tid < 32) MISC[F.tid] = 0u;
    __syncthreads();
    const int lo = args.ph_lo, hi = args.ph_hi;
    const bool multi = (hi - lo) > 1;
    XcdBarrier bar; bar.bar = F.ctl + CW_BAR; bar.x = 0; bar.st = MISC + 8;
    if (multi) bar = xcd_barrier_post(F.ctl + CW_BAR, MISC + 8);
#define IN(k) (lo <= (k) && (k) < hi)
#define SEAM(k) do { if (IN(k) && IN((k) + 1)) { XcdBarrier bb_ = bar; asm volatile("" : "+s"(bb_.bar)); xcd_barrier(bb_); } } while (0)
    if (IN(0)) phase_p0(F);
    SEAM(0);
    for (int l = 0; l < DEPTH; ++l) {
        const int pb = 1 + l * PH_PER_LAYER;
        if (IN(pb + 0)) phase_rowA(F, l);
        SEAM(pb + 0);
        if (IN(pb + 1)) phase_inproj(F, l);
        SEAM(pb + 1);
        if (IN(pb + 2)) phase_scan(F, l);
        SEAM(pb + 2);
        if (IN(pb + 3)) phase_carry(F, l);
        SEAM(pb + 3);
        if (IN(pb + 4)) phase_mix1(F, l);
        SEAM(pb + 4);
        if (IN(pb + 5)) phase_wout(F, l);
        SEAM(pb + 5);
        if (IN(pb + 6)) phase_norm2(F, l);
        SEAM(pb + 6);
        if (IN(pb + 7)) phase_gateup(F, l);
        SEAM(pb + 7);
        if (IN(pb + 8)) phase_down(F, l);
        SEAM(pb + 8);
    }
    if (IN(N_PHASES - 1)) phase_rowA(F, DEPTH);
#undef IN
#undef SEAM
}

extern "C" void kernel_launch(void* const* d_in, const int* in_sizes, int n_in, void* d_out, int out_size, void* d_ws, size_t ws_size, hipStream_t stream) {
    static int grid = 0;
    if (grid == 0) {
        if (n_in != N_IN || out_size != TL * D || ws_size < WS_END) { fprintf(stderr, "kernel_launch: unexpected shapes (n_in %d out %d ws %zu)\n", n_in, out_size, ws_size); grid = -1; return; }
        int dev = 0, cus = 0, per_cu = 0;
        if (hipGetDevice(&dev) != hipSuccess || hipDeviceGetAttribute(&cus, hipDeviceAttributeMultiprocessorCount, dev) != hipSuccess) { grid = -1; return; }
        if (hipFuncSetAttribute((const void*)fwd_kernel, hipFuncAttributeMaxDynamicSharedMemorySize, LDS_BYTES) != hipSuccess) { fprintf(stderr, "kernel_launch: hipFuncSetAttribute failed\n"); grid = -1; return; }
        if (hipOccupancyMaxActiveBlocksPerMultiprocessor(&per_cu, (const void*)fwd_kernel, NTHR, LDS_BYTES) != hipSuccess || per_cu < 1) { fprintf(stderr, "kernel_launch: occupancy query says %d\n", per_cu); }
        (void)hipGetLastError();
        grid = cus;
    }
    if (grid < 0) return;
    if (hipMemsetAsync((char*)d_ws + WS_CTL, 0, CTL_ZERO_BYTES, stream) != hipSuccess) return;
    Args a{};
    for (int i = 0; i < N_IN; ++i) a.in[i] = (const float*)d_in[i];
    a.out = (float*)d_out; a.ws = (unsigned char*)d_ws;
#if MK_ONE_LAUNCH
    a.ph_lo = 0; a.ph_hi = N_PHASES;
    hipLaunchKernelGGL(fwd_kernel, dim3(grid), dim3(NTHR), LDS_BYTES, stream, a);
#else
    for (int p = 0; p < N_PHASES; ++p) { a.ph_lo = p; a.ph_hi = p + 1; hipLaunchKernelGGL(fwd_kernel, dim3(grid), dim3(NTHR), LDS_BYTES, stream, a); }
#endif
}
```

```cpp
#include <hip/hip_runtime.h>
#include <cstdio>
#include <cstdint>

#ifndef MK_ONE_LAUNCH
#define MK_ONE_LAUNCH 1
#endif

#define GAS __attribute__((address_space(1)))
#define LAS __attribute__((address_space(3)))
#define CAS __attribute__((address_space(4)))
typedef const float* cfp_t;
typedef unsigned short bf16;
typedef float f32x4 __attribute__((ext_vector_type(4)));
typedef float f32x2 __attribute__((ext_vector_type(2)));
typedef unsigned u32x4 __attribute__((ext_vector_type(4)));
typedef unsigned u32x2 __attribute__((ext_vector_type(2)));

constexpr int D = 1024, NB = 8, SEQ = 2048, CTXL = 256, DEPTH = 2;
constexpr int TL = NB * SEQ, TC = NB * CTXL, TT = TL + TC;
constexpr int INC = 2320;
constexpr int NCOL = 2304;
constexpr int VSEQ = CTXL + SEQ;
constexpr int NEXP = 16;
constexpr float EPS = 1e-6f;

enum { I_X = 0, I_C, I_CTX, I_CCTX, I_WADA, I_BADA, I_GMIX, I_WIN, I_SCW, I_SCB, I_SDTB, I_SALOG, I_SD, I_SNG,
       I_CDW, I_CDB, I_CLG, I_CLB, I_CPW, I_CPB, I_LRE, I_LIM, I_LSTEP, I_BRE, I_BIM, I_CRE, I_CIM, I_S5D, I_GLUW, I_GLUB,
       I_WOUT, I_GFFN, I_RW, I_RB, I_WG, I_WU, I_WD, I_GFIN, N_IN };

constexpr size_t MiB = 1u << 20;
constexpr size_t WS_CTL = 0, CTL_ZERO_BYTES = 64 * 1024;
constexpr size_t WS_MOD = 1 * MiB;
constexpr size_t WS_MODP = 2 * MiB;
constexpr size_t WS_DT = 6 * MiB;
constexpr size_t WS_S5AA = 5 * MiB + 512 * 1024;
constexpr size_t WS_S5BB = WS_S5AA + 32 * 1024;
constexpr size_t WS_S5CM = WS_S5BB + 256 * 1024;
constexpr size_t WS_TOKI = 7 * MiB + 512 * 1024;
constexpr size_t WS_TOKW = WS_TOKI + (size_t)TT * 16;
constexpr size_t WS_XS = 8 * MiB;
constexpr size_t WS_HN = 80 * MiB;
constexpr size_t WS_COLS = 116 * MiB;
constexpr size_t WS_XBCC = 197 * MiB;
constexpr size_t WS_CC = 197 * MiB;
constexpr size_t WS_YI = 207 * MiB;
constexpr size_t WS_SST = 226 * MiB;
constexpr size_t WS_HIN = 264 * MiB;
constexpr size_t WS_EDEC = 302 * MiB;
constexpr size_t WS_TOT = 304 * MiB;
constexpr size_t WS_YSSD = 233 * MiB;
constexpr size_t WS_MIX = 305 * MiB;
constexpr size_t WS_YS5 = 341 * MiB;
constexpr size_t WS_S5HL = 341 * MiB;
constexpr size_t WS_S5HI = 346 * MiB;
constexpr size_t WS_CU = 377 * MiB;
constexpr size_t WS_CV = 395 * MiB;
constexpr size_t WS_LIST = 413 * MiB;
constexpr size_t WS_WIN_T = 415 * MiB;
constexpr size_t WS_WOUT_T = 424 * MiB;
constexpr size_t WS_PW_T = 428 * MiB;
constexpr size_t WS_GLU_T = 428 * MiB + 512 * 1024;
constexpr size_t WS_WGU_T = 429 * MiB;
constexpr size_t WS_WD_T = 493 * MiB;
constexpr size_t WS_END = 525 * MiB;
constexpr int MOE_ROWS = 2 * TT + NEXP * 256;
constexpr size_t WS_HMID = WS_COLS;
constexpr size_t WS_YDN = WS_XBCC;
constexpr size_t WS_YG = WS_CU;
static_assert(WS_HMID + (size_t)MOE_ROWS * 1024 * 2 <= WS_XBCC, "HMID overlay");
static_assert(WS_YDN + (size_t)MOE_ROWS * 1024 * 2 <= WS_MIX, "YDN overlay");
constexpr int CW_CNT = 64;
constexpr int CW_BAR = 1024;

constexpr int NWAVES = 8, NTHR = 512;
constexpr int LDS_BYTES = 147456;
constexpr int MISC_OFF = 131072 + 320;
constexpr int TAB_OFF = 131072 + 512, ROWS_OFF = TAB_OFF + 256;

__device__ __forceinline__ float bf2f(bf16 v) { return __uint_as_float((unsigned)v << 16); }
__device__ __forceinline__ unsigned f2bf(float f) { unsigned u = __float_as_uint(f); return (u + 0x7fffu + ((u >> 16) & 1u)) >> 16; }
typedef __bf16 bf16x2_t __attribute__((ext_vector_type(2)));
__device__ __forceinline__ unsigned pk2(float lo, float hi) { f32x2 v = {lo, hi}; return __builtin_bit_cast(unsigned, __builtin_convertvector(v, bf16x2_t)); }
__device__ __forceinline__ float shx(float v, int m, int lane) { return __int_as_float(__builtin_amdgcn_ds_bpermute((lane ^ m) << 2, __float_as_int(v))); }
__device__ __forceinline__ float wave_sum(float v, int lane) {
#pragma unroll
    for (int o = 1; o < 64; o <<= 1) v += shx(v, o, lane);
    return v;
}
__device__ __forceinline__ float sigmoidf_(float x) { return 1.f / (1.f + __expf(-x)); }
__device__ __forceinline__ float siluf_(float x) { return x / (1.f + __expf(-x)); }
__device__ __forceinline__ float softplusf_(float x) { return fmaxf(x, 0.f) + log1pf(__expf(-fabsf(x))); }
__device__ __forceinline__ float gelu_tanh(float x) { const float u = 0.7978845608028654f * (x + 0.044715f * x * x * x); return 0.5f * x * (1.f + tanhf(u)); }
__device__ __forceinline__ void sincos_red(float x, float& s, float& c) {
    const float k = rintf(x * 0.15915494309189535f);
    float r = fmaf(-k, 6.2831854820251465f, x); r = fmaf(-k, -1.7484555e-7f, r);
    s = __sinf(r); c = __cosf(r);
}
__device__ __forceinline__ int opaque_v(int v) { asm volatile("" : "+v"(v)); return v; }
__device__ __forceinline__ int modrow(int r) { return r < TL ? (r >> 11) : 8; }
__device__ __forceinline__ void seq_bounds(int r, int& lo, int& hi) {
    if (r < TL) { lo = r & ~(SEQ - 1); hi = lo + SEQ; } else { lo = TL + ((r - TL) & ~(CTXL - 1)); hi = lo + CTXL; }
}
__device__ __forceinline__ int vrow(int b, int dir, int s) {
    if (s < CTXL) return TL + b * CTXL + (dir ? CTXL - 1 - s : s);
    const int t = s - CTXL; return b * SEQ + (dir ? SEQ - 1 - t : t);
}

#define XB_TMO      128
#define XB_XCNT(j)  (256  + 64 * (j))
#define XB_XSUB(j)  (1280 + 64 * (j))
#define XB_XGEN(j)  (2304 + 64 * (j))
#define XB_TOP      3328
#define XB_TOPGEN   3392
#define XCD_BAR_WORDS 3456
#define XB_SPIN_CAP (1u << 18)
__device__ __forceinline__ unsigned xb_ld(unsigned* p)              { return __hip_atomic_load(p, __ATOMIC_RELAXED, __HIP_MEMORY_SCOPE_AGENT); }
__device__ __forceinline__ unsigned xb_add(unsigned* p, unsigned v) { return __hip_atomic_fetch_add(p, v, __ATOMIC_RELAXED, __HIP_MEMORY_SCOPE_AGENT); }
__device__ __forceinline__ unsigned xb_xcc_id() { return (unsigned)__builtin_amdgcn_s_getreg((3 << 11) | 20) & 0xFu; }
#define XB_SPIN(cond, bar) do { unsigned _sp = 0; while (cond) { __builtin_amdgcn_s_sleep(1); \
    if ((++_sp & 255u) == 0u) { if (xb_ld(&(bar)[XB_TMO])) break; if (_sp > XB_SPIN_CAP) { atomicAdd(&(bar)[XB_TMO], 1u); break; } } } } while (0)
struct XcdBarrier { unsigned* bar; unsigned x; volatile LAS unsigned* st; };
__device__ __forceinline__ XcdBarrier xcd_barrier_post(unsigned* bar, volatile LAS unsigned* st) {
    XcdBarrier b; b.bar = bar; b.x = xb_xcc_id(); b.st = st;
    if (threadIdx.x == 0) (void)xb_add(&bar[XB_XCNT(b.x)], 1u);
    return b;
}
__device__ __forceinline__ void xcd_barrier_complete(unsigned* bar, unsigned x, unsigned& nloc, unsigned& nx) {
    const unsigned G = gridDim.x * gridDim.y * gridDim.z;
    unsigned sum, cnt, mine, sp = 0u;
    for (;;) {
        sum = 0u; cnt = 0u; mine = 0u;
#pragma unroll
        for (unsigned j = 0; j < 16; ++j) { const unsigned c = xb_ld(&bar[XB_XCNT(j)]); sum += c; cnt += (c > 0u) ? 1u : 0u; mine = (j == x) ? c : mine; }
        if (sum == G) break;
        __builtin_amdgcn_s_sleep(1);
        if ((++sp & 255u) == 0u) { if (xb_ld(&bar[XB_TMO])) break; if (sp > XB_SPIN_CAP) { atomicAdd(&bar[XB_TMO], 1u); break; } }
    }
    nloc = mine > 0u ? mine : 1u; nx = cnt > 0u ? cnt : 1u;
}
__device__ __forceinline__ void xcd_barrier(const XcdBarrier& b) {
    asm volatile("s_waitcnt vmcnt(0)" ::: "memory");
    __syncthreads();
    if (threadIdx.x == 0) {
        unsigned* bar = b.bar;
        const unsigned bx = xb_xcc_id();
        __builtin_amdgcn_s_waitcnt(0);
        unsigned nloc = b.st[0], nx = b.st[1];
        if (nloc == 0u) { xcd_barrier_complete(bar, bx, nloc, nx); b.st[0] = nloc; b.st[1] = nx; }
        const unsigned old = xb_add(&bar[XB_XSUB(bx)], 1u);
        const unsigned gen = old / nloc;
        if (old + 1u == (gen + 1u) * nloc) {
            __builtin_amdgcn_fence(__ATOMIC_RELEASE, "agent");
            asm volatile("s_waitcnt vmcnt(0)" ::: "memory");
            const unsigned og = xb_add(&bar[XB_TOP], 1u);
            const unsigned tg = og / nx;
            if (og + 1u == (tg + 1u) * nx) xb_add(&bar[XB_TOPGEN], 1u);
            else XB_SPIN(xb_ld(&bar[XB_TOPGEN]) == tg, bar);
            __builtin_amdgcn_fence(__ATOMIC_ACQUIRE, "agent");
            xb_add(&bar[XB_XGEN(bx)], 1u);
            asm volatile("s_waitcnt vmcnt(0)" ::: "memory");
        } else {
            XB_SPIN(xb_ld(&bar[XB_XGEN(bx)]) == gen, bar);
            __builtin_amdgcn_fence(__ATOMIC_ACQUIRE, "agent");
            asm volatile("s_waitcnt vmcnt(0)" ::: "memory");
        }
    }
    __syncthreads();
}

struct Args { const float* in[N_IN]; float* out; unsigned char* ws; int ph_lo, ph_hi; };
struct Frame {
    LAS unsigned char* lds;
    int tid, lane, wave, G, bid;
    const CAS cfp_t* in;
    float* out; unsigned char* ws;
    unsigned* ctl;
    float *MOD, *MODP, *DT, *XS, *YSSD, *YS5, *CU;
    bf16 *HN, *COLS, *XBCC, *MIX, *HMID, *CV, *YG, *YDN, *WIN_T, *WOUT_T, *PW_T, *GLU_T, *WGU_T, *WD_T;
    int* LIST; int* TOKI; float* TOKW;
};
__device__ __forceinline__ void frame_ptrs(Frame& F, unsigned char* ws) {
    F.ws = ws; F.ctl = (unsigned*)(ws + WS_CTL);
    F.MOD = (float*)(ws + WS_MOD); F.MODP = (float*)(ws + WS_MODP); F.DT = (float*)(ws + WS_DT); F.XS = (float*)(ws + WS_XS);
    F.YSSD = (float*)(ws + WS_YSSD); F.YS5 = (float*)(ws + WS_YS5); F.CU = (float*)(ws + WS_CU); F.CV = (bf16*)(ws + WS_CV); F.YDN = (bf16*)(ws + WS_YDN); F.YG = (bf16*)(ws + WS_YG);
    F.WIN_T = (bf16*)(ws + WS_WIN_T); F.WOUT_T = (bf16*)(ws + WS_WOUT_T); F.PW_T = (bf16*)(ws + WS_PW_T); F.GLU_T = (bf16*)(ws + WS_GLU_T); F.WGU_T = (bf16*)(ws + WS_WGU_T); F.WD_T = (bf16*)(ws + WS_WD_T);
    F.HN = (bf16*)(ws + WS_HN); F.COLS = (bf16*)(ws + WS_COLS); F.XBCC = (bf16*)(ws + WS_XBCC); F.MIX = (bf16*)(ws + WS_MIX); F.HMID = (bf16*)(ws + WS_HMID);
    F.LIST = (int*)(ws + WS_LIST); F.TOKI = (int*)(ws + WS_TOKI); F.TOKW = (float*)(ws + WS_TOKW);
}
__device__ __forceinline__ int fresh_lane() { unsigned om = ~0u; asm volatile("" : "+s"(om)); int ln = (int)__builtin_amdgcn_mbcnt_hi(om, __builtin_amdgcn_mbcnt_lo(om, 0u)); asm volatile("" : "+v"(ln)); return ln; }
__device__ __forceinline__ Frame enter_phase(const Frame& F0) {
    Frame F = F0; unsigned om = ~0u; asm volatile("" : "+s"(om)); int ln = (int)__builtin_amdgcn_mbcnt_hi(om, __builtin_amdgcn_mbcnt_lo(om, 0u)); asm volatile("" : "+v"(ln));
    int wv_ = F0.wave, bid_ = F0.bid, g_ = F0.G; asm volatile("" : "+s"(wv_), "+s"(bid_), "+s"(g_));
    F.wave = wv_; F.bid = bid_; F.G = g_; F.lane = ln; F.tid = wv_ * 64 + ln;
    unsigned char* ws = F0.ws; asm volatile("" : "+s"(ws)); frame_ptrs(F, ws);
    const CAS cfp_t* ka = (const CAS cfp_t*)__builtin_amdgcn_kernarg_segment_ptr(); asm volatile("" : "+s"(ka)); F.in = ka;
    return F;
}

__device__ __forceinline__ void ld4(const float* p, float (&v)[4]) { const f32x4 t = *(const f32x4*)p; v[0] = t.x; v[1] = t.y; v[2] = t.z; v[3] = t.w; }
__device__ __forceinline__ void ld4(const bf16* p, float (&v)[4]) { const u32x2 t = *(const u32x2*)p; v[0] = __uint_as_float(t.x << 16); v[1] = __uint_as_float(t.x & 0xffff0000u); v[2] = __uint_as_float(t.y << 16); v[3] = __uint_as_float(t.y & 0xffff0000u); }

__device__ __forceinline__ void ld8(const bf16* p, float (&v)[8]) { const u32x4 t = *(const u32x4*)p;
    v[0] = __uint_as_float(t.x << 16); v[1] = __uint_as_float(t.x & 0xffff0000u); v[2] = __uint_as_float(t.y << 16); v[3] = __uint_as_float(t.y & 0xffff0000u);
    v[4] = __uint_as_float(t.z << 16); v[5] = __uint_as_float(t.z & 0xffff0000u); v[6] = __uint_as_float(t.w << 16); v[7] = __uint_as_float(t.w & 0xffff0000u); }

namespace pg8 {
typedef short bf16x8 __attribute__((ext_vector_type(8)));
constexpr int BM = 256, BK = 64, HALF = 128, HTB = HALF * BK * 2, STAGE_BYTES = 8 * HTB, NXCD = 8, WGM = 8;
__device__ __forceinline__ int lds_byte(int r, int c) { const int st = (r >> 4) * 2 + (c >> 5), rr = r & 15, cc = c & 31, ob = rr * 64 + cc * 2; return st * 1024 + (ob ^ (((ob >> 9) & 1) << 5)); }
__device__ __forceinline__ void stage_rc(int b, int& R, int& C) { const int st = b / 1024, sb = b % 1024, swz = sb ^ (((sb >> 9) & 1) << 5); R = (st >> 1) * 16 + swz / 64; C = (st & 1) * 32 + (swz % 64) / 2; }
__device__ __forceinline__ int perm32(int rho) { const int n = rho >> 4, i = rho & 15; return 8 * (i >> 2) + 4 * n + (i & 3); }
struct Unit { int pm, pn, idx; };
struct TileOrder {
    int nM, nN, nwg, G, c;
    __device__ __forceinline__ void init(int nM_, int nN_, int G_, int c_) { nM = nM_; nN = nN_; nwg = nM * nN; G = G_; c = c_; }
    __device__ __forceinline__ bool next(int i, Unit& u) const {
        const long L = (long)i * G + c; if (L >= nwg) return false;
        int wgid = (int)L; { const int q = nwg / NXCD, r = nwg % NXCD, xcd = wgid % NXCD, off = wgid / NXCD; wgid = (xcd < r ? xcd * (q + 1) : r * (q + 1) + (xcd - r) * q) + off; }
        const int nig = WGM * nN, gid = wgid / nig, fm = gid * WGM, gsz = (nM - fm) < WGM ? (nM - fm) : WGM;
        u.pm = fm + ((wgid % nig) % gsz); u.pn = (wgid % nig) / gsz; u.idx = i; return true;
    }
};
__device__ __forceinline__ unsigned cvt_pk_bf16(float lo, float hi) { return pk2(lo, hi); }

template <class Epi, class Sched, bool ALIGN_EPI>
__device__ __forceinline__ void gemm_phase(LAS unsigned char* lds, const bf16* Abase, int K, const Sched& S, const Epi& E, int tid) {
    const int wid = __builtin_amdgcn_readfirstlane(tid >> 6), lane = tid & 63, wr = wid >> 2, wc = wid & 3, fr = lane & 15, fq = lane >> 4;
    const int nt = K / BK;
    unsigned voffB[2];
#pragma unroll
    for (int i = 0; i < 2; ++i) { int R, C; stage_rc(tid * 16 + i * 8192, R, C); const int Rb = Epi::PERM ? ((R & ~31) + perm32(R & 31)) : R; voffB[i] = (unsigned)(Rb * K + C) * 2u; }
    const size_t kstep = (size_t)(BK * 2);
    const size_t hstep = (size_t)HALF * K * 2;
    const unsigned ldsw = (unsigned)wid * 1024u;
    const int aoff = lds_byte(wr * 64 + fr, fq * 8), boff = lds_byte(wc * 32 + fr, fq * 8);
#define PG8_SA(b, h) (((b) * 2 + (h)) * HTB)
#define PG8_SB(b, h) ((4 + (b) * 2 + (h)) * HTB)
#define PG8_STAGE(bufoff, gbase, voff) do { _Pragma("unroll") for (int _i = 0; _i < 2; ++_i) \
        __builtin_amdgcn_global_load_lds((const unsigned*)((const char*)(gbase) + (voff)[_i]), (LAS unsigned*)(lds + (bufoff) + ldsw + _i * 8192), 16, 0, 0); } while (0)
#define PG8_LDA(dst, b, h) do { _Pragma("unroll") for (int m = 0; m < 4; ++m) _Pragma("unroll") for (int k = 0; k < 2; ++k) dst[m][k] = *(const LAS bf16x8*)(lds + PG8_SA(b, h) + aoff + m * 2048 + k * 1024); } while (0)
#define PG8_LDB(dst, b, h) do { _Pragma("unroll") for (int n = 0; n < 2; ++n) _Pragma("unroll") for (int k = 0; k < 2; ++k) dst[n][k] = *(const LAS bf16x8*)(lds + PG8_SB(b, h) + boff + n * 2048 + k * 1024); } while (0)
#define PG8_MMA(ai, bj, At, Bt) do { __builtin_amdgcn_s_setprio(1); _Pragma("unroll") for (int m = 0; m < 4; ++m) _Pragma("unroll") for (int n = 0; n < 2; ++n) _Pragma("unroll") for (int k = 0; k < 2; ++k) \
        acc[ai][bj][m][n] = __builtin_amdgcn_mfma_f32_16x16x32_bf16(Bt[n][k], At[m][k], acc[ai][bj][m][n], 0, 0, 0); __builtin_amdgcn_s_setprio(0); } while (0)
#define PG8_WAIT_V(n) asm volatile("s_waitcnt vmcnt(" #n ")" ::: "memory")
#define PG8_WAIT_L(n) asm volatile("s_waitcnt lgkmcnt(" #n ")" ::: "memory")
#define PG8_BAR __builtin_amdgcn_s_barrier()
#define PG8_SCHED __builtin_amdgcn_sched_barrier(0)
#define PG8_SETV(v, u) do { _Pragma("unroll") for (int _i = 0; _i < 2; ++_i) { int _R, _C; stage_rc(tid * 16 + _i * 8192, _R, _C); _Pragma("unroll") for (int _h = 0; _h < 2; ++_h) v[_h][_i] = (unsigned)(S.arow(u, _h * HALF + _R) * K + _C) * 2u; } } while (0)
    Unit cur, nxt; int ui = 0;
    if (!S.next(0, cur)) return;
    f32x4 acc[2][2][4][2];
#pragma unroll
    for (int a = 0; a < 2; ++a)
#pragma unroll
        for (int b = 0; b < 2; ++b)
#pragma unroll
            for (int m = 0; m < 4; ++m)
#pragma unroll
                for (int n = 0; n < 2; ++n) acc[a][b][m][n] = (f32x4){0.f, 0.f, 0.f, 0.f};
    bf16x8 At[4][2], B0[2][2], B1[2][2];
    unsigned vC[2][2], vN[2][2];
    PG8_SETV(vC, cur);
    const char* cA = (const char*)Abase; const char* cB = S.bbase(cur);
    PG8_WAIT_L(0);
    PG8_STAGE(PG8_SB(0, 0), cB, voffB); PG8_STAGE(PG8_SB(0, 1), cB + hstep, voffB); PG8_STAGE(PG8_SA(0, 0), cA, vC[0]); PG8_STAGE(PG8_SA(0, 1), cA, vC[1]);
    if (wr == 1) PG8_BAR;
    PG8_WAIT_V(2); PG8_BAR;
    PG8_STAGE(PG8_SB(1, 0), cB + kstep, voffB); PG8_STAGE(PG8_SA(1, 0), cA + kstep, vC[0]); PG8_STAGE(PG8_SB(1, 1), cB + hstep + kstep, voffB);
    PG8_WAIT_V(6); PG8_BAR;
    for (;;) {
        const bool has_next = S.next(ui + 1, nxt);
        const char* nB = cB;
        if (has_next) { PG8_SETV(vN, nxt); nB = S.bbase(nxt); }
        else {
#pragma unroll
            for (int _h = 0; _h < 2; ++_h)
#pragma unroll
                for (int _i = 0; _i < 2; ++_i) vN[_h][_i] = vC[_h][_i];
        }
        PG8_WAIT_L(0);
#pragma unroll 1
        for (int t = 0; t < nt; t += 2) {
            const bool last = (t == nt - 2);
            const char* a1 = cA + (size_t)(t + 1) * kstep;
            const char* a2 = last ? cA : cA + (size_t)(t + 2) * kstep; const char* b2 = last ? nB : cB + (size_t)(t + 2) * kstep;
            const char* a3 = a2 + kstep; const char* b3 = b2 + kstep;
            PG8_LDB(B0, 0, 0); PG8_LDB(B1, 0, 1); PG8_SCHED; PG8_LDA(At, 0, 0); PG8_STAGE(PG8_SA(1, 1), a1, vC[1]);
            if (last) {
#pragma unroll
                for (int _h = 0; _h < 2; ++_h)
#pragma unroll
                    for (int _i = 0; _i < 2; ++_i) vC[_h][_i] = vN[_h][_i];
            }
            PG8_WAIT_V(8); PG8_WAIT_L(0); PG8_BAR; PG8_MMA(0, 0, At, B0); PG8_MMA(0, 1, At, B1); PG8_BAR; PG8_SCHED;
            PG8_LDA(At, 0, 1); PG8_STAGE(PG8_SB(0, 0), b2, voffB); PG8_STAGE(PG8_SB(0, 1), b2 + hstep, voffB); PG8_STAGE(PG8_SA(0, 0), a2, vC[0]);
            PG8_WAIT_V(8); PG8_WAIT_L(0); PG8_BAR; PG8_MMA(1, 0, At, B0); PG8_MMA(1, 1, At, B1); PG8_BAR; PG8_SCHED;
            PG8_LDB(B0, 1, 0); PG8_LDB(B1, 1, 1); PG8_SCHED; PG8_LDA(At, 1, 0); PG8_STAGE(PG8_SA(0, 1), a2, vC[1]);
            PG8_WAIT_V(8); PG8_WAIT_L(0); PG8_BAR; PG8_MMA(0, 0, At, B0); PG8_MMA(0, 1, At, B1); PG8_BAR; PG8_SCHED;
            PG8_LDA(At, 1, 1); PG8_STAGE(PG8_SB(1, 0), b3, voffB); PG8_STAGE(PG8_SB(1, 1), b3 + hstep, voffB); PG8_STAGE(PG8_SA(1, 0), a3, vC[0]);
            PG8_WAIT_V(8); PG8_WAIT_L(0); PG8_BAR; PG8_MMA(1, 0, At, B0); PG8_MMA(1, 1, At, B1); PG8_BAR; PG8_SCHED;
        }
        if constexpr (ALIGN_EPI) { if (wr == 0) PG8_BAR; }
        E(acc, cur, wr, wc, fr, fq);
        if (!has_next) break;
#pragma unroll
        for (int a = 0; a < 2; ++a)
#pragma unroll
            for (int b = 0; b < 2; ++b)
#pragma unroll
                for (int m = 0; m < 4; ++m)
#pragma unroll
                    for (int n = 0; n < 2; ++n) acc[a][b][m][n] = (f32x4){0.f, 0.f, 0.f, 0.f};
        cur = nxt; cB = nB; ++ui;
        if constexpr (ALIGN_EPI) { if (wr == 1) PG8_BAR; }
    }
    PG8_WAIT_V(0);
    if constexpr (!ALIGN_EPI) { if (wr == 0) PG8_BAR; }
    PG8_BAR;
#undef PG8_SA
#undef PG8_SB
#undef PG8_STAGE
#undef PG8_LDA
#undef PG8_LDB
#undef PG8_MMA
#undef PG8_WAIT_V
#undef PG8_WAIT_L
#undef PG8_BAR
#undef PG8_SCHED
#undef PG8_SETV
}

struct PlainSched {
    TileOrder T; const char* Bt; int K;
    __device__ __forceinline__ bool next(int i, Unit& u) const { return T.next(i, u); }
    __device__ __forceinline__ int arow(const Unit& u, int r) const { return u.pm * BM + r; }
    __device__ __forceinline__ const char* bbase(const Unit& u) const { return Bt + (size_t)u.pn * BM * K * 2; }
};
template <bool GATHER> struct MoeSched {
    TileOrder T; const char* Bt; int K, NE; const LAS int* tab; const LAS int* rows;
    __device__ __forceinline__ bool next(int i, Unit& u) const { return T.next(i, u); }
    __device__ __forceinline__ int expert(int pm) const { const int s = pm * BM; int e = 0;
#pragma unroll
        for (int k = 1; k < NEXP; ++k) if (s >= tab[k]) e = k;
        return e; }
    __device__ __forceinline__ int arow(const Unit& u, int r) const { return GATHER ? rows[u.idx * BM + r] : u.pm * BM + r; }
    __device__ __forceinline__ const char* bbase(const Unit& u) const { return Bt + ((size_t)expert(u.pm) * NE + (size_t)u.pn * BM) * K * 2; }
};
struct EpiStoreBf16 {
    static constexpr bool PERM = true;
    bf16* O; int ldc, col0; const float* bias;
    __device__ __forceinline__ void operator()(const f32x4 (&acc)[2][2][4][2], const Unit& u, int wr, int wc, int fr, int fq) const {
        const int row0 = u.pm * BM + wr * 64 + fr, ct0 = u.pn * BM + wc * 32 + 8 * fq;
        f32x4 bv[2][2];
#pragma unroll
        for (int bj = 0; bj < 2; ++bj)
#pragma unroll
            for (int n = 0; n < 2; ++n) bv[bj][n] = bias ? *(const f32x4*)(bias + ct0 + bj * HALF + 4 * n) : (f32x4){0.f, 0.f, 0.f, 0.f};
#pragma unroll
        for (int ai = 0; ai < 2; ++ai)
#pragma unroll
            for (int m = 0; m < 4; ++m) { bf16* rowp = O + (size_t)(row0 + ai * HALF + m * 16) * ldc + col0 + ct0;
#pragma unroll
                for (int bj = 0; bj < 2; ++bj) { const f32x4 v0 = acc[ai][bj][m][0] + bv[bj][0], v1 = acc[ai][bj][m][1] + bv[bj][1];
                    u32x4 w; w.x = cvt_pk_bf16(v0[0], v0[1]); w.y = cvt_pk_bf16(v0[2], v0[3]); w.z = cvt_pk_bf16(v1[0], v1[1]); w.w = cvt_pk_bf16(v1[2], v1[3]);
                    *(u32x4*)(rowp + bj * HALF) = w; } }
    }
};
template <int ACT>
struct EpiPairBf16 {
    static constexpr bool PERM = true;
    bf16* O; int ldc, col0; const float* bias; int nb;
    __device__ __forceinline__ void operator()(const f32x4 (&acc)[2][2][4][2], const Unit& u, int wr, int wc, int fr, int fq) const {
        const int row0 = u.pm * BM + wr * 64 + fr, ct0 = u.pn * HALF + wc * 32 + 8 * fq;
        f32x4 ba[2], bb[2];
#pragma unroll
        for (int n = 0; n < 2; ++n) { ba[n] = (ACT == 1) ? *(const f32x4*)(bias + ct0 + 4 * n) : (f32x4){0.f, 0.f, 0.f, 0.f}; bb[n] = (ACT == 1) ? *(const f32x4*)(bias + nb + ct0 + 4 * n) : (f32x4){0.f, 0.f, 0.f, 0.f}; }
#pragma unroll
        for (int ai = 0; ai < 2; ++ai)
#pragma unroll
            for (int m = 0; m < 4; ++m) {
                float o[8];
#pragma unroll
                for (int n = 0; n < 2; ++n)
#pragma unroll
                    for (int j = 0; j < 4; ++j) { const float a = acc[ai][0][m][n][j] + ba[n][j], b = acc[ai][1][m][n][j] + bb[n][j];
                        o[n * 4 + j] = (ACT == 0) ? (a / (1.f + __expf(-a))) * b : a / (1.f + __expf(-b)); }
                u32x4 w; w.x = cvt_pk_bf16(o[0], o[1]); w.y = cvt_pk_bf16(o[2], o[3]); w.z = cvt_pk_bf16(o[4], o[5]); w.w = cvt_pk_bf16(o[6], o[7]);
                *(u32x4*)(O + (size_t)(row0 + ai * HALF + m * 16) * ldc + col0 + ct0) = w; }
    }
};
struct EpiResidual {
    static constexpr bool PERM = false;
    float* XS; const float* g1;
    __device__ __forceinline__ void operator()(const f32x4 (&acc)[2][2][4][2], const Unit& u, int wr, int wc, int fr, int fq) const {
        const int row0 = u.pm * BM + wr * 64 + fr, ct0 = u.pn * BM + wc * 32 + 4 * fq;
#pragma unroll
        for (int ai = 0; ai < 2; ++ai)
#pragma unroll
            for (int m = 0; m < 4; ++m) { const int row = row0 + ai * HALF + m * 16; float* xp = XS + (size_t)row * D + ct0; const float* gp = g1 + (size_t)modrow(row) * 6144 + ct0;
#pragma unroll
                for (int bj = 0; bj < 2; ++bj)
#pragma unroll
                    for (int n = 0; n < 2; ++n) { const int o = bj * HALF + n * 16; const f32x4 g = *(const f32x4*)(gp + o); f32x4 x = *(const f32x4*)(xp + o); x += g * acc[ai][bj][m][n]; *(f32x4*)(xp + o) = x; }
                if (m & 1) asm volatile("" ::: "memory"); }
    }
};
}

template <class RowMap>
__device__ __forceinline__ void transpose_item(const float* W, int K, int N, bf16* WT, const RowMap& rowmap, LAS float* scr, int item, int lane) {
    const int nblk = (N + 31) / 32, kb = item / nblk, nb = item % nblk, k0 = 64 * kb, n0 = 32 * nb;
    const bool cok = n0 + (lane & 31) < N;
    float tv[32];
#pragma unroll
    for (int i = 0; i < 32; ++i) { const int kk = 2 * i + (lane >> 5); tv[i] = cok ? W[(size_t)(k0 + kk) * N + n0 + (lane & 31)] : 0.f; }
#pragma unroll
    for (int i = 0; i < 32; ++i) { const int kk = 2 * i + (lane >> 5); scr[kk * 33 + (lane & 31)] = tv[i]; }
    if (false) for (int i = 0; i < 32; ++i) { const int kk = 2 * i + (lane >> 5); scr[kk * 33 + (lane & 31)] = cok ? W[(size_t)(k0 + kk) * N + n0 + (lane & 31)] : 0.f; }
    asm volatile("s_waitcnt lgkmcnt(0)" ::: "memory");
    const int c = lane & 7;
#pragma unroll
    for (int j = 0; j < 4; ++j) { const int n = (lane >> 3) + 8 * j; const LAS float* sp = scr + (8 * c) * 33 + n;
        u32x4 o; o.x = pk2(sp[0 * 33], sp[1 * 33]); o.y = pk2(sp[2 * 33], sp[3 * 33]); o.z = pk2(sp[4 * 33], sp[5 * 33]); o.w = pk2(sp[6 * 33], sp[7 * 33]);
        const int dr = rowmap(n0 + n);
        if (dr >= 0) *(u32x4*)(WT + (size_t)dr * K + k0 + 8 * c) = o; }
    asm volatile("s_waitcnt lgkmcnt(0)" ::: "memory");
}


typedef short bf16x4s __attribute__((ext_vector_type(4)));
constexpr int S5_US = 264;
constexpr int S5_WS = 136;
__device__ __forceinline__ int s5_row0(int b, int c) { return c < 4 ? TL + b * CTXL + c * 64 : b * SEQ + (c - 4) * 64; }
template <int PASS>
__device__ __forceinline__ void s5_unit(const Frame& Fu, int l, int uidx) {
    Frame F = Fu; F.lane = fresh_lane(); F.tid = F.wave * 64 + F.lane;
    const int b = uidx / 36, c = uidx % 36, r0 = s5_row0(b, c);
    LAS bf16* U = (LAS bf16*)F.lds;
    __syncthreads();
    for (int i = F.tid; i < 64 * 32; i += NTHR) { const int row = i >> 5, c8 = i & 31; *(LAS u32x4*)(U + row * S5_US + c8 * 8) = *(const u32x4*)(F.COLS + (size_t)(r0 + row) * NCOL + 2048 + c8 * 8); }
    __syncthreads();
    LAS bf16* BuS = (LAS bf16*)(F.lds + 64 * S5_US * 2 + F.wave * (2 * 16 * S5_WS * 2)); LAS bf16* Hs = BuS + 16 * S5_WS;
    const int lane_ = F.lane;
    const int q = lane_ >> 4, c16 = lane_ & 15, p = lane_;
    const f32x2* AA = (const f32x2*)(F.ws + WS_S5AA); const bf16* BB = (const bf16*)(F.ws + WS_S5BB); const bf16* CM = (const bf16*)(F.ws + WS_S5CM);
    f32x2* HL = (f32x2*)(F.ws + WS_S5HL); const f32x2* HI = (const f32x2*)(F.ws + WS_S5HI);
    u32x2 yout[2][4];
    f32x2 aa_[2][2], h0_[2][2]; bf16x4s bb_[2][2][8]; pg8::bf16x8 cm_[2][4];
#pragma unroll
    for (int gi = 0; gi < 2; ++gi) {
        const int g = F.wave * 2 + gi;
        if (PASS == 1) {
#pragma unroll
            for (int ks = 0; ks < 4; ++ks) cm_[gi][ks] = *(const pg8::bf16x8*)(CM + ((size_t)(l * 16 + g) * 16 + c16) * 128 + 32 * ks + 8 * q);
        }
#pragma unroll
        for (int dir = 0; dir < 2; ++dir) {
            const int pidx = ((l * 2 + dir) * 16 + g);
            aa_[gi][dir] = AA[pidx * 64 + p];
#pragma unroll
            for (int rt = 0; rt < 8; ++rt) bb_[gi][dir][rt] = *(const bf16x4s*)(BB + ((size_t)pidx * 128 + 16 * rt + c16) * 16 + 4 * q);
            if (PASS == 1) h0_[gi][dir] = HI[((size_t)(b * 36 + c) * 32 + g * 2 + dir) * 64 + p];
        }
    }
#pragma unroll
    for (int gi = 0; gi < 2; ++gi) {
        const int g = F.wave * 2 + gi;
        f32x4 yacc[4];
#pragma unroll
        for (int rs = 0; rs < 4; ++rs) yacc[rs] = (f32x4){0.f, 0.f, 0.f, 0.f};
#pragma unroll
        for (int dir = 0; dir < 2; ++dir) {
            const float ar = aa_[gi][dir].x, ai = aa_[gi][dir].y;
            const size_t sidx = ((size_t)(b * 36 + c) * 32 + g * 2 + dir) * 64 + p;
            float hr = 0.f, hi = 0.f;
            if (PASS == 1) { hr = h0_[gi][dir].x; hi = h0_[gi][dir].y; }
#pragma unroll
            for (int sci = 0; sci < 4; ++sci) {
                const int rs = dir ? 3 - sci : sci;
                const bf16x4s bop = *(const LAS bf16x4s*)(U + (16 * rs + c16) * S5_US + g * 16 + 4 * q);
#pragma unroll
                for (int rt = 0; rt < 8; ++rt) {
                    const f32x4 a = __builtin_amdgcn_mfma_f32_16x16x16bf16_1k(bb_[gi][dir][rt], bop, (f32x4){0.f, 0.f, 0.f, 0.f}, 0, 0, 0);
                    u32x2 w; w.x = pk2(a[0], a[1]); w.y = pk2(a[2], a[3]);
                    *(LAS u32x2*)(BuS + c16 * S5_WS + 16 * rt + 4 * q) = w;
                }
                asm volatile("s_waitcnt lgkmcnt(0)" ::: "memory");
                unsigned bu[16];
#pragma unroll
                for (int st = 0; st < 16; ++st) bu[st] = *(const LAS unsigned*)(BuS + (dir ? 15 - st : st) * S5_WS + 2 * p);
#pragma unroll
                for (int st = 0; st < 16; ++st) {
                    const float bur = __uint_as_float(bu[st] << 16), bui = __uint_as_float(bu[st] & 0xffff0000u);
                    const float nr = fmaf(ar, hr, fmaf(-ai, hi, bur)), ni = fmaf(ar, hi, fmaf(ai, hr, bui)); hr = nr; hi = ni;
                    if (PASS == 1) *(LAS unsigned*)(Hs + (dir ? 15 - st : st) * S5_WS + 2 * p) = pk2(hr, hi);
                }
                if (PASS == 1) {
                    asm volatile("s_waitcnt lgkmcnt(0)" ::: "memory");
#pragma unroll
                    for (int ks = 0; ks < 4; ++ks) { const pg8::bf16x8 hf = *(const LAS pg8::bf16x8*)(Hs + c16 * S5_WS + 32 * ks + 8 * q);
                        yacc[rs] = __builtin_amdgcn_mfma_f32_16x16x32_bf16(cm_[gi][ks], hf, yacc[rs], 0, 0, 0); }
                }
                asm volatile("s_waitcnt lgkmcnt(0)" ::: "memory");
            }
            if (PASS == 0) HL[sidx] = (f32x2){hr, hi};
        }
        if (PASS == 1) {
            const f32x4 dsk = *(const f32x4*)(F.in[I_S5D] + l * 256 + g * 16 + 4 * q);
#pragma unroll
            for (int rs = 0; rs < 4; ++rs) {
                float u4[4]; { const u32x2 t = *(const LAS u32x2*)(U + (16 * rs + c16) * S5_US + g * 16 + 4 * q);
                    u4[0] = __uint_as_float(t.x << 16); u4[1] = __uint_as_float(t.x & 0xffff0000u); u4[2] = __uint_as_float(t.y << 16); u4[3] = __uint_as_float(t.y & 0xffff0000u); }
                float o[4];
#pragma unroll
                for (int j = 0; j < 4; ++j) o[j] = gelu_tanh(yacc[rs][j] + dsk[j] * u4[j]);
                yout[gi][rs].x = pk2(o[0], o[1]); yout[gi][rs].y = pk2(o[2], o[3]);
            }
        }
    }
    if (PASS == 1) {
        const bf16* GW = F.GLU_T + (size_t)l * 512 * 256;
        pg8::bf16x8 wv[8][2], wg[8][2];
#pragma unroll
        for (int ks = 0; ks < 8; ++ks)
#pragma unroll
            for (int nt = 0; nt < 2; ++nt) { wv[ks][nt] = *(const pg8::bf16x8*)(GW + (size_t)(32 * F.wave + 16 * nt + c16) * 256 + 32 * ks + 8 * q); wg[ks][nt] = *(const pg8::bf16x8*)(GW + (size_t)(256 + 32 * F.wave + 16 * nt + c16) * 256 + 32 * ks + 8 * q); }
        __syncthreads();
#pragma unroll
        for (int gi = 0; gi < 2; ++gi)
#pragma unroll
            for (int rs = 0; rs < 4; ++rs) *(LAS u32x2*)(U + (16 * rs + c16) * S5_US + (F.wave * 2 + gi) * 16 + 4 * q) = yout[gi][rs];
        __syncthreads();
        f32x4 av[2][4], ag[2][4];
#pragma unroll
        for (int nt = 0; nt < 2; ++nt)
#pragma unroll
            for (int rt = 0; rt < 4; ++rt) { av[nt][rt] = (f32x4){0.f, 0.f, 0.f, 0.f}; ag[nt][rt] = (f32x4){0.f, 0.f, 0.f, 0.f}; }
#pragma unroll
        for (int ks = 0; ks < 8; ++ks) {
            pg8::bf16x8 yf[4];
#pragma unroll
            for (int rt = 0; rt < 4; ++rt) yf[rt] = *(const LAS pg8::bf16x8*)(U + (16 * rt + c16) * S5_US + 32 * ks + 8 * q);
#pragma unroll
            for (int nt = 0; nt < 2; ++nt)
#pragma unroll
                for (int rt = 0; rt < 4; ++rt) { av[nt][rt] = __builtin_amdgcn_mfma_f32_16x16x32_bf16(wv[ks][nt], yf[rt], av[nt][rt], 0, 0, 0); ag[nt][rt] = __builtin_amdgcn_mfma_f32_16x16x32_bf16(wg[ks][nt], yf[rt], ag[nt][rt], 0, 0, 0); }
        }
        const float* gb = F.in[I_GLUB] + l * 512;
#pragma unroll
        for (int nt = 0; nt < 2; ++nt) { const int n0 = 32 * F.wave + 16 * nt + 4 * q; const f32x4 bv = *(const f32x4*)(gb + n0), bg = *(const f32x4*)(gb + 256 + n0);
#pragma unroll
            for (int rt = 0; rt < 4; ++rt) { float o[4];
#pragma unroll
                for (int j = 0; j < 4; ++j) o[j] = (av[nt][rt][j] + bv[j]) * sigmoidf_(ag[nt][rt][j] + bg[j]);
                u32x2 w; w.x = pk2(o[0], o[1]); w.y = pk2(o[2], o[3]);
                *(u32x2*)(F.MIX + (size_t)(r0 + 16 * rt + c16) * 1024 + 768 + n0) = w; } }
    }
}
__device__ __forceinline__ void s5_carry(const Frame& F, int l) {
    const int gt = F.bid * NTHR + F.tid, NG = F.G * NTHR;
    const f32x2* AA = (const f32x2*)(F.ws + WS_S5AA); const f32x2* HL = (const f32x2*)(F.ws + WS_S5HL); f32x2* HI = (f32x2*)(F.ws + WS_S5HI);
    for (int i = gt; i < NB * 32 * 64; i += NG) {
        const int p = i & 63, gd = (i >> 6) & 31, b = i >> 11, g = gd >> 1, dir = gd & 1;
        f32x2 a = AA[((l * 2 + dir) * 16 + g) * 64 + p];
#pragma unroll
        for (int k = 0; k < 6; ++k) a = (f32x2){a.x * a.x - a.y * a.y, 2.f * a.x * a.y};
        float hr = 0.f, hi = 0.f;
#pragma unroll 4
        for (int j = 0; j < 36; ++j) {
            const int c = dir ? (j < 4 ? 3 - j : 39 - j) : j;
            const size_t idx = ((size_t)(b * 36 + c) * 32 + gd) * 64 + p;
            HI[idx] = (f32x2){hr, hi};
            const f32x2 hl = HL[idx];
            const float nr = a.x * hr - a.y * hi + hl.x, ni = a.x * hi + a.y * hr + hl.y; hr = nr; hi = ni;
        }
    }
}


constexpr int SSD_LD = 136;
__device__ __forceinline__ int ssd_row0(int b, int cid) { return cid < 2 ? TL + b * CTXL + cid * 128 : b * SEQ + (cid - 2) * 128; }
__device__ __forceinline__ pg8::bf16x8 mk8(u32x2 lo, u32x2 hi) { u32x4 t; t.x = lo.x; t.y = lo.y; t.z = hi.x; t.w = hi.y; return __builtin_bit_cast(pg8::bf16x8, t); }
__device__ __forceinline__ void ssd_unit_a(const Frame& Fu, int l, int uidx) {
    Frame F = Fu; F.lane = fresh_lane(); F.tid = F.wave * 64 + F.lane;
    const int h = uidx & 7, uc = uidx >> 3, b = uc / 18, cid = uc % 18, g = h >> 2, r0 = ssd_row0(b, cid);
    LAS bf16* XT = (LAS bf16*)F.lds; LAS bf16* Bn = XT + 64 * SSD_LD; LAS bf16* BT = Bn + 128 * SSD_LD; LAS bf16* Cn = BT + 128 * SSD_LD;
    LAS float* cs0 = (LAS float*)(Cn + 128 * SSD_LD); LAS float* ecs1 = cs0 + 128; LAS float* dt0 = ecs1 + 128; LAS float* dt1 = dt0 + 128; LAS float* w0 = dt1 + 128; LAS float* w1 = w0 + 128;
    __syncthreads();
    if (F.wave == 0) {
        const float A0 = -expf(F.in[I_SALOG][l * 16 + h]), A1 = -expf(F.in[I_SALOG][l * 16 + 8 + h]);
        const float db0 = F.in[I_SDTB][l * 16 + h], db1 = F.in[I_SDTB][l * 16 + 8 + h];
        const int t0 = 2 * F.lane;
        const float d00 = softplusf_(F.DT[(size_t)(r0 + t0) * 16 + h] + db0), d01 = softplusf_(F.DT[(size_t)(r0 + t0 + 1) * 16 + h] + db0);
        const float d10 = softplusf_(F.DT[(size_t)(r0 + t0) * 16 + 8 + h] + db1), d11 = softplusf_(F.DT[(size_t)(r0 + t0 + 1) * 16 + 8 + h] + db1);
        const float a00 = d00 * A0, a01 = d01 * A0, a10 = d10 * A1, a11 = d11 * A1;
        float p0 = a00 + a01, p1 = a10 + a11;
#pragma unroll
        for (int o = 1; o < 64; o <<= 1) { const float u0 = __int_as_float(__builtin_amdgcn_ds_bpermute((F.lane - o) << 2, __float_as_int(p0))), u1 = __int_as_float(__builtin_amdgcn_ds_bpermute((F.lane - o) << 2, __float_as_int(p1)));
            if (F.lane >= o) { p0 += u0; p1 += u1; } }
        const float tot0 = __int_as_float(__builtin_amdgcn_readlane(__float_as_int(p0), 63)), tot1 = __int_as_float(__builtin_amdgcn_readlane(__float_as_int(p1), 63));
        const float c01 = p0, c00 = p0 - a01;
        const float e11 = p1 - a11, e10 = e11 - a10;
        cs0[t0] = c00; cs0[t0 + 1] = c01; ecs1[t0] = e10; ecs1[t0 + 1] = e11; dt0[t0] = d00; dt0[t0 + 1] = d01; dt1[t0] = d10; dt1[t0 + 1] = d11;
        w0[t0] = __expf(tot0 - c00) * d00; w0[t0 + 1] = __expf(tot0 - c01) * d01; w1[t0] = __expf(e10) * d10; w1[t0 + 1] = __expf(e11) * d11;
        float* ed = (float*)(F.ws + WS_EDEC) + ((size_t)(r0 + t0) * 8 + h) * 2;
        ed[0] = __expf(c00); ed[1] = __expf(tot1 - e10); ed[16] = __expf(c01); ed[17] = __expf(tot1 - e11);
        if (F.lane == 0) { float* tt = (float*)(F.ws + WS_TOT) + ((size_t)uc * 8 + h) * 2; tt[0] = tot0; tt[1] = tot1; }
    }
    {
        int lo, hi; seq_bounds(r0, lo, hi);
        const float* cw = F.in[I_SCW] + (size_t)l * 5 * 1024; const float* cb = F.in[I_SCB] + l * 1024;
        bf16* CC = (bf16*)(F.ws + WS_CC);
        for (int it = F.tid; it < 640; it += NTHR) {
            const int oct = it % 40, seg = it / 40, s0 = seg * 8;
            const int kind = oct < 8 ? 0 : (oct < 24 ? 1 : 2);
            const int n0 = kind == 0 ? oct * 8 : (kind == 1 ? (oct - 8) * 8 : (oct - 24) * 8);
            const int xch = kind == 0 ? h * 64 + n0 : (kind == 1 ? 512 + g * 128 + n0 : 768 + g * 128 + n0);
            u32x4 xr[12];
            const bool lo_ok = (r0 + s0 - 2) >= lo, hi_ok = (r0 + s0 + 9) < hi;
            const bf16* xp = F.COLS + (size_t)(r0 + s0) * NCOL + 512 + xch;
#pragma unroll
            for (int i = 2; i < 10; ++i) xr[i] = *(const u32x4*)(xp + (i - 2) * NCOL);
            xr[0] = xr[2]; xr[1] = xr[2]; xr[10] = xr[9]; xr[11] = xr[9];
            if (lo_ok) { xr[0] = *(const u32x4*)(xp - 2 * NCOL); xr[1] = *(const u32x4*)(xp - NCOL); } else { xr[0] = (u32x4){0u, 0u, 0u, 0u}; xr[1] = xr[0]; }
            if (hi_ok) { xr[10] = *(const u32x4*)(xp + 8 * NCOL); xr[11] = *(const u32x4*)(xp + 9 * NCOL); } else { xr[10] = (u32x4){0u, 0u, 0u, 0u}; xr[11] = xr[10]; }
#pragma unroll
            for (int hb = 0; hb < 2; ++hb) {
                float wv[5][4]; float val[8][4];
#pragma unroll
                for (int j = 0; j < 5; ++j) { const f32x4 t = *(const f32x4*)(cw + j * 1024 + xch + 4 * hb); wv[j][0] = t.x; wv[j][1] = t.y; wv[j][2] = t.z; wv[j][3] = t.w; }
                const f32x4 bias = *(const f32x4*)(cb + xch + 4 * hb);
#pragma unroll
                for (int i = 0; i < 8; ++i)
#pragma unroll
                    for (int k = 0; k < 4; ++k) val[i][k] = bias[k];
#pragma unroll
                for (int i = 0; i < 12; ++i) {
                    const unsigned wa = hb ? xr[i].z : xr[i].x, wb = hb ? xr[i].w : xr[i].y;
                    const float x4[4] = {__uint_as_float(wa << 16), __uint_as_float(wa & 0xffff0000u), __uint_as_float(wb << 16), __uint_as_float(wb & 0xffff0000u)};
#pragma unroll
                    for (int j = 0; j < 5; ++j) { const int o = i - j;
                        if (o >= 0 && o < 8) {
#pragma unroll
                            for (int k = 0; k < 4; ++k) val[o][k] = fmaf(wv[j][k], x4[k], val[o][k]); } }
                }
#pragma unroll
                for (int i = 0; i < 8; ++i)
#pragma unroll
                    for (int k = 0; k < 4; ++k) val[i][k] = siluf_(val[i][k]);
                if (kind != 0) {
                    LAS bf16* N = kind == 1 ? Bn : Cn;
#pragma unroll
                    for (int i = 0; i < 8; ++i) { u32x2 o; o.x = pk2(val[i][0], val[i][1]); o.y = pk2(val[i][2], val[i][3]); *(LAS u32x2*)(N + (s0 + i) * SSD_LD + n0 + 4 * hb) = o;
                        if (kind == 2 && (h & 3) == 0) *(u32x2*)(CC + (size_t)(r0 + s0 + i) * 256 + g * 128 + n0 + 4 * hb) = o; }
                }
                if (kind != 2) {
                    LAS bf16* T = kind == 0 ? XT : BT;
#pragma unroll
                    for (int k = 0; k < 4; ++k) { u32x4 o; o.x = pk2(val[0][k], val[1][k]); o.y = pk2(val[2][k], val[3][k]); o.z = pk2(val[4][k], val[5][k]); o.w = pk2(val[6][k], val[7][k]);
                        *(LAS u32x4*)(T + (n0 + 4 * hb + k) * SSD_LD + s0) = o; }
                }
            }
        }
    }
    __syncthreads();
    int lane_ = F.lane; asm volatile("" : "+v"(lane_));
    const int q = lane_ >> 4, c = lane_ & 15, w = F.wave;
    {
        pg8::bf16x8 cfr[4];
#pragma unroll
        for (int ks = 0; ks < 4; ++ks) cfr[ks] = *(const LAS pg8::bf16x8*)(Cn + (16 * w + c) * SSD_LD + 32 * ks + 8 * q);
        f32x4 gt[8];
#pragma unroll
        for (int a = 0; a < 8; ++a) { f32x4 acc = {0.f, 0.f, 0.f, 0.f};
#pragma unroll
            for (int ks = 0; ks < 4; ++ks) acc = __builtin_amdgcn_mfma_f32_16x16x32_bf16(*(const LAS pg8::bf16x8*)(Bn + (16 * a + c) * SSD_LD + 32 * ks + 8 * q), cfr[ks], acc, 0, 0, 0);
            gt[a] = acc; }
        const int t = 16 * w + c; const float cs0t = cs0[t], e1t = ecs1[t], Dh = F.in[I_SD][l * 8 + h];
#pragma unroll
        for (int a = 0; a < 8; ++a) {
            const f32x4 csv = *(const LAS f32x4*)&cs0[16 * a + 4 * q], d0v = *(const LAS f32x4*)&dt0[16 * a + 4 * q], e1v = *(const LAS f32x4*)&ecs1[16 * a + 4 * q], d1v = *(const LAS f32x4*)&dt1[16 * a + 4 * q];
#pragma unroll
            for (int j = 0; j < 4; ++j) { const int sidx = 16 * a + 4 * q + j;
                const float f0 = (sidx <= t) ? __expf(fminf(cs0t - csv[j], 0.f)) * d0v[j] : 0.f;
                const float f1 = (sidx >= t) ? __expf(fminf(e1v[j] - e1t, 0.f)) * d1v[j] : 0.f;
                gt[a][j] = gt[a][j] * (f0 + f1) + ((sidx == t) ? Dh : 0.f); }
        }
        pg8::bf16x8 mfr[4];
#pragma unroll
        for (int i = 0; i < 4; ++i) { u32x4 tq; tq.x = pk2(gt[2 * i][0], gt[2 * i][1]); tq.y = pk2(gt[2 * i][2], gt[2 * i][3]); tq.z = pk2(gt[2 * i + 1][0], gt[2 * i + 1][1]); tq.w = pk2(gt[2 * i + 1][2], gt[2 * i + 1][3]); mfr[i] = __builtin_bit_cast(pg8::bf16x8, tq); }
        bf16* YI = (bf16*)(F.ws + WS_YI);
#pragma unroll
        for (int pt = 0; pt < 4; ++pt) { f32x4 acc = {0.f, 0.f, 0.f, 0.f};
#pragma unroll
            for (int i = 0; i < 4; ++i) { const LAS bf16* xp = XT + (16 * pt + c) * SSD_LD + 32 * i + 4 * q;
                acc = __builtin_amdgcn_mfma_f32_16x16x32_bf16(mk8(*(const LAS u32x2*)xp, *(const LAS u32x2*)(xp + 16)), mfr[i], acc, 0, 0, 0); }
            u32x2 o; o.x = pk2(acc[0], acc[1]); o.y = pk2(acc[2], acc[3]);
            *(u32x2*)(YI + (((size_t)uidx * 32 + pt * 8 + w) * 64 + F.lane) * 4) = o; }
    }
    {
        pg8::bf16x8 btf[4];
#pragma unroll
        for (int ks = 0; ks < 4; ++ks) btf[ks] = *(const LAS pg8::bf16x8*)(BT + (16 * w + c) * SSD_LD + 32 * ks + 8 * q);
        bf16* SST = (bf16*)(F.ws + WS_SST);
#pragma unroll
        for (int d = 0; d < 2; ++d) { const LAS float* wd = d ? w1 : w0;
#pragma unroll
            for (int pt = 0; pt < 4; ++pt) { f32x4 acc = {0.f, 0.f, 0.f, 0.f};
#pragma unroll
                for (int ks = 0; ks < 4; ++ks) {
                    const u32x4 xq = *(const LAS u32x4*)(XT + (16 * pt + c) * SSD_LD + 32 * ks + 8 * q);
                    const f32x4 wa = *(const LAS f32x4*)&wd[32 * ks + 8 * q], wb = *(const LAS f32x4*)&wd[32 * ks + 8 * q + 4];
                    u32x4 sq;
                    sq.x = pk2(__uint_as_float(xq.x << 16) * wa[0], __uint_as_float(xq.x & 0xffff0000u) * wa[1]); sq.y = pk2(__uint_as_float(xq.y << 16) * wa[2], __uint_as_float(xq.y & 0xffff0000u) * wa[3]);
                    sq.z = pk2(__uint_as_float(xq.z << 16) * wb[0], __uint_as_float(xq.z & 0xffff0000u) * wb[1]); sq.w = pk2(__uint_as_float(xq.w << 16) * wb[2], __uint_as_float(xq.w & 0xffff0000u) * wb[3]);
                    acc = __builtin_amdgcn_mfma_f32_16x16x32_bf16(btf[ks], __builtin_bit_cast(pg8::bf16x8, sq), acc, 0, 0, 0); }
                u32x2 o; o.x = pk2(acc[0], acc[1]); o.y = pk2(acc[2], acc[3]);
                *(u32x2*)(SST + (((size_t)uidx * 2 + d) * 64 + 16 * pt + c) * 128 + 16 * w + 4 * q) = o; }
        }
    }
}
__device__ __forceinline__ void ssd_carry(const Frame& F) {
    const int gt = F.bid * NTHR + F.tid, NG = F.G * NTHR;
    const bf16* SST = (const bf16*)(F.ws + WS_SST); bf16* HIN = (bf16*)(F.ws + WS_HIN); const float* TOT = (const float*)(F.ws + WS_TOT);
    for (int i = gt; i < NB * 8 * 2 * 1024; i += NG) {
        const int e8 = i & 1023, d = (i >> 10) & 1, h = (i >> 11) & 7, b = i >> 14;
        float H[8];
#pragma unroll
        for (int k = 0; k < 8; ++k) H[k] = 0.f;
#pragma unroll 2
        for (int j = 0; j < 18; ++j) {
            const int cid = d ? (j < 2 ? 1 - j : 19 - j) : j;
            const size_t ui = (size_t)(b * 18 + cid) * 8 + h, off = ((ui * 2 + d) * 1024 + e8) * 8;
            u32x4 o; o.x = pk2(H[0], H[1]); o.y = pk2(H[2], H[3]); o.z = pk2(H[4], H[5]); o.w = pk2(H[6], H[7]);
            *(u32x4*)(HIN + off) = o;
            float sv[8]; ld8(SST + off, sv);
            const float dec = __expf(TOT[ui * 2 + d]);
#pragma unroll
            for (int k = 0; k < 8; ++k) H[k] = fmaf(H[k], dec, sv[k]);
        }
    }
}
__device__ __forceinline__ void ssd_unit_b(const Frame& F, int l, int u2) {
    const int uc = u2 >> 1, rh = u2 & 1, b = uc / 18, cid = uc % 18, r0 = ssd_row0(b, cid) + 64 * rh;
    const int lane_ = fresh_lane();
    const int q = lane_ >> 4, c = lane_ & 15, h = F.wave, g = h >> 2;
    const bf16* CC = (const bf16*)(F.ws + WS_CC); const bf16* HIN = (const bf16*)(F.ws + WS_HIN); const bf16* YI = (const bf16*)(F.ws + WS_YI); const float* ED = (const float*)(F.ws + WS_EDEC);
    LAS float* SSX = (LAS float*)F.lds;
    const size_t ui = (size_t)uc * 8 + h;
    pg8::bf16x8 hin[2][4][4], cfr[4][4];
#pragma unroll
    for (int d = 0; d < 2; ++d)
#pragma unroll
        for (int pt = 0; pt < 4; ++pt)
#pragma unroll
            for (int ks = 0; ks < 4; ++ks) hin[d][pt][ks] = *(const pg8::bf16x8*)(HIN + ((ui * 2 + d) * 64 + 16 * pt + c) * 128 + 32 * ks + 8 * q);
#pragma unroll
    for (int tt = 0; tt < 4; ++tt)
#pragma unroll
        for (int ks = 0; ks < 4; ++ks) cfr[tt][ks] = *(const pg8::bf16x8*)(CC + (size_t)(r0 + 16 * tt + c) * 256 + g * 128 + 32 * ks + 8 * q);
    float ssv[4];
#pragma unroll
    for (int tt = 0; tt < 4; ++tt) {
        const size_t row = (size_t)(r0 + 16 * tt + c); const int w = rh * 4 + tt;
        const f32x2 ed = *(const f32x2*)(ED + (row * 8 + h) * 2);
        u32x2 yiq[4], zq[4];
#pragma unroll
        for (int pt = 0; pt < 4; ++pt) { yiq[pt] = *(const u32x2*)(YI + ((ui * 32 + pt * 8 + w) * 64 + lane_) * 4); zq[pt] = *(const u32x2*)(F.COLS + row * NCOL + h * 64 + 16 * pt + 4 * q); }
        float ss = 0.f;
#pragma unroll
        for (int pt = 0; pt < 4; ++pt) {
            f32x4 a0 = {0.f, 0.f, 0.f, 0.f}, a1 = {0.f, 0.f, 0.f, 0.f};
#pragma unroll
            for (int ks = 0; ks < 4; ++ks) { a0 = __builtin_amdgcn_mfma_f32_16x16x32_bf16(hin[0][pt][ks], cfr[tt][ks], a0, 0, 0, 0); a1 = __builtin_amdgcn_mfma_f32_16x16x32_bf16(hin[1][pt][ks], cfr[tt][ks], a1, 0, 0, 0); }
            const float yi[4] = {__uint_as_float(yiq[pt].x << 16), __uint_as_float(yiq[pt].x & 0xffff0000u), __uint_as_float(yiq[pt].y << 16), __uint_as_float(yiq[pt].y & 0xffff0000u)};
            const float z[4] = {__uint_as_float(zq[pt].x << 16), __uint_as_float(zq[pt].x & 0xffff0000u), __uint_as_float(zq[pt].y << 16), __uint_as_float(zq[pt].y & 0xffff0000u)};
            float v[4];
#pragma unroll
            for (int j = 0; j < 4; ++j) { v[j] = (yi[j] + ed.x * a0[j] + ed.y * a1[j]) * siluf_(z[j]); ss = fmaf(v[j], v[j], ss); }
            u32x2 o; o.x = pk2(v[0], v[1]); o.y = pk2(v[2], v[3]);
            *(u32x2*)(F.MIX + row * 1024 + h * 64 + 16 * pt + 4 * q) = o;
        }
        ss += shx(ss, 16, lane_); ss += shx(ss, 32, lane_);
        ssv[tt] = ss;
    }
    __syncthreads();
    if (q == 0) {
#pragma unroll
        for (int tt = 0; tt < 4; ++tt) SSX[h * 64 + 16 * tt + c] = ssv[tt];
    }
    __syncthreads();
    const float* ng = F.in[I_SNG] + l * 512 + h * 64;
    u32x2 mv[4][4];
#pragma unroll
    for (int tt = 0; tt < 4; ++tt)
#pragma unroll
        for (int pt = 0; pt < 4; ++pt) mv[tt][pt] = *(const u32x2*)(F.MIX + (size_t)(r0 + 16 * tt + c) * 1024 + h * 64 + 16 * pt + 4 * q);
#pragma unroll
    for (int tt = 0; tt < 4; ++tt) {
        float tot = 0.f;
#pragma unroll
        for (int k = 0; k < 8; ++k) tot += SSX[k * 64 + 16 * tt + c];
        const float rstd = rsqrtf(tot * (1.f / 512.f) + EPS);
#pragma unroll
        for (int pt = 0; pt < 4; ++pt) { const f32x4 gn = *(const f32x4*)(ng + 16 * pt + 4 * q);
            u32x2 o; o.x = pk2(__uint_as_float(mv[tt][pt].x << 16) * rstd * gn[0], __uint_as_float(mv[tt][pt].x & 0xffff0000u) * rstd * gn[1]);
            o.y = pk2(__uint_as_float(mv[tt][pt].y << 16) * rstd * gn[2], __uint_as_float(mv[tt][pt].y & 0xffff0000u) * rstd * gn[3]);
            *(u32x2*)(F.MIX + (size_t)(r0 + 16 * tt + c) * 1024 + h * 64 + 16 * pt + 4 * q) = o; }
    }
}

__device__ __forceinline__ void stage_wt16(LAS float* WT, const float* src, int stride, int tid) {
    for (int i = tid; i < 4096; i += NTHR) { const int k = i >> 2, e4 = (i & 3) * 4; const f32x4 v = *(const f32x4*)(src + (size_t)k * stride + e4);
        WT[(e4 + 0) * 1024 + k] = v.x; WT[(e4 + 1) * 1024 + k] = v.y; WT[(e4 + 2) * 1024 + k] = v.z; WT[(e4 + 3) * 1024 + k] = v.w; }
}
__device__ __forceinline__ void dot16_acc(const LAS float* WT, const f32x4& h, int j, int lane, float (&acc)[16]) {
#pragma unroll
    for (int e4 = 0; e4 < 4; ++e4) {
#pragma unroll
        for (int e = 4 * e4; e < 4 * e4 + 4; ++e) { const f32x4 w = *(const LAS f32x4*)&WT[e * 1024 + 4 * lane + 256 * j]; acc[e] = fmaf(h.x, w.x, fmaf(h.y, w.y, fmaf(h.z, w.z, fmaf(h.w, w.w, acc[e])))); }
        asm volatile("" ::: "memory");
    }
}

__device__ __forceinline__ void phase_p0(const Frame& F0)  {
    Frame F = enter_phase(F0);
    {
        const size_t gt = (size_t)F.bid * NTHR + F.tid, NG = (size_t)F.G * NTHR;
        for (size_t i = gt; i < (size_t)TT * 256; i += NG) {
            const int r = (int)(i >> 8), c4 = (int)(i & 255) * 4;
            f32x4 v;
            if (r < TL) {
                v = *(const f32x4*)(F.in[I_X] + (size_t)r * D + c4);
                const int n = r & (SEQ - 1), rr = n >> 6, cc = n & 63, q = c4 >> 8, ii = c4 & 255;
                const float pos = (float)(q < 2 ? rr : cc);
                float pe[4];
#pragma unroll
                for (int k = 0; k < 4; ++k) {
                    const float invf = expf(-9.210340371976184f * (float)(ii + k) * (1.f / 256.f));
                    float s, c; sincos_red(pos * invf, s, c);
                    pe[k] = (q & 1) ? c : s;
                }
                v.x += pe[0]; v.y += pe[1]; v.z += pe[2]; v.w += pe[3];
            } else {
                v = *(const f32x4*)(F.in[I_CTX] + (size_t)(r - TL) * D + c4);
            }
            *(f32x4*)(F.XS + (size_t)r * D + c4) = v;
        }
    }
    {
        LAS float* scr = (LAS float*)F.lds + F.wave * (64 * 33);
        const int gw = F.bid * NWAVES + F.wave, NGW = F.G * NWAVES;
        constexpr int I_IN = 16 * 73, I_OUT = 16 * 32, I_PW = 4 * 8, I_GLU = 4 * 16, I_L = I_IN + I_OUT + I_PW + I_GLU;
        for (int it = gw; it < 2 * I_L; it += NGW) {
            const int l = it / I_L; int r = it % I_L;
            if (r < I_IN) { transpose_item(F.in[I_WIN] + (size_t)l * D * INC, D, INC, F.WIN_T + (size_t)l * NCOL * D, [](int n) { return n < 1536 ? n : (n < 1552 ? -1 : (n < INC ? n - 16 : -1)); }, scr, r, F.lane); continue; } r -= I_IN;
            if (r < I_OUT) { transpose_item(F.in[I_WOUT] + (size_t)l * D * D, D, D, F.WOUT_T + (size_t)l * D * D, [](int n) { return n; }, scr, r, F.lane); continue; } r -= I_OUT;
            if (r < I_PW) { transpose_item(F.in[I_CPW] + (size_t)l * 256 * 256, 256, 256, F.PW_T + (size_t)l * 256 * 256, [](int n) { return n; }, scr, r, F.lane); continue; } r -= I_PW;
            transpose_item(F.in[I_GLUW] + (size_t)l * 256 * 512, 256, 512, F.GLU_T + (size_t)l * 512 * 256, [](int n) { return n; }, scr, r, F.lane);
        }
        __syncthreads();
    }
    {
        const int gt = F.bid * NTHR + F.tid, NG = F.G * NTHR;
        f32x2* AA = (f32x2*)(F.ws + WS_S5AA); bf16* BB = (bf16*)(F.ws + WS_S5BB); bf16* CM = (bf16*)(F.ws + WS_S5CM);
        for (int i = gt; i < 2 * 2 * 16 * 64; i += NG) {
            const int p = i & 63, g = (i >> 6) & 15, dir = (i >> 10) & 1, l = i >> 11;
            const float step = expf(F.in[I_LSTEP][(l * 2 + dir) * 16 + g]);
            const float lr = F.in[I_LRE][i], li = F.in[I_LIM][i];
            const float mag = expf(lr * step); float sn, cs; sincos_red(li * step, sn, cs);
            const float ar = mag * cs, ai = mag * sn, inv_den = 1.f / (lr * lr + li * li);
            const float cr = ((ar - 1.f) * lr + ai * li) * inv_den, ci = (ai * lr - (ar - 1.f) * li) * inv_den;
            AA[i] = (f32x2){ar, ai};
            const float* bre = F.in[I_BRE] + ((size_t)(l * 16 + g) * 64 + p) * 16; const float* bim = F.in[I_BIM] + ((size_t)(l * 16 + g) * 64 + p) * 16;
            bf16* o = BB + ((size_t)((l * 2 + dir) * 16 + g) * 128 + 2 * p) * 16;
            for (int h = 0; h < 16; ++h) { const float br = bre[h], bi = bim[h]; o[h] = (bf16)f2bf(cr * br - ci * bi); o[16 + h] = (bf16)f2bf(cr * bi + ci * br); }
        }
        for (int i = gt; i < 2 * 16 * 16 * 64; i += NG) {
            *(unsigned*)(CM + (size_t)i * 2) = pk2(F.in[I_CRE][i], -F.in[I_CIM][i]);
        }
    }
    {
        LAS float* sc = (LAS float*)F.lds;
        LAS float* part = sc + 9 * 1024;
        __syncthreads();
        if (F.bid < 192) { for (int t = F.tid; t < 9 * 1024; t += NTHR) { const int r9 = t >> 10, k = t & 1023; sc[t] = siluf_(r9 < 8 ? F.in[I_C][r9 * D + k] : F.in[I_CCTX][k]); } }
        __syncthreads();
        for (int it = F.bid; it < 192; it += F.G) {
            const int l = it / 96, cb = it % 96, col = F.tid & 63, kg = F.tid >> 6;
            float acc[9];
#pragma unroll
            for (int r9 = 0; r9 < 9; ++r9) acc[r9] = 0.f;
            const float* wp = F.in[I_WADA] + ((size_t)l * D + kg * 128) * 6144 + cb * 64 + col;
#pragma unroll 4
            for (int kk = 0; kk < 128; ++kk) {
                const float w = wp[(size_t)kk * 6144];
#pragma unroll
                for (int r9 = 0; r9 < 9; ++r9) acc[r9] = fmaf(sc[r9 * 1024 + kg * 128 + kk], w, acc[r9]);
            }
#pragma unroll
            for (int r9 = 0; r9 < 9; ++r9) part[(kg * 9 + r9) * 64 + col] = acc[r9];
            __syncthreads();
            for (int t = F.tid; t < 9 * 64; t += NTHR) { const int r9 = t >> 6, cc = t & 63; float sm = F.in[I_BADA][l * 6144 + cb * 64 + cc];
#pragma unroll
                for (int k8 = 0; k8 < 8; ++k8) sm += part[(k8 * 9 + r9) * 64 + cc];
                F.MOD[((size_t)l * 9 + r9) * 6144 + cb * 64 + cc] = sm; }
            __syncthreads();
        }
    }
}
__device__ __forceinline__ LAS int* moe_tables(const Frame& F, int l) {
    LAS int* tab = (LAS int*)(F.lds + TAB_OFF);
    __syncthreads();
    if (F.tid == 0) {
        int bs = 0;
        for (int e = 0; e < NEXP; ++e) { const int c = (int)F.ctl[CW_CNT + l * 64 + e]; tab[e] = bs; tab[40 + e] = c; bs += ((c + 255) / 256) * 256; }
        tab[16] = bs;
    }
    __syncthreads();
    return tab;
}
template <int MODE>
__device__ __forceinline__ void phase_rowA(const Frame& F0, int l)  {
    constexpr bool HAS_MOE = MODE != 0, FINAL = MODE == 2;
    Frame F = enter_phase(F0);
    LAS int* tab = (LAS int*)(F.lds + TAB_OFF);
    if (HAS_MOE) tab = moe_tables(F, l - 1);
    LAS float* WDT = (LAS float*)F.lds;
    if (!FINAL) {
        __syncthreads();
        stage_wt16(WDT, F.in[I_WIN] + (size_t)l * D * INC + 1536, INC, F.tid);
        __syncthreads();
    }
    const int gw = F.bid * NWAVES + F.wave, NGW = F.G * NWAVES;
    const int RL = FINAL ? TL : TT;
    const int RPW = (RL + NGW - 1) / NGW, rbeg = gw * RPW, rend = (rbeg + RPW < RL) ? rbeg + RPW : RL;
    const float* gvec = FINAL ? F.in[I_GFIN] : F.in[I_GMIX] + l * D;
    LAS float* MV = (LAS float*)(F.lds + 65536);
    const int brow0 = F.bid * NWAVES * RPW, brow1 = (brow0 + NWAVES * RPW < RL ? brow0 + NWAVES * RPW : RL) - 1;
    const int mr_a = modrow(brow0 < RL ? brow0 : RL - 1), mr_b = modrow(brow1 > 0 ? brow1 : 0);
    for (int i = F.tid; i < 2 * 1024; i += NTHR) {
        const int sl = i >> 10, c = i & 1023, mr = sl ? mr_b : mr_a;
        const float gg = gvec[c];
        MV[sl * 3072 + c] = FINAL ? gg : gg * (F.MOD[((size_t)l * 9 + mr) * 6144 + 1024 + c] + 1.f);
        MV[sl * 3072 + 1024 + c] = FINAL ? 0.f : F.MOD[((size_t)l * 9 + mr) * 6144 + c];
        MV[sl * 3072 + 2048 + c] = HAS_MOE ? F.MOD[((size_t)(l - 1) * 9 + mr) * 6144 + 5120 + c] : 0.f;
    }
    __syncthreads();
    f32x4 vn[4]; u32x2 yan[4], ybn[4]; int4 tin = make_int4(0, 0, 0, 0), tin2 = tin; f32x2 twn = {0.f, 0.f}, twn2 = twn;
    if (rbeg < rend) {
#pragma unroll
        for (int j = 0; j < 4; ++j) vn[j] = *(const f32x4*)(F.XS + (size_t)rbeg * D + 4 * F.lane + 256 * j);
        if (HAS_MOE) {
            tin = *(const int4*)(F.TOKI + (size_t)rbeg * 4); twn = *(const f32x2*)(F.TOKW + (size_t)rbeg * 2);
            if (rbeg + 1 < rend) { tin2 = *(const int4*)(F.TOKI + (size_t)(rbeg + 1) * 4); twn2 = *(const f32x2*)(F.TOKW + (size_t)(rbeg + 1) * 2); }
            const size_t ra = (size_t)(tab[tin.x] + tin.y), rb = (size_t)(tab[tin.z] + tin.w);
#pragma unroll
            for (int j = 0; j < 4; ++j) { yan[j] = *(const u32x2*)(F.YDN + ra * D + 4 * F.lane + 256 * j); ybn[j] = *(const u32x2*)(F.YDN + rb * D + 4 * F.lane + 256 * j); }
        }
    }
#pragma unroll 1
    for (int r = rbeg; r < rend; ++r) {
        const int mr = modrow(r);
        f32x4 v[4]; u32x2 ya[4], yb[4];
#pragma unroll
        for (int j = 0; j < 4; ++j) { v[j] = vn[j]; ya[j] = yan[j]; yb[j] = ybn[j]; }
        const f32x2 tw = twn;
        if (r + 1 < rend) {
#pragma unroll
            for (int j = 0; j < 4; ++j) vn[j] = *(const f32x4*)(F.XS + (size_t)(r + 1) * D + 4 * F.lane + 256 * j);
            if (HAS_MOE) {
                tin = tin2; twn = twn2;
                if (r + 2 < rend) { tin2 = *(const int4*)(F.TOKI + (size_t)(r + 2) * 4); twn2 = *(const f32x2*)(F.TOKW + (size_t)(r + 2) * 2); }
                const size_t ra = (size_t)(tab[tin.x] + tin.y), rb = (size_t)(tab[tin.z] + tin.w);
#pragma unroll
                for (int j = 0; j < 4; ++j) { yan[j] = *(const u32x2*)(F.YDN + ra * D + 4 * F.lane + 256 * j); ybn[j] = *(const u32x2*)(F.YDN + rb * D + 4 * F.lane + 256 * j); }
            }
        }
        const LAS float* mv = MV + (mr == mr_a ? 0 : 3072);
        if (HAS_MOE) {
#pragma unroll
            for (int j = 0; j < 4; ++j) {
                const float yaf[4] = {__uint_as_float(ya[j].x << 16), __uint_as_float(ya[j].x & 0xffff0000u), __uint_as_float(ya[j].y << 16), __uint_as_float(ya[j].y & 0xffff0000u)};
                const float ybf[4] = {__uint_as_float(yb[j].x << 16), __uint_as_float(yb[j].x & 0xffff0000u), __uint_as_float(yb[j].y << 16), __uint_as_float(yb[j].y & 0xffff0000u)};
                const f32x4 g2q = *(const LAS f32x4*)&mv[2048 + 4 * F.lane + 256 * j];
#pragma unroll
                for (int e = 0; e < 4; ++e) v[j][e] += g2q[e] * (yaf[e] * tw.x + ybf[e] * tw.y);
            }
            if (!FINAL) {
#pragma unroll
                for (int j = 0; j < 4; ++j) *(f32x4*)(F.XS + (size_t)r * D + 4 * F.lane + 256 * j) = v[j];
            }
        }
        float ss = 0.f;
#pragma unroll
        for (int j = 0; j < 4; ++j) ss += (v[j].x * v[j].x + v[j].y * v[j].y) + (v[j].z * v[j].z + v[j].w * v[j].w);
        const float rstd = rsqrtf(wave_sum(ss, F.lane) * (1.f / D) + EPS);
        if (FINAL) {
#pragma unroll
            for (int j = 0; j < 4; ++j) { const int c = 4 * F.lane + 256 * j; *(f32x4*)(F.out + (size_t)r * D + c) = v[j] * rstd * *(const LAS f32x4*)&mv[c]; }
        } else {
            float dtp[16];
#pragma unroll
            for (int e = 0; e < 16; ++e) dtp[e] = 0.f;
#pragma unroll
            for (int j = 0; j < 4; ++j) {
                const int c = 4 * F.lane + 256 * j;
                const f32x4 h = v[j] * rstd * *(const LAS f32x4*)&mv[c] + *(const LAS f32x4*)&mv[1024 + c];
                u32x2 o; o.x = pk2(h.x, h.y); o.y = pk2(h.z, h.w);
                *(u32x2*)(F.HN + (size_t)r * D + c) = o;
                dot16_acc(WDT, h, j, F.lane, dtp);
            }
#pragma unroll
            for (int e = 0; e < 16; ++e) dtp[e] = wave_sum(dtp[e], F.lane);
            if (F.lane == 0) {
#pragma unroll
                for (int e4 = 0; e4 < 4; ++e4) *(f32x4*)(F.DT + (size_t)r * 16 + e4 * 4) = (f32x4){dtp[e4 * 4], dtp[e4 * 4 + 1], dtp[e4 * 4 + 2], dtp[e4 * 4 + 3]};
            }
        }
    }
}
__device__ __forceinline__ void phase_inproj(const Frame& F0, int l)  {
    Frame F = enter_phase(F0);
    pg8::PlainSched S; S.T.init(TT / 256, NCOL / 256, F.G, F.bid); S.Bt = (const char*)(F.WIN_T + (size_t)l * NCOL * D); S.K = D;
    pg8::EpiStoreBf16 E{F.COLS, NCOL, 0, nullptr};
    pg8::gemm_phase<pg8::EpiStoreBf16, pg8::PlainSched, true>(F.lds, F.HN, D, S, E, F.tid);
}
__device__ __forceinline__ void conf_unit(const Frame& Fu, int l, int uidx) {
    Frame F = Fu; F.lane = fresh_lane(); F.tid = F.wave * 64 + F.lane;
    const int r0 = uidx * 64;
    LAS bf16* XU = (LAS bf16*)F.lds;
    LAS float* WD = (LAS float*)(F.lds + 94 * 512);
    LAS bf16* CVL = (LAS bf16*)(F.lds + 94 * 512 + 31 * 1024);
    int lo, hi; seq_bounds(r0, lo, hi);
    __syncthreads();
    for (int i = F.tid; i < 94 * 64; i += NTHR) {
        const int rr = r0 - 15 + (i >> 6), c = (i & 63) * 4;
        u32x2 o = {0u, 0u};
        if (rr >= lo && rr < hi) { float a[4], g[4]; ld4(F.COLS + (size_t)rr * NCOL + 1536 + c, a); ld4(F.COLS + (size_t)rr * NCOL + 1792 + c, g);
            o.x = pk2(a[0] * sigmoidf_(g[0]), a[1] * sigmoidf_(g[1])); o.y = pk2(a[2] * sigmoidf_(g[2]), a[3] * sigmoidf_(g[3])); }
        *(LAS u32x2*)(XU + (i >> 6) * 256 + c) = o;
    }
    for (int i = F.tid; i < 31 * 64; i += NTHR) *(LAS f32x4*)&WD[i * 4] = *(const f32x4*)(F.in[I_CDW] + (size_t)l * 31 * 256 + i * 4);
    __syncthreads();
    const int ch = 4 * F.lane;
    const f32x4 db = *(const f32x4*)(F.in[I_CDB] + l * 256 + ch), lg = *(const f32x4*)(F.in[I_CLG] + l * 256 + ch), lb = *(const f32x4*)(F.in[I_CLB] + l * 256 + ch);
#pragma unroll 1
    for (int i = 0; i < 8; ++i) {
        const int lr = F.wave * 8 + i;
        f32x4 acc = db;
#pragma unroll
        for (int j = 0; j < 31; ++j) {
            const u32x2 xv = *(const LAS u32x2*)(XU + (lr + j) * 256 + ch); const f32x4 w = *(const LAS f32x4*)&WD[j * 256 + ch];
            acc.x = fmaf(w.x, __uint_as_float(xv.x << 16), acc.x); acc.y = fmaf(w.y, __uint_as_float(xv.x & 0xffff0000u), acc.y);
            acc.z = fmaf(w.z, __uint_as_float(xv.y << 16), acc.z); acc.w = fmaf(w.w, __uint_as_float(xv.y & 0xffff0000u), acc.w);
        }
        const float mean = wave_sum((acc.x + acc.y) + (acc.z + acc.w), F.lane) * (1.f / 256.f);
        const f32x4 d = acc - mean;
        const float var = wave_sum((d.x * d.x + d.y * d.y) + (d.z * d.z + d.w * d.w), F.lane) * (1.f / 256.f);
        const f32x4 y = d * rsqrtf(var + EPS) * lg + lb;
        u32x2 o; o.x = pk2(siluf_(y.x), siluf_(y.y)); o.y = pk2(siluf_(y.z), siluf_(y.w));
        *(LAS u32x2*)(CVL + lr * S5_US + ch) = o;
    }
    __syncthreads();
    {
        int lane_ = F.lane; asm volatile("" : "+v"(lane_));
        const int q = lane_ >> 4, c16 = lane_ & 15;
        const bf16* PW = F.PW_T + (size_t)l * 256 * 256;
        f32x4 acc[2][4];
#pragma unroll
        for (int nt = 0; nt < 2; ++nt)
#pragma unroll
            for (int rt = 0; rt < 4; ++rt) acc[nt][rt] = (f32x4){0.f, 0.f, 0.f, 0.f};
#pragma unroll 2
        for (int ks = 0; ks < 8; ++ks) {
            pg8::bf16x8 wf[2], vf[4];
#pragma unroll
            for (int nt = 0; nt < 2; ++nt) wf[nt] = *(const pg8::bf16x8*)(PW + (size_t)(32 * F.wave + 16 * nt + c16) * 256 + 32 * ks + 8 * q);
#pragma unroll
            for (int rt = 0; rt < 4; ++rt) vf[rt] = *(const LAS pg8::bf16x8*)(CVL + (16 * rt + c16) * S5_US + 32 * ks + 8 * q);
#pragma unroll
            for (int nt = 0; nt < 2; ++nt)
#pragma unroll
                for (int rt = 0; rt < 4; ++rt) acc[nt][rt] = __builtin_amdgcn_mfma_f32_16x16x32_bf16(wf[nt], vf[rt], acc[nt][rt], 0, 0, 0);
        }
        const float* pb = F.in[I_CPB] + l * 256;
#pragma unroll
        for (int nt = 0; nt < 2; ++nt) { const int n0 = 32 * F.wave + 16 * nt + 4 * q; const f32x4 bv = *(const f32x4*)(pb + n0);
#pragma unroll
            for (int rt = 0; rt < 4; ++rt) { u32x2 w; w.x = pk2(acc[nt][rt][0] + bv[0], acc[nt][rt][1] + bv[1]); w.y = pk2(acc[nt][rt][2] + bv[2], acc[nt][rt][3] + bv[3]);
                *(u32x2*)(F.MIX + (size_t)(r0 + 16 * rt + c16) * 1024 + 512 + n0) = w; } }
    }
}
__device__ __forceinline__ void expert_cvt_item(const Frame& F, int l, int it, LAS float* scr) {
    const int mtx = it >> 9, r = it & 511, e = mtx / 3, kind = mtx % 3;
    const size_t wofs = ((size_t)l * NEXP + e) * D * D;
    if (kind == 0) transpose_item(F.in[I_WG] + wofs, D, D, F.WGU_T + (size_t)e * 2048 * D, [](int n) { return (n >> 7) * 256 + (n & 127); }, scr, r, F.lane);
    else if (kind == 1) transpose_item(F.in[I_WU] + wofs, D, D, F.WGU_T + (size_t)e * 2048 * D, [](int n) { return (n >> 7) * 256 + 128 + (n & 127); }, scr, r, F.lane);
    else transpose_item(F.in[I_WD] + wofs, D, D, F.WD_T + (size_t)e * D * D, [](int n) { return n; }, scr, r, F.lane);
}
__device__ __forceinline__ void phase_scan(const Frame& F0, int l)  {
    Frame F = enter_phase(F0);
    const int RLc = (l == 0) ? TT : TL;
    const int NU = 1152 + 288 + RLc / 64;
    const int gw = F.bid * NWAVES + F.wave, NGW = F.G * NWAVES;
    LAS float* scr = (LAS float*)(F.lds + 131072 - NWAVES * 8448) + F.wave * (64 * 33);
    int cv = gw;
    for (int u = F.bid; u < NU; u += F.G) {
        if (u < 1152) ssd_unit_a(F, l, u);
        else if (u < 1152 + 288) s5_unit<0>(F, l, u - 1152);
        else conf_unit(F, l, u - 1440);
        __syncthreads();
#pragma unroll 1
        for (int k = 0; k < 2 && cv < 48 * 512; ++k, cv += NGW) expert_cvt_item(F, l, cv, scr);
    }
    __syncthreads();
    for (; cv < 48 * 512; cv += NGW) expert_cvt_item(F, l, cv, scr);
}
__device__ __forceinline__ void phase_carry(const Frame& F0, int l)  {
    Frame F = enter_phase(F0);
    s5_carry(F, l);
    ssd_carry(F);
}
__device__ __forceinline__ void phase_mix1(const Frame& F0, int l)  {
    Frame F = enter_phase(F0);
    const int RL = (l == 0) ? TT : TL;
    for (int u = F.bid; u < 288 + 288; u += F.G) {
        if (u < 288) { if (l == 0 || ((u >> 1) % 18) >= 2) ssd_unit_b(F, l, u); }
        else { const int v = u - 288; if (l == 0 || (v % 36) >= 4) s5_unit<1>(F, l, v); }
    }
}
__device__ __forceinline__ void phase_wout(const Frame& F0, int l)  {
    Frame F = enter_phase(F0);
    const int RL = (l == 0) ? TT : TL;
    pg8::PlainSched S; S.T.init(RL / 256, D / 256, F.G, F.bid); S.Bt = (const char*)(F.WOUT_T + (size_t)l * D * D); S.K = D;
    pg8::EpiResidual E{F.XS, F.MOD + (size_t)l * 9 * 6144 + 2048};
    pg8::gemm_phase<pg8::EpiResidual, pg8::PlainSched, true>(F.lds, F.MIX, D, S, E, F.tid);
}
__device__ __forceinline__ void phase_norm2(const Frame& F0, int l)  {
    Frame F = enter_phase(F0);
    const int RL = (l == 0) ? TT : TL;
    LAS float* RW = (LAS float*)F.lds;
    __syncthreads();
    stage_wt16(RW, F.in[I_RW], 16, F.tid);
    LAS int* lcnt = (LAS int*)(F.lds + 65536);
    if (F.tid < 32) lcnt[F.tid] = 0;
    __syncthreads();
    const int gw = F.bid * NWAVES + F.wave, NGW = F.G * NWAVES;
    const int RPW = (RL + NGW - 1) / NGW, rbeg = gw * RPW, rend = (rbeg + RPW < RL) ? rbeg + RPW : RL;
    const float* gvec = F.in[I_GFFN] + l * D;
    f32x4 gv[4], shv[4], scv[4], vn[4]; int cur_mr = -1;
#pragma unroll
    for (int j = 0; j < 4; ++j) gv[j] = *(const f32x4*)(gvec + 4 * F.lane + 256 * j);
    if (rbeg < rend) {
#pragma unroll
        for (int j = 0; j < 4; ++j) vn[j] = *(const f32x4*)(F.XS + (size_t)rbeg * D + 4 * F.lane + 256 * j);
    }
#pragma unroll 1
    for (int r = rbeg; r < rend; ++r) {
        const int mr = modrow(r);
        f32x4 v[4]; float ss = 0.f;
#pragma unroll
        for (int j = 0; j < 4; ++j) { v[j] = vn[j]; ss += (v[j].x * v[j].x + v[j].y * v[j].y) + (v[j].z * v[j].z + v[j].w * v[j].w); }
        if (r + 1 < rend) {
#pragma unroll
            for (int j = 0; j < 4; ++j) vn[j] = *(const f32x4*)(F.XS + (size_t)(r + 1) * D + 4 * F.lane + 256 * j);
        }
        if (mr != cur_mr) { cur_mr = mr;
#pragma unroll
            for (int j = 0; j < 4; ++j) { const int c = 4 * F.lane + 256 * j; shv[j] = *(const f32x4*)(F.MOD + ((size_t)l * 9 + mr) * 6144 + 3072 + c); scv[j] = *(const f32x4*)(F.MOD + ((size_t)l * 9 + mr) * 6144 + 4096 + c); } }
        const float rstd = rsqrtf(wave_sum(ss, F.lane) * (1.f / D) + EPS);
        float lg[16];
#pragma unroll
        for (int e = 0; e < 16; ++e) lg[e] = 0.f;
#pragma unroll
        for (int j = 0; j < 4; ++j) {
            const int c = 4 * F.lane + 256 * j;
            const f32x4 h = v[j] * rstd * gv[j] * (scv[j] + 1.f) + shv[j];
            u32x2 o; o.x = pk2(h.x, h.y); o.y = pk2(h.z, h.w);
            *(u32x2*)(F.HN + (size_t)r * D + c) = o;
            dot16_acc(RW, h, j, F.lane, lg);
        }
        float mx = -3.0e38f;
#pragma unroll
        for (int e = 0; e < 16; ++e) { lg[e] = wave_sum(lg[e], F.lane) + F.in[I_RB][e]; mx = fmaxf(mx, lg[e]); }
        float den = 0.f;
#pragma unroll
        for (int e = 0; e < 16; ++e) { lg[e] = expf(lg[e] - mx); den += lg[e]; }
        const float inv = 1.f / den;
#pragma unroll
        for (int e = 0; e < 16; ++e) lg[e] *= inv;
        float gs[4];
#pragma unroll
        for (int gI = 0; gI < 4; ++gI) {
            const float p0 = lg[gI * 4], p1 = lg[gI * 4 + 1], p2 = lg[gI * 4 + 2], p3 = lg[gI * 4 + 3];
            const float h01 = fmaxf(p0, p1), l01 = fminf(p0, p1), h23 = fmaxf(p2, p3), l23 = fminf(p2, p3);
            gs[gI] = fmaxf(h01, h23) + fmaxf(fminf(h01, h23), fmaxf(l01, l23));
        }
        int best = 0; float bsv = gs[0];
#pragma unroll
        for (int gI = 1; gI < 4; ++gI) if (gs[gI] > bsv) { bsv = gs[gI]; best = gI; }
        float q[4];
#pragma unroll
        for (int i = 0; i < 4; ++i) q[i] = best == 0 ? lg[i] : (best == 1 ? lg[4 + i] : (best == 2 ? lg[8 + i] : lg[12 + i]));
        int i0 = 0; float v0 = q[0];
#pragma unroll
        for (int i = 1; i < 4; ++i) if (q[i] > v0) { v0 = q[i]; i0 = i; }
        int i1 = -1; float v1 = -1.f;
#pragma unroll
        for (int i = 0; i < 4; ++i) if (i != i0 && q[i] > v1) { v1 = q[i]; i1 = i; }
        const float ginv = 1.f / (v0 + v1);
        if (F.lane == 0) {
            const int e0 = best * 4 + i0, e1 = best * 4 + i1;
            const int p0 = __hip_atomic_fetch_add(&lcnt[e0], 1, __ATOMIC_RELAXED, __HIP_MEMORY_SCOPE_WORKGROUP), p1 = __hip_atomic_fetch_add(&lcnt[e1], 1, __ATOMIC_RELAXED, __HIP_MEMORY_SCOPE_WORKGROUP);
            *(int4*)(F.TOKI + (size_t)r * 4) = make_int4(e0, p0, e1, p1);
            *(f32x2*)(F.TOKW + (size_t)r * 2) = (f32x2){v0 * ginv, v1 * ginv};
        }
    }
    __syncthreads();
    if (F.tid < 16) lcnt[16 + F.tid] = (int)atomicAdd(&F.ctl[CW_CNT + l * 64 + F.tid], (unsigned)lcnt[F.tid]);
    __syncthreads();
    if (F.lane == 0) {
        for (int r = rbeg; r < rend; ++r) {
            int4 ti = *(const int4*)(F.TOKI + (size_t)r * 4);
            ti.y += lcnt[16 + ti.x]; ti.w += lcnt[16 + ti.z];
            *(int4*)(F.TOKI + (size_t)r * 4) = ti;
            F.LIST[(size_t)ti.x * TT + ti.y] = r; F.LIST[(size_t)ti.z * TT + ti.w] = r;
        }
    }
}
__device__ __forceinline__ void phase_gateup(const Frame& F0, int l)  {
    Frame F = enter_phase(F0);
    LAS int* tab = moe_tables(F, l);
    LAS int* rows = (LAS int*)(F.lds + ROWS_OFF);
    pg8::MoeSched<true> S; S.T.init(tab[16] / 256, 8, F.G, F.bid); S.Bt = (const char*)F.WGU_T; S.K = D; S.NE = 2048; S.tab = tab; S.rows = rows;
    {
        pg8::Unit u;
        for (int i = 0; i < 15 && S.next(i, u); ++i) {
            if (F.tid < 256) { const int sr = u.pm * 256 + F.tid, e = S.expert(u.pm), pos = sr - tab[e], cnt = tab[40 + e];
                rows[i * 256 + F.tid] = F.LIST[(size_t)e * TT + (pos < cnt ? pos : 0)]; }
        }
        __syncthreads();
    }
    pg8::EpiPairBf16<0> E{F.HMID, 1024, 0, nullptr, 0};
    pg8::gemm_phase<pg8::EpiPairBf16<0>, pg8::MoeSched<true>, true>(F.lds, F.HN, D, S, E, F.tid);
}
__device__ __forceinline__ void phase_down(const Frame& F0, int l)  {
    Frame F = enter_phase(F0);
    LAS int* tab = moe_tables(F, l);
    pg8::MoeSched<false> S; S.T.init(tab[16] / 256, 4, F.G, F.bid); S.Bt = (const char*)F.WD_T; S.K = D; S.NE = 1024; S.tab = tab; S.rows = nullptr;
    pg8::EpiStoreBf16 E{F.YDN, 1024, 0, nullptr};
    pg8::gemm_phase<pg8::EpiStoreBf16, pg8::MoeSched<false>, true>(F.lds, F.HMID, D, S, E, F.tid);
}

constexpr int PH_PER_LAYER = 9, N_PHASES = 1 + DEPTH * PH_PER_LAYER + 1;

__global__ void __launch_bounds__(NTHR, 2) fwd_kernel(Args args) {
    extern __shared__ __attribute__((aligned(16))) unsigned char lds_raw[];
    Frame F;
    F.lds = (LAS unsigned char*)lds_raw;
    F.tid = threadIdx.x; F.lane = F.tid & 63; F.wave = __builtin_amdgcn_readfirstlane(F.tid >> 6);
    F.G = gridDim.x; F.bid = blockIdx.x;
    F.in = (const CAS cfp_t*)__builtin_amdgcn_kernarg_segment_ptr(); F.out = args.out; F.ws = args.ws;
    frame_ptrs(F, args.ws);
    volatile LAS unsigned* MISC = (volatile LAS unsigned*)(F.lds + MISC_OFF);
    if (F.tid < 32) MISC[F.tid] = 0u;
    __syncthreads();
    const int lo = args.ph_lo, hi = args.ph_hi;
    const bool multi = (hi - lo) > 1;
    XcdBarrier bar; bar.bar = F.ctl + CW_BAR; bar.x = 0; bar.st = MISC + 8;
    if (multi) bar = xcd_barrier_post(F.ctl + CW_BAR, MISC + 8);
#define IN(k) (lo <= (k) && (k) < hi)
#define SEAM(k) do { if (IN(k) && IN((k) + 1)) { XcdBarrier bb_ = bar; asm volatile("" : "+s"(bb_.bar)); xcd_barrier(bb_); } } while (0)
    if (IN(0)) phase_p0(F);
    SEAM(0);
    for (int l = 0; l < DEPTH; ++l) {
        const int pb = 1 + l * PH_PER_LAYER;
        if (IN(pb + 0)) { if (l == 0) phase_rowA<0>(F, l); else phase_rowA<1>(F, l); }
        SEAM(pb + 0);
        if (IN(pb + 1)) phase_inproj(F, l);
        SEAM(pb + 1);
        if (IN(pb + 2)) phase_scan(F, l);
        SEAM(pb + 2);
        if (IN(pb + 3)) phase_carry(F, l);
        SEAM(pb + 3);
        if (IN(pb + 4)) phase_mix1(F, l);
        SEAM(pb + 4);
        if (IN(pb + 5)) phase_wout(F, l);
        SEAM(pb + 5);
        if (IN(pb + 6)) phase_norm2(F, l);
        SEAM(pb + 6);
        if (IN(pb + 7)) phase_gateup(F, l);
        SEAM(pb + 7);
        if (IN(pb + 8)) phase_down(F, l);
        SEAM(pb + 8);
    }
    if (IN(N_PHASES - 1)) phase_rowA<2>(F, DEPTH);
#undef IN
#undef SEAM
}

extern "C" void kernel_launch(void* const* d_in, const int* in_sizes, int n_in, void* d_out, int out_size, void* d_ws, size_t ws_size, hipStream_t stream) {
    static int grid = 0;
    if (grid == 0) {
        if (n_in != N_IN || out_size != TL * D || ws_size < WS_END) { fprintf(stderr, "kernel_launch: unexpected shapes (n_in %d out %d ws %zu)\n", n_in, out_size, ws_size); grid = -1; return; }
        int dev = 0, cus = 0, per_cu = 0;
        if (hipGetDevice(&dev) != hipSuccess || hipDeviceGetAttribute(&cus, hipDeviceAttributeMultiprocessorCount, dev) != hipSuccess) { grid = -1; return; }
        if (hipFuncSetAttribute((const void*)fwd_kernel, hipFuncAttributeMaxDynamicSharedMemorySize, LDS_BYTES) != hipSuccess) { fprintf(stderr, "kernel_launch: hipFuncSetAttribute failed\n"); grid = -1; return; }
        if (hipOccupancyMaxActiveBlocksPerMultiprocessor(&per_cu, (const void*)fwd_kernel, NTHR, LDS_BYTES) != hipSuccess || per_cu < 1) { fprintf(stderr, "kernel_launch: occupancy query says %d\n", per_cu); }
        (void)hipGetLastError();
        grid = cus;
    }
    if (grid < 0) return;
    if (hipMemsetAsync((char*)d_ws + WS_CTL, 0, CTL_ZERO_BYTES, stream) != hipSuccess) return;
    Args a{};
    for (int i = 0; i < N_IN; ++i) a.in[i] = (const float*)d_in[i];
    a.out = (float*)d_out; a.ws = (unsigned char*)d_ws;
#if MK_ONE_LAUNCH
    a.ph_lo = 0; a.ph_hi = N_PHASES;
    hipLaunchKernelGGL(fwd_kernel, dim3(grid), dim3(NTHR), LDS_BYTES, stream, a);
#else
    for (int p = 0; p < N_PHASES; ++p) { a.ph_lo = p; a.ph_hi = p + 1; hipLaunchKernelGGL(fwd_kernel, dim3(grid), dim3(NTHR), LDS_BYTES, stream, a); }
#endif
}
```

```cpp
#include <hip/hip_runtime.h>
#include <cstdio>
#include <cstdint>

#ifndef MK_ONE_LAUNCH
#define MK_ONE_LAUNCH 1
#endif

#define GAS __attribute__((address_space(1)))
#define LAS __attribute__((address_space(3)))
#define CAS __attribute__((address_space(4)))
typedef const float* cfp_t;
typedef unsigned short bf16;
typedef float f32x4 __attribute__((ext_vector_type(4)));
typedef float f32x2 __attribute__((ext_vector_type(2)));
typedef unsigned u32x4 __attribute__((ext_vector_type(4)));
typedef unsigned u32x2 __attribute__((ext_vector_type(2)));

constexpr int D = 1024, NB = 8, SEQ = 2048, CTXL = 256, DEPTH = 2;
constexpr int TL = NB * SEQ, TC = NB * CTXL, TT = TL + TC;
constexpr int INC = 2320;
constexpr int NCOL = 2304;
constexpr int VSEQ = CTXL + SEQ;
constexpr int NEXP = 16;
constexpr float EPS = 1e-6f;

enum { I_X = 0, I_C, I_CTX, I_CCTX, I_WADA, I_BADA, I_GMIX, I_WIN, I_SCW, I_SCB, I_SDTB, I_SALOG, I_SD, I_SNG,
       I_CDW, I_CDB, I_CLG, I_CLB, I_CPW, I_CPB, I_LRE, I_LIM, I_LSTEP, I_BRE, I_BIM, I_CRE, I_CIM, I_S5D, I_GLUW, I_GLUB,
       I_WOUT, I_GFFN, I_RW, I_RB, I_WG, I_WU, I_WD, I_GFIN, N_IN };

constexpr size_t MiB = 1u << 20;
constexpr size_t WS_CTL = 0, CTL_ZERO_BYTES = 64 * 1024;
constexpr size_t WS_MOD = 1 * MiB;
constexpr size_t WS_MODP = 2 * MiB;
constexpr size_t WS_DT = 6 * MiB;
constexpr size_t WS_S5AA = 5 * MiB + 512 * 1024;
constexpr size_t WS_S5BB = WS_S5AA + 32 * 1024;
constexpr size_t WS_S5CM = WS_S5BB + 256 * 1024;
constexpr size_t WS_TOKI = 7 * MiB + 512 * 1024;
constexpr size_t WS_TOKW = WS_TOKI + (size_t)TT * 16;
constexpr size_t WS_XS = 8 * MiB;
constexpr size_t WS_HN = 80 * MiB;
constexpr size_t WS_COLS = 116 * MiB;
constexpr size_t WS_XBCC = 197 * MiB;
constexpr size_t WS_CC = 197 * MiB;
constexpr size_t WS_YI = 207 * MiB;
constexpr size_t WS_SST = 226 * MiB;
constexpr size_t WS_HIN = 264 * MiB;
constexpr size_t WS_EDEC = 302 * MiB;
constexpr size_t WS_TOT = 304 * MiB;
constexpr size_t WS_YSSD = 233 * MiB;
constexpr size_t WS_MIX = 305 * MiB;
constexpr size_t WS_YS5 = 341 * MiB;
constexpr size_t WS_S5HL = 341 * MiB;
constexpr size_t WS_S5HI = 346 * MiB;
constexpr size_t WS_CU = 377 * MiB;
constexpr size_t WS_CV = 395 * MiB;
constexpr size_t WS_LIST = 413 * MiB;
constexpr size_t WS_WIN_T = 415 * MiB;
constexpr size_t WS_WOUT_T = 424 * MiB;
constexpr size_t WS_PW_T = 428 * MiB;
constexpr size_t WS_GLU_T = 428 * MiB + 512 * 1024;
constexpr size_t WS_WGU_T = 429 * MiB;
constexpr size_t WS_WD_T = 493 * MiB;
constexpr size_t WS_END = 525 * MiB;
constexpr int MOE_ROWS = 2 * TT + NEXP * 256;
constexpr size_t WS_HMID = WS_COLS;
constexpr size_t WS_YDN = WS_XBCC;
constexpr size_t WS_YG = WS_CU;
static_assert(WS_HMID + (size_t)MOE_ROWS * 1024 * 2 <= WS_XBCC, "HMID overlay");
static_assert(WS_YDN + (size_t)MOE_ROWS * 1024 * 2 <= WS_MIX, "YDN overlay");
constexpr int CW_CNT = 64;
constexpr int CW_BAR = 1024;

constexpr int NWAVES = 8, NTHR = 512;
constexpr int LDS_BYTES = 147456;
constexpr int MISC_OFF = 131072 + 320;
constexpr int TAB_OFF = 131072 + 512, ROWS_OFF = TAB_OFF + 256;

__device__ __forceinline__ float bf2f(bf16 v) { return __uint_as_float((unsigned)v << 16); }
__device__ __forceinline__ unsigned f2bf(float f) { unsigned u = __float_as_uint(f); return (u + 0x7fffu + ((u >> 16) & 1u)) >> 16; }
typedef __bf16 bf16x2_t __attribute__((ext_vector_type(2)));
__device__ __forceinline__ unsigned pk2(float lo, float hi) { f32x2 v = {lo, hi}; return __builtin_bit_cast(unsigned, __builtin_convertvector(v, bf16x2_t)); }
__device__ __forceinline__ float shx(float v, int m, int lane) { return __int_as_float(__builtin_amdgcn_ds_bpermute((lane ^ m) << 2, __float_as_int(v))); }
__device__ __forceinline__ float wave_sum(float v, int lane) {
#pragma unroll
    for (int o = 1; o < 64; o <<= 1) v += shx(v, o, lane);
    return v;
}
__device__ __forceinline__ float sigmoidf_(float x) { return 1.f / (1.f + __expf(-x)); }
__device__ __forceinline__ float siluf_(float x) { return x / (1.f + __expf(-x)); }
__device__ __forceinline__ float softplusf_(float x) { return fmaxf(x, 0.f) + log1pf(__expf(-fabsf(x))); }
__device__ __forceinline__ float gelu_tanh(float x) { const float u = 0.7978845608028654f * (x + 0.044715f * x * x * x); return 0.5f * x * (1.f + tanhf(u)); }
__device__ __forceinline__ void sincos_red(float x, float& s, float& c) {
    const float k = rintf(x * 0.15915494309189535f);
    float r = fmaf(-k, 6.2831854820251465f, x); r = fmaf(-k, -1.7484555e-7f, r);
    s = __sinf(r); c = __cosf(r);
}
__device__ __forceinline__ int opaque_v(int v) { asm volatile("" : "+v"(v)); return v; }
__device__ __forceinline__ int modrow(int r) { return r < TL ? (r >> 11) : 8; }
__device__ __forceinline__ void seq_bounds(int r, int& lo, int& hi) {
    if (r < TL) { lo = r & ~(SEQ - 1); hi = lo + SEQ; } else { lo = TL + ((r - TL) & ~(CTXL - 1)); hi = lo + CTXL; }
}
__device__ __forceinline__ int vrow(int b, int dir, int s) {
    if (s < CTXL) return TL + b * CTXL + (dir ? CTXL - 1 - s : s);
    const int t = s - CTXL; return b * SEQ + (dir ? SEQ - 1 - t : t);
}

#define XB_TMO      128
#define XB_XCNT(j)  (256  + 64 * (j))
#define XB_XSUB(j)  (1280 + 64 * (j))
#define XB_XGEN(j)  (2304 + 64 * (j))
#define XB_TOP      3328
#define XB_TOPGEN   3392
#define XCD_BAR_WORDS 3456
#define XB_SPIN_CAP (1u << 18)
__device__ __forceinline__ unsigned xb_ld(unsigned* p)              { return __hip_atomic_load(p, __ATOMIC_RELAXED, __HIP_MEMORY_SCOPE_AGENT); }
__device__ __forceinline__ unsigned xb_add(unsigned* p, unsigned v) { return __hip_atomic_fetch_add(p, v, __ATOMIC_RELAXED, __HIP_MEMORY_SCOPE_AGENT); }
__device__ __forceinline__ unsigned xb_xcc_id() { return (unsigned)__builtin_amdgcn_s_getreg((3 << 11) | 20) & 0xFu; }
#define XB_SPIN(cond, bar) do { unsigned _sp = 0; while (cond) { __builtin_amdgcn_s_sleep(1); \
    if ((++_sp & 255u) == 0u) { if (xb_ld(&(bar)[XB_TMO])) break; if (_sp > XB_SPIN_CAP) { atomicAdd(&(bar)[XB_TMO], 1u); break; } } } } while (0)
struct XcdBarrier { unsigned* bar; unsigned x; volatile LAS unsigned* st; };
__device__ __forceinline__ XcdBarrier xcd_barrier_post(unsigned* bar, volatile LAS unsigned* st) {
    XcdBarrier b; b.bar = bar; b.x = xb_xcc_id(); b.st = st;
    if (threadIdx.x == 0) (void)xb_add(&bar[XB_XCNT(b.x)], 1u);
    return b;
}
__device__ __forceinline__ void xcd_barrier_complete(unsigned* bar, unsigned x, unsigned& nloc, unsigned& nx) {
    const unsigned G = gridDim.x * gridDim.y * gridDim.z;
    unsigned sum, cnt, mine, sp = 0u;
    for (;;) {
        sum = 0u; cnt = 0u; mine = 0u;
#pragma unroll
        for (unsigned j = 0; j < 16; ++j) { const unsigned c = xb_ld(&bar[XB_XCNT(j)]); sum += c; cnt += (c > 0u) ? 1u : 0u; mine = (j == x) ? c : mine; }
        if (sum == G) break;
        __builtin_amdgcn_s_sleep(1);
        if ((++sp & 255u) == 0u) { if (xb_ld(&bar[XB_TMO])) break; if (sp > XB_SPIN_CAP) { atomicAdd(&bar[XB_TMO], 1u); break; } }
    }
    nloc = mine > 0u ? mine : 1u; nx = cnt > 0u ? cnt : 1u;
}
__device__ __forceinline__ void xcd_barrier(const XcdBarrier& b) {
    asm volatile("s_waitcnt vmcnt(0)" ::: "memory");
    __syncthreads();
    if (threadIdx.x == 0) {
        unsigned* bar = b.bar;
        const unsigned bx = xb_xcc_id();
        __builtin_amdgcn_s_waitcnt(0);
        unsigned nloc = b.st[0], nx = b.st[1];
        if (nloc == 0u) { xcd_barrier_complete(bar, bx, nloc, nx); b.st[0] = nloc; b.st[1] = nx; }
        const unsigned old = xb_add(&bar[XB_XSUB(bx)], 1u);
        const unsigned gen = old / nloc;
        if (old + 1u == (gen + 1u) * nloc) {
            __builtin_amdgcn_fence(__ATOMIC_RELEASE, "agent");
            asm volatile("s_waitcnt vmcnt(0)" ::: "memory");
            const unsigned og = xb_add(&bar[XB_TOP], 1u);
            const unsigned tg = og / nx;
            if (og + 1u == (tg + 1u) * nx) xb_add(&bar[XB_TOPGEN], 1u);
            else XB_SPIN(xb_ld(&bar[XB_TOPGEN]) == tg, bar);
            __builtin_amdgcn_fence(__ATOMIC_ACQUIRE, "agent");
            xb_add(&bar[XB_XGEN(bx)], 1u);
            asm volatile("s_waitcnt vmcnt(0)" ::: "memory");
        } else {
            XB_SPIN(xb_ld(&bar[XB_XGEN(bx)]) == gen, bar);
            __builtin_amdgcn_fence(__ATOMIC_ACQUIRE, "agent");
            asm volatile("s_waitcnt vmcnt(0)" ::: "memory");
        }
    }
    __syncthreads();
}

struct Args { const float* in[N_IN]; float* out; unsigned char* ws; int ph_lo, ph_hi; };
struct Frame {
    LAS unsigned char* lds;
    int tid, lane, wave, G, bid;
    const CAS cfp_t* in;
    float* out; unsigned char* ws;
    unsigned* ctl;
    float *MOD, *MODP, *DT, *XS, *YSSD, *YS5, *CU;
    bf16 *HN, *COLS, *XBCC, *MIX, *HMID, *CV, *YG, *YDN, *WIN_T, *WOUT_T, *PW_T, *GLU_T, *WGU_T, *WD_T;
    int* LIST; int* TOKI; float* TOKW;
};
__device__ __forceinline__ void frame_ptrs(Frame& F, unsigned char* ws) {
    F.ws = ws; F.ctl = (unsigned*)(ws + WS_CTL);
    F.MOD = (float*)(ws + WS_MOD); F.MODP = (float*)(ws + WS_MODP); F.DT = (float*)(ws + WS_DT); F.XS = (float*)(ws + WS_XS);
    F.YSSD = (float*)(ws + WS_YSSD); F.YS5 = (float*)(ws + WS_YS5); F.CU = (float*)(ws + WS_CU); F.CV = (bf16*)(ws + WS_CV); F.YDN = (bf16*)(ws + WS_YDN); F.YG = (bf16*)(ws + WS_YG);
    F.WIN_T = (bf16*)(ws + WS_WIN_T); F.WOUT_T = (bf16*)(ws + WS_WOUT_T); F.PW_T = (bf16*)(ws + WS_PW_T); F.GLU_T = (bf16*)(ws + WS_GLU_T); F.WGU_T = (bf16*)(ws + WS_WGU_T); F.WD_T = (bf16*)(ws + WS_WD_T);
    F.HN = (bf16*)(ws + WS_HN); F.COLS = (bf16*)(ws + WS_COLS); F.XBCC = (bf16*)(ws + WS_XBCC); F.MIX = (bf16*)(ws + WS_MIX); F.HMID = (bf16*)(ws + WS_HMID);
    F.LIST = (int*)(ws + WS_LIST); F.TOKI = (int*)(ws + WS_TOKI); F.TOKW = (float*)(ws + WS_TOKW);
}
__device__ __forceinline__ int fresh_lane() { unsigned om = ~0u; asm volatile("" : "+s"(om)); int ln = (int)__builtin_amdgcn_mbcnt_hi(om, __builtin_amdgcn_mbcnt_lo(om, 0u)); asm volatile("" : "+v"(ln)); return ln; }
__device__ __forceinline__ Frame enter_phase(const Frame& F0) {
    Frame F = F0; unsigned om = ~0u; asm volatile("" : "+s"(om)); int ln = (int)__builtin_amdgcn_mbcnt_hi(om, __builtin_amdgcn_mbcnt_lo(om, 0u)); asm volatile("" : "+v"(ln));
    int wv_ = F0.wave, bid_ = F0.bid, g_ = F0.G; asm volatile("" : "+s"(wv_), "+s"(bid_), "+s"(g_));
    F.wave = wv_; F.bid = bid_; F.G = g_; F.lane = ln; F.tid = wv_ * 64 + ln;
    unsigned char* ws = F0.ws; asm volatile("" : "+s"(ws)); frame_ptrs(F, ws);
    const CAS cfp_t* ka = (const CAS cfp_t*)__builtin_amdgcn_kernarg_segment_ptr(); asm volatile("" : "+s"(ka)); F.in = ka;
    return F;
}

__device__ __forceinline__ void ld4(const float* p, float (&v)[4]) { const f32x4 t = *(const f32x4*)p; v[0] = t.x; v[1] = t.y; v[2] = t.z; v[3] = t.w; }
__device__ __forceinline__ void ld4(const bf16* p, float (&v)[4]) { const u32x2 t = *(const u32x2*)p; v[0] = __uint_as_float(t.x << 16); v[1] = __uint_as_float(t.x & 0xffff0000u); v[2] = __uint_as_float(t.y << 16); v[3] = __uint_as_float(t.y & 0xffff0000u); }

__device__ __forceinline__ void ld8(const bf16* p, float (&v)[8]) { const u32x4 t = *(const u32x4*)p;
    v[0] = __uint_as_float(t.x << 16); v[1] = __uint_as_float(t.x & 0xffff0000u); v[2] = __uint_as_float(t.y << 16); v[3] = __uint_as_float(t.y & 0xffff0000u);
    v[4] = __uint_as_float(t.z << 16); v[5] = __uint_as_float(t.z & 0xffff0000u); v[6] = __uint_as_float(t.w << 16); v[7] = __uint_as_float(t.w & 0xffff0000u); }

namespace pg8 {
typedef short bf16x8 __attribute__((ext_vector_type(8)));
constexpr int BM = 256, BK = 64, HALF = 128, HTB = HALF * BK * 2, STAGE_BYTES = 8 * HTB, NXCD = 8, WGM = 8;
__device__ __forceinline__ int lds_byte(int r, int c) { const int st = (r >> 4) * 2 + (c >> 5), rr = r & 15, cc = c & 31, ob = rr * 64 + cc * 2; return st * 1024 + (ob ^ (((ob >> 9) & 1) << 5)); }
__device__ __forceinline__ void stage_rc(int b, int& R, int& C) { const int st = b / 1024, sb = b % 1024, swz = sb ^ (((sb >> 9) & 1) << 5); R = (st >> 1) * 16 + swz / 64; C = (st & 1) * 32 + (swz % 64) / 2; }
__device__ __forceinline__ int perm32(int rho) { const int n = rho >> 4, i = rho & 15; return 8 * (i >> 2) + 4 * n + (i & 3); }
struct Unit { int pm, pn, idx; };
struct TileOrder {
    int nM, nN, nwg, G, c;
    __device__ __forceinline__ void init(int nM_, int nN_, int G_, int c_) { nM = nM_; nN = nN_; nwg = nM * nN; G = G_; c = c_; }
    __device__ __forceinline__ bool next(int i, Unit& u) const {
        const long L = (long)i * G + c; if (L >= nwg) return false;
        int wgid = (int)L; { const int q = nwg / NXCD, r = nwg % NXCD, xcd = wgid % NXCD, off = wgid / NXCD; wgid = (xcd < r ? xcd * (q + 1) : r * (q + 1) + (xcd - r) * q) + off; }
        const int nig = WGM * nN, gid = wgid / nig, fm = gid * WGM, gsz = (nM - fm) < WGM ? (nM - fm) : WGM;
        u.pm = fm + ((wgid % nig) % gsz); u.pn = (wgid % nig) / gsz; u.idx = i; return true;
    }
};
__device__ __forceinline__ unsigned cvt_pk_bf16(float lo, float hi) { return pk2(lo, hi); }

template <class Epi, class Sched, bool ALIGN_EPI>
__device__ __forceinline__ void gemm_phase(LAS unsigned char* lds, const bf16* Abase, int K, const Sched& S, const Epi& E, int tid) {
    const int wid = __builtin_amdgcn_readfirstlane(tid >> 6), lane = tid & 63, wr = wid >> 2, wc = wid & 3, fr = lane & 15, fq = lane >> 4;
    const int nt = K / BK;
    unsigned voffB[2];
#pragma unroll
    for (int i = 0; i < 2; ++i) { int R, C; stage_rc(tid * 16 + i * 8192, R, C); const int Rb = Epi::PERM ? ((R & ~31) + perm32(R & 31)) : R; voffB[i] = (unsigned)(Rb * K + C) * 2u; }
    const size_t kstep = (size_t)(BK * 2);
    const size_t hstep = (size_t)HALF * K * 2;
    const unsigned ldsw = (unsigned)wid * 1024u;
    const int aoff = lds_byte(wr * 64 + fr, fq * 8), boff = lds_byte(wc * 32 + fr, fq * 8);
#define PG8_SA(b, h) (((b) * 2 + (h)) * HTB)
#define PG8_SB(b, h) ((4 + (b) * 2 + (h)) * HTB)
#define PG8_STAGE(bufoff, gbase, voff) do { _Pragma("unroll") for (int _i = 0; _i < 2; ++_i) \
        __builtin_amdgcn_global_load_lds((const unsigned*)((const char*)(gbase) + (voff)[_i]), (LAS unsigned*)(lds + (bufoff) + ldsw + _i * 8192), 16, 0, 0); } while (0)
#define PG8_LDA(dst, b, h) do { _Pragma("unroll") for (int m = 0; m < 4; ++m) _Pragma("unroll") for (int k = 0; k < 2; ++k) dst[m][k] = *(const LAS bf16x8*)(lds + PG8_SA(b, h) + aoff + m * 2048 + k * 1024); } while (0)
#define PG8_LDB(dst, b, h) do { _Pragma("unroll") for (int n = 0; n < 2; ++n) _Pragma("unroll") for (int k = 0; k < 2; ++k) dst[n][k] = *(const LAS bf16x8*)(lds + PG8_SB(b, h) + boff + n * 2048 + k * 1024); } while (0)
#define PG8_MMA(ai, bj, At, Bt) do { __builtin_amdgcn_s_setprio(1); _Pragma("unroll") for (int m = 0; m < 4; ++m) _Pragma("unroll") for (int n = 0; n < 2; ++n) _Pragma("unroll") for (int k = 0; k < 2; ++k) \
        acc[ai][bj][m][n] = __builtin_amdgcn_mfma_f32_16x16x32_bf16(Bt[n][k], At[m][k], acc[ai][bj][m][n], 0, 0, 0); __builtin_amdgcn_s_setprio(0); } while (0)
#define PG8_WAIT_V(n) asm volatile("s_waitcnt vmcnt(" #n ")" ::: "memory")
#define PG8_WAIT_L(n) asm volatile("s_waitcnt lgkmcnt(" #n ")" ::: "memory")
#define PG8_BAR __builtin_amdgcn_s_barrier()
#define PG8_SCHED __builtin_amdgcn_sched_barrier(0)
#define PG8_SETV(v, u) do { _Pragma("unroll") for (int _i = 0; _i < 2; ++_i) { int _R, _C; stage_rc(tid * 16 + _i * 8192, _R, _C); _Pragma("unroll") for (int _h = 0; _h < 2; ++_h) v[_h][_i] = (unsigned)(S.arow(u, _h * HALF + _R) * K + _C) * 2u; } } while (0)
    Unit cur, nxt; int ui = 0;
    if (!S.next(0, cur)) return;
    f32x4 acc[2][2][4][2];
#pragma unroll
    for (int a = 0; a < 2; ++a)
#pragma unroll
        for (int b = 0; b < 2; ++b)
#pragma unroll
            for (int m = 0; m < 4; ++m)
#pragma unroll
                for (int n = 0; n < 2; ++n) acc[a][b][m][n] = (f32x4){0.f, 0.f, 0.f, 0.f};
    bf16x8 At[4][2], B0[2][2], B1[2][2];
    unsigned vC[2][2], vN[2][2];
    PG8_SETV(vC, cur);
    const char* cA = (const char*)Abase; const char* cB = S.bbase(cur);
    PG8_WAIT_L(0);
    PG8_STAGE(PG8_SB(0, 0), cB, voffB); PG8_STAGE(PG8_SB(0, 1), cB + hstep, voffB); PG8_STAGE(PG8_SA(0, 0), cA, vC[0]); PG8_STAGE(PG8_SA(0, 1), cA, vC[1]);
    if (wr == 1) PG8_BAR;
    PG8_WAIT_V(2); PG8_BAR;
    PG8_STAGE(PG8_SB(1, 0), cB + kstep, voffB); PG8_STAGE(PG8_SA(1, 0), cA + kstep, vC[0]); PG8_STAGE(PG8_SB(1, 1), cB + hstep + kstep, voffB);
    PG8_WAIT_V(6); PG8_BAR;
    for (;;) {
        const bool has_next = S.next(ui + 1, nxt);
        const char* nB = cB;
        if (has_next) { PG8_SETV(vN, nxt); nB = S.bbase(nxt); }
        else {
#pragma unroll
            for (int _h = 0; _h < 2; ++_h)
#pragma unroll
                for (int _i = 0; _i < 2; ++_i) vN[_h][_i] = vC[_h][_i];
        }
        PG8_WAIT_L(0);
#pragma unroll 1
        for (int t = 0; t < nt; t += 2) {
            const bool last = (t == nt - 2);
            const char* a1 = cA + (size_t)(t + 1) * kstep;
            const char* a2 = last ? cA : cA + (size_t)(t + 2) * kstep; const char* b2 = last ? nB : cB + (size_t)(t + 2) * kstep;
            const char* a3 = a2 + kstep; const char* b3 = b2 + kstep;
            PG8_LDB(B0, 0, 0); PG8_LDB(B1, 0, 1); PG8_SCHED; PG8_LDA(At, 0, 0); PG8_STAGE(PG8_SA(1, 1), a1, vC[1]);
            if (last) {
#pragma unroll
                for (int _h = 0; _h < 2; ++_h)
#pragma unroll
                    for (int _i = 0; _i < 2; ++_i) vC[_h][_i] = vN[_h][_i];
            }
            PG8_WAIT_V(8); PG8_WAIT_L(0); PG8_BAR; PG8_MMA(0, 0, At, B0); PG8_MMA(0, 1, At, B1); PG8_BAR; PG8_SCHED;
            PG8_LDA(At, 0, 1); PG8_STAGE(PG8_SB(0, 0), b2, voffB); PG8_STAGE(PG8_SB(0, 1), b2 + hstep, voffB); PG8_STAGE(PG8_SA(0, 0), a2, vC[0]);
            PG8_WAIT_V(8); PG8_WAIT_L(0); PG8_BAR; PG8_MMA(1, 0, At, B0); PG8_MMA(1, 1, At, B1); PG8_BAR; PG8_SCHED;
            PG8_LDB(B0, 1, 0); PG8_LDB(B1, 1, 1); PG8_SCHED; PG8_LDA(At, 1, 0); PG8_STAGE(PG8_SA(0, 1), a2, vC[1]);
            PG8_WAIT_V(8); PG8_WAIT_L(0); PG8_BAR; PG8_MMA(0, 0, At, B0); PG8_MMA(0, 1, At, B1); PG8_BAR; PG8_SCHED;
            PG8_LDA(At, 1, 1); PG8_STAGE(PG8_SB(1, 0), b3, voffB); PG8_STAGE(PG8_SB(1, 1), b3 + hstep, voffB); PG8_STAGE(PG8_SA(1, 0), a3, vC[0]);
            PG8_WAIT_V(8); PG8_WAIT_L(0); PG8_BAR; PG8_MMA(1, 0, At, B0); PG8_MMA(1, 1, At, B1); PG8_BAR; PG8_SCHED;
        }
        if constexpr (ALIGN_EPI) { if (wr == 0) PG8_BAR; }
        E(acc, cur, wr, wc, fr, fq);
        if (!has_next) break;
#pragma unroll
        for (int a = 0; a < 2; ++a)
#pragma unroll
            for (int b = 0; b < 2; ++b)
#pragma unroll
                for (int m = 0; m < 4; ++m)
#pragma unroll
                    for (int n = 0; n < 2; ++n) acc[a][b][m][n] = (f32x4){0.f, 0.f, 0.f, 0.f};
        cur = nxt; cB = nB; ++ui;
        if constexpr (ALIGN_EPI) { if (wr == 1) PG8_BAR; }
    }
    PG8_WAIT_V(0);
    if constexpr (!ALIGN_EPI) { if (wr == 0) PG8_BAR; }
    PG8_BAR;
#undef PG8_SA
#undef PG8_SB
#undef PG8_STAGE
#undef PG8_LDA
#undef PG8_LDB
#undef PG8_MMA
#undef PG8_WAIT_V
#undef PG8_WAIT_L
#undef PG8_BAR
#undef PG8_SCHED
#undef PG8_SETV
}

struct PlainSched {
    TileOrder T; const char* Bt; int K;
    __device__ __forceinline__ bool next(int i, Unit& u) const { return T.next(i, u); }
    __device__ __forceinline__ int arow(const Unit& u, int r) const { return u.pm * BM + r; }
    __device__ __forceinline__ const char* bbase(const Unit& u) const { return Bt + (size_t)u.pn * BM * K * 2; }
};
template <bool GATHER> struct MoeSched {
    TileOrder T; const char* Bt; int K, NE; const LAS int* tab; const LAS int* rows;
    __device__ __forceinline__ bool next(int i, Unit& u) const { return T.next(i, u); }
    __device__ __forceinline__ int expert(int pm) const { const int s = pm * BM; int e = 0;
#pragma unroll
        for (int k = 1; k < NEXP; ++k) if (s >= tab[k]) e = k;
        return e; }
    __device__ __forceinline__ int arow(const Unit& u, int r) const { return GATHER ? rows[u.idx * BM + r] : u.pm * BM + r; }
    __device__ __forceinline__ const char* bbase(const Unit& u) const { return Bt + ((size_t)expert(u.pm) * NE + (size_t)u.pn * BM) * K * 2; }
};
struct EpiStoreBf16 {
    static constexpr bool PERM = true;
    bf16* O; int ldc, col0; const float* bias;
    __device__ __forceinline__ void operator()(const f32x4 (&acc)[2][2][4][2], const Unit& u, int wr, int wc, int fr, int fq) const {
        const int row0 = u.pm * BM + wr * 64 + fr, ct0 = u.pn * BM + wc * 32 + 8 * fq;
        f32x4 bv[2][2];
#pragma unroll
        for (int bj = 0; bj < 2; ++bj)
#pragma unroll
            for (int n = 0; n < 2; ++n) bv[bj][n] = bias ? *(const f32x4*)(bias + ct0 + bj * HALF + 4 * n) : (f32x4){0.f, 0.f, 0.f, 0.f};
#pragma unroll
        for (int ai = 0; ai < 2; ++ai)
#pragma unroll
            for (int m = 0; m < 4; ++m) { bf16* rowp = O + (size_t)(row0 + ai * HALF + m * 16) * ldc + col0 + ct0;
#pragma unroll
                for (int bj = 0; bj < 2; ++bj) { const f32x4 v0 = acc[ai][bj][m][0] + bv[bj][0], v1 = acc[ai][bj][m][1] + bv[bj][1];
                    u32x4 w; w.x = cvt_pk_bf16(v0[0], v0[1]); w.y = cvt_pk_bf16(v0[2], v0[3]); w.z = cvt_pk_bf16(v1[0], v1[1]); w.w = cvt_pk_bf16(v1[2], v1[3]);
                    *(u32x4*)(rowp + bj * HALF) = w; } }
    }
};
template <int ACT>
struct EpiPairBf16 {
    static constexpr bool PERM = true;
    bf16* O; int ldc, col0; const float* bias; int nb;
    __device__ __forceinline__ void operator()(const f32x4 (&acc)[2][2][4][2], const Unit& u, int wr, int wc, int fr, int fq) const {
        const int row0 = u.pm * BM + wr * 64 + fr, ct0 = u.pn * HALF + wc * 32 + 8 * fq;
        f32x4 ba[2], bb[2];
#pragma unroll
        for (int n = 0; n < 2; ++n) { ba[n] = (ACT == 1) ? *(const f32x4*)(bias + ct0 + 4 * n) : (f32x4){0.f, 0.f, 0.f, 0.f}; bb[n] = (ACT == 1) ? *(const f32x4*)(bias + nb + ct0 + 4 * n) : (f32x4){0.f, 0.f, 0.f, 0.f}; }
#pragma unroll
        for (int ai = 0; ai < 2; ++ai)
#pragma unroll
            for (int m = 0; m < 4; ++m) {
                float o[8];
#pragma unroll
                for (int n = 0; n < 2; ++n)
#pragma unroll
                    for (int j = 0; j < 4; ++j) { const float a = acc[ai][0][m][n][j] + ba[n][j], b = acc[ai][1][m][n][j] + bb[n][j];
                        o[n * 4 + j] = (ACT == 0) ? (a / (1.f + __expf(-a))) * b : a / (1.f + __expf(-b)); }
                u32x4 w; w.x = cvt_pk_bf16(o[0], o[1]); w.y = cvt_pk_bf16(o[2], o[3]); w.z = cvt_pk_bf16(o[4], o[5]); w.w = cvt_pk_bf16(o[6], o[7]);
                *(u32x4*)(O + (size_t)(row0 + ai * HALF + m * 16) * ldc + col0 + ct0) = w; }
    }
};
struct EpiResidual {
    static constexpr bool PERM = false;
    float* XS; const float* g1;
    __device__ __forceinline__ void operator()(const f32x4 (&acc)[2][2][4][2], const Unit& u, int wr, int wc, int fr, int fq) const {
        const int row0 = u.pm * BM + wr * 64 + fr, ct0 = u.pn * BM + wc * 32 + 4 * fq;
#pragma unroll
        for (int ai = 0; ai < 2; ++ai)
#pragma unroll
            for (int m = 0; m < 4; ++m) { const int row = row0 + ai * HALF + m * 16; float* xp = XS + (size_t)row * D + ct0; const float* gp = g1 + (size_t)modrow(row) * 6144 + ct0;
#pragma unroll
                for (int bj = 0; bj < 2; ++bj)
#pragma unroll
                    for (int n = 0; n < 2; ++n) { const int o = bj * HALF + n * 16; const f32x4 g = *(const f32x4*)(gp + o); f32x4 x = *(const f32x4*)(xp + o); x += g * acc[ai][bj][m][n]; *(f32x4*)(xp + o) = x; }
                if (m & 1) asm volatile("" ::: "memory"); }
    }
};
}

template <class RowMap>
__device__ __forceinline__ void transpose_item(const float* W, int K, int N, bf16* WT, const RowMap& rowmap, LAS float* scr, int item, int lane) {
    const int nblk = (N + 31) / 32, kb = item / nblk, nb = item % nblk, k0 = 64 * kb, n0 = 32 * nb;
    const bool cok = n0 + (lane & 31) < N;
    float tv[32];
#pragma unroll
    for (int i = 0; i < 32; ++i) { const int kk = 2 * i + (lane >> 5); tv[i] = cok ? W[(size_t)(k0 + kk) * N + n0 + (lane & 31)] : 0.f; }
#pragma unroll
    for (int i = 0; i < 32; ++i) { const int kk = 2 * i + (lane >> 5); scr[kk * 33 + (lane & 31)] = tv[i]; }
    if (false) for (int i = 0; i < 32; ++i) { const int kk = 2 * i + (lane >> 5); scr[kk * 33 + (lane & 31)] = cok ? W[(size_t)(k0 + kk) * N + n0 + (lane & 31)] : 0.f; }
    asm volatile("s_waitcnt lgkmcnt(0)" ::: "memory");
    const int c = lane & 7;
#pragma unroll
    for (int j = 0; j < 4; ++j) { const int n = (lane >> 3) + 8 * j; const LAS float* sp = scr + (8 * c) * 33 + n;
        u32x4 o; o.x = pk2(sp[0 * 33], sp[1 * 33]); o.y = pk2(sp[2 * 33], sp[3 * 33]); o.z = pk2(sp[4 * 33], sp[5 * 33]); o.w = pk2(sp[6 * 33], sp[7 * 33]);
        const int dr = rowmap(n0 + n);
        if (dr >= 0) *(u32x4*)(WT + (size_t)dr * K + k0 + 8 * c) = o; }
    asm volatile("s_waitcnt lgkmcnt(0)" ::: "memory");
}


typedef short bf16x4s __attribute__((ext_vector_type(4)));
constexpr int S5_US = 264;
constexpr int S5_WS = 136;
__device__ __forceinline__ int s5_row0(int b, int c) { return c < 4 ? TL + b * CTXL + c * 64 : b * SEQ + (c - 4) * 64; }
template <int PASS>
__device__ __forceinline__ void s5_unit(const Frame& Fu, int l, int uidx) {
    Frame F = Fu; F.lane = fresh_lane(); F.tid = F.wave * 64 + F.lane;
    const int b = uidx / 36, c = uidx % 36, r0 = s5_row0(b, c);
    LAS bf16* U = (LAS bf16*)F.lds;
    __syncthreads();
    for (int i = F.tid; i < 64 * 32; i += NTHR) { const int row = i >> 5, c8 = i & 31; *(LAS u32x4*)(U + row * S5_US + c8 * 8) = *(const u32x4*)(F.COLS + (size_t)(r0 + row) * NCOL + 2048 + c8 * 8); }
    __syncthreads();
    LAS bf16* BuS = (LAS bf16*)(F.lds + 64 * S5_US * 2 + F.wave * (2 * 16 * S5_WS * 2)); LAS bf16* Hs = BuS + 16 * S5_WS;
    const int lane_ = F.lane;
    const int q = lane_ >> 4, c16 = lane_ & 15, p = lane_;
    const f32x2* AA = (const f32x2*)(F.ws + WS_S5AA); const bf16* BB = (const bf16*)(F.ws + WS_S5BB); const bf16* CM = (const bf16*)(F.ws + WS_S5CM);
    f32x2* HL = (f32x2*)(F.ws + WS_S5HL); const f32x2* HI = (const f32x2*)(F.ws + WS_S5HI);
    u32x2 yout[2][4];
    f32x2 aa_[2][2], h0_[2][2]; bf16x4s bb_[2][2][8]; pg8::bf16x8 cm_[2][4];
#pragma unroll
    for (int gi = 0; gi < 2; ++gi) {
        const int g = F.wave * 2 + gi;
        if (PASS == 1) {
#pragma unroll
            for (int ks = 0; ks < 4; ++ks) cm_[gi][ks] = *(const pg8::bf16x8*)(CM + ((size_t)(l * 16 + g) * 16 + c16) * 128 + 32 * ks + 8 * q);
        }
#pragma unroll
        for (int dir = 0; dir < 2; ++dir) {
            const int pidx = ((l * 2 + dir) * 16 + g);
            aa_[gi][dir] = AA[pidx * 64 + p];
#pragma unroll
            for (int rt = 0; rt < 8; ++rt) bb_[gi][dir][rt] = *(const bf16x4s*)(BB + ((size_t)pidx * 128 + 16 * rt + c16) * 16 + 4 * q);
            if (PASS == 1) h0_[gi][dir] = HI[((size_t)(b * 36 + c) * 32 + g * 2 + dir) * 64 + p];
        }
    }
#pragma unroll
    for (int gi = 0; gi < 2; ++gi) {
        const int g = F.wave * 2 + gi;
        f32x4 yacc[4];
#pragma unroll
        for (int rs = 0; rs < 4; ++rs) yacc[rs] = (f32x4){0.f, 0.f, 0.f, 0.f};
#pragma unroll
        for (int dir = 0; dir < 2; ++dir) {
            const float ar = aa_[gi][dir].x, ai = aa_[gi][dir].y;
            const size_t sidx = ((size_t)(b * 36 + c) * 32 + g * 2 + dir) * 64 + p;
            float hr = 0.f, hi = 0.f;
            if (PASS == 1) { hr = h0_[gi][dir].x; hi = h0_[gi][dir].y; }
#pragma unroll
            for (int sci = 0; sci < 4; ++sci) {
                const int rs = dir ? 3 - sci : sci;
                const bf16x4s bop = *(const LAS bf16x4s*)(U + (16 * rs + c16) * S5_US + g * 16 + 4 * q);
#pragma unroll
                for (int rt = 0; rt < 8; ++rt) {
                    const f32x4 a = __builtin_amdgcn_mfma_f32_16x16x16bf16_1k(bb_[gi][dir][rt], bop, (f32x4){0.f, 0.f, 0.f, 0.f}, 0, 0, 0);
                    u32x2 w; w.x = pk2(a[0], a[1]); w.y = pk2(a[2], a[3]);
                    *(LAS u32x2*)(BuS + c16 * S5_WS + 16 * rt + 4 * q) = w;
                }
                asm volatile("s_waitcnt lgkmcnt(0)" ::: "memory");
                unsigned bu[16];
#pragma unroll
                for (int st = 0; st < 16; ++st) bu[st] = *(const LAS unsigned*)(BuS + (dir ? 15 - st : st) * S5_WS + 2 * p);
#pragma unroll
                for (int st = 0; st < 16; ++st) {
                    const float bur = __uint_as_float(bu[st] << 16), bui = __uint_as_float(bu[st] & 0xffff0000u);
                    const float nr = fmaf(ar, hr, fmaf(-ai, hi, bur)), ni = fmaf(ar, hi, fmaf(ai, hr, bui)); hr = nr; hi = ni;
                    if (PASS == 1) *(LAS unsigned*)(Hs + (dir ? 15 - st : st) * S5_WS + 2 * p) = pk2(hr, hi);
                }
                if (PASS == 1) {
                    asm volatile("s_waitcnt lgkmcnt(0)" ::: "memory");
#pragma unroll
                    for (int ks = 0; ks < 4; ++ks) { const pg8::bf16x8 hf = *(const LAS pg8::bf16x8*)(Hs + c16 * S5_WS + 32 * ks + 8 * q);
                        yacc[rs] = __builtin_amdgcn_mfma_f32_16x16x32_bf16(cm_[gi][ks], hf, yacc[rs], 0, 0, 0); }
                }
                asm volatile("s_waitcnt lgkmcnt(0)" ::: "memory");
            }
            if (PASS == 0) HL[sidx] = (f32x2){hr, hi};
        }
        if (PASS == 1) {
            const f32x4 dsk = *(const f32x4*)(F.in[I_S5D] + l * 256 + g * 16 + 4 * q);
#pragma unroll
            for (int rs = 0; rs < 4; ++rs) {
                float u4[4]; { const u32x2 t = *(const LAS u32x2*)(U + (16 * rs + c16) * S5_US + g * 16 + 4 * q);
                    u4[0] = __uint_as_float(t.x << 16); u4[1] = __uint_as_float(t.x & 0xffff0000u); u4[2] = __uint_as_float(t.y << 16); u4[3] = __uint_as_float(t.y & 0xffff0000u); }
                float o[4];
#pragma unroll
                for (int j = 0; j < 4; ++j) o[j] = gelu_tanh(yacc[rs][j] + dsk[j] * u4[j]);
                yout[gi][rs].x = pk2(o[0], o[1]); yout[gi][rs].y = pk2(o[2], o[3]);
            }
        }
    }
    if (PASS == 1) {
        const bf16* GW = F.GLU_T + (size_t)l * 512 * 256;
        pg8::bf16x8 wv[8][2], wg[8][2];
#pragma unroll
        for (int ks = 0; ks < 8; ++ks)
#pragma unroll
            for (int nt = 0; nt < 2; ++nt) { wv[ks][nt] = *(const pg8::bf16x8*)(GW + (size_t)(32 * F.wave + 16 * nt + c16) * 256 + 32 * ks + 8 * q); wg[ks][nt] = *(const pg8::bf16x8*)(GW + (size_t)(256 + 32 * F.wave + 16 * nt + c16) * 256 + 32 * ks + 8 * q); }
        __syncthreads();
#pragma unroll
        for (int gi = 0; gi < 2; ++gi)
#pragma unroll
            for (int rs = 0; rs < 4; ++rs) *(LAS u32x2*)(U + (16 * rs + c16) * S5_US + (F.wave * 2 + gi) * 16 + 4 * q) = yout[gi][rs];
        __syncthreads();
        f32x4 av[2][4], ag[2][4];
#pragma unroll
        for (int nt = 0; nt < 2; ++nt)
#pragma unroll
            for (int rt = 0; rt < 4; ++rt) { av[nt][rt] = (f32x4){0.f, 0.f, 0.f, 0.f}; ag[nt][rt] = (f32x4){0.f, 0.f, 0.f, 0.f}; }
#pragma unroll
        for (int ks = 0; ks < 8; ++ks) {
            pg8::bf16x8 yf[4];
#pragma unroll
            for (int rt = 0; rt < 4; ++rt) yf[rt] = *(const LAS pg8::bf16x8*)(U + (16 * rt + c16) * S5_US + 32 * ks + 8 * q);
#pragma unroll
            for (int nt = 0; nt < 2; ++nt)
#pragma unroll
                for (int rt = 0; rt < 4; ++rt) { av[nt][rt] = __builtin_amdgcn_mfma_f32_16x16x32_bf16(wv[ks][nt], yf[rt], av[nt][rt], 0, 0, 0); ag[nt][rt] = __builtin_amdgcn_mfma_f32_16x16x32_bf16(wg[ks][nt], yf[rt], ag[nt][rt], 0, 0, 0); }
        }
        const float* gb = F.in[I_GLUB] + l * 512;
#pragma unroll
        for (int nt = 0; nt < 2; ++nt) { const int n0 = 32 * F.wave + 16 * nt + 4 * q; const f32x4 bv = *(const f32x4*)(gb + n0), bg = *(const f32x4*)(gb + 256 + n0);
#pragma unroll
            for (int rt = 0; rt < 4; ++rt) { float o[4];
#pragma unroll
                for (int j = 0; j < 4; ++j) o[j] = (av[nt][rt][j] + bv[j]) * sigmoidf_(ag[nt][rt][j] + bg[j]);
                u32x2 w; w.x = pk2(o[0], o[1]); w.y = pk2(o[2], o[3]);
                *(u32x2*)(F.MIX + (size_t)(r0 + 16 * rt + c16) * 1024 + 768 + n0) = w; } }
    }
}
__device__ __forceinline__ void s5_carry(const Frame& F, int l) {
    const int gt = F.bid * NTHR + F.tid, NG = F.G * NTHR;
    const f32x2* AA = (const f32x2*)(F.ws + WS_S5AA); const f32x2* HL = (const f32x2*)(F.ws + WS_S5HL); f32x2* HI = (f32x2*)(F.ws + WS_S5HI);
    for (int i = gt; i < NB * 32 * 64; i += NG) {
        const int p = i & 63, gd = (i >> 6) & 31, b = i >> 11, g = gd >> 1, dir = gd & 1;
        f32x2 a = AA[((l * 2 + dir) * 16 + g) * 64 + p];
#pragma unroll
        for (int k = 0; k < 6; ++k) a = (f32x2){a.x * a.x - a.y * a.y, 2.f * a.x * a.y};
        float hr = 0.f, hi = 0.f;
#pragma unroll 4
        for (int j = 0; j < 36; ++j) {
            const int c = dir ? (j < 4 ? 3 - j : 39 - j) : j;
            const size_t idx = ((size_t)(b * 36 + c) * 32 + gd) * 64 + p;
            HI[idx] = (f32x2){hr, hi};
            const f32x2 hl = HL[idx];
            const float nr = a.x * hr - a.y * hi + hl.x, ni = a.x * hi + a.y * hr + hl.y; hr = nr; hi = ni;
        }
    }
}


constexpr int SSD_LD = 136;
__device__ __forceinline__ int ssd_row0(int b, int cid) { return cid < 2 ? TL + b * CTXL + cid * 128 : b * SEQ + (cid - 2) * 128; }
__device__ __forceinline__ pg8::bf16x8 mk8(u32x2 lo, u32x2 hi) { u32x4 t; t.x = lo.x; t.y = lo.y; t.z = hi.x; t.w = hi.y; return __builtin_bit_cast(pg8::bf16x8, t); }
__device__ __forceinline__ void ssd_conv_item(const Frame& F, int l, int r0, int lo, int hi, int s0, int xch, bool do_nat, LAS bf16* NAT, int ncol, bool do_tr, LAS bf16* TR, int trow, bool do_cc, bf16* CCg) {
    const float* cw = F.in[I_SCW] + (size_t)l * 5 * 1024; const float* cb = F.in[I_SCB] + l * 1024;
    u32x4 xr[12];
    const bool lo_ok = (r0 + s0 - 2) >= lo, hi_ok = (r0 + s0 + 9) < hi;
    const bf16* xp = F.COLS + (size_t)(r0 + s0) * NCOL + 512 + xch;
#pragma unroll
    for (int i = 2; i < 10; ++i) xr[i] = *(const u32x4*)(xp + (i - 2) * NCOL);
    if (lo_ok) { xr[0] = *(const u32x4*)(xp - 2 * NCOL); xr[1] = *(const u32x4*)(xp - NCOL); } else { xr[0] = (u32x4){0u, 0u, 0u, 0u}; xr[1] = xr[0]; }
    if (hi_ok) { xr[10] = *(const u32x4*)(xp + 8 * NCOL); xr[11] = *(const u32x4*)(xp + 9 * NCOL); } else { xr[10] = (u32x4){0u, 0u, 0u, 0u}; xr[11] = xr[10]; }
#pragma unroll
    for (int hb = 0; hb < 2; ++hb) {
        float wv[5][4]; float val[8][4];
#pragma unroll
        for (int j = 0; j < 5; ++j) { const f32x4 t = *(const f32x4*)(cw + j * 1024 + xch + 4 * hb); wv[j][0] = t.x; wv[j][1] = t.y; wv[j][2] = t.z; wv[j][3] = t.w; }
        const f32x4 bias = *(const f32x4*)(cb + xch + 4 * hb);
#pragma unroll
        for (int i = 0; i < 8; ++i)
#pragma unroll
            for (int k = 0; k < 4; ++k) val[i][k] = bias[k];
#pragma unroll
        for (int i = 0; i < 12; ++i) {
            const unsigned wa = hb ? xr[i].z : xr[i].x, wb = hb ? xr[i].w : xr[i].y;
            const float x4[4] = {__uint_as_float(wa << 16), __uint_as_float(wa & 0xffff0000u), __uint_as_float(wb << 16), __uint_as_float(wb & 0xffff0000u)};
#pragma unroll
            for (int j = 0; j < 5; ++j) { const int o = i - j;
                if (o >= 0 && o < 8) {
#pragma unroll
                    for (int k = 0; k < 4; ++k) val[o][k] = fmaf(wv[j][k], x4[k], val[o][k]); } }
        }
#pragma unroll
        for (int i = 0; i < 8; ++i)
#pragma unroll
            for (int k = 0; k < 4; ++k) val[i][k] = siluf_(val[i][k]);
        if (do_nat) {
#pragma unroll
            for (int i = 0; i < 8; ++i) { u32x2 o; o.x = pk2(val[i][0], val[i][1]); o.y = pk2(val[i][2], val[i][3]); *(LAS u32x2*)(NAT + (s0 + i) * SSD_LD + ncol + 4 * hb) = o;
                if (do_cc) *(u32x2*)(CCg + (size_t)(s0 + i) * 256 + 4 * hb) = o; }
        }
        if (do_tr) {
#pragma unroll
            for (int k = 0; k < 4; ++k) { u32x4 o; o.x = pk2(val[0][k], val[1][k]); o.y = pk2(val[2][k], val[3][k]); o.z = pk2(val[4][k], val[5][k]); o.w = pk2(val[6][k], val[7][k]);
                *(LAS u32x4*)(TR + (trow + 4 * hb + k) * SSD_LD + s0) = o; }
        }
    }
}
__device__ __forceinline__ void ssd_unit_a(const Frame& Fu, int l, int ug) {
    Frame F = Fu; F.lane = fresh_lane(); F.tid = F.wave * 64 + F.lane;
    const int g = ug & 1, uc = ug >> 1, b = uc / 18, cid = uc % 18, r0 = ssd_row0(b, cid);
    LAS bf16* Bn = (LAS bf16*)F.lds; LAS bf16* Cn = Bn + 128 * SSD_LD; LAS bf16* BT = Cn + 128 * SSD_LD; LAS bf16* XT4 = Bn;
    LAS float* ARR = (LAS float*)(BT + 128 * SSD_LD);
    int lo, hi; seq_bounds(r0, lo, hi);
    __syncthreads();
    if (F.wave < 4) {
        const int h = 4 * g + F.wave;
        LAS float* cs0 = ARR + F.wave * 768; LAS float* ecs1 = cs0 + 128; LAS float* dt0 = ecs1 + 128; LAS float* dt1 = dt0 + 128; LAS float* w0 = dt1 + 128; LAS float* w1 = w0 + 128;
        const float A0 = -expf(F.in[I_SALOG][l * 16 + h]), A1 = -expf(F.in[I_SALOG][l * 16 + 8 + h]);
        const float db0 = F.in[I_SDTB][l * 16 + h], db1 = F.in[I_SDTB][l * 16 + 8 + h];
        const int t0 = 2 * F.lane;
        const float d00 = softplusf_(F.DT[(size_t)(r0 + t0) * 16 + h] + db0), d01 = softplusf_(F.DT[(size_t)(r0 + t0 + 1) * 16 + h] + db0);
        const float d10 = softplusf_(F.DT[(size_t)(r0 + t0) * 16 + 8 + h] + db1), d11 = softplusf_(F.DT[(size_t)(r0 + t0 + 1) * 16 + 8 + h] + db1);
        const float a00 = d00 * A0, a01 = d01 * A0, a10 = d10 * A1, a11 = d11 * A1;
        float p0 = a00 + a01, p1 = a10 + a11;
#pragma unroll
        for (int o = 1; o < 64; o <<= 1) { const float u0 = __int_as_float(__builtin_amdgcn_ds_bpermute((F.lane - o) << 2, __float_as_int(p0))), u1 = __int_as_float(__builtin_amdgcn_ds_bpermute((F.lane - o) << 2, __float_as_int(p1)));
            if (F.lane >= o) { p0 += u0; p1 += u1; } }
        const float tot0 = __int_as_float(__builtin_amdgcn_readlane(__float_as_int(p0), 63)), tot1 = __int_as_float(__builtin_amdgcn_readlane(__float_as_int(p1), 63));
        const float c01 = p0, c00 = p0 - a01;
        const float e11 = p1 - a11, e10 = e11 - a10;
        cs0[t0] = c00; cs0[t0 + 1] = c01; ecs1[t0] = e10; ecs1[t0 + 1] = e11; dt0[t0] = d00; dt0[t0 + 1] = d01; dt1[t0] = d10; dt1[t0 + 1] = d11;
        w0[t0] = __expf(tot0 - c00) * d00; w0[t0 + 1] = __expf(tot0 - c01) * d01; w1[t0] = __expf(e10) * d10; w1[t0 + 1] = __expf(e11) * d11;
        float* ed = (float*)(F.ws + WS_EDEC) + ((size_t)(r0 + t0) * 8 + h) * 2;
        ed[0] = __expf(c00); ed[1] = __expf(tot1 - e10); ed[16] = __expf(c01); ed[17] = __expf(tot1 - e11);
        if (F.lane == 0) { float* tt = (float*)(F.ws + WS_TOT) + ((size_t)uc * 8 + h) * 2; tt[0] = tot0; tt[1] = tot1; }
    }
    {
        const int oct = F.tid & 31, seg = F.tid >> 5, s0 = seg * 8, isC = oct >> 4, n0 = (oct & 15) * 8;
        bf16* CC = (bf16*)(F.ws + WS_CC) + (size_t)r0 * 256 + g * 128 + n0;
        ssd_conv_item(F, l, r0, lo, hi, s0, (isC ? 768 : 512) + g * 128 + n0, true, isC ? Cn : Bn, n0, !isC, BT, n0, isC != 0, CC);
    }
    __syncthreads();
    const int q = F.lane >> 4, c = F.lane & 15, w = F.wave;
    f32x4 gt[8];
    {
        pg8::bf16x8 cfr[4];
#pragma unroll
        for (int ks = 0; ks < 4; ++ks) cfr[ks] = *(const LAS pg8::bf16x8*)(Cn + (16 * w + c) * SSD_LD + 32 * ks + 8 * q);
#pragma unroll
        for (int a = 0; a < 8; ++a) { f32x4 acc = {0.f, 0.f, 0.f, 0.f};
#pragma unroll
            for (int ks = 0; ks < 4; ++ks) acc = __builtin_amdgcn_mfma_f32_16x16x32_bf16(*(const LAS pg8::bf16x8*)(Bn + (16 * a + c) * SSD_LD + 32 * ks + 8 * q), cfr[ks], acc, 0, 0, 0);
            gt[a] = acc; }
    }
    __syncthreads();
    {
        const int oct = F.tid & 31, seg = F.tid >> 5, s0 = seg * 8, hl = oct >> 3, p0 = (oct & 7) * 8;
        ssd_conv_item(F, l, r0, lo, hi, s0, (4 * g + hl) * 64 + p0, false, XT4, 0, true, XT4, hl * 64 + p0, false, (bf16*)nullptr);
    }
    __syncthreads();
    pg8::bf16x8 btf[4];
#pragma unroll
    for (int ks = 0; ks < 4; ++ks) btf[ks] = *(const LAS pg8::bf16x8*)(BT + (16 * w + c) * SSD_LD + 32 * ks + 8 * q);
    const int t = 16 * w + c;
#pragma unroll 1
    for (int hl = 0; hl < 4; ++hl) {
        const int h = 4 * g + hl, uidx = uc * 8 + h;
        const LAS float* cs0 = ARR + hl * 768; const LAS float* ecs1 = cs0 + 128; const LAS float* dt0 = ecs1 + 128; const LAS float* dt1 = dt0 + 128; const LAS float* w0 = dt1 + 128; const LAS float* w1 = w0 + 128;
        const LAS bf16* XT = XT4 + hl * 64 * SSD_LD;
        {
            const float cs0t = cs0[t], e1t = ecs1[t], Dh = F.in[I_SD][l * 8 + h];
            f32x4 m[8];
#pragma unroll
            for (int a = 0; a < 8; ++a) {
                const f32x4 csv = *(const LAS f32x4*)&cs0[16 * a + 4 * q], d0v = *(const LAS f32x4*)&dt0[16 * a + 4 * q], e1v = *(const LAS f32x4*)&ecs1[16 * a + 4 * q], d1v = *(const LAS f32x4*)&dt1[16 * a + 4 * q];
                if (a < w) {
#pragma unroll
                    for (int j = 0; j < 4; ++j) m[a][j] = gt[a][j] * (__expf(cs0t - csv[j]) * d0v[j]);
                } else if (a > w) {
#pragma unroll
                    for (int j = 0; j < 4; ++j) m[a][j] = gt[a][j] * (__expf(e1v[j] - e1t) * d1v[j]);
                } else {
#pragma unroll
                    for (int j = 0; j < 4; ++j) { const int sidx = 16 * a + 4 * q + j;
                        const float f0 = (sidx <= t) ? __expf(fminf(cs0t - csv[j], 0.f)) * d0v[j] : 0.f;
                        const float f1 = (sidx >= t) ? __expf(fminf(e1v[j] - e1t, 0.f)) * d1v[j] : 0.f;
                        m[a][j] = gt[a][j] * (f0 + f1) + ((sidx == t) ? Dh : 0.f); }
                }
            }
            pg8::bf16x8 mfr[4];
#pragma unroll
            for (int i = 0; i < 4; ++i) { u32x4 tq; tq.x = pk2(m[2 * i][0], m[2 * i][1]); tq.y = pk2(m[2 * i][2], m[2 * i][3]); tq.z = pk2(m[2 * i + 1][0], m[2 * i + 1][1]); tq.w = pk2(m[2 * i + 1][2], m[2 * i + 1][3]); mfr[i] = __builtin_bit_cast(pg8::bf16x8, tq); }
            bf16* YI = (bf16*)(F.ws + WS_YI);
#pragma unroll
            for (int pt = 0; pt < 4; ++pt) { f32x4 acc = {0.f, 0.f, 0.f, 0.f};
#pragma unroll
                for (int i = 0; i < 4; ++i) { const LAS bf16* xp = XT + (16 * pt + c) * SSD_LD + 32 * i + 4 * q;
                    acc = __builtin_amdgcn_mfma_f32_16x16x32_bf16(mk8(*(const LAS u32x2*)xp, *(const LAS u32x2*)(xp + 16)), mfr[i], acc, 0, 0, 0); }
                u32x2 o; o.x = pk2(acc[0], acc[1]); o.y = pk2(acc[2], acc[3]);
                *(u32x2*)(YI + (((size_t)uidx * 32 + pt * 8 + w) * 64 + F.lane) * 4) = o; }
        }
        {
            bf16* SST = (bf16*)(F.ws + WS_SST);
#pragma unroll
            for (int d = 0; d < 2; ++d) { const LAS float* wd = d ? w1 : w0;
                pg8::bf16x8 bsf[4];
#pragma unroll
                for (int ks = 0; ks < 4; ++ks) {
                    const u32x4 bq = __builtin_bit_cast(u32x4, btf[ks]);
                    const f32x4 wa = *(const LAS f32x4*)&wd[32 * ks + 8 * q], wb = *(const LAS f32x4*)&wd[32 * ks + 8 * q + 4];
                    u32x4 sq;
                    sq.x = pk2(__uint_as_float(bq.x << 16) * wa[0], __uint_as_float(bq.x & 0xffff0000u) * wa[1]); sq.y = pk2(__uint_as_float(bq.y << 16) * wa[2], __uint_as_float(bq.y & 0xffff0000u) * wa[3]);
                    sq.z = pk2(__uint_as_float(bq.z << 16) * wb[0], __uint_as_float(bq.z & 0xffff0000u) * wb[1]); sq.w = pk2(__uint_as_float(bq.w << 16) * wb[2], __uint_as_float(bq.w & 0xffff0000u) * wb[3]);
                    bsf[ks] = __builtin_bit_cast(pg8::bf16x8, sq);
                }
#pragma unroll
                for (int pt = 0; pt < 4; ++pt) { f32x4 acc = {0.f, 0.f, 0.f, 0.f};
#pragma unroll
                    for (int ks = 0; ks < 4; ++ks) acc = __builtin_amdgcn_mfma_f32_16x16x32_bf16(bsf[ks], *(const LAS pg8::bf16x8*)(XT + (16 * pt + c) * SSD_LD + 32 * ks + 8 * q), acc, 0, 0, 0);
                    u32x2 o; o.x = pk2(acc[0], acc[1]); o.y = pk2(acc[2], acc[3]);
                    *(u32x2*)(SST + (((size_t)uidx * 2 + d) * 64 + 16 * pt + c) * 128 + 16 * w + 4 * q) = o; }
            }
        }
    }
}
__device__ __forceinline__ void ssd_carry(const Frame& F) {
    const int gt = F.bid * NTHR + F.tid, NG = F.G * NTHR;
    const bf16* SST = (const bf16*)(F.ws + WS_SST); bf16* HIN = (bf16*)(F.ws + WS_HIN); const float* TOT = (const float*)(F.ws + WS_TOT);
    for (int i = gt; i < NB * 8 * 2 * 1024; i += NG) {
        const int e8 = i & 1023, d = (i >> 10) & 1, h = (i >> 11) & 7, b = i >> 14;
        float H[8];
#pragma unroll
        for (int k = 0; k < 8; ++k) H[k] = 0.f;
#pragma unroll 2
        for (int j = 0; j < 18; ++j) {
            const int cid = d ? (j < 2 ? 1 - j : 19 - j) : j;
            const size_t ui = (size_t)(b * 18 + cid) * 8 + h, off = ((ui * 2 + d) * 1024 + e8) * 8;
            u32x4 o; o.x = pk2(H[0], H[1]); o.y = pk2(H[2], H[3]); o.z = pk2(H[4], H[5]); o.w = pk2(H[6], H[7]);
            *(u32x4*)(HIN + off) = o;
            float sv[8]; ld8(SST + off, sv);
            const float dec = __expf(TOT[ui * 2 + d]);
#pragma unroll
            for (int k = 0; k < 8; ++k) H[k] = fmaf(H[k], dec, sv[k]);
        }
    }
}
__device__ __forceinline__ void ssd_unit_b(const Frame& F, int l, int u2) {
    const int uc = u2 >> 1, rh = u2 & 1, b = uc / 18, cid = uc % 18, r0 = ssd_row0(b, cid) + 64 * rh;
    const int lane_ = fresh_lane();
    const int q = lane_ >> 4, c = lane_ & 15, h = F.wave, g = h >> 2;
    const bf16* CC = (const bf16*)(F.ws + WS_CC); const bf16* HIN = (const bf16*)(F.ws + WS_HIN); const bf16* YI = (const bf16*)(F.ws + WS_YI); const float* ED = (const float*)(F.ws + WS_EDEC);
    LAS float* SSX = (LAS float*)F.lds;
    const size_t ui = (size_t)uc * 8 + h;
    pg8::bf16x8 hin[2][4][4], cfr[4][4];
#pragma unroll
    for (int d = 0; d < 2; ++d)
#pragma unroll
        for (int pt = 0; pt < 4; ++pt)
#pragma unroll
            for (int ks = 0; ks < 4; ++ks) hin[d][pt][ks] = *(const pg8::bf16x8*)(HIN + ((ui * 2 + d) * 64 + 16 * pt + c) * 128 + 32 * ks + 8 * q);
#pragma unroll
    for (int tt = 0; tt < 4; ++tt)
#pragma unroll
        for (int ks = 0; ks < 4; ++ks) cfr[tt][ks] = *(const pg8::bf16x8*)(CC + (size_t)(r0 + 16 * tt + c) * 256 + g * 128 + 32 * ks + 8 * q);
    float ssv[4];
#pragma unroll
    for (int tt = 0; tt < 4; ++tt) {
        const size_t row = (size_t)(r0 + 16 * tt + c); const int w = rh * 4 + tt;
        const f32x2 ed = *(const f32x2*)(ED + (row * 8 + h) * 2);
        u32x2 yiq[4], zq[4];
#pragma unroll
        for (int pt = 0; pt < 4; ++pt) { yiq[pt] = *(const u32x2*)(YI + ((ui * 32 + pt * 8 + w) * 64 + lane_) * 4); zq[pt] = *(const u32x2*)(F.COLS + row * NCOL + h * 64 + 16 * pt + 4 * q); }
        float ss = 0.f;
#pragma unroll
        for (int pt = 0; pt < 4; ++pt) {
            f32x4 a0 = {0.f, 0.f, 0.f, 0.f}, a1 = {0.f, 0.f, 0.f, 0.f};
#pragma unroll
            for (int ks = 0; ks < 4; ++ks) { a0 = __builtin_amdgcn_mfma_f32_16x16x32_bf16(hin[0][pt][ks], cfr[tt][ks], a0, 0, 0, 0); a1 = __builtin_amdgcn_mfma_f32_16x16x32_bf16(hin[1][pt][ks], cfr[tt][ks], a1, 0, 0, 0); }
            const float yi[4] = {__uint_as_float(yiq[pt].x << 16), __uint_as_float(yiq[pt].x & 0xffff0000u), __uint_as_float(yiq[pt].y << 16), __uint_as_float(yiq[pt].y & 0xffff0000u)};
            const float z[4] = {__uint_as_float(zq[pt].x << 16), __uint_as_float(zq[pt].x & 0xffff0000u), __uint_as_float(zq[pt].y << 16), __uint_as_float(zq[pt].y & 0xffff0000u)};
            float v[4];
#pragma unroll
            for (int j = 0; j < 4; ++j) { v[j] = (yi[j] + ed.x * a0[j] + ed.y * a1[j]) * siluf_(z[j]); ss = fmaf(v[j], v[j], ss); }
            u32x2 o; o.x = pk2(v[0], v[1]); o.y = pk2(v[2], v[3]);
            *(u32x2*)(F.MIX + row * 1024 + h * 64 + 16 * pt + 4 * q) = o;
        }
        ss += shx(ss, 16, lane_); ss += shx(ss, 32, lane_);
        ssv[tt] = ss;
    }
    __syncthreads();
    if (q == 0) {
#pragma unroll
        for (int tt = 0; tt < 4; ++tt) SSX[h * 64 + 16 * tt + c] = ssv[tt];
    }
    __syncthreads();
    const float* ng = F.in[I_SNG] + l * 512 + h * 64;
    u32x2 mv[4][4];
#pragma unroll
    for (int tt = 0; tt < 4; ++tt)
#pragma unroll
        for (int pt = 0; pt < 4; ++pt) mv[tt][pt] = *(const u32x2*)(F.MIX + (size_t)(r0 + 16 * tt + c) * 1024 + h * 64 + 16 * pt + 4 * q);
#pragma unroll
    for (int tt = 0; tt < 4; ++tt) {
        float tot = 0.f;
#pragma unroll
        for (int k = 0; k < 8; ++k) tot += SSX[k * 64 + 16 * tt + c];
        const float rstd = rsqrtf(tot * (1.f / 512.f) + EPS);
#pragma unroll
        for (int pt = 0; pt < 4; ++pt) { const f32x4 gn = *(const f32x4*)(ng + 16 * pt + 4 * q);
            u32x2 o; o.x = pk2(__uint_as_float(mv[tt][pt].x << 16) * rstd * gn[0], __uint_as_float(mv[tt][pt].x & 0xffff0000u) * rstd * gn[1]);
            o.y = pk2(__uint_as_float(mv[tt][pt].y << 16) * rstd * gn[2], __uint_as_float(mv[tt][pt].y & 0xffff0000u) * rstd * gn[3]);
            *(u32x2*)(F.MIX + (size_t)(r0 + 16 * tt + c) * 1024 + h * 64 + 16 * pt + 4 * q) = o; }
    }
}

__device__ __forceinline__ void stage_wt16(LAS float* WT, const float* src, int stride, int tid) {
    for (int i = tid; i < 4096; i += NTHR) { const int k = i >> 2, e4 = (i & 3) * 4; const f32x4 v = *(const f32x4*)(src + (size_t)k * stride + e4);
        WT[(e4 + 0) * 1024 + k] = v.x; WT[(e4 + 1) * 1024 + k] = v.y; WT[(e4 + 2) * 1024 + k] = v.z; WT[(e4 + 3) * 1024 + k] = v.w; }
}
__device__ __forceinline__ void dot16_acc(const LAS float* WT, const f32x4& h, int j, int lane, float (&acc)[16]) {
#pragma unroll
    for (int e4 = 0; e4 < 4; ++e4) {
#pragma unroll
        for (int e = 4 * e4; e < 4 * e4 + 4; ++e) { const f32x4 w = *(const LAS f32x4*)&WT[e * 1024 + 4 * lane + 256 * j]; acc[e] = fmaf(h.x, w.x, fmaf(h.y, w.y, fmaf(h.z, w.z, fmaf(h.w, w.w, acc[e])))); }
        asm volatile("" ::: "memory");
    }
}

__device__ __forceinline__ void phase_p0(const Frame& F0)  {
    Frame F = enter_phase(F0);
    {
        const size_t gt = (size_t)F.bid * NTHR + F.tid, NG = (size_t)F.G * NTHR;
        for (size_t i = gt; i < (size_t)TT * 256; i += NG) {
            const int r = (int)(i >> 8), c4 = (int)(i & 255) * 4;
            f32x4 v;
            if (r < TL) {
                v = *(const f32x4*)(F.in[I_X] + (size_t)r * D + c4);
                const int n = r & (SEQ - 1), rr = n >> 6, cc = n & 63, q = c4 >> 8, ii = c4 & 255;
                const float pos = (float)(q < 2 ? rr : cc);
                float pe[4];
#pragma unroll
                for (int k = 0; k < 4; ++k) {
                    const float invf = expf(-9.210340371976184f * (float)(ii + k) * (1.f / 256.f));
                    float s, c; sincos_red(pos * invf, s, c);
                    pe[k] = (q & 1) ? c : s;
                }
                v.x += pe[0]; v.y += pe[1]; v.z += pe[2]; v.w += pe[3];
            } else {
                v = *(const f32x4*)(F.in[I_CTX] + (size_t)(r - TL) * D + c4);
            }
            *(f32x4*)(F.XS + (size_t)r * D + c4) = v;
        }
    }
    {
        LAS float* scr = (LAS float*)F.lds + F.wave * (64 * 33);
        const int gw = F.bid * NWAVES + F.wave, NGW = F.G * NWAVES;
        constexpr int I_IN = 16 * 73, I_OUT = 16 * 32, I_PW = 4 * 8, I_GLU = 4 * 16, I_L = I_IN + I_OUT + I_PW + I_GLU;
        for (int it = gw; it < 2 * I_L; it += NGW) {
            const int l = it / I_L; int r = it % I_L;
            if (r < I_IN) { transpose_item(F.in[I_WIN] + (size_t)l * D * INC, D, INC, F.WIN_T + (size_t)l * NCOL * D, [](int n) { return n < 1536 ? n : (n < 1552 ? -1 : (n < INC ? n - 16 : -1)); }, scr, r, F.lane); continue; } r -= I_IN;
            if (r < I_OUT) { transpose_item(F.in[I_WOUT] + (size_t)l * D * D, D, D, F.WOUT_T + (size_t)l * D * D, [](int n) { return n; }, scr, r, F.lane); continue; } r -= I_OUT;
            if (r < I_PW) { transpose_item(F.in[I_CPW] + (size_t)l * 256 * 256, 256, 256, F.PW_T + (size_t)l * 256 * 256, [](int n) { return n; }, scr, r, F.lane); continue; } r -= I_PW;
            transpose_item(F.in[I_GLUW] + (size_t)l * 256 * 512, 256, 512, F.GLU_T + (size_t)l * 512 * 256, [](int n) { return n; }, scr, r, F.lane);
        }
        __syncthreads();
    }
    {
        const int gt = F.bid * NTHR + F.tid, NG = F.G * NTHR;
        f32x2* AA = (f32x2*)(F.ws + WS_S5AA); bf16* BB = (bf16*)(F.ws + WS_S5BB); bf16* CM = (bf16*)(F.ws + WS_S5CM);
        for (int i = gt; i < 2 * 2 * 16 * 64; i += NG) {
            const int p = i & 63, g = (i >> 6) & 15, dir = (i >> 10) & 1, l = i >> 11;
            const float step = expf(F.in[I_LSTEP][(l * 2 + dir) * 16 + g]);
            const float lr = F.in[I_LRE][i], li = F.in[I_LIM][i];
            const float mag = expf(lr * step); float sn, cs; sincos_red(li * step, sn, cs);
            const float ar = mag * cs, ai = mag * sn, inv_den = 1.f / (lr * lr + li * li);
            const float cr = ((ar - 1.f) * lr + ai * li) * inv_den, ci = (ai * lr - (ar - 1.f) * li) * inv_den;
            AA[i] = (f32x2){ar, ai};
            const float* bre = F.in[I_BRE] + ((size_t)(l * 16 + g) * 64 + p) * 16; const float* bim = F.in[I_BIM] + ((size_t)(l * 16 + g) * 64 + p) * 16;
            bf16* o = BB + ((size_t)((l * 2 + dir) * 16 + g) * 128 + 2 * p) * 16;
            for (int h = 0; h < 16; ++h) { const float br = bre[h], bi = bim[h]; o[h] = (bf16)f2bf(cr * br - ci * bi); o[16 + h] = (bf16)f2bf(cr * bi + ci * br); }
        }
        for (int i = gt; i < 2 * 16 * 16 * 64; i += NG) {
            *(unsigned*)(CM + (size_t)i * 2) = pk2(F.in[I_CRE][i], -F.in[I_CIM][i]);
        }
    }
    {
        LAS float* sc = (LAS float*)F.lds;
        LAS float* part = sc + 9 * 1024;
        __syncthreads();
        if (F.bid < 192) { for (int t = F.tid; t < 9 * 1024; t += NTHR) { const int r9 = t >> 10, k = t & 1023; sc[t] = siluf_(r9 < 8 ? F.in[I_C][r9 * D + k] : F.in[I_CCTX][k]); } }
        __syncthreads();
        for (int it = F.bid; it < 192; it += F.G) {
            const int l = it / 96, cb = it % 96, col = F.tid & 63, kg = F.tid >> 6;
            float acc[9];
#pragma unroll
            for (int r9 = 0; r9 < 9; ++r9) acc[r9] = 0.f;
            const float* wp = F.in[I_WADA] + ((size_t)l * D + kg * 128) * 6144 + cb * 64 + col;
#pragma unroll 4
            for (int kk = 0; kk < 128; ++kk) {
                const float w = wp[(size_t)kk * 6144];
#pragma unroll
                for (int r9 = 0; r9 < 9; ++r9) acc[r9] = fmaf(sc[r9 * 1024 + kg * 128 + kk], w, acc[r9]);
            }
#pragma unroll
            for (int r9 = 0; r9 < 9; ++r9) part[(kg * 9 + r9) * 64 + col] = acc[r9];
            __syncthreads();
            for (int t = F.tid; t < 9 * 64; t += NTHR) { const int r9 = t >> 6, cc = t & 63; float sm = F.in[I_BADA][l * 6144 + cb * 64 + cc];
#pragma unroll
                for (int k8 = 0; k8 < 8; ++k8) sm += part[(k8 * 9 + r9) * 64 + cc];
                F.MOD[((size_t)l * 9 + r9) * 6144 + cb * 64 + cc] = sm; }
            __syncthreads();
        }
    }
}
__device__ __forceinline__ LAS int* moe_tables(const Frame& F, int l) {
    LAS int* tab = (LAS int*)(F.lds + TAB_OFF);
    __syncthreads();
    if (F.tid == 0) {
        int bs = 0;
        for (int e = 0; e < NEXP; ++e) { const int c = (int)F.ctl[CW_CNT + l * 64 + e]; tab[e] = bs; tab[40 + e] = c; bs += ((c + 255) / 256) * 256; }
        tab[16] = bs;
    }
    __syncthreads();
    return tab;
}
template <int MODE>
__device__ __forceinline__ void phase_rowA(const Frame& F0, int l)  {
    constexpr bool HAS_MOE = MODE != 0, FINAL = MODE == 2;
    Frame F = enter_phase(F0);
    LAS int* tab = (LAS int*)(F.lds + TAB_OFF);
    if (HAS_MOE) tab = moe_tables(F, l - 1);
    LAS float* WDT = (LAS float*)F.lds;
    if (!FINAL) {
        __syncthreads();
        stage_wt16(WDT, F.in[I_WIN] + (size_t)l * D * INC + 1536, INC, F.tid);
        __syncthreads();
    }
    const int gw = F.bid * NWAVES + F.wave, NGW = F.G * NWAVES;
    const int RL = FINAL ? TL : TT;
    const int RPW = (RL + NGW - 1) / NGW, rbeg = gw * RPW, rend = (rbeg + RPW < RL) ? rbeg + RPW : RL;
    const float* gvec = FINAL ? F.in[I_GFIN] : F.in[I_GMIX] + l * D;
    LAS float* MV = (LAS float*)(F.lds + 65536);
    const int brow0 = F.bid * NWAVES * RPW, brow1 = (brow0 + NWAVES * RPW < RL ? brow0 + NWAVES * RPW : RL) - 1;
    const int mr_a = modrow(brow0 < RL ? brow0 : RL - 1), mr_b = modrow(brow1 > 0 ? brow1 : 0);
    for (int i = F.tid; i < 2 * 1024; i += NTHR) {
        const int sl = i >> 10, c = i & 1023, mr = sl ? mr_b : mr_a;
        const float gg = gvec[c];
        MV[sl * 3072 + c] = FINAL ? gg : gg * (F.MOD[((size_t)l * 9 + mr) * 6144 + 1024 + c] + 1.f);
        MV[sl * 3072 + 1024 + c] = FINAL ? 0.f : F.MOD[((size_t)l * 9 + mr) * 6144 + c];
        MV[sl * 3072 + 2048 + c] = HAS_MOE ? F.MOD[((size_t)(l - 1) * 9 + mr) * 6144 + 5120 + c] : 0.f;
    }
    __syncthreads();
    f32x4 vn[4]; u32x2 yan[4], ybn[4]; int4 tin = make_int4(0, 0, 0, 0), tin2 = tin; f32x2 twn = {0.f, 0.f}, twn2 = twn;
    if (rbeg < rend) {
#pragma unroll
        for (int j = 0; j < 4; ++j) vn[j] = *(const f32x4*)(F.XS + (size_t)rbeg * D + 4 * F.lane + 256 * j);
        if (HAS_MOE) {
            tin = *(const int4*)(F.TOKI + (size_t)rbeg * 4); twn = *(const f32x2*)(F.TOKW + (size_t)rbeg * 2);
            if (rbeg + 1 < rend) { tin2 = *(const int4*)(F.TOKI + (size_t)(rbeg + 1) * 4); twn2 = *(const f32x2*)(F.TOKW + (size_t)(rbeg + 1) * 2); }
            const size_t ra = (size_t)(tab[tin.x] + tin.y), rb = (size_t)(tab[tin.z] + tin.w);
#pragma unroll
            for (int j = 0; j < 4; ++j) { yan[j] = *(const u32x2*)(F.YDN + ra * D + 4 * F.lane + 256 * j); ybn[j] = *(const u32x2*)(F.YDN + rb * D + 4 * F.lane + 256 * j); }
        }
    }
#pragma unroll 1
    for (int r = rbeg; r < rend; ++r) {
        const int mr = modrow(r);
        f32x4 v[4]; u32x2 ya[4], yb[4];
#pragma unroll
        for (int j = 0; j < 4; ++j) { v[j] = vn[j]; ya[j] = yan[j]; yb[j] = ybn[j]; }
        const f32x2 tw = twn;
        if (r + 1 < rend) {
#pragma unroll
            for (int j = 0; j < 4; ++j) vn[j] = *(const f32x4*)(F.XS + (size_t)(r + 1) * D + 4 * F.lane + 256 * j);
            if (HAS_MOE) {
                tin = tin2; twn = twn2;
                if (r + 2 < rend) { tin2 = *(const int4*)(F.TOKI + (size_t)(r + 2) * 4); twn2 = *(const f32x2*)(F.TOKW + (size_t)(r + 2) * 2); }
                const size_t ra = (size_t)(tab[tin.x] + tin.y), rb = (size_t)(tab[tin.z] + tin.w);
#pragma unroll
                for (int j = 0; j < 4; ++j) { yan[j] = *(const u32x2*)(F.YDN + ra * D + 4 * F.lane + 256 * j); ybn[j] = *(const u32x2*)(F.YDN + rb * D + 4 * F.lane + 256 * j); }
            }
        }
        const LAS float* mv = MV + (mr == mr_a ? 0 : 3072);
        if (HAS_MOE) {
#pragma unroll
            for (int j = 0; j < 4; ++j) {
                const float yaf[4] = {__uint_as_float(ya[j].x << 16), __uint_as_float(ya[j].x & 0xffff0000u), __uint_as_float(ya[j].y << 16), __uint_as_float(ya[j].y & 0xffff0000u)};
                const float ybf[4] = {__uint_as_float(yb[j].x << 16), __uint_as_float(yb[j].x & 0xffff0000u), __uint_as_float(yb[j].y << 16), __uint_as_float(yb[j].y & 0xffff0000u)};
                const f32x4 g2q = *(const LAS f32x4*)&mv[2048 + 4 * F.lane + 256 * j];
#pragma unroll
                for (int e = 0; e < 4; ++e) v[j][e] += g2q[e] * (yaf[e] * tw.x + ybf[e] * tw.y);
            }
            if (!FINAL) {
#pragma unroll
                for (int j = 0; j < 4; ++j) *(f32x4*)(F.XS + (size_t)r * D + 4 * F.lane + 256 * j) = v[j];
            }
        }
        float ss = 0.f;
#pragma unroll
        for (int j = 0; j < 4; ++j) ss += (v[j].x * v[j].x + v[j].y * v[j].y) + (v[j].z * v[j].z + v[j].w * v[j].w);
        const float rstd = rsqrtf(wave_sum(ss, F.lane) * (1.f / D) + EPS);
        if (FINAL) {
#pragma unroll
            for (int j = 0; j < 4; ++j) { const int c = 4 * F.lane + 256 * j; *(f32x4*)(F.out + (size_t)r * D + c) = v[j] * rstd * *(const LAS f32x4*)&mv[c]; }
        } else {
            float dtp[16];
#pragma unroll
            for (int e = 0; e < 16; ++e) dtp[e] = 0.f;
#pragma unroll
            for (int j = 0; j < 4; ++j) {
                const int c = 4 * F.lane + 256 * j;
                const f32x4 h = v[j] * rstd * *(const LAS f32x4*)&mv[c] + *(const LAS f32x4*)&mv[1024 + c];
                u32x2 o; o.x = pk2(h.x, h.y); o.y = pk2(h.z, h.w);
                *(u32x2*)(F.HN + (size_t)r * D + c) = o;
                dot16_acc(WDT, h, j, F.lane, dtp);
            }
#pragma unroll
            for (int e = 0; e < 16; ++e) dtp[e] = wave_sum(dtp[e], F.lane);
            if (F.lane == 0) {
#pragma unroll
                for (int e4 = 0; e4 < 4; ++e4) *(f32x4*)(F.DT + (size_t)r * 16 + e4 * 4) = (f32x4){dtp[e4 * 4], dtp[e4 * 4 + 1], dtp[e4 * 4 + 2], dtp[e4 * 4 + 3]};
            }
        }
    }
}
__device__ __forceinline__ void phase_inproj(const Frame& F0, int l)  {
    Frame F = enter_phase(F0);
    pg8::PlainSched S; S.T.init(TT / 256, NCOL / 256, F.G, F.bid); S.Bt = (const char*)(F.WIN_T + (size_t)l * NCOL * D); S.K = D;
    pg8::EpiStoreBf16 E{F.COLS, NCOL, 0, nullptr};
    pg8::gemm_phase<pg8::EpiStoreBf16, pg8::PlainSched, true>(F.lds, F.HN, D, S, E, F.tid);
}
__device__ __forceinline__ void conf_unit(const Frame& Fu, int l, int uidx) {
    Frame F = Fu; F.lane = fresh_lane(); F.tid = F.wave * 64 + F.lane;
    const int r0 = uidx * 64;
    LAS bf16* XU = (LAS bf16*)F.lds;
    LAS float* WD = (LAS float*)(F.lds + 94 * 512);
    LAS bf16* CVL = (LAS bf16*)(F.lds + 94 * 512 + 31 * 1024);
    int lo, hi; seq_bounds(r0, lo, hi);
    __syncthreads();
    for (int i = F.tid; i < 94 * 64; i += NTHR) {
        const int rr = r0 - 15 + (i >> 6), c = (i & 63) * 4;
        u32x2 o = {0u, 0u};
        if (rr >= lo && rr < hi) { float a[4], g[4]; ld4(F.COLS + (size_t)rr * NCOL + 1536 + c, a); ld4(F.COLS + (size_t)rr * NCOL + 1792 + c, g);
            o.x = pk2(a[0] * sigmoidf_(g[0]), a[1] * sigmoidf_(g[1])); o.y = pk2(a[2] * sigmoidf_(g[2]), a[3] * sigmoidf_(g[3])); }
        *(LAS u32x2*)(XU + (i >> 6) * 256 + c) = o;
    }
    for (int i = F.tid; i < 31 * 64; i += NTHR) *(LAS f32x4*)&WD[i * 4] = *(const f32x4*)(F.in[I_CDW] + (size_t)l * 31 * 256 + i * 4);
    __syncthreads();
    const int ch = 4 * F.lane;
    const f32x4 db = *(const f32x4*)(F.in[I_CDB] + l * 256 + ch), lg = *(const f32x4*)(F.in[I_CLG] + l * 256 + ch), lb = *(const f32x4*)(F.in[I_CLB] + l * 256 + ch);
#pragma unroll 1
    for (int i = 0; i < 8; ++i) {
        const int lr = F.wave * 8 + i;
        f32x4 acc = db;
#pragma unroll
        for (int j = 0; j < 31; ++j) {
            const u32x2 xv = *(const LAS u32x2*)(XU + (lr + j) * 256 + ch); const f32x4 w = *(const LAS f32x4*)&WD[j * 256 + ch];
            acc.x = fmaf(w.x, __uint_as_float(xv.x << 16), acc.x); acc.y = fmaf(w.y, __uint_as_float(xv.x & 0xffff0000u), acc.y);
            acc.z = fmaf(w.z, __uint_as_float(xv.y << 16), acc.z); acc.w = fmaf(w.w, __uint_as_float(xv.y & 0xffff0000u), acc.w);
        }
        const float mean = wave_sum((acc.x + acc.y) + (acc.z + acc.w), F.lane) * (1.f / 256.f);
        const f32x4 d = acc - mean;
        const float var = wave_sum((d.x * d.x + d.y * d.y) + (d.z * d.z + d.w * d.w), F.lane) * (1.f / 256.f);
        const f32x4 y = d * rsqrtf(var + EPS) * lg + lb;
        u32x2 o; o.x = pk2(siluf_(y.x), siluf_(y.y)); o.y = pk2(siluf_(y.z), siluf_(y.w));
        *(LAS u32x2*)(CVL + lr * S5_US + ch) = o;
    }
    __syncthreads();
    {
        int lane_ = F.lane; asm volatile("" : "+v"(lane_));
        const int q = lane_ >> 4, c16 = lane_ & 15;
        const bf16* PW = F.PW_T + (size_t)l * 256 * 256;
        f32x4 acc[2][4];
#pragma unroll
        for (int nt = 0; nt < 2; ++nt)
#pragma unroll
            for (int rt = 0; rt < 4; ++rt) acc[nt][rt] = (f32x4){0.f, 0.f, 0.f, 0.f};
#pragma unroll 2
        for (int ks = 0; ks < 8; ++ks) {
            pg8::bf16x8 wf[2], vf[4];
#pragma unroll
            for (int nt = 0; nt < 2; ++nt) wf[nt] = *(const pg8::bf16x8*)(PW + (size_t)(32 * F.wave + 16 * nt + c16) * 256 + 32 * ks + 8 * q);
#pragma unroll
            for (int rt = 0; rt < 4; ++rt) vf[rt] = *(const LAS pg8::bf16x8*)(CVL + (16 * rt + c16) * S5_US + 32 * ks + 8 * q);
#pragma unroll
            for (int nt = 0; nt < 2; ++nt)
#pragma unroll
                for (int rt = 0; rt < 4; ++rt) acc[nt][rt] = __builtin_amdgcn_mfma_f32_16x16x32_bf16(wf[nt], vf[rt], acc[nt][rt], 0, 0, 0);
        }
        const float* pb = F.in[I_CPB] + l * 256;
#pragma unroll
        for (int nt = 0; nt < 2; ++nt) { const int n0 = 32 * F.wave + 16 * nt + 4 * q; const f32x4 bv = *(const f32x4*)(pb + n0);
#pragma unroll
            for (int rt = 0; rt < 4; ++rt) { u32x2 w; w.x = pk2(acc[nt][rt][0] + bv[0], acc[nt][rt][1] + bv[1]); w.y = pk2(acc[nt][rt][2] + bv[2], acc[nt][rt][3] + bv[3]);
                *(u32x2*)(F.MIX + (size_t)(r0 + 16 * rt + c16) * 1024 + 512 + n0) = w; } }
    }
}
__device__ __forceinline__ void expert_cvt_item(const Frame& F, int l, int it, LAS float* scr) {
    const int mtx = it >> 9, r = it & 511, e = mtx / 3, kind = mtx % 3;
    const size_t wofs = ((size_t)l * NEXP + e) * D * D;
    if (kind == 0) transpose_item(F.in[I_WG] + wofs, D, D, F.WGU_T + (size_t)e * 2048 * D, [](int n) { return (n >> 7) * 256 + (n & 127); }, scr, r, F.lane);
    else if (kind == 1) transpose_item(F.in[I_WU] + wofs, D, D, F.WGU_T + (size_t)e * 2048 * D, [](int n) { return (n >> 7) * 256 + 128 + (n & 127); }, scr, r, F.lane);
    else transpose_item(F.in[I_WD] + wofs, D, D, F.WD_T + (size_t)e * D * D, [](int n) { return n; }, scr, r, F.lane);
}
__device__ __forceinline__ void phase_scan(const Frame& F0, int l)  {
    Frame F = enter_phase(F0);
    const int RLc = (l == 0) ? TT : TL;
    const int NU = 288 + 288 + RLc / 64;
    const int gw = F.bid * NWAVES + F.wave, NGW = F.G * NWAVES;
    LAS float* scr = (LAS float*)(F.lds + 131072 - NWAVES * 8448) + F.wave * (64 * 33);
    int cv = gw;
    const int nconf = RLc / 64, nb2 = F.G - 32;
    for (int k = 0; k < 6; ++k) {
        int kind = -1, idx = 0;
        if (F.G == 256) {
            if (k == 0) { kind = 0; idx = F.bid; }
            else if (F.bid < 32) { if (k == 1) { kind = 0; idx = 256 + F.bid; } }
            else { const int j = F.bid - 32;
                if (k == 1) { kind = 1; idx = j; } else if (k == 2) { kind = 2; idx = j; }
                else if (k == 3) { if (j + nb2 < 288) { kind = 1; idx = j + nb2; } } else if (k == 4) { if (j + nb2 < nconf) { kind = 2; idx = j + nb2; } } }
        } else {
            const int u = F.bid + k * F.G; if (u < 288) { kind = 0; idx = u; } else if (u < 576) { kind = 1; idx = u - 288; } else if (u < 576 + nconf) { kind = 2; idx = u - 576; }
        }
        if (kind == 0) ssd_unit_a(F, l, idx);
        else if (kind == 1) s5_unit<0>(F, l, idx);
        else if (kind == 2) conf_unit(F, l, idx);
        __syncthreads();
#pragma unroll 1
        for (int k2 = 0; k2 < 2 && cv < 48 * 512; ++k2, cv += NGW) expert_cvt_item(F, l, cv, scr);
    }
    __syncthreads();
    for (; cv < 48 * 512; cv += NGW) expert_cvt_item(F, l, cv, scr);
}
__device__ __forceinline__ void phase_carry(const Frame& F0, int l)  {
    Frame F = enter_phase(F0);
    s5_carry(F, l);
    ssd_carry(F);
}
__device__ __forceinline__ void phase_mix1(const Frame& F0, int l)  {
    Frame F = enter_phase(F0);
    const int RL = (l == 0) ? TT : TL;
    for (int u = F.bid; u < 288 + 288; u += F.G) {
        if (u < 288) { if (l == 0 || ((u >> 1) % 18) >= 2) ssd_unit_b(F, l, u); }
        else { const int v = u - 288; if (l == 0 || (v % 36) >= 4) s5_unit<1>(F, l, v); }
    }
}
__device__ __forceinline__ void phase_wout(const Frame& F0, int l)  {
    Frame F = enter_phase(F0);
    const int RL = (l == 0) ? TT : TL;
    pg8::PlainSched S; S.T.init(RL / 256, D / 256, F.G, F.bid); S.Bt = (const char*)(F.WOUT_T + (size_t)l * D * D); S.K = D;
    pg8::EpiResidual E{F.XS, F.MOD + (size_t)l * 9 * 6144 + 2048};
    pg8::gemm_phase<pg8::EpiResidual, pg8::PlainSched, true>(F.lds, F.MIX, D, S, E, F.tid);
}
__device__ __forceinline__ void phase_norm2(const Frame& F0, int l)  {
    Frame F = enter_phase(F0);
    const int RL = (l == 0) ? TT : TL;
    LAS float* RW = (LAS float*)F.lds;
    __syncthreads();
    stage_wt16(RW, F.in[I_RW], 16, F.tid);
    LAS int* lcnt = (LAS int*)(F.lds + 65536);
    if (F.tid < 32) lcnt[F.tid] = 0;
    __syncthreads();
    const int gw = F.bid * NWAVES + F.wave, NGW = F.G * NWAVES;
    const int RPW = (RL + NGW - 1) / NGW, rbeg = gw * RPW, rend = (rbeg + RPW < RL) ? rbeg + RPW : RL;
    const float* gvec = F.in[I_GFFN] + l * D;
    f32x4 gv[4], shv[4], scv[4], vn[4]; int cur_mr = -1;
#pragma unroll
    for (int j = 0; j < 4; ++j) gv[j] = *(const f32x4*)(gvec + 4 * F.lane + 256 * j);
    if (rbeg < rend) {
#pragma unroll
        for (int j = 0; j < 4; ++j) vn[j] = *(const f32x4*)(F.XS + (size_t)rbeg * D + 4 * F.lane + 256 * j);
    }
#pragma unroll 1
    for (int r = rbeg; r < rend; ++r) {
        const int mr = modrow(r);
        f32x4 v[4]; float ss = 0.f;
#pragma unroll
        for (int j = 0; j < 4; ++j) { v[j] = vn[j]; ss += (v[j].x * v[j].x + v[j].y * v[j].y) + (v[j].z * v[j].z + v[j].w * v[j].w); }
        if (r + 1 < rend) {
#pragma unroll
            for (int j = 0; j < 4; ++j) vn[j] = *(const f32x4*)(F.XS + (size_t)(r + 1) * D + 4 * F.lane + 256 * j);
        }
        if (mr != cur_mr) { cur_mr = mr;
#pragma unroll
            for (int j = 0; j < 4; ++j) { const int c = 4 * F.lane + 256 * j; shv[j] = *(const f32x4*)(F.MOD + ((size_t)l * 9 + mr) * 6144 + 3072 + c); scv[j] = *(const f32x4*)(F.MOD + ((size_t)l * 9 + mr) * 6144 + 4096 + c); } }
        const float rstd = rsqrtf(wave_sum(ss, F.lane) * (1.f / D) + EPS);
        float lg[16];
#pragma unroll
        for (int e = 0; e < 16; ++e) lg[e] = 0.f;
#pragma unroll
        for (int j = 0; j < 4; ++j) {
            const int c = 4 * F.lane + 256 * j;
            const f32x4 h = v[j] * rstd * gv[j] * (scv[j] + 1.f) + shv[j];
            u32x2 o; o.x = pk2(h.x, h.y); o.y = pk2(h.z, h.w);
            *(u32x2*)(F.HN + (size_t)r * D + c) = o;
            dot16_acc(RW, h, j, F.lane, lg);
        }
        float mx = -3.0e38f;
#pragma unroll
        for (int e = 0; e < 16; ++e) { lg[e] = wave_sum(lg[e], F.lane) + F.in[I_RB][e]; mx = fmaxf(mx, lg[e]); }
        float den = 0.f;
#pragma unroll
        for (int e = 0; e < 16; ++e) { lg[e] = expf(lg[e] - mx); den += lg[e]; }
        const float inv = 1.f / den;
#pragma unroll
        for (int e = 0; e < 16; ++e) lg[e] *= inv;
        float gs[4];
#pragma unroll
        for (int gI = 0; gI < 4; ++gI) {
            const float p0 = lg[gI * 4], p1 = lg[gI * 4 + 1], p2 = lg[gI * 4 + 2], p3 = lg[gI * 4 + 3];
            const float h01 = fmaxf(p0, p1), l01 = fminf(p0, p1), h23 = fmaxf(p2, p3), l23 = fminf(p2, p3);
            gs[gI] = fmaxf(h01, h23) + fmaxf(fminf(h01, h23), fmaxf(l01, l23));
        }
        int best = 0; float bsv = gs[0];
#pragma unroll
        for (int gI = 1; gI < 4; ++gI) if (gs[gI] > bsv) { bsv = gs[gI]; best = gI; }
        float q[4];
#pragma unroll
        for (int i = 0; i < 4; ++i) q[i] = best == 0 ? lg[i] : (best == 1 ? lg[4 + i] : (best == 2 ? lg[8 + i] : lg[12 + i]));
        int i0 = 0; float v0 = q[0];
#pragma unroll
        for (int i = 1; i < 4; ++i) if (q[i] > v0) { v0 = q[i]; i0 = i; }
        int i1 = -1; float v1 = -1.f;
#pragma unroll
        for (int i = 0; i < 4; ++i) if (i != i0 && q[i] > v1) { v1 = q[i]; i1 = i; }
        const float ginv = 1.f / (v0 + v1);
        if (F.lane == 0) {
            const int e0 = best * 4 + i0, e1 = best * 4 + i1;
            const int p0 = __hip_atomic_fetch_add(&lcnt[e0], 1, __ATOMIC_RELAXED, __HIP_MEMORY_SCOPE_WORKGROUP), p1 = __hip_atomic_fetch_add(&lcnt[e1], 1, __ATOMIC_RELAXED, __HIP_MEMORY_SCOPE_WORKGROUP);
            *(int4*)(F.TOKI + (size_t)r * 4) = make_int4(e0, p0, e1, p1);
            *(f32x2*)(F.TOKW + (size_t)r * 2) = (f32x2){v0 * ginv, v1 * ginv};
        }
    }
    __syncthreads();
    if (F.tid < 16) lcnt[16 + F.tid] = (int)atomicAdd(&F.ctl[CW_CNT + l * 64 + F.tid], (unsigned)lcnt[F.tid]);
    __syncthreads();
    if (F.lane == 0) {
        for (int r = rbeg; r < rend; ++r) {
            int4 ti = *(const int4*)(F.TOKI + (size_t)r * 4);
            ti.y += lcnt[16 + ti.x]; ti.w += lcnt[16 + ti.z];
            *(int4*)(F.TOKI + (size_t)r * 4) = ti;
            F.LIST[(size_t)ti.x * TT + ti.y] = r; F.LIST[(size_t)ti.z * TT + ti.w] = r;
        }
    }
}
__device__ __forceinline__ void phase_gateup(const Frame& F0, int l)  {
    Frame F = enter_phase(F0);
    LAS int* tab = moe_tables(F, l);
    LAS int* rows = (LAS int*)(F.lds + ROWS_OFF);
    pg8::MoeSched<true> S; S.T.init(tab[16] / 256, 8, F.G, F.bid); S.Bt = (const char*)F.WGU_T; S.K = D; S.NE = 2048; S.tab = tab; S.rows = rows;
    {
        pg8::Unit u;
        for (int i = 0; i < 15 && S.next(i, u); ++i) {
            if (F.tid < 256) { const int sr = u.pm * 256 + F.tid, e = S.expert(u.pm), pos = sr - tab[e], cnt = tab[40 + e];
                rows[i * 256 + F.tid] = F.LIST[(size_t)e * TT + (pos < cnt ? pos : 0)]; }
        }
        __syncthreads();
    }
    pg8::EpiPairBf16<0> E{F.HMID, 1024, 0, nullptr, 0};
    pg8::gemm_phase<pg8::EpiPairBf16<0>, pg8::MoeSched<true>, true>(F.lds, F.HN, D, S, E, F.tid);
}
__device__ __forceinline__ void phase_down(const Frame& F0, int l)  {
    Frame F = enter_phase(F0);
    LAS int* tab = moe_tables(F, l);
    pg8::MoeSched<false> S; S.T.init(tab[16] / 256, 4, F.G, F.bid); S.Bt = (const char*)F.WD_T; S.K = D; S.NE = 1024; S.tab = tab; S.rows = nullptr;
    pg8::EpiStoreBf16 E{F.YDN, 1024, 0, nullptr};
    pg8::gemm_phase<pg8::EpiStoreBf16, pg8::MoeSched<false>, true>(F.lds, F.HMID, D, S, E, F.tid);
}

constexpr int PH_PER_LAYER = 9, N_PHASES = 1 + DEPTH * PH_PER_LAYER + 1;

__global__ void __launch_bounds__(NTHR, 2) fwd_kernel(Args args) {
    extern __shared__ __attribute__((aligned(16))) unsigned char lds_raw[];
    Frame F;
    F.lds = (LAS unsigned char*)lds_raw;
    F.tid = threadIdx.x; F.lane = F.tid & 63; F.wave = __builtin_amdgcn_readfirstlane(F.tid >> 6);
    F.G = gridDim.x; F.bid = blockIdx.x;
    F.in = (const CAS cfp_t*)__builtin_amdgcn_kernarg_segment_ptr(); F.out = args.out; F.ws = args.ws;
    frame_ptrs(F, args.ws);
    volatile LAS unsigned* MISC = (volatile LAS unsigned*)(F.lds + MISC_OFF);
    if (F.tid < 32) MISC[F.tid] = 0u;
    __syncthreads();
    const int lo = args.ph_lo, hi = args.ph_hi;
    const bool multi = (hi - lo) > 1;
    XcdBarrier bar; bar.bar = F.ctl + CW_BAR; bar.x = 0; bar.st = MISC + 8;
    if (multi) bar = xcd_barrier_post(F.ctl + CW_BAR, MISC + 8);
#define IN(k) (lo <= (k) && (k) < hi)
#define SEAM(k) do { if (IN(k) && IN((k) + 1)) { XcdBarrier bb_ = bar; asm volatile("" : "+s"(bb_.bar)); xcd_barrier(bb_); } } while (0)
    if (IN(0)) phase_p0(F);
    SEAM(0);
    for (int l = 0; l < DEPTH; ++l) {
        const int pb = 1 + l * PH_PER_LAYER;
        if (IN(pb + 0)) { if (l == 0) phase_rowA<0>(F, l); else phase_rowA<1>(F, l); }
        SEAM(pb + 0);
        if (IN(pb + 1)) phase_inproj(F, l);
        SEAM(pb + 1);
        if (IN(pb + 2)) phase_scan(F, l);
        SEAM(pb + 2);
        if (IN(pb + 3)) phase_carry(F, l);
        SEAM(pb + 3);
        if (IN(pb + 4)) phase_mix1(F, l);
        SEAM(pb + 4);
        if (IN(pb + 5)) phase_wout(F, l);
        SEAM(pb + 5);
        if (IN(pb + 6)) phase_norm2(F, l);
        SEAM(pb + 6);
        if (IN(pb + 7)) phase_gateup(F, l);
        SEAM(pb + 7);
        if (IN(pb + 8)) phase_down(F, l);
        SEAM(pb + 8);
    }
    if (IN(N_PHASES - 1)) phase_rowA<2>(F, DEPTH);
#undef IN
#undef SEAM
}

extern "C" void kernel_launch(void* const* d_in, const int* in_sizes, int n_in, void* d_out, int out_size, void* d_ws, size_t ws_size, hipStream_t stream) {
    static int grid = 0;
    if (grid == 0) {
        if (n_in != N_IN || out_size != TL * D || ws_size < WS_END) { fprintf(stderr, "kernel_launch: unexpected shapes (n_in %d out %d ws %zu)\n", n_in, out_size, ws_size); grid = -1; return; }
        int dev = 0, cus = 0, per_cu = 0;
        if (hipGetDevice(&dev) != hipSuccess || hipDeviceGetAttribute(&cus, hipDeviceAttributeMultiprocessorCount, dev) != hipSuccess) { grid = -1; return; }
        if (hipFuncSetAttribute((const void*)fwd_kernel, hipFuncAttributeMaxDynamicSharedMemorySize, LDS_BYTES) != hipSuccess) { fprintf(stderr, "kernel_launch: hipFuncSetAttribute failed\n"); grid = -1; return; }
        if (hipOccupancyMaxActiveBlocksPerMultiprocessor(&per_cu, (const void*)fwd_kernel, NTHR, LDS_BYTES) != hipSuccess || per_cu < 1) { fprintf(stderr, "kernel_launch: occupancy query says %d\n", per_cu); }
        (void)hipGetLastError();
        grid = cus;
    }
    if (grid < 0) return;
    if (hipMemsetAsync((char*)d_ws + WS_CTL, 0, CTL_ZERO_BYTES, stream) != hipSuccess) return;
    Args a{};
    for (int i = 0; i < N_IN; ++i) a.in[i] = (const float*)d_in[i];
    a.out = (float*)d_out; a.ws = (unsigned char*)d_ws;
#if MK_ONE_LAUNCH
    a.ph_lo = 0; a.ph_hi = N_PHASES;
    hipLaunchKernelGGL(fwd_kernel, dim3(grid), dim3(NTHR), LDS_BYTES, stream, a);
#else
    for (int p = 0; p < N_PHASES; ++p) { a.ph_lo = p; a.ph_hi = p + 1; hipLaunchKernelGGL(fwd_kernel, dim3(grid), dim3(NTHR), LDS_BYTES, stream, a); }
#endif
}
```

```cpp
#include <hip/hip_runtime.h>
#include <cstdio>
#include <cstdint>

#ifndef MK_ONE_LAUNCH
#define MK_ONE_LAUNCH 1
#endif

#define GAS __attribute__((address_space(1)))
#define LAS __attribute__((address_space(3)))
#define CAS __attribute__((address_space(4)))
typedef const float* cfp_t;
typedef unsigned short bf16;
typedef float f32x4 __attribute__((ext_vector_type(4)));
typedef float f32x2 __attribute__((ext_vector_type(2)));
typedef unsigned u32x4 __attribute__((ext_vector_type(4)));
typedef unsigned u32x2 __attribute__((ext_vector_type(2)));

constexpr int D = 1024, NB = 8, SEQ = 2048, CTXL = 256, DEPTH = 2;
constexpr int TL = NB * SEQ, TC = NB * CTXL, TT = TL + TC;
constexpr int INC = 2320;
constexpr int NCOL = 2304;
constexpr int VSEQ = CTXL + SEQ;
constexpr int NEXP = 16;
constexpr float EPS = 1e-6f;

enum { I_X = 0, I_C, I_CTX, I_CCTX, I_WADA, I_BADA, I_GMIX, I_WIN, I_SCW, I_SCB, I_SDTB, I_SALOG, I_SD, I_SNG,
       I_CDW, I_CDB, I_CLG, I_CLB, I_CPW, I_CPB, I_LRE, I_LIM, I_LSTEP, I_BRE, I_BIM, I_CRE, I_CIM, I_S5D, I_GLUW, I_GLUB,
       I_WOUT, I_GFFN, I_RW, I_RB, I_WG, I_WU, I_WD, I_GFIN, N_IN };

constexpr size_t MiB = 1u << 20;
constexpr size_t WS_CTL = 0, CTL_ZERO_BYTES = 64 * 1024;
constexpr size_t WS_MOD = 1 * MiB;
constexpr size_t WS_MODP = 2 * MiB;
constexpr size_t WS_DT = 6 * MiB;
constexpr size_t WS_S5AA = 5 * MiB + 512 * 1024;
constexpr size_t WS_S5BB = WS_S5AA + 32 * 1024;
constexpr size_t WS_S5CM = WS_S5BB + 256 * 1024;
constexpr size_t WS_TOKI = 7 * MiB + 512 * 1024;
constexpr size_t WS_TOKW = WS_TOKI + (size_t)TT * 16;
constexpr size_t WS_XS = 8 * MiB;
constexpr size_t WS_HN = 80 * MiB;
constexpr size_t WS_COLS = 116 * MiB;
constexpr size_t WS_XBCC = 197 * MiB;
constexpr size_t WS_CC = 197 * MiB;
constexpr size_t WS_YI = 207 * MiB;
constexpr size_t WS_SST = 226 * MiB;
constexpr size_t WS_HIN = 264 * MiB;
constexpr size_t WS_EDEC = 302 * MiB;
constexpr size_t WS_TOT = 304 * MiB;
constexpr size_t WS_YSSD = 233 * MiB;
constexpr size_t WS_MIX = 305 * MiB;
constexpr size_t WS_YS5 = 341 * MiB;
constexpr size_t WS_S5HL = 341 * MiB;
constexpr size_t WS_S5HI = 346 * MiB;
constexpr size_t WS_CU = 377 * MiB;
constexpr size_t WS_CV = 395 * MiB;
constexpr size_t WS_LIST = 413 * MiB;
constexpr size_t WS_WIN_T = 415 * MiB;
constexpr size_t WS_WOUT_T = 424 * MiB;
constexpr size_t WS_PW_T = 428 * MiB;
constexpr size_t WS_GLU_T = 428 * MiB + 512 * 1024;
constexpr size_t WS_WGU_T = 429 * MiB;
constexpr size_t WS_WD_T = 493 * MiB;
constexpr size_t WS_END = 525 * MiB;
constexpr int MOE_ROWS = 2 * TT + NEXP * 256;
constexpr size_t WS_HMID = WS_COLS;
constexpr size_t WS_YDN = WS_XBCC;
constexpr size_t WS_YG = WS_CU;
static_assert(WS_HMID + (size_t)MOE_ROWS * 1024 * 2 <= WS_XBCC, "HMID overlay");
static_assert(WS_YDN + (size_t)MOE_ROWS * 1024 * 2 <= WS_MIX, "YDN overlay");
constexpr int CW_CNT = 64;
constexpr int CW_BAR = 1024;

constexpr int NWAVES = 8, NTHR = 512;
constexpr int LDS_BYTES = 147456;
constexpr int MISC_OFF = 131072 + 320;
constexpr int TAB_OFF = 131072 + 512, ROWS_OFF = TAB_OFF + 256;

__device__ __forceinline__ float bf2f(bf16 v) { return __uint_as_float((unsigned)v << 16); }
__device__ __forceinline__ unsigned f2bf(float f) { unsigned u = __float_as_uint(f); return (u + 0x7fffu + ((u >> 16) & 1u)) >> 16; }
typedef __bf16 bf16x2_t __attribute__((ext_vector_type(2)));
__device__ __forceinline__ unsigned pk2(float lo, float hi) { f32x2 v = {lo, hi}; return __builtin_bit_cast(unsigned, __builtin_convertvector(v, bf16x2_t)); }
__device__ __forceinline__ float shx(float v, int m, int lane) { return __int_as_float(__builtin_amdgcn_ds_bpermute((lane ^ m) << 2, __float_as_int(v))); }
__device__ __forceinline__ float wave_sum(float v, int lane) {
    (void)lane;
    v += __int_as_float(__builtin_amdgcn_update_dpp(0, __float_as_int(v), 0xB1, 0xF, 0xF, false));
    v += __int_as_float(__builtin_amdgcn_update_dpp(0, __float_as_int(v), 0x4E, 0xF, 0xF, false));
    v += __int_as_float(__builtin_amdgcn_update_dpp(0, __float_as_int(v), 0x141, 0xF, 0xF, false));
    v += __int_as_float(__builtin_amdgcn_update_dpp(0, __float_as_int(v), 0x140, 0xF, 0xF, false));
    const int iv = __float_as_int(v);
    return (__int_as_float(__builtin_amdgcn_readlane(iv, 0)) + __int_as_float(__builtin_amdgcn_readlane(iv, 16))) + (__int_as_float(__builtin_amdgcn_readlane(iv, 32)) + __int_as_float(__builtin_amdgcn_readlane(iv, 48)));
}
__device__ __forceinline__ float sigmoidf_(float x) { return 1.f / (1.f + __expf(-x)); }
__device__ __forceinline__ float siluf_(float x) { return x / (1.f + __expf(-x)); }
__device__ __forceinline__ float softplusf_(float x) { return fmaxf(x, 0.f) + log1pf(__expf(-fabsf(x))); }
__device__ __forceinline__ float gelu_tanh(float x) { const float u2 = 1.5957691216057308f * (x + 0.044715f * x * x * x); return x / (1.f + __expf(-u2)); }
__device__ __forceinline__ void sincos_red(float x, float& s, float& c) {
    const float k = rintf(x * 0.15915494309189535f);
    float r = fmaf(-k, 6.2831854820251465f, x); r = fmaf(-k, -1.7484555e-7f, r);
    s = __sinf(r); c = __cosf(r);
}
__device__ __forceinline__ int opaque_v(int v) { asm volatile("" : "+v"(v)); return v; }
__device__ __forceinline__ int modrow(int r) { return r < TL ? (r >> 11) : 8; }
__device__ __forceinline__ void seq_bounds(int r, int& lo, int& hi) {
    if (r < TL) { lo = r & ~(SEQ - 1); hi = lo + SEQ; } else { lo = TL + ((r - TL) & ~(CTXL - 1)); hi = lo + CTXL; }
}
__device__ __forceinline__ int vrow(int b, int dir, int s) {
    if (s < CTXL) return TL + b * CTXL + (dir ? CTXL - 1 - s : s);
    const int t = s - CTXL; return b * SEQ + (dir ? SEQ - 1 - t : t);
}

#define XB_TMO      128
#define XB_XCNT(j)  (256  + 64 * (j))
#define XB_XSUB(j)  (1280 + 64 * (j))
#define XB_XGEN(j)  (2304 + 64 * (j))
#define XB_TOP      3328
#define XB_TOPGEN   3392
#define XCD_BAR_WORDS 3456
#define XB_SPIN_CAP (1u << 18)
__device__ __forceinline__ unsigned xb_ld(unsigned* p)              { return __hip_atomic_load(p, __ATOMIC_RELAXED, __HIP_MEMORY_SCOPE_AGENT); }
__device__ __forceinline__ unsigned xb_add(unsigned* p, unsigned v) { return __hip_atomic_fetch_add(p, v, __ATOMIC_RELAXED, __HIP_MEMORY_SCOPE_AGENT); }
__device__ __forceinline__ unsigned xb_xcc_id() { return (unsigned)__builtin_amdgcn_s_getreg((3 << 11) | 20) & 0xFu; }
#define XB_SPIN(cond, bar) do { unsigned _sp = 0; while (cond) { __builtin_amdgcn_s_sleep(1); \
    if ((++_sp & 255u) == 0u) { if (xb_ld(&(bar)[XB_TMO])) break; if (_sp > XB_SPIN_CAP) { atomicAdd(&(bar)[XB_TMO], 1u); break; } } } } while (0)
struct XcdBarrier { unsigned* bar; unsigned x; volatile LAS unsigned* st; };
__device__ __forceinline__ XcdBarrier xcd_barrier_post(unsigned* bar, volatile LAS unsigned* st) {
    XcdBarrier b; b.bar = bar; b.x = xb_xcc_id(); b.st = st;
    if (threadIdx.x == 0) (void)xb_add(&bar[XB_XCNT(b.x)], 1u);
    return b;
}
__device__ __forceinline__ void xcd_barrier_complete(unsigned* bar, unsigned x, unsigned& nloc, unsigned& nx) {
    const unsigned G = gridDim.x * gridDim.y * gridDim.z;
    unsigned sum, cnt, mine, sp = 0u;
    for (;;) {
        sum = 0u; cnt = 0u; mine = 0u;
#pragma unroll
        for (unsigned j = 0; j < 16; ++j) { const unsigned c = xb_ld(&bar[XB_XCNT(j)]); sum += c; cnt += (c > 0u) ? 1u : 0u; mine = (j == x) ? c : mine; }
        if (sum == G) break;
        __builtin_amdgcn_s_sleep(1);
        if ((++sp & 255u) == 0u) { if (xb_ld(&bar[XB_TMO])) break; if (sp > XB_SPIN_CAP) { atomicAdd(&bar[XB_TMO], 1u); break; } }
    }
    nloc = mine > 0u ? mine : 1u; nx = cnt > 0u ? cnt : 1u;
}
__device__ __forceinline__ void xcd_barrier(const XcdBarrier& b) {
    asm volatile("s_waitcnt vmcnt(0)" ::: "memory");
    __syncthreads();
    if (threadIdx.x == 0) {
        unsigned* bar = b.bar;
        const unsigned bx = xb_xcc_id();
        __builtin_amdgcn_s_waitcnt(0);
        unsigned nloc = b.st[0], nx = b.st[1];
        if (nloc == 0u) { xcd_barrier_complete(bar, bx, nloc, nx); b.st[0] = nloc; b.st[1] = nx; }
        const unsigned old = xb_add(&bar[XB_XSUB(bx)], 1u);
        const unsigned gen = old / nloc;
        if (old + 1u == (gen + 1u) * nloc) {
            __builtin_amdgcn_fence(__ATOMIC_RELEASE, "agent");
            asm volatile("s_waitcnt vmcnt(0)" ::: "memory");
            const unsigned og = xb_add(&bar[XB_TOP], 1u);
            const unsigned tg = og / nx;
            if (og + 1u == (tg + 1u) * nx) xb_add(&bar[XB_TOPGEN], 1u);
            else XB_SPIN(xb_ld(&bar[XB_TOPGEN]) == tg, bar);
            __builtin_amdgcn_fence(__ATOMIC_ACQUIRE, "agent");
            xb_add(&bar[XB_XGEN(bx)], 1u);
            asm volatile("s_waitcnt vmcnt(0)" ::: "memory");
        } else {
            XB_SPIN(xb_ld(&bar[XB_XGEN(bx)]) == gen, bar);
            __builtin_amdgcn_fence(__ATOMIC_ACQUIRE, "agent");
            asm volatile("s_waitcnt vmcnt(0)" ::: "memory");
        }
    }
    __syncthreads();
}

struct Args { const float* in[N_IN]; float* out; unsigned char* ws; int ph_lo, ph_hi; };
struct Frame {
    LAS unsigned char* lds;
    int tid, lane, wave, G, bid;
    const CAS cfp_t* in;
    float* out; unsigned char* ws;
    unsigned* ctl;
    float *MOD, *MODP, *DT, *XS, *YSSD, *YS5, *CU;
    bf16 *HN, *COLS, *XBCC, *MIX, *HMID, *CV, *YG, *YDN, *WIN_T, *WOUT_T, *PW_T, *GLU_T, *WGU_T, *WD_T;
    int* LIST; int* TOKI; float* TOKW;
};
__device__ __forceinline__ void frame_ptrs(Frame& F, unsigned char* ws) {
    F.ws = ws; F.ctl = (unsigned*)(ws + WS_CTL);
    F.MOD = (float*)(ws + WS_MOD); F.MODP = (float*)(ws + WS_MODP); F.DT = (float*)(ws + WS_DT); F.XS = (float*)(ws + WS_XS);
    F.YSSD = (float*)(ws + WS_YSSD); F.YS5 = (float*)(ws + WS_YS5); F.CU = (float*)(ws + WS_CU); F.CV = (bf16*)(ws + WS_CV); F.YDN = (bf16*)(ws + WS_YDN); F.YG = (bf16*)(ws + WS_YG);
    F.WIN_T = (bf16*)(ws + WS_WIN_T); F.WOUT_T = (bf16*)(ws + WS_WOUT_T); F.PW_T = (bf16*)(ws + WS_PW_T); F.GLU_T = (bf16*)(ws + WS_GLU_T); F.WGU_T = (bf16*)(ws + WS_WGU_T); F.WD_T = (bf16*)(ws + WS_WD_T);
    F.HN = (bf16*)(ws + WS_HN); F.COLS = (bf16*)(ws + WS_COLS); F.XBCC = (bf16*)(ws + WS_XBCC); F.MIX = (bf16*)(ws + WS_MIX); F.HMID = (bf16*)(ws + WS_HMID);
    F.LIST = (int*)(ws + WS_LIST); F.TOKI = (int*)(ws + WS_TOKI); F.TOKW = (float*)(ws + WS_TOKW);
}
__device__ __forceinline__ int fresh_lane() { unsigned om = ~0u; asm volatile("" : "+s"(om)); int ln = (int)__builtin_amdgcn_mbcnt_hi(om, __builtin_amdgcn_mbcnt_lo(om, 0u)); asm volatile("" : "+v"(ln)); return ln; }
__device__ __forceinline__ Frame enter_phase(const Frame& F0) {
    Frame F = F0; unsigned om = ~0u; asm volatile("" : "+s"(om)); int ln = (int)__builtin_amdgcn_mbcnt_hi(om, __builtin_amdgcn_mbcnt_lo(om, 0u)); asm volatile("" : "+v"(ln));
    int wv_ = F0.wave, bid_ = F0.bid, g_ = F0.G; asm volatile("" : "+s"(wv_), "+s"(bid_), "+s"(g_));
    F.wave = wv_; F.bid = bid_; F.G = g_; F.lane = ln; F.tid = wv_ * 64 + ln;
    unsigned char* ws = F0.ws; asm volatile("" : "+s"(ws)); frame_ptrs(F, ws);
    const CAS cfp_t* ka = (const CAS cfp_t*)__builtin_amdgcn_kernarg_segment_ptr(); asm volatile("" : "+s"(ka)); F.in = ka;
    return F;
}

__device__ __forceinline__ void ld4(const float* p, float (&v)[4]) { const f32x4 t = *(const f32x4*)p; v[0] = t.x; v[1] = t.y; v[2] = t.z; v[3] = t.w; }
__device__ __forceinline__ void ld4(const bf16* p, float (&v)[4]) { const u32x2 t = *(const u32x2*)p; v[0] = __uint_as_float(t.x << 16); v[1] = __uint_as_float(t.x & 0xffff0000u); v[2] = __uint_as_float(t.y << 16); v[3] = __uint_as_float(t.y & 0xffff0000u); }

__device__ __forceinline__ void ld8(const bf16* p, float (&v)[8]) { const u32x4 t = *(const u32x4*)p;
    v[0] = __uint_as_float(t.x << 16); v[1] = __uint_as_float(t.x & 0xffff0000u); v[2] = __uint_as_float(t.y << 16); v[3] = __uint_as_float(t.y & 0xffff0000u);
    v[4] = __uint_as_float(t.z << 16); v[5] = __uint_as_float(t.z & 0xffff0000u); v[6] = __uint_as_float(t.w << 16); v[7] = __uint_as_float(t.w & 0xffff0000u); }

namespace pg8 {
typedef short bf16x8 __attribute__((ext_vector_type(8)));
constexpr int BM = 256, BK = 64, HALF = 128, HTB = HALF * BK * 2, STAGE_BYTES = 8 * HTB, NXCD = 8, WGM = 8;
__device__ __forceinline__ int lds_byte(int r, int c) { const int st = (r >> 4) * 2 + (c >> 5), rr = r & 15, cc = c & 31, ob = rr * 64 + cc * 2; return st * 1024 + (ob ^ (((ob >> 9) & 1) << 5)); }
__device__ __forceinline__ void stage_rc(int b, int& R, int& C) { const int st = b / 1024, sb = b % 1024, swz = sb ^ (((sb >> 9) & 1) << 5); R = (st >> 1) * 16 + swz / 64; C = (st & 1) * 32 + (swz % 64) / 2; }
__device__ __forceinline__ int perm32(int rho) { const int n = rho >> 4, i = rho & 15; return 8 * (i >> 2) + 4 * n + (i & 3); }
struct Unit { int pm, pn, idx; };
struct TileOrder {
    int nM, nN, nwg, G, c;
    __device__ __forceinline__ void init(int nM_, int nN_, int G_, int c_) { nM = nM_; nN = nN_; nwg = nM * nN; G = G_; c = c_; }
    __device__ __forceinline__ bool next(int i, Unit& u) const {
        const long L = (long)i * G + c; if (L >= nwg) return false;
        int wgid = (int)L; { const int q = nwg / NXCD, r = nwg % NXCD, xcd = wgid % NXCD, off = wgid / NXCD; wgid = (xcd < r ? xcd * (q + 1) : r * (q + 1) + (xcd - r) * q) + off; }
        const int nig = WGM * nN, gid = wgid / nig, fm = gid * WGM, gsz = (nM - fm) < WGM ? (nM - fm) : WGM;
        u.pm = fm + ((wgid % nig) % gsz); u.pn = (wgid % nig) / gsz; u.idx = i; return true;
    }
};
__device__ __forceinline__ unsigned cvt_pk_bf16(float lo, float hi) { return pk2(lo, hi); }

template <class Epi, class Sched, bool ALIGN_EPI>
__device__ __forceinline__ void gemm_phase(LAS unsigned char* lds, const bf16* Abase, int K, const Sched& S, const Epi& E, int tid) {
    const int wid = __builtin_amdgcn_readfirstlane(tid >> 6), lane = tid & 63, wr = wid >> 2, wc = wid & 3, fr = lane & 15, fq = lane >> 4;
    const int nt = K / BK;
    unsigned voffB[2];
#pragma unroll
    for (int i = 0; i < 2; ++i) { int R, C; stage_rc(tid * 16 + i * 8192, R, C); const int Rb = Epi::PERM ? ((R & ~31) + perm32(R & 31)) : R; voffB[i] = (unsigned)(Rb * K + C) * 2u; }
    const size_t kstep = (size_t)(BK * 2);
    const size_t hstep = (size_t)HALF * K * 2;
    const unsigned ldsw = (unsigned)wid * 1024u;
    const int aoff = lds_byte(wr * 64 + fr, fq * 8), boff = lds_byte(wc * 32 + fr, fq * 8);
#define PG8_SA(b, h) (((b) * 2 + (h)) * HTB)
#define PG8_SB(b, h) ((4 + (b) * 2 + (h)) * HTB)
#define PG8_STAGE(bufoff, gbase, voff) do { _Pragma("unroll") for (int _i = 0; _i < 2; ++_i) \
        __builtin_amdgcn_global_load_lds((const unsigned*)((const char*)(gbase) + (voff)[_i]), (LAS unsigned*)(lds + (bufoff) + ldsw + _i * 8192), 16, 0, 0); } while (0)
#define PG8_LDA(dst, b, h) do { _Pragma("unroll") for (int m = 0; m < 4; ++m) _Pragma("unroll") for (int k = 0; k < 2; ++k) dst[m][k] = *(const LAS bf16x8*)(lds + PG8_SA(b, h) + aoff + m * 2048 + k * 1024); } while (0)
#define PG8_LDB(dst, b, h) do { _Pragma("unroll") for (int n = 0; n < 2; ++n) _Pragma("unroll") for (int k = 0; k < 2; ++k) dst[n][k] = *(const LAS bf16x8*)(lds + PG8_SB(b, h) + boff + n * 2048 + k * 1024); } while (0)
#define PG8_MMA(ai, bj, At, Bt) do { __builtin_amdgcn_s_setprio(1); _Pragma("unroll") for (int m = 0; m < 4; ++m) _Pragma("unroll") for (int n = 0; n < 2; ++n) _Pragma("unroll") for (int k = 0; k < 2; ++k) \
        acc[ai][bj][m][n] = __builtin_amdgcn_mfma_f32_16x16x32_bf16(Bt[n][k], At[m][k], acc[ai][bj][m][n], 0, 0, 0); __builtin_amdgcn_s_setprio(0); } while (0)
#define PG8_WAIT_V(n) asm volatile("s_waitcnt vmcnt(" #n ")" ::: "memory")
#define PG8_WAIT_L(n) asm volatile("s_waitcnt lgkmcnt(" #n ")" ::: "memory")
#define PG8_BAR __builtin_amdgcn_s_barrier()
#define PG8_SCHED __builtin_amdgcn_sched_barrier(0)
#define PG8_SETV(v, u) do { _Pragma("unroll") for (int _i = 0; _i < 2; ++_i) { int _R, _C; stage_rc(tid * 16 + _i * 8192, _R, _C); _Pragma("unroll") for (int _h = 0; _h < 2; ++_h) v[_h][_i] = (unsigned)(S.arow(u, _h * HALF + _R) * K + _C) * 2u; } } while (0)
    Unit cur, nxt; int ui = 0;
    if (!S.next(0, cur)) return;
    f32x4 acc[2][2][4][2];
#pragma unroll
    for (int a = 0; a < 2; ++a)
#pragma unroll
        for (int b = 0; b < 2; ++b)
#pragma unroll
            for (int m = 0; m < 4; ++m)
#pragma unroll
                for (int n = 0; n < 2; ++n) acc[a][b][m][n] = (f32x4){0.f, 0.f, 0.f, 0.f};
    bf16x8 At[4][2], B0[2][2], B1[2][2];
    unsigned vC[2][2], vN[2][2];
    PG8_SETV(vC, cur);
    const char* cA = (const char*)Abase; const char* cB = S.bbase(cur);
    PG8_WAIT_L(0);
    PG8_STAGE(PG8_SB(0, 0), cB, voffB); PG8_STAGE(PG8_SB(0, 1), cB + hstep, voffB); PG8_STAGE(PG8_SA(0, 0), cA, vC[0]); PG8_STAGE(PG8_SA(0, 1), cA, vC[1]);
    if (wr == 1) PG8_BAR;
    PG8_WAIT_V(2); PG8_BAR;
    PG8_STAGE(PG8_SB(1, 0), cB + kstep, voffB); PG8_STAGE(PG8_SA(1, 0), cA + kstep, vC[0]); PG8_STAGE(PG8_SB(1, 1), cB + hstep + kstep, voffB);
    PG8_WAIT_V(6); PG8_BAR;
    for (;;) {
        const bool has_next = S.next(ui + 1, nxt);
        const char* nB = cB;
        if (has_next) { PG8_SETV(vN, nxt); nB = S.bbase(nxt); }
        else {
#pragma unroll
            for (int _h = 0; _h < 2; ++_h)
#pragma unroll
                for (int _i = 0; _i < 2; ++_i) vN[_h][_i] = vC[_h][_i];
        }
        PG8_WAIT_L(0);
#pragma unroll 1
        for (int t = 0; t < nt; t += 2) {
            const bool last = (t == nt - 2);
            const char* a1 = cA + (size_t)(t + 1) * kstep;
            const char* a2 = last ? cA : cA + (size_t)(t + 2) * kstep; const char* b2 = last ? nB : cB + (size_t)(t + 2) * kstep;
            const char* a3 = a2 + kstep; const char* b3 = b2 + kstep;
            PG8_LDB(B0, 0, 0); PG8_LDB(B1, 0, 1); PG8_SCHED; PG8_LDA(At, 0, 0); PG8_STAGE(PG8_SA(1, 1), a1, vC[1]);
            if (last) {
#pragma unroll
                for (int _h = 0; _h < 2; ++_h)
#pragma unroll
                    for (int _i = 0; _i < 2; ++_i) vC[_h][_i] = vN[_h][_i];
            }
            PG8_WAIT_V(8); PG8_WAIT_L(0); PG8_BAR; PG8_MMA(0, 0, At, B0); PG8_MMA(0, 1, At, B1); PG8_BAR; PG8_SCHED;
            PG8_LDA(At, 0, 1); PG8_STAGE(PG8_SB(0, 0), b2, voffB); PG8_STAGE(PG8_SB(0, 1), b2 + hstep, voffB); PG8_STAGE(PG8_SA(0, 0), a2, vC[0]);
            PG8_WAIT_V(8); PG8_WAIT_L(0); PG8_BAR; PG8_MMA(1, 0, At, B0); PG8_MMA(1, 1, At, B1); PG8_BAR; PG8_SCHED;
            PG8_LDB(B0, 1, 0); PG8_LDB(B1, 1, 1); PG8_SCHED; PG8_LDA(At, 1, 0); PG8_STAGE(PG8_SA(0, 1), a2, vC[1]);
            PG8_WAIT_V(8); PG8_WAIT_L(0); PG8_BAR; PG8_MMA(0, 0, At, B0); PG8_MMA(0, 1, At, B1); PG8_BAR; PG8_SCHED;
            PG8_LDA(At, 1, 1); PG8_STAGE(PG8_SB(1, 0), b3, voffB); PG8_STAGE(PG8_SB(1, 1), b3 + hstep, voffB); PG8_STAGE(PG8_SA(1, 0), a3, vC[0]);
            PG8_WAIT_V(8); PG8_WAIT_L(0); PG8_BAR; PG8_MMA(1, 0, At, B0); PG8_MMA(1, 1, At, B1); PG8_BAR; PG8_SCHED;
        }
        if constexpr (ALIGN_EPI) { if (wr == 0) PG8_BAR; }
        E(acc, cur, wr, wc, fr, fq);
        if (!has_next) break;
#pragma unroll
        for (int a = 0; a < 2; ++a)
#pragma unroll
            for (int b = 0; b < 2; ++b)
#pragma unroll
                for (int m = 0; m < 4; ++m)
#pragma unroll
                    for (int n = 0; n < 2; ++n) acc[a][b][m][n] = (f32x4){0.f, 0.f, 0.f, 0.f};
        cur = nxt; cB = nB; ++ui;
        if constexpr (ALIGN_EPI) { if (wr == 1) PG8_BAR; }
    }
    PG8_WAIT_V(0);
    if constexpr (!ALIGN_EPI) { if (wr == 0) PG8_BAR; }
    PG8_BAR;
#undef PG8_SA
#undef PG8_SB
#undef PG8_STAGE
#undef PG8_LDA
#undef PG8_LDB
#undef PG8_MMA
#undef PG8_WAIT_V
#undef PG8_WAIT_L
#undef PG8_BAR
#undef PG8_SCHED
#undef PG8_SETV
}

struct PlainSched {
    TileOrder T; const char* Bt; int K;
    __device__ __forceinline__ bool next(int i, Unit& u) const { return T.next(i, u); }
    __device__ __forceinline__ int arow(const Unit& u, int r) const { return u.pm * BM + r; }
    __device__ __forceinline__ const char* bbase(const Unit& u) const { return Bt + (size_t)u.pn * BM * K * 2; }
};
template <bool GATHER> struct MoeSched {
    TileOrder T; const char* Bt; int K, NE; const LAS int* tab; const LAS int* rows;
    __device__ __forceinline__ bool next(int i, Unit& u) const { return T.next(i, u); }
    __device__ __forceinline__ int expert(int pm) const { const int s = pm * BM; int e = 0;
#pragma unroll
        for (int k = 1; k < NEXP; ++k) if (s >= tab[k]) e = k;
        return e; }
    __device__ __forceinline__ int arow(const Unit& u, int r) const { return GATHER ? rows[u.idx * BM + r] : u.pm * BM + r; }
    __device__ __forceinline__ const char* bbase(const Unit& u) const { return Bt + ((size_t)expert(u.pm) * NE + (size_t)u.pn * BM) * K * 2; }
};
struct EpiStoreBf16 {
    static constexpr bool PERM = true;
    bf16* O; int ldc, col0; const float* bias;
    __device__ __forceinline__ void operator()(const f32x4 (&acc)[2][2][4][2], const Unit& u, int wr, int wc, int fr, int fq) const {
        const int row0 = u.pm * BM + wr * 64 + fr, ct0 = u.pn * BM + wc * 32 + 8 * fq;
        f32x4 bv[2][2];
#pragma unroll
        for (int bj = 0; bj < 2; ++bj)
#pragma unroll
            for (int n = 0; n < 2; ++n) bv[bj][n] = bias ? *(const f32x4*)(bias + ct0 + bj * HALF + 4 * n) : (f32x4){0.f, 0.f, 0.f, 0.f};
#pragma unroll
        for (int ai = 0; ai < 2; ++ai)
#pragma unroll
            for (int m = 0; m < 4; ++m) { bf16* rowp = O + (size_t)(row0 + ai * HALF + m * 16) * ldc + col0 + ct0;
#pragma unroll
                for (int bj = 0; bj < 2; ++bj) { const f32x4 v0 = acc[ai][bj][m][0] + bv[bj][0], v1 = acc[ai][bj][m][1] + bv[bj][1];
                    u32x4 w; w.x = cvt_pk_bf16(v0[0], v0[1]); w.y = cvt_pk_bf16(v0[2], v0[3]); w.z = cvt_pk_bf16(v1[0], v1[1]); w.w = cvt_pk_bf16(v1[2], v1[3]);
                    *(u32x4*)(rowp + bj * HALF) = w; } }
    }
};
template <int ACT>
struct EpiPairBf16 {
    static constexpr bool PERM = true;
    bf16* O; int ldc, col0; const float* bias; int nb;
    __device__ __forceinline__ void operator()(const f32x4 (&acc)[2][2][4][2], const Unit& u, int wr, int wc, int fr, int fq) const {
        const int row0 = u.pm * BM + wr * 64 + fr, ct0 = u.pn * HALF + wc * 32 + 8 * fq;
        f32x4 ba[2], bb[2];
#pragma unroll
        for (int n = 0; n < 2; ++n) { ba[n] = (ACT == 1) ? *(const f32x4*)(bias + ct0 + 4 * n) : (f32x4){0.f, 0.f, 0.f, 0.f}; bb[n] = (ACT == 1) ? *(const f32x4*)(bias + nb + ct0 + 4 * n) : (f32x4){0.f, 0.f, 0.f, 0.f}; }
#pragma unroll
        for (int ai = 0; ai < 2; ++ai)
#pragma unroll
            for (int m = 0; m < 4; ++m) {
                float o[8];
#pragma unroll
                for (int n = 0; n < 2; ++n)
#pragma unroll
                    for (int j = 0; j < 4; ++j) { const float a = acc[ai][0][m][n][j] + ba[n][j], b = acc[ai][1][m][n][j] + bb[n][j];
                        o[n * 4 + j] = (ACT == 0) ? (a / (1.f + __expf(-a))) * b : a / (1.f + __expf(-b)); }
                u32x4 w; w.x = cvt_pk_bf16(o[0], o[1]); w.y = cvt_pk_bf16(o[2], o[3]); w.z = cvt_pk_bf16(o[4], o[5]); w.w = cvt_pk_bf16(o[6], o[7]);
                *(u32x4*)(O + (size_t)(row0 + ai * HALF + m * 16) * ldc + col0 + ct0) = w; }
    }
};
struct EpiResidual {
    static constexpr bool PERM = false;
    float* XS; const float* g1;
    __device__ __forceinline__ void operator()(const f32x4 (&acc)[2][2][4][2], const Unit& u, int wr, int wc, int fr, int fq) const {
        const int row0 = u.pm * BM + wr * 64 + fr, ct0 = u.pn * BM + wc * 32 + 4 * fq;
#pragma unroll
        for (int ai = 0; ai < 2; ++ai)
#pragma unroll
            for (int m = 0; m < 4; ++m) { const int row = row0 + ai * HALF + m * 16; float* xp = XS + (size_t)row * D + ct0; const float* gp = g1 + (size_t)modrow(row) * 6144 + ct0;
#pragma unroll
                for (int bj = 0; bj < 2; ++bj)
#pragma unroll
                    for (int n = 0; n < 2; ++n) { const int o = bj * HALF + n * 16; const f32x4 g = *(const f32x4*)(gp + o); f32x4 x = *(const f32x4*)(xp + o); x += g * acc[ai][bj][m][n]; *(f32x4*)(xp + o) = x; }
                if (m & 1) asm volatile("" ::: "memory"); }
    }
};
}

template <class RowMap>
__device__ __forceinline__ void transpose_item(const float* W, int K, int N, bf16* WT, const RowMap& rowmap, LAS float* scr, int item, int lane) {
    const int nblk = (N + 31) / 32, kb = item / nblk, nb = item % nblk, k0 = 64 * kb, n0 = 32 * nb;
    const bool cok = n0 + (lane & 31) < N;
    float tv[32];
#pragma unroll
    for (int i = 0; i < 32; ++i) { const int kk = 2 * i + (lane >> 5); tv[i] = cok ? W[(size_t)(k0 + kk) * N + n0 + (lane & 31)] : 0.f; }
#pragma unroll
    for (int i = 0; i < 32; ++i) { const int kk = 2 * i + (lane >> 5); scr[kk * 33 + (lane & 31)] = tv[i]; }
    if (false) for (int i = 0; i < 32; ++i) { const int kk = 2 * i + (lane >> 5); scr[kk * 33 + (lane & 31)] = cok ? W[(size_t)(k0 + kk) * N + n0 + (lane & 31)] : 0.f; }
    asm volatile("s_waitcnt lgkmcnt(0)" ::: "memory");
    const int c = lane & 7;
#pragma unroll
    for (int j = 0; j < 4; ++j) { const int n = (lane >> 3) + 8 * j; const LAS float* sp = scr + (8 * c) * 33 + n;
        u32x4 o; o.x = pk2(sp[0 * 33], sp[1 * 33]); o.y = pk2(sp[2 * 33], sp[3 * 33]); o.z = pk2(sp[4 * 33], sp[5 * 33]); o.w = pk2(sp[6 * 33], sp[7 * 33]);
        const int dr = rowmap(n0 + n);
        if (dr >= 0) *(u32x4*)(WT + (size_t)dr * K + k0 + 8 * c) = o; }
    asm volatile("s_waitcnt lgkmcnt(0)" ::: "memory");
}


typedef short bf16x4s __attribute__((ext_vector_type(4)));
constexpr int S5_US = 264;
constexpr int S5_WS = 136;
__device__ __forceinline__ int s5_row0(int b, int c) { return c < 4 ? TL + b * CTXL + c * 64 : b * SEQ + (c - 4) * 64; }
template <int PASS>
__device__ __forceinline__ void s5_unit(const Frame& Fu, int l, int uidx) {
    Frame F = Fu; { int wv_ = Fu.wave; asm volatile("" : "+s"(wv_), "+s"(l)); F.wave = wv_; } F.lane = fresh_lane(); F.tid = F.wave * 64 + F.lane;
    const int b = uidx / 36, c = uidx % 36, r0 = s5_row0(b, c);
    LAS bf16* U = (LAS bf16*)F.lds;
    __syncthreads();
    for (int i = F.tid; i < 64 * 32; i += NTHR) { const int row = i >> 5, c8 = i & 31; *(LAS u32x4*)(U + row * S5_US + c8 * 8) = *(const u32x4*)(F.COLS + (size_t)(r0 + row) * NCOL + 2048 + c8 * 8); }
    __syncthreads();
    LAS bf16* BuS = (LAS bf16*)(F.lds + 64 * S5_US * 2 + F.wave * (2 * 16 * S5_WS * 2)); LAS bf16* Hs = BuS + 16 * S5_WS;
    const int lane_ = F.lane;
    const int q = lane_ >> 4, c16 = lane_ & 15, p = lane_;
    const f32x2* AA = (const f32x2*)(F.ws + WS_S5AA); const bf16* BB = (const bf16*)(F.ws + WS_S5BB); const bf16* CM = (const bf16*)(F.ws + WS_S5CM);
    f32x2* HL = (f32x2*)(F.ws + WS_S5HL); const f32x2* HI = (const f32x2*)(F.ws + WS_S5HI);
    u32x2 yout[2][4];
    f32x2 aa_[2][2], h0_[2][2]; bf16x4s bb_[2][2][8]; pg8::bf16x8 cm_[2][4];
#pragma unroll
    for (int gi = 0; gi < 2; ++gi) {
        const int g = F.wave * 2 + gi;
        if (PASS == 1) {
#pragma unroll
            for (int ks = 0; ks < 4; ++ks) cm_[gi][ks] = *(const pg8::bf16x8*)(CM + ((size_t)(l * 16 + g) * 16 + c16) * 128 + 32 * ks + 8 * q);
        }
#pragma unroll
        for (int dir = 0; dir < 2; ++dir) {
            const int pidx = ((l * 2 + dir) * 16 + g);
            aa_[gi][dir] = AA[pidx * 64 + p];
#pragma unroll
            for (int rt = 0; rt < 8; ++rt) bb_[gi][dir][rt] = *(const bf16x4s*)(BB + ((size_t)pidx * 128 + 16 * rt + c16) * 16 + 4 * q);
            if (PASS == 1) h0_[gi][dir] = HI[((size_t)(b * 36 + c) * 32 + g * 2 + dir) * 64 + p];
        }
    }
#pragma unroll
    for (int gi = 0; gi < 2; ++gi) {
        const int g = F.wave * 2 + gi;
        f32x4 yacc[4];
#pragma unroll
        for (int rs = 0; rs < 4; ++rs) yacc[rs] = (f32x4){0.f, 0.f, 0.f, 0.f};
#pragma unroll
        for (int dir = 0; dir < 2; ++dir) {
            const float ar = aa_[gi][dir].x, ai = aa_[gi][dir].y;
            const size_t sidx = ((size_t)(b * 36 + c) * 32 + g * 2 + dir) * 64 + p;
            float hr = 0.f, hi = 0.f;
            if (PASS == 1) { hr = h0_[gi][dir].x; hi = h0_[gi][dir].y; }
#pragma unroll
            for (int sci = 0; sci < 4; ++sci) {
                const int rs = dir ? 3 - sci : sci;
                const bf16x4s bop = *(const LAS bf16x4s*)(U + (16 * rs + c16) * S5_US + g * 16 + 4 * q);
#pragma unroll
                for (int rt = 0; rt < 8; ++rt) {
                    const f32x4 a = __builtin_amdgcn_mfma_f32_16x16x16bf16_1k(bb_[gi][dir][rt], bop, (f32x4){0.f, 0.f, 0.f, 0.f}, 0, 0, 0);
                    u32x2 w; w.x = pk2(a[0], a[1]); w.y = pk2(a[2], a[3]);
                    *(LAS u32x2*)(BuS + c16 * S5_WS + 16 * rt + 4 * q) = w;
                }
                asm volatile("s_waitcnt lgkmcnt(0)" ::: "memory");
                unsigned bu[16];
#pragma unroll
                for (int st = 0; st < 16; ++st) bu[st] = *(const LAS unsigned*)(BuS + (dir ? 15 - st : st) * S5_WS + 2 * p);
#pragma unroll
                for (int st = 0; st < 16; ++st) {
                    const float bur = __uint_as_float(bu[st] << 16), bui = __uint_as_float(bu[st] & 0xffff0000u);
                    const float nr = fmaf(ar, hr, fmaf(-ai, hi, bur)), ni = fmaf(ar, hi, fmaf(ai, hr, bui)); hr = nr; hi = ni;
                    if (PASS == 1) *(LAS unsigned*)(Hs + (dir ? 15 - st : st) * S5_WS + 2 * p) = pk2(hr, hi);
                }
                if (PASS == 1) {
                    asm volatile("s_waitcnt lgkmcnt(0)" ::: "memory");
#pragma unroll
                    for (int ks = 0; ks < 4; ++ks) { const pg8::bf16x8 hf = *(const LAS pg8::bf16x8*)(Hs + c16 * S5_WS + 32 * ks + 8 * q);
                        yacc[rs] = __builtin_amdgcn_mfma_f32_16x16x32_bf16(cm_[gi][ks], hf, yacc[rs], 0, 0, 0); }
                }
                asm volatile("s_waitcnt lgkmcnt(0)" ::: "memory");
            }
            if (PASS == 0) HL[sidx] = (f32x2){hr, hi};
        }
        if (PASS == 1) {
            const f32x4 dsk = *(const f32x4*)(F.in[I_S5D] + l * 256 + g * 16 + 4 * q);
#pragma unroll
            for (int rs = 0; rs < 4; ++rs) {
                float u4[4]; { const u32x2 t = *(const LAS u32x2*)(U + (16 * rs + c16) * S5_US + g * 16 + 4 * q);
                    u4[0] = __uint_as_float(t.x << 16); u4[1] = __uint_as_float(t.x & 0xffff0000u); u4[2] = __uint_as_float(t.y << 16); u4[3] = __uint_as_float(t.y & 0xffff0000u); }
                float o[4];
#pragma unroll
                for (int j = 0; j < 4; ++j) o[j] = gelu_tanh(yacc[rs][j] + dsk[j] * u4[j]);
                yout[gi][rs].x = pk2(o[0], o[1]); yout[gi][rs].y = pk2(o[2], o[3]);
            }
        }
    }
    if (PASS == 1) {
        const bf16* GW = F.GLU_T + (size_t)l * 512 * 256;
        pg8::bf16x8 wv[8][2], wg[8][2];
#pragma unroll
        for (int ks = 0; ks < 8; ++ks)
#pragma unroll
            for (int nt = 0; nt < 2; ++nt) { wv[ks][nt] = *(const pg8::bf16x8*)(GW + (size_t)(32 * F.wave + 16 * nt + c16) * 256 + 32 * ks + 8 * q); wg[ks][nt] = *(const pg8::bf16x8*)(GW + (size_t)(256 + 32 * F.wave + 16 * nt + c16) * 256 + 32 * ks + 8 * q); }
        __syncthreads();
#pragma unroll
        for (int gi = 0; gi < 2; ++gi)
#pragma unroll
            for (int rs = 0; rs < 4; ++rs) *(LAS u32x2*)(U + (16 * rs + c16) * S5_US + (F.wave * 2 + gi) * 16 + 4 * q) = yout[gi][rs];
        __syncthreads();
        f32x4 av[2][4], ag[2][4];
#pragma unroll
        for (int nt = 0; nt < 2; ++nt)
#pragma unroll
            for (int rt = 0; rt < 4; ++rt) { av[nt][rt] = (f32x4){0.f, 0.f, 0.f, 0.f}; ag[nt][rt] = (f32x4){0.f, 0.f, 0.f, 0.f}; }
#pragma unroll
        for (int ks = 0; ks < 8; ++ks) {
            pg8::bf16x8 yf[4];
#pragma unroll
            for (int rt = 0; rt < 4; ++rt) yf[rt] = *(const LAS pg8::bf16x8*)(U + (16 * rt + c16) * S5_US + 32 * ks + 8 * q);
#pragma unroll
            for (int nt = 0; nt < 2; ++nt)
#pragma unroll
                for (int rt = 0; rt < 4; ++rt) { av[nt][rt] = __builtin_amdgcn_mfma_f32_16x16x32_bf16(wv[ks][nt], yf[rt], av[nt][rt], 0, 0, 0); ag[nt][rt] = __builtin_amdgcn_mfma_f32_16x16x32_bf16(wg[ks][nt], yf[rt], ag[nt][rt], 0, 0, 0); }
        }
        const float* gb = F.in[I_GLUB] + l * 512;
#pragma unroll
        for (int nt = 0; nt < 2; ++nt) { const int n0 = 32 * F.wave + 16 * nt + 4 * q; const f32x4 bv = *(const f32x4*)(gb + n0), bg = *(const f32x4*)(gb + 256 + n0);
#pragma unroll
            for (int rt = 0; rt < 4; ++rt) { float o[4];
#pragma unroll
                for (int j = 0; j < 4; ++j) o[j] = (av[nt][rt][j] + bv[j]) * sigmoidf_(ag[nt][rt][j] + bg[j]);
                u32x2 w; w.x = pk2(o[0], o[1]); w.y = pk2(o[2], o[3]);
                *(u32x2*)(F.MIX + (size_t)(r0 + 16 * rt + c16) * 1024 + 768 + n0) = w; } }
    }
}
__device__ __forceinline__ void s5_carry(const Frame& F, int l) {
    const int gt = F.bid * NTHR + F.tid, NG = F.G * NTHR;
    const f32x2* AA = (const f32x2*)(F.ws + WS_S5AA); const f32x2* HL = (const f32x2*)(F.ws + WS_S5HL); f32x2* HI = (f32x2*)(F.ws + WS_S5HI);
    for (int i = gt; i < NB * 32 * 64; i += NG) {
        const int p = i & 63, gd = (i >> 6) & 31, b = i >> 11, g = gd >> 1, dir = gd & 1;
        f32x2 a = AA[((l * 2 + dir) * 16 + g) * 64 + p];
#pragma unroll
        for (int k = 0; k < 6; ++k) a = (f32x2){a.x * a.x - a.y * a.y, 2.f * a.x * a.y};
        f32x2 hl[36];
#pragma unroll
        for (int j = 0; j < 36; ++j) { const int c = dir ? (j < 4 ? 3 - j : 39 - j) : j; hl[j] = HL[((size_t)(b * 36 + c) * 32 + gd) * 64 + p]; }
        float hr = 0.f, hi = 0.f;
#pragma unroll
        for (int j = 0; j < 36; ++j) {
            const int c = dir ? (j < 4 ? 3 - j : 39 - j) : j;
            HI[((size_t)(b * 36 + c) * 32 + gd) * 64 + p] = (f32x2){hr, hi};
            const float nr = a.x * hr - a.y * hi + hl[j].x, ni = a.x * hi + a.y * hr + hl[j].y; hr = nr; hi = ni;
        }
    }
}

constexpr int SSD_LD = 136;
__device__ __forceinline__ int ssd_row0(int b, int cid) { return cid < 2 ? TL + b * CTXL + cid * 128 : b * SEQ + (cid - 2) * 128; }
__device__ __forceinline__ pg8::bf16x8 mk8(u32x2 lo, u32x2 hi) { u32x4 t; t.x = lo.x; t.y = lo.y; t.z = hi.x; t.w = hi.y; return __builtin_bit_cast(pg8::bf16x8, t); }
__device__ __forceinline__ void ssd_conv_item(const Frame& F, int l, int r0, int lo, int hi, int s0, int xch, bool do_nat, LAS bf16* NAT, int ncol, bool do_tr, LAS bf16* TR, int trow, bool do_cc, bf16* CCg) {
    const float* cw = F.in[I_SCW] + (size_t)l * 5 * 1024; const float* cb = F.in[I_SCB] + l * 1024;
    u32x4 xr[12];
    const bool lo_ok = (r0 + s0 - 2) >= lo, hi_ok = (r0 + s0 + 9) < hi;
    const bf16* xp = F.COLS + (size_t)(r0 + s0) * NCOL + 512 + xch;
#pragma unroll
    for (int i = 2; i < 10; ++i) xr[i] = *(const u32x4*)(xp + (i - 2) * NCOL);
    if (lo_ok) { xr[0] = *(const u32x4*)(xp - 2 * NCOL); xr[1] = *(const u32x4*)(xp - NCOL); } else { xr[0] = (u32x4){0u, 0u, 0u, 0u}; xr[1] = xr[0]; }
    if (hi_ok) { xr[10] = *(const u32x4*)(xp + 8 * NCOL); xr[11] = *(const u32x4*)(xp + 9 * NCOL); } else { xr[10] = (u32x4){0u, 0u, 0u, 0u}; xr[11] = xr[10]; }
#pragma unroll
    for (int hb = 0; hb < 2; ++hb) {
        float wv[5][4]; float val[8][4];
#pragma unroll
        for (int j = 0; j < 5; ++j) { const f32x4 t = *(const f32x4*)(cw + j * 1024 + xch + 4 * hb); wv[j][0] = t.x; wv[j][1] = t.y; wv[j][2] = t.z; wv[j][3] = t.w; }
        const f32x4 bias = *(const f32x4*)(cb + xch + 4 * hb);
#pragma unroll
        for (int i = 0; i < 8; ++i)
#pragma unroll
            for (int k = 0; k < 4; ++k) val[i][k] = bias[k];
#pragma unroll
        for (int i = 0; i < 12; ++i) {
            const unsigned wa = hb ? xr[i].z : xr[i].x, wb = hb ? xr[i].w : xr[i].y;
            const float x4[4] = {__uint_as_float(wa << 16), __uint_as_float(wa & 0xffff0000u), __uint_as_float(wb << 16), __uint_as_float(wb & 0xffff0000u)};
#pragma unroll
            for (int j = 0; j < 5; ++j) { const int o = i - j;
                if (o >= 0 && o < 8) {
#pragma unroll
                    for (int k = 0; k < 4; ++k) val[o][k] = fmaf(wv[j][k], x4[k], val[o][k]); } }
        }
#pragma unroll
        for (int i = 0; i < 8; ++i)
#pragma unroll
            for (int k = 0; k < 4; ++k) val[i][k] = siluf_(val[i][k]);
        if (do_nat) {
#pragma unroll
            for (int i = 0; i < 8; ++i) { u32x2 o; o.x = pk2(val[i][0], val[i][1]); o.y = pk2(val[i][2], val[i][3]); *(LAS u32x2*)(NAT + (s0 + i) * SSD_LD + ncol + 4 * hb) = o;
                if (do_cc) *(u32x2*)(CCg + (size_t)(s0 + i) * 256 + 4 * hb) = o; }
        }
        if (do_tr) {
#pragma unroll
            for (int k = 0; k < 4; ++k) { u32x4 o; o.x = pk2(val[0][k], val[1][k]); o.y = pk2(val[2][k], val[3][k]); o.z = pk2(val[4][k], val[5][k]); o.w = pk2(val[6][k], val[7][k]);
                *(LAS u32x4*)(TR + (trow + 4 * hb + k) * SSD_LD + s0) = o; }
        }
    }
}
__device__ __forceinline__ void ssd_unit_a(const Frame& Fu, int l, int ug) {
    Frame F = Fu; { int wv_ = Fu.wave; asm volatile("" : "+s"(wv_), "+s"(l)); F.wave = wv_; } F.lane = fresh_lane(); F.tid = F.wave * 64 + F.lane;
    const int g = ug & 1, uc = ug >> 1, b = uc / 18, cid = uc % 18, r0 = ssd_row0(b, cid);
    LAS bf16* Bn = (LAS bf16*)F.lds; LAS bf16* Cn = Bn + 128 * SSD_LD; LAS bf16* BT = Cn + 128 * SSD_LD; LAS bf16* XT4 = Bn;
    LAS float* ARR = (LAS float*)(BT + 128 * SSD_LD);
    int lo, hi; seq_bounds(r0, lo, hi);
    __syncthreads();
    if (F.wave < 4) {
        const int h = 4 * g + F.wave;
        LAS float* cs0 = ARR + F.wave * 768; LAS float* ecs1 = cs0 + 128; LAS float* dt0 = ecs1 + 128; LAS float* dt1 = dt0 + 128; LAS float* w0 = dt1 + 128; LAS float* w1 = w0 + 128;
        const float A0 = -expf(F.in[I_SALOG][l * 16 + h]), A1 = -expf(F.in[I_SALOG][l * 16 + 8 + h]);
        const float db0 = F.in[I_SDTB][l * 16 + h], db1 = F.in[I_SDTB][l * 16 + 8 + h];
        const int t0 = 2 * F.lane;
        const float d00 = softplusf_(F.DT[(size_t)(r0 + t0) * 16 + h] + db0), d01 = softplusf_(F.DT[(size_t)(r0 + t0 + 1) * 16 + h] + db0);
        const float d10 = softplusf_(F.DT[(size_t)(r0 + t0) * 16 + 8 + h] + db1), d11 = softplusf_(F.DT[(size_t)(r0 + t0 + 1) * 16 + 8 + h] + db1);
        const float a00 = d00 * A0, a01 = d01 * A0, a10 = d10 * A1, a11 = d11 * A1;
        float p0 = a00 + a01, p1 = a10 + a11;
#pragma unroll
        for (int o = 1; o < 64; o <<= 1) { const float u0 = __int_as_float(__builtin_amdgcn_ds_bpermute((F.lane - o) << 2, __float_as_int(p0))), u1 = __int_as_float(__builtin_amdgcn_ds_bpermute((F.lane - o) << 2, __float_as_int(p1)));
            if (F.lane >= o) { p0 += u0; p1 += u1; } }
        const float tot0 = __int_as_float(__builtin_amdgcn_readlane(__float_as_int(p0), 63)), tot1 = __int_as_float(__builtin_amdgcn_readlane(__float_as_int(p1), 63));
        const float c01 = p0, c00 = p0 - a01;
        const float e11 = p1 - a11, e10 = e11 - a10;
        cs0[t0] = c00; cs0[t0 + 1] = c01; ecs1[t0] = e10; ecs1[t0 + 1] = e11; dt0[t0] = d00; dt0[t0 + 1] = d01; dt1[t0] = d10; dt1[t0 + 1] = d11;
        w0[t0] = __expf(tot0 - c00) * d00; w0[t0 + 1] = __expf(tot0 - c01) * d01; w1[t0] = __expf(e10) * d10; w1[t0 + 1] = __expf(e11) * d11;
        float* ed = (float*)(F.ws + WS_EDEC) + ((size_t)(r0 + t0) * 8 + h) * 2;
        ed[0] = __expf(c00); ed[1] = __expf(tot1 - e10); ed[16] = __expf(c01); ed[17] = __expf(tot1 - e11);
        if (F.lane == 0) { float* tt = (float*)(F.ws + WS_TOT) + ((size_t)uc * 8 + h) * 2; tt[0] = tot0; tt[1] = tot1; }
    }
    {
        const int oct = F.tid & 31, seg = F.tid >> 5, s0 = seg * 8, isC = oct >> 4, n0 = (oct & 15) * 8;
        bf16* CC = (bf16*)(F.ws + WS_CC) + (size_t)r0 * 256 + g * 128 + n0;
        ssd_conv_item(F, l, r0, lo, hi, s0, (isC ? 768 : 512) + g * 128 + n0, true, isC ? Cn : Bn, n0, !isC, BT, n0, isC != 0, CC);
    }
    __syncthreads();
    const int q = F.lane >> 4, c = F.lane & 15, w = F.wave;
    f32x4 gt[8];
    {
        pg8::bf16x8 cfr[4];
#pragma unroll
        for (int ks = 0; ks < 4; ++ks) cfr[ks] = *(const LAS pg8::bf16x8*)(Cn + (16 * w + c) * SSD_LD + 32 * ks + 8 * q);
#pragma unroll
        for (int a = 0; a < 8; ++a) { f32x4 acc = {0.f, 0.f, 0.f, 0.f};
#pragma unroll
            for (int ks = 0; ks < 4; ++ks) acc = __builtin_amdgcn_mfma_f32_16x16x32_bf16(*(const LAS pg8::bf16x8*)(Bn + (16 * a + c) * SSD_LD + 32 * ks + 8 * q), cfr[ks], acc, 0, 0, 0);
            gt[a] = acc; }
    }
    __syncthreads();
    {
        const int oct = F.tid & 31, seg = F.tid >> 5, s0 = seg * 8, hl = oct >> 3, p0 = (oct & 7) * 8;
        ssd_conv_item(F, l, r0, lo, hi, s0, (4 * g + hl) * 64 + p0, false, XT4, 0, true, XT4, hl * 64 + p0, false, (bf16*)nullptr);
    }
    __syncthreads();
    pg8::bf16x8 btf[4];
#pragma unroll
    for (int ks = 0; ks < 4; ++ks) btf[ks] = *(const LAS pg8::bf16x8*)(BT + (16 * w + c) * SSD_LD + 32 * ks + 8 * q);
    const int t = 16 * w + c;
#pragma unroll 1
    for (int hl = 0; hl < 4; ++hl) {
        const int h = 4 * g + hl, uidx = uc * 8 + h;
        const LAS float* cs0 = ARR + hl * 768; const LAS float* ecs1 = cs0 + 128; const LAS float* dt0 = ecs1 + 128; const LAS float* dt1 = dt0 + 128; const LAS float* w0 = dt1 + 128; const LAS float* w1 = w0 + 128;
        const LAS bf16* XT = XT4 + hl * 64 * SSD_LD;
        {
            int t_ = t; asm volatile("" : "+v"(t_));
            const float cs0t = cs0[t_], e1t = ecs1[t_], Dh = F.in[I_SD][l * 8 + h];
            f32x4 m[8];
#pragma unroll
            for (int a = 0; a < 8; ++a) {
                const f32x4 csv = *(const LAS f32x4*)&cs0[16 * a + 4 * q], d0v = *(const LAS f32x4*)&dt0[16 * a + 4 * q], e1v = *(const LAS f32x4*)&ecs1[16 * a + 4 * q], d1v = *(const LAS f32x4*)&dt1[16 * a + 4 * q];
                if (a < w) {
#pragma unroll
                    for (int j = 0; j < 4; ++j) m[a][j] = gt[a][j] * (__expf(cs0t - csv[j]) * d0v[j]);
                } else if (a > w) {
#pragma unroll
                    for (int j = 0; j < 4; ++j) m[a][j] = gt[a][j] * (__expf(e1v[j] - e1t) * d1v[j]);
                } else {
#pragma unroll
                    for (int j = 0; j < 4; ++j) { const int sidx = 16 * a + 4 * q + j;
                        const float f0 = (sidx <= t_) ? __expf(fminf(cs0t - csv[j], 0.f)) * d0v[j] : 0.f;
                        const float f1 = (sidx >= t_) ? __expf(fminf(e1v[j] - e1t, 0.f)) * d1v[j] : 0.f;
                        m[a][j] = gt[a][j] * (f0 + f1) + ((sidx == t_) ? Dh : 0.f); }
                }
            }
            pg8::bf16x8 mfr[4];
#pragma unroll
            for (int i = 0; i < 4; ++i) { u32x4 tq; tq.x = pk2(m[2 * i][0], m[2 * i][1]); tq.y = pk2(m[2 * i][2], m[2 * i][3]); tq.z = pk2(m[2 * i + 1][0], m[2 * i + 1][1]); tq.w = pk2(m[2 * i + 1][2], m[2 * i + 1][3]); mfr[i] = __builtin_bit_cast(pg8::bf16x8, tq); }
            bf16* YI = (bf16*)(F.ws + WS_YI);
#pragma unroll
            for (int pt = 0; pt < 4; ++pt) { f32x4 acc = {0.f, 0.f, 0.f, 0.f};
#pragma unroll
                for (int i = 0; i < 4; ++i) { const LAS bf16* xp = XT + (16 * pt + c) * SSD_LD + 32 * i + 4 * q;
                    acc = __builtin_amdgcn_mfma_f32_16x16x32_bf16(mk8(*(const LAS u32x2*)xp, *(const LAS u32x2*)(xp + 16)), mfr[i], acc, 0, 0, 0); }
                u32x2 o; o.x = pk2(acc[0], acc[1]); o.y = pk2(acc[2], acc[3]);
                *(u32x2*)(YI + (((size_t)uidx * 32 + pt * 8 + w) * 64 + F.lane) * 4) = o; }
        }
        {
            bf16* SST = (bf16*)(F.ws + WS_SST);
#pragma unroll
            for (int d = 0; d < 2; ++d) { const LAS float* wd = d ? w1 : w0;
                pg8::bf16x8 bsf[4];
#pragma unroll
                for (int ks = 0; ks < 4; ++ks) {
                    const u32x4 bq = __builtin_bit_cast(u32x4, btf[ks]);
                    const f32x4 wa = *(const LAS f32x4*)&wd[32 * ks + 8 * q], wb = *(const LAS f32x4*)&wd[32 * ks + 8 * q + 4];
                    u32x4 sq;
                    sq.x = pk2(__uint_as_float(bq.x << 16) * wa[0], __uint_as_float(bq.x & 0xffff0000u) * wa[1]); sq.y = pk2(__uint_as_float(bq.y << 16) * wa[2], __uint_as_float(bq.y & 0xffff0000u) * wa[3]);
                    sq.z = pk2(__uint_as_float(bq.z << 16) * wb[0], __uint_as_float(bq.z & 0xffff0000u) * wb[1]); sq.w = pk2(__uint_as_float(bq.w << 16) * wb[2], __uint_as_float(bq.w & 0xffff0000u) * wb[3]);
                    bsf[ks] = __builtin_bit_cast(pg8::bf16x8, sq);
                }
#pragma unroll
                for (int pt = 0; pt < 4; ++pt) { f32x4 acc = {0.f, 0.f, 0.f, 0.f};
#pragma unroll
                    for (int ks = 0; ks < 4; ++ks) acc = __builtin_amdgcn_mfma_f32_16x16x32_bf16(bsf[ks], *(const LAS pg8::bf16x8*)(XT + (16 * pt + c) * SSD_LD + 32 * ks + 8 * q), acc, 0, 0, 0);
                    u32x2 o; o.x = pk2(acc[0], acc[1]); o.y = pk2(acc[2], acc[3]);
                    *(u32x2*)(SST + (((size_t)uidx * 2 + d) * 64 + 16 * pt + c) * 128 + 16 * w + 4 * q) = o; }
            }
        }
    }
}
__device__ __forceinline__ void ssd_carry(const Frame& F) {
    const int gt = F.bid * NTHR + F.tid, NG = F.G * NTHR;
    const bf16* SST = (const bf16*)(F.ws + WS_SST); bf16* HIN = (bf16*)(F.ws + WS_HIN); const float* TOT = (const float*)(F.ws + WS_TOT);
    for (int i = gt; i < NB * 8 * 2 * 1024; i += NG) {
        const int e8 = i & 1023, d = (i >> 10) & 1, h = (i >> 11) & 7, b = i >> 14;
        u32x4 sv[18]; float tv[18];
#pragma unroll
        for (int j = 0; j < 18; ++j) {
            const int cid = d ? (j < 2 ? 1 - j : 19 - j) : j;
            const size_t ui = (size_t)(b * 18 + cid) * 8 + h;
            sv[j] = *(const u32x4*)(SST + ((ui * 2 + d) * 1024 + e8) * 8); tv[j] = TOT[ui * 2 + d];
        }
        float H[8];
#pragma unroll
        for (int k = 0; k < 8; ++k) H[k] = 0.f;
#pragma unroll
        for (int j = 0; j < 18; ++j) {
            const int cid = d ? (j < 2 ? 1 - j : 19 - j) : j;
            const size_t ui = (size_t)(b * 18 + cid) * 8 + h, off = ((ui * 2 + d) * 1024 + e8) * 8;
            u32x4 o; o.x = pk2(H[0], H[1]); o.y = pk2(H[2], H[3]); o.z = pk2(H[4], H[5]); o.w = pk2(H[6], H[7]);
            *(u32x4*)(HIN + off) = o;
            const float dec = __expf(tv[j]);
            const float s8[8] = {__uint_as_float(sv[j].x << 16), __uint_as_float(sv[j].x & 0xffff0000u), __uint_as_float(sv[j].y << 16), __uint_as_float(sv[j].y & 0xffff0000u),
                                 __uint_as_float(sv[j].z << 16), __uint_as_float(sv[j].z & 0xffff0000u), __uint_as_float(sv[j].w << 16), __uint_as_float(sv[j].w & 0xffff0000u)};
#pragma unroll
            for (int k = 0; k < 8; ++k) H[k] = fmaf(H[k], dec, s8[k]);
        }
    }
}
__device__ __forceinline__ void ssd_unit_b(const Frame& F, int l, int u2) {
    const int uc = u2 >> 1, rh = u2 & 1, b = uc / 18, cid = uc % 18, r0 = ssd_row0(b, cid) + 64 * rh;
    const int lane_ = fresh_lane();
    int wv_ = F.wave; asm volatile("" : "+s"(wv_), "+s"(l));
    const int q = lane_ >> 4, c = lane_ & 15, h = wv_, g = h >> 2;
    const bf16* CC = (const bf16*)(F.ws + WS_CC); const bf16* HIN = (const bf16*)(F.ws + WS_HIN); const bf16* YI = (const bf16*)(F.ws + WS_YI); const float* ED = (const float*)(F.ws + WS_EDEC);
    LAS float* SSX = (LAS float*)F.lds;
    const size_t ui = (size_t)uc * 8 + h;
    pg8::bf16x8 hin[2][4][4], cfr[4][4];
#pragma unroll
    for (int d = 0; d < 2; ++d)
#pragma unroll
        for (int pt = 0; pt < 4; ++pt)
#pragma unroll
            for (int ks = 0; ks < 4; ++ks) hin[d][pt][ks] = *(const pg8::bf16x8*)(HIN + ((ui * 2 + d) * 64 + 16 * pt + c) * 128 + 32 * ks + 8 * q);
#pragma unroll
    for (int tt = 0; tt < 4; ++tt)
#pragma unroll
        for (int ks = 0; ks < 4; ++ks) cfr[tt][ks] = *(const pg8::bf16x8*)(CC + (size_t)(r0 + 16 * tt + c) * 256 + g * 128 + 32 * ks + 8 * q);
    float ssv[4];
#pragma unroll
    for (int tt = 0; tt < 4; ++tt) {
        const size_t row = (size_t)(r0 + 16 * tt + c); const int w = rh * 4 + tt;
        const f32x2 ed = *(const f32x2*)(ED + (row * 8 + h) * 2);
        u32x2 yiq[4], zq[4];
#pragma unroll
        for (int pt = 0; pt < 4; ++pt) { yiq[pt] = *(const u32x2*)(YI + ((ui * 32 + pt * 8 + w) * 64 + lane_) * 4); zq[pt] = *(const u32x2*)(F.COLS + row * NCOL + h * 64 + 16 * pt + 4 * q); }
        float ss = 0.f;
#pragma unroll
        for (int pt = 0; pt < 4; ++pt) {
            f32x4 a0 = {0.f, 0.f, 0.f, 0.f}, a1 = {0.f, 0.f, 0.f, 0.f};
#pragma unroll
            for (int ks = 0; ks < 4; ++ks) { a0 = __builtin_amdgcn_mfma_f32_16x16x32_bf16(hin[0][pt][ks], cfr[tt][ks], a0, 0, 0, 0); a1 = __builtin_amdgcn_mfma_f32_16x16x32_bf16(hin[1][pt][ks], cfr[tt][ks], a1, 0, 0, 0); }
            const float yi[4] = {__uint_as_float(yiq[pt].x << 16), __uint_as_float(yiq[pt].x & 0xffff0000u), __uint_as_float(yiq[pt].y << 16), __uint_as_float(yiq[pt].y & 0xffff0000u)};
            const float z[4] = {__uint_as_float(zq[pt].x << 16), __uint_as_float(zq[pt].x & 0xffff0000u), __uint_as_float(zq[pt].y << 16), __uint_as_float(zq[pt].y & 0xffff0000u)};
            float v[4];
#pragma unroll
            for (int j = 0; j < 4; ++j) { v[j] = (yi[j] + ed.x * a0[j] + ed.y * a1[j]) * siluf_(z[j]); ss = fmaf(v[j], v[j], ss); }
            u32x2 o; o.x = pk2(v[0], v[1]); o.y = pk2(v[2], v[3]);
            *(u32x2*)(F.MIX + row * 1024 + h * 64 + 16 * pt + 4 * q) = o;
        }
        ss += shx(ss, 16, lane_); ss += shx(ss, 32, lane_);
        ssv[tt] = ss;
    }
    __syncthreads();
    if (q == 0) {
#pragma unroll
        for (int tt = 0; tt < 4; ++tt) SSX[h * 64 + 16 * tt + c] = ssv[tt];
    }
    __syncthreads();
    const float* ng = F.in[I_SNG] + l * 512 + h * 64;
    u32x2 mv[4][4];
#pragma unroll
    for (int tt = 0; tt < 4; ++tt)
#pragma unroll
        for (int pt = 0; pt < 4; ++pt) mv[tt][pt] = *(const u32x2*)(F.MIX + (size_t)(r0 + 16 * tt + c) * 1024 + h * 64 + 16 * pt + 4 * q);
#pragma unroll
    for (int tt = 0; tt < 4; ++tt) {
        float tot = 0.f;
#pragma unroll
        for (int k = 0; k < 8; ++k) tot += SSX[k * 64 + 16 * tt + c];
        const float rstd = rsqrtf(tot * (1.f / 512.f) + EPS);
#pragma unroll
        for (int pt = 0; pt < 4; ++pt) { const f32x4 gn = *(const f32x4*)(ng + 16 * pt + 4 * q);
            u32x2 o; o.x = pk2(__uint_as_float(mv[tt][pt].x << 16) * rstd * gn[0], __uint_as_float(mv[tt][pt].x & 0xffff0000u) * rstd * gn[1]);
            o.y = pk2(__uint_as_float(mv[tt][pt].y << 16) * rstd * gn[2], __uint_as_float(mv[tt][pt].y & 0xffff0000u) * rstd * gn[3]);
            *(u32x2*)(F.MIX + (size_t)(r0 + 16 * tt + c) * 1024 + h * 64 + 16 * pt + 4 * q) = o; }
    }
}

__device__ __forceinline__ void stage_wt16(LAS float* WT, const float* src, int stride, int tid) {
    for (int i = tid; i < 4096; i += NTHR) { const int k = i >> 2, e4 = (i & 3) * 4; const f32x4 v = *(const f32x4*)(src + (size_t)k * stride + e4);
        WT[(e4 + 0) * 1024 + k] = v.x; WT[(e4 + 1) * 1024 + k] = v.y; WT[(e4 + 2) * 1024 + k] = v.z; WT[(e4 + 3) * 1024 + k] = v.w; }
}
__device__ __forceinline__ void dot16_acc(const LAS float* WT, const f32x4& h, int j, int lane, float (&acc)[16]) {
#pragma unroll
    for (int e4 = 0; e4 < 4; ++e4) {
#pragma unroll
        for (int e = 4 * e4; e < 4 * e4 + 4; ++e) { const f32x4 w = *(const LAS f32x4*)&WT[e * 1024 + 4 * lane + 256 * j]; acc[e] = fmaf(h.x, w.x, fmaf(h.y, w.y, fmaf(h.z, w.z, fmaf(h.w, w.w, acc[e])))); }
        asm volatile("" ::: "memory");
    }
}

__device__ __forceinline__ void phase_p0(const Frame& F0)  {
    Frame F = enter_phase(F0);
    {
        const size_t gt = (size_t)F.bid * NTHR + F.tid, NG = (size_t)F.G * NTHR;
        for (size_t i = gt; i < (size_t)TT * 256; i += NG) {
            const int r = (int)(i >> 8), c4 = (int)(i & 255) * 4;
            f32x4 v;
            if (r < TL) {
                v = *(const f32x4*)(F.in[I_X] + (size_t)r * D + c4);
                const int n = r & (SEQ - 1), rr = n >> 6, cc = n & 63, q = c4 >> 8, ii = c4 & 255;
                const float pos = (float)(q < 2 ? rr : cc);
                float pe[4];
#pragma unroll
                for (int k = 0; k < 4; ++k) {
                    const float invf = expf(-9.210340371976184f * (float)(ii + k) * (1.f / 256.f));
                    float s, c; sincos_red(pos * invf, s, c);
                    pe[k] = (q & 1) ? c : s;
                }
                v.x += pe[0]; v.y += pe[1]; v.z += pe[2]; v.w += pe[3];
            } else {
                v = *(const f32x4*)(F.in[I_CTX] + (size_t)(r - TL) * D + c4);
            }
            *(f32x4*)(F.XS + (size_t)r * D + c4) = v;
        }
    }
    {
        LAS float* scr = (LAS float*)F.lds + F.wave * (64 * 33);
        const int gw = F.bid * NWAVES + F.wave, NGW = F.G * NWAVES;
        constexpr int I_IN = 16 * 73, I_OUT = 16 * 32, I_PW = 4 * 8, I_GLU = 4 * 16, I_L = I_IN + I_OUT + I_PW + I_GLU;
        for (int it = gw; it < 2 * I_L; it += NGW) {
            const int l = it / I_L; int r = it % I_L;
            if (r < I_IN) { transpose_item(F.in[I_WIN] + (size_t)l * D * INC, D, INC, F.WIN_T + (size_t)l * NCOL * D, [](int n) { return n < 1536 ? n : (n < 1552 ? -1 : (n < INC ? n - 16 : -1)); }, scr, r, F.lane); continue; } r -= I_IN;
            if (r < I_OUT) { transpose_item(F.in[I_WOUT] + (size_t)l * D * D, D, D, F.WOUT_T + (size_t)l * D * D, [](int n) { return n; }, scr, r, F.lane); continue; } r -= I_OUT;
            if (r < I_PW) { transpose_item(F.in[I_CPW] + (size_t)l * 256 * 256, 256, 256, F.PW_T + (size_t)l * 256 * 256, [](int n) { return n; }, scr, r, F.lane); continue; } r -= I_PW;
            transpose_item(F.in[I_GLUW] + (size_t)l * 256 * 512, 256, 512, F.GLU_T + (size_t)l * 512 * 256, [](int n) { return n; }, scr, r, F.lane);
        }
        __syncthreads();
    }
    {
        const int gt = F.bid * NTHR + F.tid, NG = F.G * NTHR;
        f32x2* AA = (f32x2*)(F.ws + WS_S5AA); bf16* BB = (bf16*)(F.ws + WS_S5BB); bf16* CM = (bf16*)(F.ws + WS_S5CM);
        for (int i = gt; i < 2 * 2 * 16 * 64; i += NG) {
            const int p = i & 63, g = (i >> 6) & 15, dir = (i >> 10) & 1, l = i >> 11;
            const float step = expf(F.in[I_LSTEP][(l * 2 + dir) * 16 + g]);
            const float lr = F.in[I_LRE][i], li = F.in[I_LIM][i];
            const float mag = expf(lr * step); float sn, cs; sincos_red(li * step, sn, cs);
            const float ar = mag * cs, ai = mag * sn, inv_den = 1.f / (lr * lr + li * li);
            const float cr = ((ar - 1.f) * lr + ai * li) * inv_den, ci = (ai * lr - (ar - 1.f) * li) * inv_den;
            AA[i] = (f32x2){ar, ai};
            const float* bre = F.in[I_BRE] + ((size_t)(l * 16 + g) * 64 + p) * 16; const float* bim = F.in[I_BIM] + ((size_t)(l * 16 + g) * 64 + p) * 16;
            bf16* o = BB + ((size_t)((l * 2 + dir) * 16 + g) * 128 + 2 * p) * 16;
            for (int h = 0; h < 16; ++h) { const float br = bre[h], bi = bim[h]; o[h] = (bf16)f2bf(cr * br - ci * bi); o[16 + h] = (bf16)f2bf(cr * bi + ci * br); }
        }
        for (int i = gt; i < 2 * 16 * 16 * 64; i += NG) {
            *(unsigned*)(CM + (size_t)i * 2) = pk2(F.in[I_CRE][i], -F.in[I_CIM][i]);
        }
    }
    {
        LAS float* sc = (LAS float*)F.lds;
        LAS float* part = sc + 9 * 1024;
        __syncthreads();
        if (F.bid < 192) { for (int t = F.tid; t < 9 * 1024; t += NTHR) { const int r9 = t >> 10, k = t & 1023; sc[t] = siluf_(r9 < 8 ? F.in[I_C][r9 * D + k] : F.in[I_CCTX][k]); } }
        __syncthreads();
        for (int it = F.bid; it < 192; it += F.G) {
            const int l = it / 96, cb = it % 96, col = F.tid & 63, kg = F.tid >> 6;
            float acc[9];
#pragma unroll
            for (int r9 = 0; r9 < 9; ++r9) acc[r9] = 0.f;
            const float* wp = F.in[I_WADA] + ((size_t)l * D + kg * 128) * 6144 + cb * 64 + col;
#pragma unroll 4
            for (int kk = 0; kk < 128; ++kk) {
                const float w = wp[(size_t)kk * 6144];
#pragma unroll
                for (int r9 = 0; r9 < 9; ++r9) acc[r9] = fmaf(sc[r9 * 1024 + kg * 128 + kk], w, acc[r9]);
            }
#pragma unroll
            for (int r9 = 0; r9 < 9; ++r9) part[(kg * 9 + r9) * 64 + col] = acc[r9];
            __syncthreads();
            for (int t = F.tid; t < 9 * 64; t += NTHR) { const int r9 = t >> 6, cc = t & 63; float sm = F.in[I_BADA][l * 6144 + cb * 64 + cc];
#pragma unroll
                for (int k8 = 0; k8 < 8; ++k8) sm += part[(k8 * 9 + r9) * 64 + cc];
                F.MOD[((size_t)l * 9 + r9) * 6144 + cb * 64 + cc] = sm; }
            __syncthreads();
        }
    }
}
__device__ __forceinline__ LAS int* moe_tables(const Frame& F, int l) {
    LAS int* tab = (LAS int*)(F.lds + TAB_OFF);
    __syncthreads();
    if (F.tid == 0) {
        int bs = 0;
        for (int e = 0; e < NEXP; ++e) { const int c = (int)F.ctl[CW_CNT + l * 64 + e]; tab[e] = bs; tab[40 + e] = c; bs += ((c + 255) / 256) * 256; }
        tab[16] = bs;
    }
    __syncthreads();
    return tab;
}
template <int MODE>
__device__ __forceinline__ void phase_rowA(const Frame& F0, int l)  {
    constexpr bool HAS_MOE = MODE != 0, FINAL = MODE == 2;
    Frame F = enter_phase(F0);
    LAS int* tab = (LAS int*)(F.lds + TAB_OFF);
    if (HAS_MOE) tab = moe_tables(F, l - 1);
    LAS float* WDT = (LAS float*)F.lds;
    if (!FINAL) {
        __syncthreads();
        stage_wt16(WDT, F.in[I_WIN] + (size_t)l * D * INC + 1536, INC, F.tid);
        __syncthreads();
    }
    const int gw = F.bid * NWAVES + F.wave, NGW = F.G * NWAVES;
    const int RL = FINAL ? TL : TT;
    const int RPW = (RL + NGW - 1) / NGW, rbeg = gw * RPW, rend = (rbeg + RPW < RL) ? rbeg + RPW : RL;
    const float* gvec = FINAL ? F.in[I_GFIN] : F.in[I_GMIX] + l * D;
    LAS float* MV = (LAS float*)(F.lds + 65536);
    const int brow0 = F.bid * NWAVES * RPW, brow1 = (brow0 + NWAVES * RPW < RL ? brow0 + NWAVES * RPW : RL) - 1;
    const int mr_a = modrow(brow0 < RL ? brow0 : RL - 1), mr_b = modrow(brow1 > 0 ? brow1 : 0);
    for (int i = F.tid; i < 2 * 1024; i += NTHR) {
        const int sl = i >> 10, c = i & 1023, mr = sl ? mr_b : mr_a;
        const float gg = gvec[c];
        MV[sl * 3072 + c] = FINAL ? gg : gg * (F.MOD[((size_t)l * 9 + mr) * 6144 + 1024 + c] + 1.f);
        MV[sl * 3072 + 1024 + c] = FINAL ? 0.f : F.MOD[((size_t)l * 9 + mr) * 6144 + c];
        MV[sl * 3072 + 2048 + c] = HAS_MOE ? F.MOD[((size_t)(l - 1) * 9 + mr) * 6144 + 5120 + c] : 0.f;
    }
    __syncthreads();
    f32x4 vn[4]; u32x2 yan[4], ybn[4]; int4 tin = make_int4(0, 0, 0, 0), tin2 = tin; f32x2 twn = {0.f, 0.f}, twn2 = twn;
    if (rbeg < rend) {
#pragma unroll
        for (int j = 0; j < 4; ++j) vn[j] = *(const f32x4*)(F.XS + (size_t)rbeg * D + 4 * F.lane + 256 * j);
        if (HAS_MOE) {
            tin = *(const int4*)(F.TOKI + (size_t)rbeg * 4); twn = *(const f32x2*)(F.TOKW + (size_t)rbeg * 2);
            if (rbeg + 1 < rend) { tin2 = *(const int4*)(F.TOKI + (size_t)(rbeg + 1) * 4); twn2 = *(const f32x2*)(F.TOKW + (size_t)(rbeg + 1) * 2); }
            const size_t ra = (size_t)(tab[tin.x] + tin.y), rb = (size_t)(tab[tin.z] + tin.w);
#pragma unroll
            for (int j = 0; j < 4; ++j) { yan[j] = *(const u32x2*)(F.YDN + ra * D + 4 * F.lane + 256 * j); ybn[j] = *(const u32x2*)(F.YDN + rb * D + 4 * F.lane + 256 * j); }
        }
    }
#pragma unroll 1
    for (int r = rbeg; r < rend; ++r) {
        const int mr = modrow(r);
        f32x4 v[4]; u32x2 ya[4], yb[4];
#pragma unroll
        for (int j = 0; j < 4; ++j) { v[j] = vn[j]; ya[j] = yan[j]; yb[j] = ybn[j]; }
        const f32x2 tw = twn;
        if (r + 1 < rend) {
#pragma unroll
            for (int j = 0; j < 4; ++j) vn[j] = *(const f32x4*)(F.XS + (size_t)(r + 1) * D + 4 * F.lane + 256 * j);
            if (HAS_MOE) {
                tin = tin2; twn = twn2;
                if (r + 2 < rend) { tin2 = *(const int4*)(F.TOKI + (size_t)(r + 2) * 4); twn2 = *(const f32x2*)(F.TOKW + (size_t)(r + 2) * 2); }
                const size_t ra = (size_t)(tab[tin.x] + tin.y), rb = (size_t)(tab[tin.z] + tin.w);
#pragma unroll
                for (int j = 0; j < 4; ++j) { yan[j] = *(const u32x2*)(F.YDN + ra * D + 4 * F.lane + 256 * j); ybn[j] = *(const u32x2*)(F.YDN + rb * D + 4 * F.lane + 256 * j); }
            }
        }
        const LAS float* mv = MV + (mr == mr_a ? 0 : 3072);
        if (HAS_MOE) {
#pragma unroll
            for (int j = 0; j < 4; ++j) {
                const float yaf[4] = {__uint_as_float(ya[j].x << 16), __uint_as_float(ya[j].x & 0xffff0000u), __uint_as_float(ya[j].y << 16), __uint_as_float(ya[j].y & 0xffff0000u)};
                const float ybf[4] = {__uint_as_float(yb[j].x << 16), __uint_as_float(yb[j].x & 0xffff0000u), __uint_as_float(yb[j].y << 16), __uint_as_float(yb[j].y & 0xffff0000u)};
                const f32x4 g2q = *(const LAS f32x4*)&mv[2048 + 4 * F.lane + 256 * j];
#pragma unroll
                for (int e = 0; e < 4; ++e) v[j][e] += g2q[e] * (yaf[e] * tw.x + ybf[e] * tw.y);
            }
            if (!FINAL) {
#pragma unroll
                for (int j = 0; j < 4; ++j) *(f32x4*)(F.XS + (size_t)r * D + 4 * F.lane + 256 * j) = v[j];
            }
        }
        float ss = 0.f;
#pragma unroll
        for (int j = 0; j < 4; ++j) ss += (v[j].x * v[j].x + v[j].y * v[j].y) + (v[j].z * v[j].z + v[j].w * v[j].w);
        const float rstd = rsqrtf(wave_sum(ss, F.lane) * (1.f / D) + EPS);
        if (FINAL) {
#pragma unroll
            for (int j = 0; j < 4; ++j) { const int c = 4 * F.lane + 256 * j; *(f32x4*)(F.out + (size_t)r * D + c) = v[j] * rstd * *(const LAS f32x4*)&mv[c]; }
        } else {
            float dtp[16];
#pragma unroll
            for (int e = 0; e < 16; ++e) dtp[e] = 0.f;
#pragma unroll
            for (int j = 0; j < 4; ++j) {
                const int c = 4 * F.lane + 256 * j;
                const f32x4 h = v[j] * rstd * *(const LAS f32x4*)&mv[c] + *(const LAS f32x4*)&mv[1024 + c];
                u32x2 o; o.x = pk2(h.x, h.y); o.y = pk2(h.z, h.w);
                *(u32x2*)(F.HN + (size_t)r * D + c) = o;
                dot16_acc(WDT, h, j, F.lane, dtp);
            }
#pragma unroll
            for (int e = 0; e < 16; ++e) dtp[e] = wave_sum(dtp[e], F.lane);
            if (F.lane == 0) {
#pragma unroll
                for (int e4 = 0; e4 < 4; ++e4) *(f32x4*)(F.DT + (size_t)r * 16 + e4 * 4) = (f32x4){dtp[e4 * 4], dtp[e4 * 4 + 1], dtp[e4 * 4 + 2], dtp[e4 * 4 + 3]};
            }
        }
    }
}
__device__ __forceinline__ void phase_inproj(const Frame& F0, int l)  {
    Frame F = enter_phase(F0);
    pg8::PlainSched S; S.T.init(TT / 256, NCOL / 256, F.G, F.bid); S.Bt = (const char*)(F.WIN_T + (size_t)l * NCOL * D); S.K = D;
    pg8::EpiStoreBf16 E{F.COLS, NCOL, 0, nullptr};
    pg8::gemm_phase<pg8::EpiStoreBf16, pg8::PlainSched, true>(F.lds, F.HN, D, S, E, F.tid);
}
__device__ __forceinline__ void conf_unit(const Frame& Fu, int l, int uidx) {
    Frame F = Fu; { int wv_ = Fu.wave; asm volatile("" : "+s"(wv_), "+s"(l)); F.wave = wv_; } F.lane = fresh_lane(); F.tid = F.wave * 64 + F.lane;
    const int r0 = uidx * 64;
    LAS bf16* XU = (LAS bf16*)F.lds;
    LAS float* WD = (LAS float*)(F.lds + 94 * 512);
    LAS bf16* CVL = (LAS bf16*)(F.lds + 94 * 512 + 31 * 1024);
    int lo, hi; seq_bounds(r0, lo, hi);
    __syncthreads();
    for (int i = F.tid; i < 94 * 64; i += NTHR) {
        const int rr = r0 - 15 + (i >> 6), c = (i & 63) * 4;
        u32x2 o = {0u, 0u};
        if (rr >= lo && rr < hi) { float a[4], g[4]; ld4(F.COLS + (size_t)rr * NCOL + 1536 + c, a); ld4(F.COLS + (size_t)rr * NCOL + 1792 + c, g);
            o.x = pk2(a[0] * sigmoidf_(g[0]), a[1] * sigmoidf_(g[1])); o.y = pk2(a[2] * sigmoidf_(g[2]), a[3] * sigmoidf_(g[3])); }
        *(LAS u32x2*)(XU + (i >> 6) * 256 + c) = o;
    }
    for (int i = F.tid; i < 31 * 64; i += NTHR) *(LAS f32x4*)&WD[i * 4] = *(const f32x4*)(F.in[I_CDW] + (size_t)l * 31 * 256 + i * 4);
    __syncthreads();
    const int ch = 4 * F.lane;
    const f32x4 db = *(const f32x4*)(F.in[I_CDB] + l * 256 + ch), lg = *(const f32x4*)(F.in[I_CLG] + l * 256 + ch), lb = *(const f32x4*)(F.in[I_CLB] + l * 256 + ch);
#pragma unroll 1
    for (int i = 0; i < 8; ++i) {
        const int lr = F.wave * 8 + i;
        f32x4 acc = db;
#pragma unroll
        for (int j = 0; j < 31; ++j) {
            const u32x2 xv = *(const LAS u32x2*)(XU + (lr + j) * 256 + ch); const f32x4 w = *(const LAS f32x4*)&WD[j * 256 + ch];
            acc.x = fmaf(w.x, __uint_as_float(xv.x << 16), acc.x); acc.y = fmaf(w.y, __uint_as_float(xv.x & 0xffff0000u), acc.y);
            acc.z = fmaf(w.z, __uint_as_float(xv.y << 16), acc.z); acc.w = fmaf(w.w, __uint_as_float(xv.y & 0xffff0000u), acc.w);
        }
        const float mean = wave_sum((acc.x + acc.y) + (acc.z + acc.w), F.lane) * (1.f / 256.f);
        const f32x4 d = acc - mean;
        const float var = wave_sum((d.x * d.x + d.y * d.y) + (d.z * d.z + d.w * d.w), F.lane) * (1.f / 256.f);
        const f32x4 y = d * rsqrtf(var + EPS) * lg + lb;
        u32x2 o; o.x = pk2(siluf_(y.x), siluf_(y.y)); o.y = pk2(siluf_(y.z), siluf_(y.w));
        *(LAS u32x2*)(CVL + lr * S5_US + ch) = o;
    }
    __syncthreads();
    {
        int lane_ = F.lane; asm volatile("" : "+v"(lane_));
        const int q = lane_ >> 4, c16 = lane_ & 15;
        const bf16* PW = F.PW_T + (size_t)l * 256 * 256;
        f32x4 acc[2][4];
#pragma unroll
        for (int nt = 0; nt < 2; ++nt)
#pragma unroll
            for (int rt = 0; rt < 4; ++rt) acc[nt][rt] = (f32x4){0.f, 0.f, 0.f, 0.f};
#pragma unroll 2
        for (int ks = 0; ks < 8; ++ks) {
            pg8::bf16x8 wf[2], vf[4];
#pragma unroll
            for (int nt = 0; nt < 2; ++nt) wf[nt] = *(const pg8::bf16x8*)(PW + (size_t)(32 * F.wave + 16 * nt + c16) * 256 + 32 * ks + 8 * q);
#pragma unroll
            for (int rt = 0; rt < 4; ++rt) vf[rt] = *(const LAS pg8::bf16x8*)(CVL + (16 * rt + c16) * S5_US + 32 * ks + 8 * q);
#pragma unroll
            for (int nt = 0; nt < 2; ++nt)
#pragma unroll
                for (int rt = 0; rt < 4; ++rt) acc[nt][rt] = __builtin_amdgcn_mfma_f32_16x16x32_bf16(wf[nt], vf[rt], acc[nt][rt], 0, 0, 0);
        }
        const float* pb = F.in[I_CPB] + l * 256;
#pragma unroll
        for (int nt = 0; nt < 2; ++nt) { const int n0 = 32 * F.wave + 16 * nt + 4 * q; const f32x4 bv = *(const f32x4*)(pb + n0);
#pragma unroll
            for (int rt = 0; rt < 4; ++rt) { u32x2 w; w.x = pk2(acc[nt][rt][0] + bv[0], acc[nt][rt][1] + bv[1]); w.y = pk2(acc[nt][rt][2] + bv[2], acc[nt][rt][3] + bv[3]);
                *(u32x2*)(F.MIX + (size_t)(r0 + 16 * rt + c16) * 1024 + 512 + n0) = w; } }
    }
}
__device__ __forceinline__ void expert_cvt_item(const Frame& F, int l, int it, LAS float* scr) {
    const int mtx = it >> 9, r = it & 511, e = mtx / 3, kind = mtx % 3;
    const size_t wofs = ((size_t)l * NEXP + e) * D * D;
    if (kind == 0) transpose_item(F.in[I_WG] + wofs, D, D, F.WGU_T + (size_t)e * 2048 * D, [](int n) { return (n >> 7) * 256 + (n & 127); }, scr, r, F.lane);
    else if (kind == 1) transpose_item(F.in[I_WU] + wofs, D, D, F.WGU_T + (size_t)e * 2048 * D, [](int n) { return (n >> 7) * 256 + 128 + (n & 127); }, scr, r, F.lane);
    else transpose_item(F.in[I_WD] + wofs, D, D, F.WD_T + (size_t)e * D * D, [](int n) { return n; }, scr, r, F.lane);
}
__device__ __forceinline__ void phase_scan(const Frame& F0, int l)  {
    Frame F = enter_phase(F0);
    const int RLc = (l == 0) ? TT : TL;
    const int NU = 288 + 288 + RLc / 64;
    const int gw = F.bid * NWAVES + F.wave, NGW = F.G * NWAVES;
    LAS float* scr = (LAS float*)(F.lds + 131072 - NWAVES * 8448) + F.wave * (64 * 33);
    int cv = gw;
    const int nconf = RLc / 64, nb2 = F.G - 32;
    for (int k = 0; k < 6; ++k) {
        int kind = -1, idx = 0;
        if (F.G == 256) {
            if (k == 0) { kind = 0; idx = F.bid; }
            else if (F.bid < 32) { if (k == 1) { kind = 0; idx = 256 + F.bid; } }
            else { const int j = F.bid - 32;
                if (k == 1) { kind = 1; idx = j; } else if (k == 2) { kind = 2; idx = j; }
                else if (k == 3) { if (j + nb2 < 288) { kind = 1; idx = j + nb2; } } else if (k == 4) { if (j + nb2 < nconf) { kind = 2; idx = j + nb2; } } }
        } else {
            const int u = F.bid + k * F.G; if (u < 288) { kind = 0; idx = u; } else if (u < 576) { kind = 1; idx = u - 288; } else if (u < 576 + nconf) { kind = 2; idx = u - 576; }
        }
        if (kind == 0) ssd_unit_a(F, l, idx);
        else if (kind == 1) s5_unit<0>(F, l, idx);
        else if (kind == 2) conf_unit(F, l, idx);
        __syncthreads();
#pragma unroll 1
        for (int k2 = 0; k2 < 2 && cv < 48 * 512; ++k2, cv += NGW) expert_cvt_item(F, l, cv, scr);
    }
    __syncthreads();
    for (; cv < 48 * 512; cv += NGW) expert_cvt_item(F, l, cv, scr);
}
__device__ __forceinline__ void phase_carry(const Frame& F0, int l)  {
    Frame F = enter_phase(F0);
    s5_carry(F, l);
    ssd_carry(F);
}
__device__ __forceinline__ void phase_mix1(const Frame& F0, int l)  {
    Frame F = enter_phase(F0);
    const int RL = (l == 0) ? TT : TL;
    for (int u = F.bid; u < 288 + 288; u += F.G) {
        if (u < 288) { if (l == 0 || ((u >> 1) % 18) >= 2) ssd_unit_b(F, l, u); }
        else { const int v = u - 288; if (l == 0 || (v % 36) >= 4) s5_unit<1>(F, l, v); }
    }
}
__device__ __forceinline__ void phase_wout(const Frame& F0, int l)  {
    Frame F = enter_phase(F0);
    const int RL = (l == 0) ? TT : TL;
    pg8::PlainSched S; S.T.init(RL / 256, D / 256, F.G, F.bid); S.Bt = (const char*)(F.WOUT_T + (size_t)l * D * D); S.K = D;
    pg8::EpiResidual E{F.XS, F.MOD + (size_t)l * 9 * 6144 + 2048};
    pg8::gemm_phase<pg8::EpiResidual, pg8::PlainSched, true>(F.lds, F.MIX, D, S, E, F.tid);
}
__device__ __forceinline__ void phase_norm2(const Frame& F0, int l)  {
    Frame F = enter_phase(F0);
    const int RL = (l == 0) ? TT : TL;
    LAS float* RW = (LAS float*)F.lds;
    __syncthreads();
    stage_wt16(RW, F.in[I_RW], 16, F.tid);
    LAS int* lcnt = (LAS int*)(F.lds + 65536);
    if (F.tid < 32) lcnt[F.tid] = 0;
    __syncthreads();
    const int gw = F.bid * NWAVES + F.wave, NGW = F.G * NWAVES;
    const int RPW = (RL + NGW - 1) / NGW, rbeg = gw * RPW, rend = (rbeg + RPW < RL) ? rbeg + RPW : RL;
    const float* gvec = F.in[I_GFFN] + l * D;
    f32x4 gv[4], shv[4], scv[4], vn[4]; int cur_mr = -1;
#pragma unroll
    for (int j = 0; j < 4; ++j) gv[j] = *(const f32x4*)(gvec + 4 * F.lane + 256 * j);
    if (rbeg < rend) {
#pragma unroll
        for (int j = 0; j < 4; ++j) vn[j] = *(const f32x4*)(F.XS + (size_t)rbeg * D + 4 * F.lane + 256 * j);
    }
#pragma unroll 1
    for (int r = rbeg; r < rend; ++r) {
        const int mr = modrow(r);
        f32x4 v[4]; float ss = 0.f;
#pragma unroll
        for (int j = 0; j < 4; ++j) { v[j] = vn[j]; ss += (v[j].x * v[j].x + v[j].y * v[j].y) + (v[j].z * v[j].z + v[j].w * v[j].w); }
        if (r + 1 < rend) {
#pragma unroll
            for (int j = 0; j < 4; ++j) vn[j] = *(const f32x4*)(F.XS + (size_t)(r + 1) * D + 4 * F.lane + 256 * j);
        }
        if (mr != cur_mr) { cur_mr = mr;
#pragma unroll
            for (int j = 0; j < 4; ++j) { const int c = 4 * F.lane + 256 * j; shv[j] = *(const f32x4*)(F.MOD + ((size_t)l * 9 + mr) * 6144 + 3072 + c); scv[j] = *(const f32x4*)(F.MOD + ((size_t)l * 9 + mr) * 6144 + 4096 + c); } }
        const float rstd = rsqrtf(wave_sum(ss, F.lane) * (1.f / D) + EPS);
        float lg[16];
#pragma unroll
        for (int e = 0; e < 16; ++e) lg[e] = 0.f;
#pragma unroll
        for (int j = 0; j < 4; ++j) {
            const int c = 4 * F.lane + 256 * j;
            const f32x4 h = v[j] * rstd * gv[j] * (scv[j] + 1.f) + shv[j];
            u32x2 o; o.x = pk2(h.x, h.y); o.y = pk2(h.z, h.w);
            *(u32x2*)(F.HN + (size_t)r * D + c) = o;
            dot16_acc(RW, h, j, F.lane, lg);
        }
        float mx = -3.0e38f;
#pragma unroll
        for (int e = 0; e < 16; ++e) { lg[e] = wave_sum(lg[e], F.lane) + F.in[I_RB][e]; mx = fmaxf(mx, lg[e]); }
        float den = 0.f;
#pragma unroll
        for (int e = 0; e < 16; ++e) { lg[e] = expf(lg[e] - mx); den += lg[e]; }
        const float inv = 1.f / den;
#pragma unroll
        for (int e = 0; e < 16; ++e) lg[e] *= inv;
        float gs[4];
#pragma unroll
        for (int gI = 0; gI < 4; ++gI) {
            const float p0 = lg[gI * 4], p1 = lg[gI * 4 + 1], p2 = lg[gI * 4 + 2], p3 = lg[gI * 4 + 3];
            const float h01 = fmaxf(p0, p1), l01 = fminf(p0, p1), h23 = fmaxf(p2, p3), l23 = fminf(p2, p3);
            gs[gI] = fmaxf(h01, h23) + fmaxf(fminf(h01, h23), fmaxf(l01, l23));
        }
        int best = 0; float bsv = gs[0];
#pragma unroll
        for (int gI = 1; gI < 4; ++gI) if (gs[gI] > bsv) { bsv = gs[gI]; best = gI; }
        float q[4];
#pragma unroll
        for (int i = 0; i < 4; ++i) q[i] = best == 0 ? lg[i] : (best == 1 ? lg[4 + i] : (best == 2 ? lg[8 + i] : lg[12 + i]));
        int i0 = 0; float v0 = q[0];
#pragma unroll
        for (int i = 1; i < 4; ++i) if (q[i] > v0) { v0 = q[i]; i0 = i; }
        int i1 = -1; float v1 = -1.f;
#pragma unroll
        for (int i = 0; i < 4; ++i) if (i != i0 && q[i] > v1) { v1 = q[i]; i1 = i; }
        const float ginv = 1.f / (v0 + v1);
        if (F.lane == 0) {
            const int e0 = best * 4 + i0, e1 = best * 4 + i1;
            const int p0 = __hip_atomic_fetch_add(&lcnt[e0], 1, __ATOMIC_RELAXED, __HIP_MEMORY_SCOPE_WORKGROUP), p1 = __hip_atomic_fetch_add(&lcnt[e1], 1, __ATOMIC_RELAXED, __HIP_MEMORY_SCOPE_WORKGROUP);
            *(int4*)(F.TOKI + (size_t)r * 4) = make_int4(e0, p0, e1, p1);
            *(f32x2*)(F.TOKW + (size_t)r * 2) = (f32x2){v0 * ginv, v1 * ginv};
        }
    }
    __syncthreads();
    if (F.tid < 16) lcnt[16 + F.tid] = (int)atomicAdd(&F.ctl[CW_CNT + l * 64 + F.tid], (unsigned)lcnt[F.tid]);
    __syncthreads();
    if (F.lane == 0) {
        for (int r = rbeg; r < rend; ++r) {
            int4 ti = *(const int4*)(F.TOKI + (size_t)r * 4);
            ti.y += lcnt[16 + ti.x]; ti.w += lcnt[16 + ti.z];
            *(int4*)(F.TOKI + (size_t)r * 4) = ti;
            F.LIST[(size_t)ti.x * TT + ti.y] = r; F.LIST[(size_t)ti.z * TT + ti.w] = r;
        }
    }
}
__device__ __forceinline__ void phase_gateup(const Frame& F0, int l)  {
    Frame F = enter_phase(F0);
    LAS int* tab = moe_tables(F, l);
    LAS int* rows = (LAS int*)(F.lds + ROWS_OFF);
    pg8::MoeSched<true> S; S.T.init(tab[16] / 256, 8, F.G, F.bid); S.Bt = (const char*)F.WGU_T; S.K = D; S.NE = 2048; S.tab = tab; S.rows = rows;
    {
        pg8::Unit u;
        for (int i = 0; i < 15 && S.next(i, u); ++i) {
            if (F.tid < 256) { const int sr = u.pm * 256 + F.tid, e = S.expert(u.pm), pos = sr - tab[e], cnt = tab[40 + e];
                rows[i * 256 + F.tid] = F.LIST[(size_t)e * TT + (pos < cnt ? pos : 0)]; }
        }
        __syncthreads();
    }
    pg8::EpiPairBf16<0> E{F.HMID, 1024, 0, nullptr, 0};
    pg8::gemm_phase<pg8::EpiPairBf16<0>, pg8::MoeSched<true>, true>(F.lds, F.HN, D, S, E, F.tid);
}
__device__ __forceinline__ void phase_down(const Frame& F0, int l)  {
    Frame F = enter_phase(F0);
    LAS int* tab = moe_tables(F, l);
    pg8::MoeSched<false> S; S.T.init(tab[16] / 256, 4, F.G, F.bid); S.Bt = (const char*)F.WD_T; S.K = D; S.NE = 1024; S.tab = tab; S.rows = nullptr;
    pg8::EpiStoreBf16 E{F.YDN, 1024, 0, nullptr};
    pg8::gemm_phase<pg8::EpiStoreBf16, pg8::MoeSched<false>, true>(F.lds, F.HMID, D, S, E, F.tid);
}

constexpr int PH_PER_LAYER = 9, N_PHASES = 1 + DEPTH * PH_PER_LAYER + 1;

__global__ void __launch_bounds__(NTHR, 2) fwd_kernel(Args args) {
    extern __shared__ __attribute__((aligned(16))) unsigned char lds_raw[];
    Frame F;
    F.lds = (LAS unsigned char*)lds_raw;
    F.tid = threadIdx.x; F.lane = F.tid & 63; F.wave = __builtin_amdgcn_readfirstlane(F.tid >> 6);
    F.G = gridDim.x; F.bid = blockIdx.x;
    F.in = (const CAS cfp_t*)__builtin_amdgcn_kernarg_segment_ptr(); F.out = args.out; F.ws = args.ws;
    frame_ptrs(F, args.ws);
    volatile LAS unsigned* MISC = (volatile LAS unsigned*)(F.lds + MISC_OFF);
    if (F.tid < 32) MISC[F.tid] = 0u;
    __syncthreads();
    const int lo = args.ph_lo, hi = args.ph_hi;
    const bool multi = (hi - lo) > 1;
    XcdBarrier bar; bar.bar = F.ctl + CW_BAR; bar.x = 0; bar.st = MISC + 8;
    if (multi) bar = xcd_barrier_post(F.ctl + CW_BAR, MISC + 8);
#define IN(k) (lo <= (k) && (k) < hi)
#define SEAM(k) do { if (IN(k) && IN((k) + 1)) { XcdBarrier bb_ = bar; asm volatile("" : "+s"(bb_.bar)); xcd_barrier(bb_); } } while (0)
    if (IN(0)) phase_p0(F);
    SEAM(0);
    for (int l = 0; l < DEPTH; ++l) {
        const int pb = 1 + l * PH_PER_LAYER;
        if (IN(pb + 0)) { if (l == 0) phase_rowA<0>(F, l); else phase_rowA<1>(F, l); }
        SEAM(pb + 0);
        if (IN(pb + 1)) phase_inproj(F, l);
        SEAM(pb + 1);
        if (IN(pb + 2)) phase_scan(F, l);
        SEAM(pb + 2);
        if (IN(pb + 3)) phase_carry(F, l);
        SEAM(pb + 3);
        if (IN(pb + 4)) phase_mix1(F, l);
        SEAM(pb + 4);
        if (IN(pb + 5)) phase_wout(F, l);
        SEAM(pb + 5);
        if (IN(pb + 6)) phase_norm2(F, l);
        SEAM(pb + 6);
        if (IN(pb + 7)) phase_gateup(F, l);
        SEAM(pb + 7);
        if (IN(pb + 8)) phase_down(F, l);
        SEAM(pb + 8);
    }
    if (IN(N_PHASES - 1)) phase_rowA<2>(F, DEPTH);
#undef IN
#undef SEAM
}

extern "C" void kernel_launch(void* const* d_in, const int* in_sizes, int n_in, void* d_out, int out_size, void* d_ws, size_t ws_size, hipStream_t stream) {
    static int grid = 0;
    if (grid == 0) {
        if (n_in != N_IN || out_size != TL * D || ws_size < WS_END) { fprintf(stderr, "kernel_launch: unexpected shapes (n_in %d out %d ws %zu)\n", n_in, out_size, ws_size); grid = -1; return; }
        int dev = 0, cus = 0, per_cu = 0;
        if (hipGetDevice(&dev) != hipSuccess || hipDeviceGetAttribute(&cus, hipDeviceAttributeMultiprocessorCount, dev) != hipSuccess) { grid = -1; return; }
        if (hipFuncSetAttribute((const void*)fwd_kernel, hipFuncAttributeMaxDynamicSharedMemorySize, LDS_BYTES) != hipSuccess) { fprintf(stderr, "kernel_launch: hipFuncSetAttribute failed\n"); grid = -1; return; }
        if (hipOccupancyMaxActiveBlocksPerMultiprocessor(&per_cu, (const void*)fwd_kernel, NTHR, LDS_BYTES) != hipSuccess || per_cu < 1) { fprintf(stderr, "kernel_launch: occupancy query says %d\n", per_cu); }
        (void)hipGetLastError();
        grid = cus;
    }
    if (grid < 0) return;
    if (hipMemsetAsync((char*)d_ws + WS_CTL, 0, CTL_ZERO_BYTES, stream) != hipSuccess) return;
    Args a{};
    for (int i = 0; i < N_IN; ++i) a.in[i] = (const float*)d_in[i];
    a.out = (float*)d_out; a.ws = (unsigned char*)d_ws;
#if MK_ONE_LAUNCH
    a.ph_lo = 0; a.ph_hi = N_PHASES;
    hipLaunchKernelGGL(fwd_kernel, dim3(grid), dim3(NTHR), LDS_BYTES, stream, a);
#else
    for (int p = 0; p < N_PHASES; ++p) { a.ph_lo = p; a.ph_hi = p + 1; hipLaunchKernelGGL(fwd_kernel, dim3(grid), dim3(NTHR), LDS_BYTES, stream, a); }
#endif
}
```

```cpp
#include <hip/hip_runtime.h>
#include <cstdio>
#include <cstdint>

#ifndef MK_ONE_LAUNCH
#define MK_ONE_LAUNCH 1
#endif

#define GAS __attribute__((address_space(1)))
#define LAS __attribute__((address_space(3)))
#define CAS __attribute__((address_space(4)))
typedef const float* cfp_t;
#if defined(__HIP_DEVICE_COMPILE__)
#define ASSUME_GLOBAL(p) __builtin_assume(!__builtin_amdgcn_is_shared((const __attribute__((address_space(0))) void*)(p)) && !__builtin_amdgcn_is_private((const __attribute__((address_space(0))) void*)(p)))
#else
#define ASSUME_GLOBAL(p) ((void)0)
#endif
typedef const GAS float* gcfp_t;
#define GIN(Fx, k) ((const float*)(((const CAS gcfp_t*)(const CAS void*)(Fx).in)[k]))
typedef unsigned short bf16;
typedef float f32x4 __attribute__((ext_vector_type(4)));
typedef float f32x2 __attribute__((ext_vector_type(2)));
typedef unsigned u32x4 __attribute__((ext_vector_type(4)));
typedef unsigned u32x2 __attribute__((ext_vector_type(2)));

constexpr int D = 1024, NB = 8, SEQ = 2048, CTXL = 256, DEPTH = 2;
constexpr int TL = NB * SEQ, TC = NB * CTXL, TT = TL + TC;
constexpr int INC = 2320;
constexpr int NCOL = 2304;
constexpr int VSEQ = CTXL + SEQ;
constexpr int NEXP = 16;
constexpr float EPS = 1e-6f;

enum { I_X = 0, I_C, I_CTX, I_CCTX, I_WADA, I_BADA, I_GMIX, I_WIN, I_SCW, I_SCB, I_SDTB, I_SALOG, I_SD, I_SNG,
       I_CDW, I_CDB, I_CLG, I_CLB, I_CPW, I_CPB, I_LRE, I_LIM, I_LSTEP, I_BRE, I_BIM, I_CRE, I_CIM, I_S5D, I_GLUW, I_GLUB,
       I_WOUT, I_GFFN, I_RW, I_RB, I_WG, I_WU, I_WD, I_GFIN, N_IN };

constexpr size_t MiB = 1u << 20;
constexpr size_t WS_CTL = 0, CTL_ZERO_BYTES = 64 * 1024;
constexpr size_t WS_MOD = 1 * MiB;
constexpr size_t WS_DT = 6 * MiB;
constexpr size_t WS_S5AA = 5 * MiB + 512 * 1024;
constexpr size_t WS_S5BB = WS_S5AA + 32 * 1024;
constexpr size_t WS_S5CM = WS_S5BB + 256 * 1024;
constexpr size_t WS_TOKI = 7 * MiB + 512 * 1024;
constexpr size_t WS_TOKW = WS_TOKI + (size_t)TT * 16;
constexpr size_t WS_XS = 8 * MiB;
constexpr size_t WS_HN = 80 * MiB;
constexpr size_t WS_COLS = 116 * MiB;
constexpr size_t WS_SSDBUF = 197 * MiB;
constexpr size_t WS_CC = 197 * MiB;
constexpr size_t WS_YI = 207 * MiB;
constexpr size_t WS_SST = 226 * MiB;
constexpr size_t WS_HIN = 264 * MiB;
constexpr size_t WS_EDEC = 302 * MiB;
constexpr size_t WS_TOT = 304 * MiB;
constexpr size_t WS_MIX = 305 * MiB;
constexpr size_t WS_S5HL = 341 * MiB;
constexpr size_t WS_S5HI = 351 * MiB;
constexpr size_t WS_POS = 361 * MiB;
constexpr size_t WS_LIST = 413 * MiB;
constexpr size_t WS_WIN_T = 415 * MiB;
constexpr size_t WS_WOUT_T = 424 * MiB;
constexpr size_t WS_PW_T = 428 * MiB;
constexpr size_t WS_GLU_T = 428 * MiB + 512 * 1024;
constexpr size_t WS_WGU_T = 429 * MiB;
constexpr size_t WS_WD_T = 493 * MiB;
constexpr size_t WS_END = 525 * MiB;
constexpr int MOE_ROWS = 2 * TT + NEXP * 256;
constexpr size_t WS_HMID = WS_COLS;
constexpr size_t WS_YDN = WS_SSDBUF;
static_assert(WS_HMID + (size_t)MOE_ROWS * 1024 * 2 <= WS_SSDBUF, "HMID overlay");
static_assert(WS_YDN + (size_t)MOE_ROWS * 1024 * 2 <= WS_MIX, "YDN overlay");
constexpr int CW_CNT = 64;
constexpr int CW_BAR = 1024;

constexpr int NWAVES = 8, NTHR = 512;
constexpr int LDS_BYTES = 147456;
constexpr int MISC_OFF = 131072 + 320;
constexpr int TAB_OFF = 131072 + 512, ROWS_OFF = TAB_OFF + 256;

__device__ __forceinline__ float bf2f(bf16 v) { return __uint_as_float((unsigned)v << 16); }
__device__ __forceinline__ unsigned f2bf(float f) { unsigned u = __float_as_uint(f); return (u + 0x7fffu + ((u >> 16) & 1u)) >> 16; }
typedef __bf16 bf16x2_t __attribute__((ext_vector_type(2)));
__device__ __forceinline__ unsigned pk2(float lo, float hi) { f32x2 v = {lo, hi}; return __builtin_bit_cast(unsigned, __builtin_convertvector(v, bf16x2_t)); }
__device__ __forceinline__ float dpp_x1(float v) { return __int_as_float(__builtin_amdgcn_update_dpp(0, __float_as_int(v), 0xB1, 0xF, 0xF, false)); }
__device__ __forceinline__ float dpp_x2(float v) { return __int_as_float(__builtin_amdgcn_update_dpp(0, __float_as_int(v), 0x4E, 0xF, 0xF, false)); }
__device__ __forceinline__ float reduce16_scatter(const float (&t)[16], int lane) {
    const bool b0 = lane & 1, b1 = lane & 2, b2 = lane & 4, b3 = lane & 8;
    float u[8], w[4], x[2];
#pragma unroll
    for (int i = 0; i < 8; ++i) u[i] = (b0 ? t[i + 8] : t[i]) + dpp_x1(b0 ? t[i] : t[i + 8]);
#pragma unroll
    for (int i = 0; i < 4; ++i) w[i] = (b1 ? u[i + 4] : u[i]) + dpp_x2(b1 ? u[i] : u[i + 4]);
#pragma unroll
    for (int i = 0; i < 2; ++i) x[i] = (b2 ? w[i + 2] : w[i]) + __int_as_float(__builtin_amdgcn_ds_swizzle(__float_as_int(b2 ? w[i] : w[i + 2]), 0x101F));
    float y = (b3 ? x[1] : x[0]) + __int_as_float(__builtin_amdgcn_ds_swizzle(__float_as_int(b3 ? x[0] : x[1]), 0x201F));
    y += __int_as_float(__builtin_amdgcn_ds_swizzle(__float_as_int(y), 0x401F));
    y += __int_as_float(__builtin_amdgcn_ds_bpermute((lane ^ 32) << 2, __float_as_int(y)));
    return y;
}
__host__ __device__ constexpr int bitrev4(int e) { return ((e & 1) << 3) | ((e & 2) << 1) | ((e & 4) >> 1) | ((e & 8) >> 3); }
__device__ __forceinline__ float shx(float v, int m, int lane) { return __int_as_float(__builtin_amdgcn_ds_bpermute((lane ^ m) << 2, __float_as_int(v))); }
__device__ __forceinline__ float wave_sum(float v, int lane) {
    (void)lane;
    v += __int_as_float(__builtin_amdgcn_update_dpp(0, __float_as_int(v), 0xB1, 0xF, 0xF, false));
    v += __int_as_float(__builtin_amdgcn_update_dpp(0, __float_as_int(v), 0x4E, 0xF, 0xF, false));
    v += __int_as_float(__builtin_amdgcn_update_dpp(0, __float_as_int(v), 0x141, 0xF, 0xF, false));
    v += __int_as_float(__builtin_amdgcn_update_dpp(0, __float_as_int(v), 0x140, 0xF, 0xF, false));
    const int iv = __float_as_int(v);
    return (__int_as_float(__builtin_amdgcn_readlane(iv, 0)) + __int_as_float(__builtin_amdgcn_readlane(iv, 16))) + (__int_as_float(__builtin_amdgcn_readlane(iv, 32)) + __int_as_float(__builtin_amdgcn_readlane(iv, 48)));
}
__device__ __forceinline__ float sigmoidf_(float x) { return __builtin_amdgcn_rcpf(1.f + __expf(-x)); }
__device__ __forceinline__ float siluf_(float x) { return x * __builtin_amdgcn_rcpf(1.f + __expf(-x)); }
__device__ __forceinline__ float softplusf_(float x) { return fmaxf(x, 0.f) + __logf(1.f + __expf(-fabsf(x))); }
__device__ __forceinline__ float gelu_tanh(float x) { const float u2 = 1.5957691216057308f * (x + 0.044715f * x * x * x); return x * __builtin_amdgcn_rcpf(1.f + __expf(-u2)); }
__device__ __forceinline__ void sincos_red(float x, float& s, float& c) {
    const float k = rintf(x * 0.15915494309189535f);
    float r = fmaf(-k, 6.2831854820251465f, x); r = fmaf(-k, -1.7484555e-7f, r);
    s = __sinf(r); c = __cosf(r);
}
__device__ __forceinline__ int opaque_v(int v) { asm volatile("" : "+v"(v)); return v; }
__device__ __forceinline__ int modrow(int r) { return r < TL ? (r >> 11) : 8; }
__device__ __forceinline__ void seq_bounds(int r, int& lo, int& hi) {
    if (r < TL) { lo = r & ~(SEQ - 1); hi = lo + SEQ; } else { lo = TL + ((r - TL) & ~(CTXL - 1)); hi = lo + CTXL; }
}
__device__ __forceinline__ int vrow(int b, int dir, int s) {
    if (s < CTXL) return TL + b * CTXL + (dir ? CTXL - 1 - s : s);
    const int t = s - CTXL; return b * SEQ + (dir ? SEQ - 1 - t : t);
}

#define XB_TMO      128
#define XB_XCNT(j)  (256  + 64 * (j))
#define XB_XSUB(j)  (1280 + 64 * (j))
#define XB_XGEN(j)  (2304 + 64 * (j))
#define XB_TOP      3328
#define XB_TOPGEN   3392
#define XCD_BAR_WORDS 3456
#define XB_SPIN_CAP (1u << 18)
__device__ __forceinline__ unsigned xb_ld(unsigned* p)              { return __hip_atomic_load(p, __ATOMIC_RELAXED, __HIP_MEMORY_SCOPE_AGENT); }
__device__ __forceinline__ unsigned xb_add(unsigned* p, unsigned v) { return __hip_atomic_fetch_add(p, v, __ATOMIC_RELAXED, __HIP_MEMORY_SCOPE_AGENT); }
__device__ __forceinline__ unsigned xb_xcc_id() { return (unsigned)__builtin_amdgcn_s_getreg((3 << 11) | 20) & 0xFu; }
#define XB_SPIN(cond, bar) do { unsigned _sp = 0; while (cond) { __builtin_amdgcn_s_sleep(1); \
    if ((++_sp & 255u) == 0u) { if (xb_ld(&(bar)[XB_TMO])) break; if (_sp > XB_SPIN_CAP) { atomicAdd(&(bar)[XB_TMO], 1u); break; } } } } while (0)
struct XcdBarrier { unsigned* bar; unsigned x; volatile LAS unsigned* st; };
__device__ __forceinline__ XcdBarrier xcd_barrier_post(unsigned* bar, volatile LAS unsigned* st) {
    XcdBarrier b; b.bar = bar; b.x = xb_xcc_id(); b.st = st;
    if (threadIdx.x == 0) (void)xb_add(&bar[XB_XCNT(b.x)], 1u);
    return b;
}
__device__ __forceinline__ void xcd_barrier_complete(unsigned* bar, unsigned x, unsigned& nloc, unsigned& nx) {
    const unsigned G = gridDim.x * gridDim.y * gridDim.z;
    unsigned sum, cnt, mine, sp = 0u;
    for (;;) {
        sum = 0u; cnt = 0u; mine = 0u;
#pragma unroll
        for (unsigned j = 0; j < 16; ++j) { const unsigned c = xb_ld(&bar[XB_XCNT(j)]); sum += c; cnt += (c > 0u) ? 1u : 0u; mine = (j == x) ? c : mine; }
        if (sum == G) break;
        __builtin_amdgcn_s_sleep(1);
        if ((++sp & 255u) == 0u) { if (xb_ld(&bar[XB_TMO])) break; if (sp > XB_SPIN_CAP) { atomicAdd(&bar[XB_TMO], 1u); break; } }
    }
    nloc = mine > 0u ? mine : 1u; nx = cnt > 0u ? cnt : 1u;
}
__device__ __forceinline__ void xcd_barrier(const XcdBarrier& b) {
    asm volatile("s_waitcnt vmcnt(0)" ::: "memory");
    __syncthreads();
    if (threadIdx.x == 0) {
        unsigned* bar = b.bar;
        const unsigned bx = xb_xcc_id();
        __builtin_amdgcn_s_waitcnt(0);
        unsigned nloc = b.st[0], nx = b.st[1];
        if (nloc == 0u) { xcd_barrier_complete(bar, bx, nloc, nx); b.st[0] = nloc; b.st[1] = nx; }
        const unsigned old = xb_add(&bar[XB_XSUB(bx)], 1u);
        const unsigned gen = old / nloc;
        if (old + 1u == (gen + 1u) * nloc) {
            __builtin_amdgcn_fence(__ATOMIC_RELEASE, "agent");
            asm volatile("s_waitcnt vmcnt(0)" ::: "memory");
            const unsigned og = xb_add(&bar[XB_TOP], 1u);
            const unsigned tg = og / nx;
            if (og + 1u == (tg + 1u) * nx) xb_add(&bar[XB_TOPGEN], 1u);
            else XB_SPIN(xb_ld(&bar[XB_TOPGEN]) == tg, bar);
            __builtin_amdgcn_fence(__ATOMIC_ACQUIRE, "agent");
            xb_add(&bar[XB_XGEN(bx)], 1u);
            asm volatile("s_waitcnt vmcnt(0)" ::: "memory");
        } else {
            XB_SPIN(xb_ld(&bar[XB_XGEN(bx)]) == gen, bar);
            __builtin_amdgcn_fence(__ATOMIC_ACQUIRE, "agent");
            asm volatile("s_waitcnt vmcnt(0)" ::: "memory");
        }
    }
    __syncthreads();
}

struct Args { const float* in[N_IN]; float* out; unsigned char* ws; int ph_lo, ph_hi; };
struct Frame {
    LAS unsigned char* lds;
    int tid, lane, wave, G, bid;
    const CAS cfp_t* in;
    float* out; unsigned char* ws;
    unsigned* ctl;
    float *MOD, *DT; bf16* XS;
    bf16 *HN, *COLS, *MIX, *HMID, *YDN, *WIN_T, *WOUT_T, *PW_T, *GLU_T, *WGU_T, *WD_T;
    int* LIST; int* TOKI; float* TOKW;
};
__device__ __forceinline__ void frame_ptrs(Frame& F, unsigned char* ws) {
    F.ws = ws; F.ctl = (unsigned*)(ws + WS_CTL);
    F.MOD = (float*)(ws + WS_MOD); F.DT = (float*)(ws + WS_DT); F.XS = (bf16*)(ws + WS_XS);
    F.YDN = (bf16*)(ws + WS_YDN);
    F.WIN_T = (bf16*)(ws + WS_WIN_T); F.WOUT_T = (bf16*)(ws + WS_WOUT_T); F.PW_T = (bf16*)(ws + WS_PW_T); F.GLU_T = (bf16*)(ws + WS_GLU_T); F.WGU_T = (bf16*)(ws + WS_WGU_T); F.WD_T = (bf16*)(ws + WS_WD_T);
    F.HN = (bf16*)(ws + WS_HN); F.COLS = (bf16*)(ws + WS_COLS); F.MIX = (bf16*)(ws + WS_MIX); F.HMID = (bf16*)(ws + WS_HMID);
    F.LIST = (int*)(ws + WS_LIST); F.TOKI = (int*)(ws + WS_TOKI); F.TOKW = (float*)(ws + WS_TOKW);
}
__device__ __forceinline__ int fresh_lane() { unsigned om = ~0u; asm volatile("" : "+s"(om)); int ln = (int)__builtin_amdgcn_mbcnt_hi(om, __builtin_amdgcn_mbcnt_lo(om, 0u)); asm volatile("" : "+v"(ln)); return ln; }
__device__ __forceinline__ Frame enter_phase(const Frame& F0) {
    Frame F = F0; unsigned om = ~0u; asm volatile("" : "+s"(om)); int ln = (int)__builtin_amdgcn_mbcnt_hi(om, __builtin_amdgcn_mbcnt_lo(om, 0u)); asm volatile("" : "+v"(ln));
    int wv_ = F0.wave, bid_ = F0.bid, g_ = F0.G; asm volatile("" : "+s"(wv_), "+s"(bid_), "+s"(g_));
    F.wave = wv_; F.bid = bid_; F.G = g_; F.lane = ln; F.tid = wv_ * 64 + ln;
    GAS unsigned char* wsg = (GAS unsigned char*)F0.ws; asm volatile("" : "+s"(wsg)); frame_ptrs(F, (unsigned char*)wsg);
    const CAS cfp_t* ka = (const CAS cfp_t*)__builtin_amdgcn_kernarg_segment_ptr(); asm volatile("" : "+s"(ka)); F.in = ka;
    return F;
}

__device__ __forceinline__ void ld4(const float* p, float (&v)[4]) { const f32x4 t = *(const f32x4*)p; v[0] = t.x; v[1] = t.y; v[2] = t.z; v[3] = t.w; }
__device__ __forceinline__ void ld4(const bf16* p, float (&v)[4]) { const u32x2 t = *(const u32x2*)p; v[0] = __uint_as_float(t.x << 16); v[1] = __uint_as_float(t.x & 0xffff0000u); v[2] = __uint_as_float(t.y << 16); v[3] = __uint_as_float(t.y & 0xffff0000u); }

__device__ __forceinline__ f32x4 ldbf4(const bf16* p) { const u32x2 t = *(const u32x2*)p; return (f32x4){__uint_as_float(t.x << 16), __uint_as_float(t.x & 0xffff0000u), __uint_as_float(t.y << 16), __uint_as_float(t.y & 0xffff0000u)}; }
__device__ __forceinline__ void stbf4(bf16* p, const f32x4& v) { u32x2 o; o.x = pk2(v.x, v.y); o.y = pk2(v.z, v.w); *(u32x2*)p = o; }
__device__ __forceinline__ void ld8(const bf16* p, float (&v)[8]) { const u32x4 t = *(const u32x4*)p;
    v[0] = __uint_as_float(t.x << 16); v[1] = __uint_as_float(t.x & 0xffff0000u); v[2] = __uint_as_float(t.y << 16); v[3] = __uint_as_float(t.y & 0xffff0000u);
    v[4] = __uint_as_float(t.z << 16); v[5] = __uint_as_float(t.z & 0xffff0000u); v[6] = __uint_as_float(t.w << 16); v[7] = __uint_as_float(t.w & 0xffff0000u); }

namespace pg8 {
typedef short bf16x8 __attribute__((ext_vector_type(8)));
constexpr int BM = 256, BK = 64, HALF = 128, HTB = HALF * BK * 2, STAGE_BYTES = 8 * HTB, NXCD = 8, WGM = 8;
__device__ __forceinline__ int lds_byte(int r, int c) { const int st = (r >> 4) * 2 + (c >> 5), rr = r & 15, cc = c & 31, ob = rr * 64 + cc * 2; return st * 1024 + (ob ^ (((ob >> 9) & 1) << 5)); }
__device__ __forceinline__ void stage_rc(int b, int& R, int& C) { const int st = b / 1024, sb = b % 1024, swz = sb ^ (((sb >> 9) & 1) << 5); R = (st >> 1) * 16 + swz / 64; C = (st & 1) * 32 + (swz % 64) / 2; }
__device__ __forceinline__ int perm32(int rho) { const int n = rho >> 4, i = rho & 15; return 8 * (i >> 2) + 4 * n + (i & 3); }
struct Unit { int pm, pn, idx; };
struct TileOrder {
    int nM, nN, nwg, G, c;
    __device__ __forceinline__ void init(int nM_, int nN_, int G_, int c_) { nM = nM_; nN = nN_; nwg = nM * nN; G = G_; c = c_; }
    __device__ __forceinline__ bool next(int i, Unit& u) const {
        const long L = (long)i * G + c; if (L >= nwg) return false;
        int wgid = (int)L; { const int q = nwg / NXCD, r = nwg % NXCD, xcd = wgid % NXCD, off = wgid / NXCD; wgid = (xcd < r ? xcd * (q + 1) : r * (q + 1) + (xcd - r) * q) + off; }
        const int nig = WGM * nN, gid = wgid / nig, fm = gid * WGM, gsz = (nM - fm) < WGM ? (nM - fm) : WGM;
        u.pm = fm + ((wgid % nig) % gsz); u.pn = (wgid % nig) / gsz; u.idx = i; return true;
    }
};
__device__ __forceinline__ unsigned cvt_pk_bf16(float lo, float hi) { return pk2(lo, hi); }

template <class Epi, class Sched, bool ALIGN_EPI>
__device__ __forceinline__ void gemm_phase(LAS unsigned char* lds, const bf16* Abase, int K, const Sched& S, const Epi& E, int tid) {
    const int wid = __builtin_amdgcn_readfirstlane(tid >> 6), lane = tid & 63, wr = wid >> 2, wc = wid & 3, fr = lane & 15, fq = lane >> 4;
    const int nt = K / BK;
    unsigned voffB[2];
#pragma unroll
    for (int i = 0; i < 2; ++i) { int R, C; stage_rc(tid * 16 + i * 8192, R, C); const int Rb = Epi::PERM ? ((R & ~31) + perm32(R & 31)) : R; voffB[i] = (unsigned)(Rb * K + C) * 2u; }
    const size_t kstep = (size_t)(BK * 2);
    const size_t hstep = (size_t)HALF * K * 2;
    const unsigned ldsw = (unsigned)wid * 1024u;
    const int aoff = lds_byte(wr * 64 + fr, fq * 8), boff = lds_byte(wc * 32 + fr, fq * 8);
#define PG8_SA(b, h) (((b) * 2 + (h)) * HTB)
#define PG8_SB(b, h) ((4 + (b) * 2 + (h)) * HTB)
#define PG8_STAGE(bufoff, gbase, voff) do { _Pragma("unroll") for (int _i = 0; _i < 2; ++_i) \
        __builtin_amdgcn_global_load_lds((const unsigned*)((const char*)(gbase) + (voff)[_i]), (LAS unsigned*)(lds + (bufoff) + ldsw + _i * 8192), 16, 0, 0); } while (0)
#define PG8_LDA(dst, b, h) do { _Pragma("unroll") for (int m = 0; m < 4; ++m) _Pragma("unroll") for (int k = 0; k < 2; ++k) dst[m][k] = *(const LAS bf16x8*)(lds + PG8_SA(b, h) + aoff + m * 2048 + k * 1024); } while (0)
#define PG8_LDB(dst, b, h) do { _Pragma("unroll") for (int n = 0; n < 2; ++n) _Pragma("unroll") for (int k = 0; k < 2; ++k) dst[n][k] = *(const LAS bf16x8*)(lds + PG8_SB(b, h) + boff + n * 2048 + k * 1024); } while (0)
#define PG8_MMA(ai, bj, At, Bt) do { __builtin_amdgcn_s_setprio(1); _Pragma("unroll") for (int m = 0; m < 4; ++m) _Pragma("unroll") for (int n = 0; n < 2; ++n) _Pragma("unroll") for (int k = 0; k < 2; ++k) \
        acc[ai][bj][m][n] = __builtin_amdgcn_mfma_f32_16x16x32_bf16(Bt[n][k], At[m][k], acc[ai][bj][m][n], 0, 0, 0); __builtin_amdgcn_s_setprio(0); } while (0)
#define PG8_WAIT_V(n) asm volatile("s_waitcnt vmcnt(" #n ")" ::: "memory")
#define PG8_WAIT_L(n) asm volatile("s_waitcnt lgkmcnt(" #n ")" ::: "memory")
#define PG8_BAR __builtin_amdgcn_s_barrier()
#define PG8_SCHED __builtin_amdgcn_sched_barrier(0)
#define PG8_SETV(v, u) do { _Pragma("unroll") for (int _i = 0; _i < 2; ++_i) { int _R, _C; stage_rc(tid * 16 + _i * 8192, _R, _C); _Pragma("unroll") for (int _h = 0; _h < 2; ++_h) v[_h][_i] = (unsigned)(S.arow(u, _h * HALF + _R) * K + _C) * 2u; } } while (0)
    Unit cur, nxt; int ui = 0;
    if (!S.next(0, cur)) return;
    f32x4 acc[2][2][4][2];
#pragma unroll
    for (int a = 0; a < 2; ++a)
#pragma unroll
        for (int b = 0; b < 2; ++b)
#pragma unroll
            for (int m = 0; m < 4; ++m)
#pragma unroll
                for (int n = 0; n < 2; ++n) acc[a][b][m][n] = (f32x4){0.f, 0.f, 0.f, 0.f};
    bf16x8 At[4][2], B0[2][2], B1[2][2];
    unsigned vC[2][2], vN[2][2];
    PG8_SETV(vC, cur);
    const char* cA = (const char*)Abase; const char* cB = S.bbase(cur);
    PG8_WAIT_L(0);
    PG8_STAGE(PG8_SB(0, 0), cB, voffB); PG8_STAGE(PG8_SB(0, 1), cB + hstep, voffB); PG8_STAGE(PG8_SA(0, 0), cA, vC[0]); PG8_STAGE(PG8_SA(0, 1), cA, vC[1]);
    if (wr == 1) PG8_BAR;
    PG8_WAIT_V(2); PG8_BAR;
    PG8_STAGE(PG8_SB(1, 0), cB + kstep, voffB); PG8_STAGE(PG8_SA(1, 0), cA + kstep, vC[0]); PG8_STAGE(PG8_SB(1, 1), cB + hstep + kstep, voffB);
    PG8_WAIT_V(6); PG8_BAR;
    for (;;) {
        const bool has_next = S.next(ui + 1, nxt);
        const char* nB = cB;
        if (has_next) { PG8_SETV(vN, nxt); nB = S.bbase(nxt); }
        else {
#pragma unroll
            for (int _h = 0; _h < 2; ++_h)
#pragma unroll
                for (int _i = 0; _i < 2; ++_i) vN[_h][_i] = vC[_h][_i];
        }
        PG8_WAIT_L(0);
#pragma unroll 1
        for (int t = 0; t < nt; t += 2) {
            const bool last = (t == nt - 2);
            const char* a1 = cA + (size_t)(t + 1) * kstep;
            const char* a2 = last ? cA : cA + (size_t)(t + 2) * kstep; const char* b2 = last ? nB : cB + (size_t)(t + 2) * kstep;
            const char* a3 = a2 + kstep; const char* b3 = b2 + kstep;
            PG8_LDB(B0, 0, 0); PG8_LDB(B1, 0, 1); PG8_SCHED; PG8_LDA(At, 0, 0); PG8_STAGE(PG8_SA(1, 1), a1, vC[1]);
            if (last) {
#pragma unroll
                for (int _h = 0; _h < 2; ++_h)
#pragma unroll
                    for (int _i = 0; _i < 2; ++_i) vC[_h][_i] = vN[_h][_i];
            }
            PG8_WAIT_V(8); PG8_WAIT_L(0); PG8_BAR; PG8_MMA(0, 0, At, B0); PG8_MMA(0, 1, At, B1); PG8_BAR; PG8_SCHED;
            PG8_LDA(At, 0, 1); PG8_STAGE(PG8_SB(0, 0), b2, voffB); PG8_STAGE(PG8_SB(0, 1), b2 + hstep, voffB); PG8_STAGE(PG8_SA(0, 0), a2, vC[0]);
            PG8_WAIT_V(8); PG8_WAIT_L(0); PG8_BAR; PG8_MMA(1, 0, At, B0); PG8_MMA(1, 1, At, B1); PG8_BAR; PG8_SCHED;
            PG8_LDB(B0, 1, 0); PG8_LDB(B1, 1, 1); PG8_SCHED; PG8_LDA(At, 1, 0); PG8_STAGE(PG8_SA(0, 1), a2, vC[1]);
            PG8_WAIT_V(8); PG8_WAIT_L(0); PG8_BAR; PG8_MMA(0, 0, At, B0); PG8_MMA(0, 1, At, B1); PG8_BAR; PG8_SCHED;
            PG8_LDA(At, 1, 1); PG8_STAGE(PG8_SB(1, 0), b3, voffB); PG8_STAGE(PG8_SB(1, 1), b3 + hstep, voffB); PG8_STAGE(PG8_SA(1, 0), a3, vC[0]);
            PG8_WAIT_V(8); PG8_WAIT_L(0); PG8_BAR; PG8_MMA(1, 0, At, B0); PG8_MMA(1, 1, At, B1); PG8_BAR; PG8_SCHED;
        }
        if constexpr (ALIGN_EPI) { if (wr == 0) PG8_BAR; }
        E(acc, cur, wr, wc, fr, fq);
        if (!has_next) break;
#pragma unroll
        for (int a = 0; a < 2; ++a)
#pragma unroll
            for (int b = 0; b < 2; ++b)
#pragma unroll
                for (int m = 0; m < 4; ++m)
#pragma unroll
                    for (int n = 0; n < 2; ++n) acc[a][b][m][n] = (f32x4){0.f, 0.f, 0.f, 0.f};
        cur = nxt; cB = nB; ++ui;
        if constexpr (ALIGN_EPI) { if (wr == 1) PG8_BAR; }
    }
    PG8_WAIT_V(0);
    if constexpr (!ALIGN_EPI) { if (wr == 0) PG8_BAR; }
    PG8_BAR;
#undef PG8_SA
#undef PG8_SB
#undef PG8_STAGE
#undef PG8_LDA
#undef PG8_LDB
#undef PG8_MMA
#undef PG8_WAIT_V
#undef PG8_WAIT_L
#undef PG8_BAR
#undef PG8_SCHED
#undef PG8_SETV
}

struct PlainSched {
    TileOrder T; const char* Bt; int K;
    __device__ __forceinline__ bool next(int i, Unit& u) const { return T.next(i, u); }
    __device__ __forceinline__ int arow(const Unit& u, int r) const { return u.pm * BM + r; }
    __device__ __forceinline__ const char* bbase(const Unit& u) const { return Bt + (size_t)u.pn * BM * K * 2; }
};
template <bool GATHER> struct MoeSched {
    TileOrder T; const char* Bt; int K, NE; const LAS int* tab; const LAS int* rows;
    __device__ __forceinline__ bool next(int i, Unit& u) const { return T.next(i, u); }
    __device__ __forceinline__ int expert(int pm) const { const int s = pm * BM; int e = 0;
#pragma unroll
        for (int k = 1; k < NEXP; ++k) if (s >= tab[k]) e = k;
        return e; }
    __device__ __forceinline__ int arow(const Unit& u, int r) const { return GATHER ? rows[u.idx * BM + r] : u.pm * BM + r; }
    __device__ __forceinline__ const char* bbase(const Unit& u) const { return Bt + ((size_t)expert(u.pm) * NE + (size_t)u.pn * BM) * K * 2; }
};
struct EpiStoreBf16 {
    static constexpr bool PERM = true;
    bf16* O; int ldc, col0; const float* bias;
    __device__ __forceinline__ void operator()(const f32x4 (&acc)[2][2][4][2], const Unit& u, int wr, int wc, int fr, int fq) const {
        const int row0 = u.pm * BM + wr * 64 + fr, ct0 = u.pn * BM + wc * 32 + 8 * fq;
        f32x4 bv[2][2];
#pragma unroll
        for (int bj = 0; bj < 2; ++bj)
#pragma unroll
            for (int n = 0; n < 2; ++n) bv[bj][n] = bias ? *(const f32x4*)(bias + ct0 + bj * HALF + 4 * n) : (f32x4){0.f, 0.f, 0.f, 0.f};
#pragma unroll
        for (int ai = 0; ai < 2; ++ai)
#pragma unroll
            for (int m = 0; m < 4; ++m) { bf16* rowp = O + (size_t)(row0 + ai * HALF + m * 16) * ldc + col0 + ct0;
#pragma unroll
                for (int bj = 0; bj < 2; ++bj) { const f32x4 v0 = acc[ai][bj][m][0] + bv[bj][0], v1 = acc[ai][bj][m][1] + bv[bj][1];
                    u32x4 w; w.x = cvt_pk_bf16(v0[0], v0[1]); w.y = cvt_pk_bf16(v0[2], v0[3]); w.z = cvt_pk_bf16(v1[0], v1[1]); w.w = cvt_pk_bf16(v1[2], v1[3]);
                    *(u32x4*)(rowp + bj * HALF) = w; } }
    }
};
template <int ACT>
struct EpiPairBf16 {
    static constexpr bool PERM = true;
    bf16* O; int ldc, col0; const float* bias; int nb;
    __device__ __forceinline__ void operator()(const f32x4 (&acc)[2][2][4][2], const Unit& u, int wr, int wc, int fr, int fq) const {
        const int row0 = u.pm * BM + wr * 64 + fr, ct0 = u.pn * HALF + wc * 32 + 8 * fq;
        f32x4 ba[2], bb[2];
#pragma unroll
        for (int n = 0; n < 2; ++n) { ba[n] = (ACT == 1) ? *(const f32x4*)(bias + ct0 + 4 * n) : (f32x4){0.f, 0.f, 0.f, 0.f}; bb[n] = (ACT == 1) ? *(const f32x4*)(bias + nb + ct0 + 4 * n) : (f32x4){0.f, 0.f, 0.f, 0.f}; }
#pragma unroll
        for (int ai = 0; ai < 2; ++ai)
#pragma unroll
            for (int m = 0; m < 4; ++m) {
                float o[8];
#pragma unroll
                for (int n = 0; n < 2; ++n)
#pragma unroll
                    for (int j = 0; j < 4; ++j) { const float a = acc[ai][0][m][n][j] + ba[n][j], b = acc[ai][1][m][n][j] + bb[n][j];
                        o[n * 4 + j] = (ACT == 0) ? (a * __builtin_amdgcn_rcpf(1.f + __expf(-a))) * b : a * __builtin_amdgcn_rcpf(1.f + __expf(-b)); }
                u32x4 w; w.x = cvt_pk_bf16(o[0], o[1]); w.y = cvt_pk_bf16(o[2], o[3]); w.z = cvt_pk_bf16(o[4], o[5]); w.w = cvt_pk_bf16(o[6], o[7]);
                *(u32x4*)(O + (size_t)(row0 + ai * HALF + m * 16) * ldc + col0 + ct0) = w; }
    }
};
struct EpiResidual {
    static constexpr bool PERM = true;
    bf16* XS; const float* g1;
    __device__ __forceinline__ void operator()(const f32x4 (&acc)[2][2][4][2], const Unit& u, int wr, int wc, int fr, int fq) const {
        const int row0 = u.pm * BM + wr * 64 + fr, ct0 = u.pn * BM + wc * 32 + 8 * fq;
#pragma unroll
        for (int ai = 0; ai < 2; ++ai)
#pragma unroll
            for (int m = 0; m < 4; ++m) { const int row = row0 + ai * HALF + m * 16; bf16* xp = XS + (size_t)row * D + ct0; const float* gp = g1 + (size_t)modrow(row) * 6144 + ct0;
#pragma unroll
                for (int bj = 0; bj < 2; ++bj) { const int o = bj * HALF; const f32x4 ga = *(const f32x4*)(gp + o), gb = *(const f32x4*)(gp + o + 4); const u32x4 xw = *(const u32x4*)(xp + o);
                    const f32x4 xa = {__uint_as_float(xw.x << 16), __uint_as_float(xw.x & 0xffff0000u), __uint_as_float(xw.y << 16), __uint_as_float(xw.y & 0xffff0000u)};
                    const f32x4 xb = {__uint_as_float(xw.z << 16), __uint_as_float(xw.z & 0xffff0000u), __uint_as_float(xw.w << 16), __uint_as_float(xw.w & 0xffff0000u)};
                    const f32x4 ya = xa + ga * acc[ai][bj][m][0], yb = xb + gb * acc[ai][bj][m][1];
                    u32x4 w; w.x = cvt_pk_bf16(ya[0], ya[1]); w.y = cvt_pk_bf16(ya[2], ya[3]); w.z = cvt_pk_bf16(yb[0], yb[1]); w.w = cvt_pk_bf16(yb[2], yb[3]);
                    *(u32x4*)(xp + o) = w; }
                if (m & 1) asm volatile("" ::: "memory"); }
    }
};
}

template <class RowMap>
__device__ __forceinline__ void transpose_item(const float* W, int K, int N, bf16* WT, const RowMap& rowmap, LAS float* scr, int item, int lane) {
    const int nblk = (N + 31) / 32, kb = item / nblk, nb = item % nblk, k0 = 64 * kb, n0 = 32 * nb;
    const bool cok = n0 + (lane & 31) < N;
    float tv[32];
#pragma unroll
    for (int i = 0; i < 32; ++i) { const int kk = 2 * i + (lane >> 5); tv[i] = cok ? W[(size_t)(k0 + kk) * N + n0 + (lane & 31)] : 0.f; }
#pragma unroll
    for (int i = 0; i < 32; ++i) { const int kk = 2 * i + (lane >> 5); scr[kk * 33 + (lane & 31)] = tv[i]; }
    asm volatile("s_waitcnt lgkmcnt(0)" ::: "memory");
    const int c = lane & 7;
#pragma unroll
    for (int j = 0; j < 4; ++j) { const int n = (lane >> 3) + 8 * j; const LAS float* sp = scr + (8 * c) * 33 + n;
        u32x4 o; o.x = pk2(sp[0 * 33], sp[1 * 33]); o.y = pk2(sp[2 * 33], sp[3 * 33]); o.z = pk2(sp[4 * 33], sp[5 * 33]); o.w = pk2(sp[6 * 33], sp[7 * 33]);
        const int dr = rowmap(n0 + n);
        if (dr >= 0) *(u32x4*)(WT + (size_t)dr * K + k0 + 8 * c) = o; }
    asm volatile("s_waitcnt lgkmcnt(0)" ::: "memory");
}


typedef short bf16x4s __attribute__((ext_vector_type(4)));
constexpr int S5_US = 264;
constexpr int S5_WS = 136;
constexpr int S5_BS = 132;
constexpr int S5T = 32, S5SC = S5T / 16, S5NCX = CTXL / S5T, S5NC = VSEQ / S5T, S5NU = NB * S5NC;
__device__ __forceinline__ int s5_row0(int b, int c) { return c < S5NCX ? TL + b * CTXL + c * S5T : b * SEQ + (c - S5NCX) * S5T; }
template <int PASS>
__device__ __forceinline__ void s5_unit(const Frame& Fu, int l, int uidx0, int nrun) {
    Frame F = Fu; { int wv_ = Fu.wave; asm volatile("" : "+s"(wv_), "+s"(l)); F.wave = wv_; } F.lane = fresh_lane(); F.tid = F.wave * 64 + F.lane;
    LAS bf16* U = (LAS bf16*)F.lds;
    LAS float* BuS = (LAS float*)(F.lds + S5T * S5_US * 2 + F.wave * (16 * S5_BS * 4 + 16 * S5_WS * 2)); LAS bf16* Hs = (LAS bf16*)(BuS + 16 * S5_BS);
    const int lane_ = F.lane;
    const int q = lane_ >> 4, c16 = lane_ & 15, p = lane_;
    const f32x2* AA = (const f32x2*)(F.ws + WS_S5AA); const bf16* BB = (const bf16*)(F.ws + WS_S5BB); const bf16* CM = (const bf16*)(F.ws + WS_S5CM);
    f32x2* HL = (f32x2*)(F.ws + WS_S5HL); const f32x2* HI = (const f32x2*)(F.ws + WS_S5HI);
    u32x2 yout[2][S5SC];
    u32x4 ustage[(S5T * 32 + NTHR - 1) / NTHR];
    f32x2 h0n[2][2];
#define S5_LOADU(ux) do { const int b_ = (ux) / S5NC, c_ = (ux) % S5NC, r0_ = s5_row0(b_, c_); \
        _Pragma("unroll") for (int k = 0; k < (S5T * 32 + NTHR - 1) / NTHR; ++k) { const int i = F.tid + k * NTHR, row = i >> 5, c8 = i & 31; ustage[k] = *(const u32x4*)(F.COLS + (size_t)(r0_ + row) * NCOL + 2048 + c8 * 8); } \
        } while (0)
#define S5_LOADH(ux) do { const int b_ = (ux) / S5NC, c_ = (ux) % S5NC; \
        _Pragma("unroll") for (int gi = 0; gi < 2; ++gi) _Pragma("unroll") for (int dir = 0; dir < 2; ++dir) h0n[gi][dir] = HI[((size_t)(b_ * S5NC + c_) * 32 + (F.wave * 2 + gi) * 2 + dir) * 64 + p]; } while (0)
    S5_LOADU(uidx0);
    f32x2 aa_[2][2]; bf16x4s bb_[2][2][8]; pg8::bf16x8 cm_[2][4];
    f32x4 dsk_[2], gbv_[2], gbg_[2];
#define S5_LOADC do { \
    if (PASS == 1) { \
        const float* s5d = GIN(F, I_S5D) + l * 256; const float* gb = GIN(F, I_GLUB) + l * 512; \
_Pragma("unroll") \
        for (int gi = 0; gi < 2; ++gi) { dsk_[gi] = *(const f32x4*)(s5d + (F.wave * 2 + gi) * 16 + 4 * q); gbv_[gi] = *(const f32x4*)(gb + 32 * F.wave + 16 * gi + 4 * q); gbg_[gi] = *(const f32x4*)(gb + 256 + 32 * F.wave + 16 * gi + 4 * q); } \
    } \
_Pragma("unroll") \
    for (int gi = 0; gi < 2; ++gi) { \
        const int g = F.wave * 2 + gi; \
        if (PASS == 1) { \
_Pragma("unroll") \
            for (int ks = 0; ks < 4; ++ks) cm_[gi][ks] = *(const pg8::bf16x8*)(CM + ((size_t)(l * 16 + g) * 16 + c16) * 128 + 32 * ks + 8 * q); \
        } \
_Pragma("unroll") \
        for (int dir = 0; dir < 2; ++dir) { \
            const int pidx = ((l * 2 + dir) * 16 + g); \
            aa_[gi][dir] = AA[pidx * 64 + p]; \
_Pragma("unroll") \
            for (int rt = 0; rt < 8; ++rt) bb_[gi][dir][rt] = *(const bf16x4s*)(BB + ((size_t)pidx * 128 + 16 * rt + c16) * 16 + 4 * q); \
        } \
    } \
    } while (0)
    if (PASS == 0) S5_LOADC;
#pragma unroll 1
    for (int ku = 0; ku < nrun; ++ku) {
    const int uidx = uidx0 + ku, b = uidx / S5NC, c = uidx % S5NC, r0 = s5_row0(b, c);
    if (PASS == 1) { S5_LOADC; S5_LOADH(uidx); }
    __syncthreads();
#pragma unroll
    for (int k = 0; k < (S5T * 32 + NTHR - 1) / NTHR; ++k) { const int i = F.tid + k * NTHR, row = i >> 5, c8 = i & 31; *(LAS u32x4*)(U + row * S5_US + c8 * 8) = ustage[k]; }
    __syncthreads();
    f32x2 h0_[2][2];
#pragma unroll
    for (int gi = 0; gi < 2; ++gi)
#pragma unroll
        for (int dir = 0; dir < 2; ++dir) h0_[gi][dir] = (PASS == 1) ? h0n[gi][dir] : (f32x2){0.f, 0.f};
    if (PASS == 0 && ku + 1 < nrun) S5_LOADU(uidx + 1);
    pg8::bf16x8 wv[8][2];
#pragma unroll
    for (int gi = 0; gi < 2; ++gi) {
        const int g = F.wave * 2 + gi;
        if (PASS == 1 && gi == 1) { const bf16* GW = F.GLU_T + (size_t)l * 512 * 256;
#pragma unroll
            for (int ks = 0; ks < 8; ++ks)
#pragma unroll
                for (int nt = 0; nt < 2; ++nt) wv[ks][nt] = *(const pg8::bf16x8*)(GW + (size_t)(32 * F.wave + 16 * nt + c16) * 256 + 32 * ks + 8 * q);
        }
        f32x4 yacc[S5SC];
#pragma unroll
        for (int rs = 0; rs < S5SC; ++rs) yacc[rs] = (f32x4){0.f, 0.f, 0.f, 0.f};
#pragma unroll
        for (int dir = 0; dir < 2; ++dir) {
            const float ar = aa_[gi][dir].x, ai = aa_[gi][dir].y;
            const size_t sidx = ((size_t)(b * S5NC + c) * 32 + g * 2 + dir) * 64 + p;
            float hr = 0.f, hi = 0.f;
            if (PASS == 1) { hr = h0_[gi][dir].x; hi = h0_[gi][dir].y; }
#pragma unroll
            for (int sci = 0; sci < S5SC; ++sci) {
                const int rs = dir ? S5SC - 1 - sci : sci;
                const bf16x4s bop = *(const LAS bf16x4s*)(U + (16 * rs + c16) * S5_US + g * 16 + 4 * q);
#pragma unroll
                for (int rt = 0; rt < 8; ++rt) {
                    const f32x4 a = __builtin_amdgcn_mfma_f32_16x16x16bf16_1k(bb_[gi][dir][rt], bop, (f32x4){0.f, 0.f, 0.f, 0.f}, 0, 0, 0);
                    *(LAS f32x4*)(BuS + c16 * S5_BS + 16 * rt + 4 * q) = a;
                }
                asm volatile("s_waitcnt lgkmcnt(0)" ::: "memory");
                f32x2 bu[16];
#pragma unroll
                for (int st = 0; st < 16; ++st) bu[st] = *(const LAS f32x2*)(BuS + (dir ? 15 - st : st) * S5_BS + 2 * p);
#pragma unroll
                for (int st = 0; st < 16; ++st) {
                    const float bur = bu[st].x, bui = bu[st].y;
                    const float nr = fmaf(ar, hr, fmaf(-ai, hi, bur)), ni = fmaf(ar, hi, fmaf(ai, hr, bui)); hr = nr; hi = ni;
                    if (PASS == 1) *(LAS unsigned*)(Hs + (dir ? 15 - st : st) * S5_WS + 2 * p) = pk2(hr, hi);
                }
                if (PASS == 1) {
                    asm volatile("s_waitcnt lgkmcnt(0)" ::: "memory");
#pragma unroll
                    for (int ks = 0; ks < 4; ++ks) { const pg8::bf16x8 hf = *(const LAS pg8::bf16x8*)(Hs + c16 * S5_WS + 32 * ks + 8 * q);
                        yacc[rs] = __builtin_amdgcn_mfma_f32_16x16x32_bf16(cm_[gi][ks], hf, yacc[rs], 0, 0, 0); }
                }
                asm volatile("s_waitcnt lgkmcnt(0)" ::: "memory");
            }
            if (PASS == 0) HL[sidx] = (f32x2){hr, hi};
        }
        if (PASS == 1) {
            const f32x4 dsk = dsk_[gi];
#pragma unroll
            for (int rs = 0; rs < S5SC; ++rs) {
                float u4[4]; { const u32x2 t = *(const LAS u32x2*)(U + (16 * rs + c16) * S5_US + g * 16 + 4 * q);
                    u4[0] = __uint_as_float(t.x << 16); u4[1] = __uint_as_float(t.x & 0xffff0000u); u4[2] = __uint_as_float(t.y << 16); u4[3] = __uint_as_float(t.y & 0xffff0000u); }
                float o[4];
#pragma unroll
                for (int j = 0; j < 4; ++j) o[j] = gelu_tanh(yacc[rs][j] + dsk[j] * u4[j]);
                yout[gi][rs].x = pk2(o[0], o[1]); yout[gi][rs].y = pk2(o[2], o[3]);
            }
        }
    }
    if (PASS == 1 && ku + 1 < nrun) S5_LOADU(uidx + 1);
    if (PASS == 1) {
        const bf16* GW = F.GLU_T + (size_t)l * 512 * 256;
        pg8::bf16x8 wg[8][2];
#pragma unroll
        for (int ks = 0; ks < 8; ++ks)
#pragma unroll
            for (int nt = 0; nt < 2; ++nt) wg[ks][nt] = *(const pg8::bf16x8*)(GW + (size_t)(256 + 32 * F.wave + 16 * nt + c16) * 256 + 32 * ks + 8 * q);
        __syncthreads();
#pragma unroll
        for (int gi = 0; gi < 2; ++gi)
#pragma unroll
            for (int rs = 0; rs < S5SC; ++rs) *(LAS u32x2*)(U + (16 * rs + c16) * S5_US + (F.wave * 2 + gi) * 16 + 4 * q) = yout[gi][rs];
        __syncthreads();
        f32x4 av[2][S5SC], ag[2][S5SC];
#pragma unroll
        for (int nt = 0; nt < 2; ++nt)
#pragma unroll
            for (int rt = 0; rt < S5SC; ++rt) { av[nt][rt] = (f32x4){0.f, 0.f, 0.f, 0.f}; ag[nt][rt] = (f32x4){0.f, 0.f, 0.f, 0.f}; }
#pragma unroll
        for (int ks = 0; ks < 8; ++ks) {
            pg8::bf16x8 yf[S5SC];
#pragma unroll
            for (int rt = 0; rt < S5SC; ++rt) yf[rt] = *(const LAS pg8::bf16x8*)(U + (16 * rt + c16) * S5_US + 32 * ks + 8 * q);
#pragma unroll
            for (int nt = 0; nt < 2; ++nt)
#pragma unroll
                for (int rt = 0; rt < S5SC; ++rt) { av[nt][rt] = __builtin_amdgcn_mfma_f32_16x16x32_bf16(wv[ks][nt], yf[rt], av[nt][rt], 0, 0, 0); ag[nt][rt] = __builtin_amdgcn_mfma_f32_16x16x32_bf16(wg[ks][nt], yf[rt], ag[nt][rt], 0, 0, 0); }
        }
#pragma unroll
        for (int nt = 0; nt < 2; ++nt) { const int n0 = 32 * F.wave + 16 * nt + 4 * q; const f32x4 bv = gbv_[nt], bg = gbg_[nt];
#pragma unroll
            for (int rt = 0; rt < S5SC; ++rt) { float o[4];
#pragma unroll
                for (int j = 0; j < 4; ++j) o[j] = (av[nt][rt][j] + bv[j]) * sigmoidf_(ag[nt][rt][j] + bg[j]);
                u32x2 w; w.x = pk2(o[0], o[1]); w.y = pk2(o[2], o[3]);
                *(u32x2*)(F.MIX + (size_t)(r0 + 16 * rt + c16) * 1024 + 768 + n0) = w; } }
    }
    }
#undef S5_LOADU
#undef S5_LOADH
#undef S5_LOADC
}
__device__ __forceinline__ void s5_carry(const Frame& F, int l) {
    const int gt = F.bid * NTHR + F.tid, NG = F.G * NTHR;
    const f32x2* AA = (const f32x2*)(F.ws + WS_S5AA); const f32x2* HL = (const f32x2*)(F.ws + WS_S5HL); f32x2* HI = (f32x2*)(F.ws + WS_S5HI);
    for (int i = gt; i < NB * 32 * 64; i += NG) {
        const int p = i & 63, gd = (i >> 6) & 31, b = i >> 11, g = gd >> 1, dir = gd & 1;
        f32x2 a = AA[((l * 2 + dir) * 16 + g) * 64 + p];
#pragma unroll
        for (int k = 0; k < 5; ++k) a = (f32x2){a.x * a.x - a.y * a.y, 2.f * a.x * a.y};
        float hr = 0.f, hi = 0.f;
#pragma unroll 1
        for (int jb = 0; jb < S5NC; jb += 36) {
            f32x2 hl[36];
#pragma unroll
            for (int jj = 0; jj < 36; ++jj) { const int j = jb + jj, c = dir ? (j < S5NCX ? S5NCX - 1 - j : S5NC + S5NCX - 1 - j) : j; hl[jj] = HL[((size_t)(b * S5NC + c) * 32 + gd) * 64 + p]; }
#pragma unroll
            for (int jj = 0; jj < 36; ++jj) {
                const int j = jb + jj, c = dir ? (j < S5NCX ? S5NCX - 1 - j : S5NC + S5NCX - 1 - j) : j;
                HI[((size_t)(b * S5NC + c) * 32 + gd) * 64 + p] = (f32x2){hr, hi};
                const float nr = a.x * hr - a.y * hi + hl[jj].x, ni = a.x * hi + a.y * hr + hl[jj].y; hr = nr; hi = ni;
            }
        }
    }
}

constexpr int SSD_LD = 136;
__device__ __forceinline__ int ssd_row0(int b, int cid) { return cid < 2 ? TL + b * CTXL + cid * 128 : b * SEQ + (cid - 2) * 128; }
__device__ __forceinline__ pg8::bf16x8 mk8(u32x2 lo, u32x2 hi) { u32x4 t; t.x = lo.x; t.y = lo.y; t.z = hi.x; t.w = hi.y; return __builtin_bit_cast(pg8::bf16x8, t); }
struct ConvIn { u32x4 xr[12]; f32x4 w[2][6]; };
__device__ __forceinline__ void ssd_conv_load(const Frame& F, int l, int r0, int lo, int hi, int s0, int xch, ConvIn& ci) {
    const float* cw = GIN(F, I_SCW) + (size_t)l * 5 * 1024; const float* cb = GIN(F, I_SCB) + l * 1024;
    const bool lo_ok = (r0 + s0 - 2) >= lo, hi_ok = (r0 + s0 + 9) < hi;
    const bf16* xp = F.COLS + (size_t)(r0 + s0) * NCOL + 512 + xch;
#pragma unroll
    for (int i = 2; i < 10; ++i) ci.xr[i] = *(const u32x4*)(xp + (i - 2) * NCOL);
    if (lo_ok) { ci.xr[0] = *(const u32x4*)(xp - 2 * NCOL); ci.xr[1] = *(const u32x4*)(xp - NCOL); } else { ci.xr[0] = (u32x4){0u, 0u, 0u, 0u}; ci.xr[1] = ci.xr[0]; }
    if (hi_ok) { ci.xr[10] = *(const u32x4*)(xp + 8 * NCOL); ci.xr[11] = *(const u32x4*)(xp + 9 * NCOL); } else { ci.xr[10] = (u32x4){0u, 0u, 0u, 0u}; ci.xr[11] = ci.xr[10]; }
#pragma unroll
    for (int hb = 0; hb < 2; ++hb) {
#pragma unroll
        for (int j = 0; j < 5; ++j) ci.w[hb][j] = *(const f32x4*)(cw + j * 1024 + xch + 4 * hb);
        ci.w[hb][5] = *(const f32x4*)(cb + xch + 4 * hb); }
}
__device__ __forceinline__ void ssd_conv_item(const ConvIn& ci, const Frame& F, int l, int r0, int lo, int hi, int s0, int xch, bool do_nat, LAS bf16* NAT, int ncol, bool do_tr, LAS bf16* TR, int trow, bool do_cc, bf16* CCg) {
    const u32x4 (&xr)[12] = ci.xr;
#pragma unroll
    for (int hb = 0; hb < 2; ++hb) {
        float wv[5][4]; float val[8][4];
#pragma unroll
        for (int j = 0; j < 5; ++j) { const f32x4 t = ci.w[hb][j]; wv[j][0] = t.x; wv[j][1] = t.y; wv[j][2] = t.z; wv[j][3] = t.w; }
        const f32x4 bias = ci.w[hb][5];
#pragma unroll
        for (int i = 0; i < 8; ++i)
#pragma unroll
            for (int k = 0; k < 4; ++k) val[i][k] = bias[k];
#pragma unroll
        for (int i = 0; i < 12; ++i) {
            const unsigned wa = hb ? xr[i].z : xr[i].x, wb = hb ? xr[i].w : xr[i].y;
            const float x4[4] = {__uint_as_float(wa << 16), __uint_as_float(wa & 0xffff0000u), __uint_as_float(wb << 16), __uint_as_float(wb & 0xffff0000u)};
#pragma unroll
            for (int j = 0; j < 5; ++j) { const int o = i - j;
                if (o >= 0 && o < 8) {
#pragma unroll
                    for (int k = 0; k < 4; ++k) val[o][k] = fmaf(wv[j][k], x4[k], val[o][k]); } }
        }
#pragma unroll
        for (int i = 0; i < 8; ++i)
#pragma unroll
            for (int k = 0; k < 4; ++k) val[i][k] = siluf_(val[i][k]);
        if (do_nat) {
#pragma unroll
            for (int i = 0; i < 8; ++i) { u32x2 o; o.x = pk2(val[i][0], val[i][1]); o.y = pk2(val[i][2], val[i][3]); *(LAS u32x2*)(NAT + (s0 + i) * SSD_LD + ncol + 4 * hb) = o;
                if (do_cc) *(u32x2*)(CCg + (size_t)(s0 + i) * 256 + 4 * hb) = o; }
        }
        if (do_tr) {
#pragma unroll
            for (int k = 0; k < 4; ++k) { u32x4 o; o.x = pk2(val[0][k], val[1][k]); o.y = pk2(val[2][k], val[3][k]); o.z = pk2(val[4][k], val[5][k]); o.w = pk2(val[6][k], val[7][k]);
                *(LAS u32x4*)(TR + (trow + 4 * hb + k) * SSD_LD + s0) = o; }
        }
    }
}
__device__ __forceinline__ void ssd_unit_a(const Frame& Fu, int l, int ug, int h_lo, int h_hi) {
    Frame F = Fu; { int wv_ = Fu.wave; asm volatile("" : "+s"(wv_), "+s"(l)); F.wave = wv_; } F.lane = fresh_lane(); F.tid = F.wave * 64 + F.lane;
    const int g = ug & 1, uc = ug >> 1, b = uc / 18, cid = uc % 18, r0 = ssd_row0(b, cid);
    LAS bf16* Bn = (LAS bf16*)F.lds; LAS bf16* Cn = Bn + 128 * SSD_LD; LAS bf16* BT = Cn + 128 * SSD_LD; LAS bf16* XT4 = Bn;
    LAS float* ARR = (LAS float*)(BT + 128 * SSD_LD);
    int lo, hi; seq_bounds(r0, lo, hi);
    __syncthreads();
    ConvIn ci;
    { const int oct = F.tid & 31, seg = F.tid >> 5, isC = oct >> 4, n0 = (oct & 15) * 8; ssd_conv_load(F, l, r0, lo, hi, seg * 8, (isC ? 768 : 512) + g * 128 + n0, ci); }
    if (F.wave >= h_lo && F.wave < h_hi) {
        const int h = 4 * g + F.wave;
        LAS float* cs0 = ARR + F.wave * 768; LAS float* ecs1 = cs0 + 128; LAS float* dt0 = ecs1 + 128; LAS float* dt1 = dt0 + 128; LAS float* w0 = dt1 + 128; LAS float* w1 = w0 + 128;
        const float A0 = -expf(GIN(F, I_SALOG)[l * 16 + h]), A1 = -expf(GIN(F, I_SALOG)[l * 16 + 8 + h]);
        const float db0 = GIN(F, I_SDTB)[l * 16 + h], db1 = GIN(F, I_SDTB)[l * 16 + 8 + h];
        const int t0 = 2 * F.lane;
        const float d00 = softplusf_(F.DT[(size_t)(r0 + t0) * 16 + h] + db0), d01 = softplusf_(F.DT[(size_t)(r0 + t0 + 1) * 16 + h] + db0);
        const float d10 = softplusf_(F.DT[(size_t)(r0 + t0) * 16 + 8 + h] + db1), d11 = softplusf_(F.DT[(size_t)(r0 + t0 + 1) * 16 + 8 + h] + db1);
        const float a00 = d00 * A0, a01 = d01 * A0, a10 = d10 * A1, a11 = d11 * A1;
        float p0 = a00 + a01, p1 = a10 + a11;
#pragma unroll
        for (int o = 1; o < 64; o <<= 1) { const float u0 = __int_as_float(__builtin_amdgcn_ds_bpermute((F.lane - o) << 2, __float_as_int(p0))), u1 = __int_as_float(__builtin_amdgcn_ds_bpermute((F.lane - o) << 2, __float_as_int(p1)));
            if (F.lane >= o) { p0 += u0; p1 += u1; } }
        const float tot0 = __int_as_float(__builtin_amdgcn_readlane(__float_as_int(p0), 63)), tot1 = __int_as_float(__builtin_amdgcn_readlane(__float_as_int(p1), 63));
        const float c01 = p0, c00 = p0 - a01;
        const float e11 = p1 - a11, e10 = e11 - a10;
        cs0[t0] = c00; cs0[t0 + 1] = c01; ecs1[t0] = e10; ecs1[t0 + 1] = e11; dt0[t0] = d00; dt0[t0 + 1] = d01; dt1[t0] = d10; dt1[t0 + 1] = d11;
        w0[t0] = __expf(tot0 - c00) * d00; w0[t0 + 1] = __expf(tot0 - c01) * d01; w1[t0] = __expf(e10) * d10; w1[t0 + 1] = __expf(e11) * d11;
        float* ed = (float*)(F.ws + WS_EDEC) + ((size_t)(r0 + t0) * 8 + h) * 2;
        ed[0] = __expf(c00); ed[1] = __expf(tot1 - e10); ed[16] = __expf(c01); ed[17] = __expf(tot1 - e11);
        if (F.lane == 0) { float* tt = (float*)(F.ws + WS_TOT) + ((size_t)uc * 8 + h) * 2; tt[0] = tot0; tt[1] = tot1; }
    }
    {
        const int oct = F.tid & 31, seg = F.tid >> 5, s0 = seg * 8, isC = oct >> 4, n0 = (oct & 15) * 8;
        bf16* CC = (bf16*)(F.ws + WS_CC) + (size_t)r0 * 256 + g * 128 + n0;
        ssd_conv_item(ci, F, l, r0, lo, hi, s0, (isC ? 768 : 512) + g * 128 + n0, true, isC ? Cn : Bn, n0, !isC, BT, n0, isC != 0 && h_lo == 0, CC);
    }
    const bool s3_on = ((F.tid & 31) >> 3) >= h_lo && ((F.tid & 31) >> 3) < h_hi;
    if (s3_on) { const int oct = F.tid & 31, seg = F.tid >> 5, hl = oct >> 3, p0 = (oct & 7) * 8; ssd_conv_load(F, l, r0, lo, hi, seg * 8, (4 * g + hl) * 64 + p0, ci); }
    __syncthreads();
    const int q = F.lane >> 4, c = F.lane & 15, w = F.wave;
    f32x4 gt[8];
    {
        pg8::bf16x8 cfr[4];
#pragma unroll
        for (int ks = 0; ks < 4; ++ks) cfr[ks] = *(const LAS pg8::bf16x8*)(Cn + (16 * w + c) * SSD_LD + 32 * ks + 8 * q);
#pragma unroll
        for (int a = 0; a < 8; ++a) { f32x4 acc = {0.f, 0.f, 0.f, 0.f};
#pragma unroll
            for (int ks = 0; ks < 4; ++ks) acc = __builtin_amdgcn_mfma_f32_16x16x32_bf16(*(const LAS pg8::bf16x8*)(Bn + (16 * a + c) * SSD_LD + 32 * ks + 8 * q), cfr[ks], acc, 0, 0, 0);
            gt[a] = acc; }
    }
    __syncthreads();
    {
        const int oct = F.tid & 31, seg = F.tid >> 5, s0 = seg * 8, hl = oct >> 3, p0 = (oct & 7) * 8;
        if (s3_on) ssd_conv_item(ci, F, l, r0, lo, hi, s0, (4 * g + hl) * 64 + p0, false, XT4, 0, true, XT4, hl * 64 + p0, false, (bf16*)nullptr);
    }
    __syncthreads();
    pg8::bf16x8 btf[4];
#pragma unroll
    for (int ks = 0; ks < 4; ++ks) btf[ks] = *(const LAS pg8::bf16x8*)(BT + (16 * w + c) * SSD_LD + 32 * ks + 8 * q);
    const int t = 16 * w + c;
#pragma unroll 1
    for (int hl = h_lo; hl < h_hi; ++hl) {
        const int h = 4 * g + hl, uidx = uc * 8 + h;
        const LAS float* cs0 = ARR + hl * 768; const LAS float* ecs1 = cs0 + 128; const LAS float* dt0 = ecs1 + 128; const LAS float* dt1 = dt0 + 128; const LAS float* w0 = dt1 + 128; const LAS float* w1 = w0 + 128;
        const LAS bf16* XT = XT4 + hl * 64 * SSD_LD;
        {
            int t_ = t; asm volatile("" : "+v"(t_));
            const float cs0t = cs0[t_], e1t = ecs1[t_], Dh = GIN(F, I_SD)[l * 8 + h];
            f32x4 m[8];
#pragma unroll
            for (int a = 0; a < 8; ++a) {
                if (a < w) {
                    const f32x4 csv = *(const LAS f32x4*)&cs0[16 * a + 4 * q], d0v = *(const LAS f32x4*)&dt0[16 * a + 4 * q];
#pragma unroll
                    for (int j = 0; j < 4; ++j) m[a][j] = gt[a][j] * (__expf(cs0t - csv[j]) * d0v[j]);
                } else if (a > w) {
                    const f32x4 e1v = *(const LAS f32x4*)&ecs1[16 * a + 4 * q], d1v = *(const LAS f32x4*)&dt1[16 * a + 4 * q];
#pragma unroll
                    for (int j = 0; j < 4; ++j) m[a][j] = gt[a][j] * (__expf(e1v[j] - e1t) * d1v[j]);
                } else {
                    const f32x4 csv = *(const LAS f32x4*)&cs0[16 * a + 4 * q], d0v = *(const LAS f32x4*)&dt0[16 * a + 4 * q], e1v = *(const LAS f32x4*)&ecs1[16 * a + 4 * q], d1v = *(const LAS f32x4*)&dt1[16 * a + 4 * q];
#pragma unroll
                    for (int j = 0; j < 4; ++j) { const int sidx = 16 * a + 4 * q + j;
                        const float f0 = (sidx <= t_) ? __expf(fminf(cs0t - csv[j], 0.f)) * d0v[j] : 0.f;
                        const float f1 = (sidx >= t_) ? __expf(fminf(e1v[j] - e1t, 0.f)) * d1v[j] : 0.f;
                        m[a][j] = gt[a][j] * (f0 + f1) + ((sidx == t_) ? Dh : 0.f); }
                }
            }
            pg8::bf16x8 mfr[4];
#pragma unroll
            for (int i = 0; i < 4; ++i) { u32x4 tq; tq.x = pk2(m[2 * i][0], m[2 * i][1]); tq.y = pk2(m[2 * i][2], m[2 * i][3]); tq.z = pk2(m[2 * i + 1][0], m[2 * i + 1][1]); tq.w = pk2(m[2 * i + 1][2], m[2 * i + 1][3]); mfr[i] = __builtin_bit_cast(pg8::bf16x8, tq); }
            bf16* YI = (bf16*)(F.ws + WS_YI);
#pragma unroll
            for (int pt = 0; pt < 4; ++pt) { f32x4 acc = {0.f, 0.f, 0.f, 0.f};
#pragma unroll
                for (int i = 0; i < 4; ++i) { const LAS bf16* xp = XT + (16 * pt + c) * SSD_LD + 32 * i + 4 * q;
                    acc = __builtin_amdgcn_mfma_f32_16x16x32_bf16(mk8(*(const LAS u32x2*)xp, *(const LAS u32x2*)(xp + 16)), mfr[i], acc, 0, 0, 0); }
                u32x2 o; o.x = pk2(acc[0], acc[1]); o.y = pk2(acc[2], acc[3]);
                *(u32x2*)(YI + (((size_t)uidx * 32 + pt * 8 + w) * 64 + F.lane) * 4) = o; }
        }
        {
            bf16* SST = (bf16*)(F.ws + WS_SST);
            pg8::bf16x8 bsf[2][4];
#pragma unroll
            for (int d = 0; d < 2; ++d) { const LAS float* wd = d ? w1 : w0;
#pragma unroll
                for (int ks = 0; ks < 4; ++ks) {
                    const u32x4 bq = __builtin_bit_cast(u32x4, btf[ks]);
                    const f32x4 wa = *(const LAS f32x4*)&wd[32 * ks + 8 * q], wb = *(const LAS f32x4*)&wd[32 * ks + 8 * q + 4];
                    u32x4 sq;
                    sq.x = pk2(__uint_as_float(bq.x << 16) * wa[0], __uint_as_float(bq.x & 0xffff0000u) * wa[1]); sq.y = pk2(__uint_as_float(bq.y << 16) * wa[2], __uint_as_float(bq.y & 0xffff0000u) * wa[3]);
                    sq.z = pk2(__uint_as_float(bq.z << 16) * wb[0], __uint_as_float(bq.z & 0xffff0000u) * wb[1]); sq.w = pk2(__uint_as_float(bq.w << 16) * wb[2], __uint_as_float(bq.w & 0xffff0000u) * wb[3]);
                    bsf[d][ks] = __builtin_bit_cast(pg8::bf16x8, sq);
                }
            }
#pragma unroll
            for (int pt = 0; pt < 4; ++pt) { f32x4 a0 = {0.f, 0.f, 0.f, 0.f}, a1 = {0.f, 0.f, 0.f, 0.f};
#pragma unroll
                for (int ks = 0; ks < 4; ++ks) { const pg8::bf16x8 xf = *(const LAS pg8::bf16x8*)(XT + (16 * pt + c) * SSD_LD + 32 * ks + 8 * q);
                    a0 = __builtin_amdgcn_mfma_f32_16x16x32_bf16(bsf[0][ks], xf, a0, 0, 0, 0); a1 = __builtin_amdgcn_mfma_f32_16x16x32_bf16(bsf[1][ks], xf, a1, 0, 0, 0); }
                u32x2 o0; o0.x = pk2(a0[0], a0[1]); o0.y = pk2(a0[2], a0[3]);
                u32x2 o1; o1.x = pk2(a1[0], a1[1]); o1.y = pk2(a1[2], a1[3]);
                *(u32x2*)(SST + (((size_t)uidx * 2 + 0) * 64 + 16 * pt + c) * 128 + 16 * w + 4 * q) = o0;
                *(u32x2*)(SST + (((size_t)uidx * 2 + 1) * 64 + 16 * pt + c) * 128 + 16 * w + 4 * q) = o1; }
        }
    }
}
__device__ __forceinline__ void ssd_carry(const Frame& F) {
    const int gt = F.bid * NTHR + F.tid, NG = F.G * NTHR;
    const bf16* SST = (const bf16*)(F.ws + WS_SST); bf16* HIN = (bf16*)(F.ws + WS_HIN); const float* TOT = (const float*)(F.ws + WS_TOT);
    for (int i = gt; i < NB * 8 * 2 * 1024; i += NG) {
        const int e8 = i & 1023, d = (i >> 10) & 1, h = (i >> 11) & 7, b = i >> 14;
        u32x4 sv[18]; float tv[18];
#pragma unroll
        for (int j = 0; j < 18; ++j) {
            const int cid = d ? (j < 2 ? 1 - j : 19 - j) : j;
            const size_t ui = (size_t)(b * 18 + cid) * 8 + h;
            sv[j] = *(const u32x4*)(SST + ((ui * 2 + d) * 1024 + e8) * 8); tv[j] = TOT[ui * 2 + d];
        }
        float H[8];
#pragma unroll
        for (int k = 0; k < 8; ++k) H[k] = 0.f;
#pragma unroll
        for (int j = 0; j < 18; ++j) {
            const int cid = d ? (j < 2 ? 1 - j : 19 - j) : j;
            const size_t ui = (size_t)(b * 18 + cid) * 8 + h, off = ((ui * 2 + d) * 1024 + e8) * 8;
            u32x4 o; o.x = pk2(H[0], H[1]); o.y = pk2(H[2], H[3]); o.z = pk2(H[4], H[5]); o.w = pk2(H[6], H[7]);
            *(u32x4*)(HIN + off) = o;
            const float dec = __expf(tv[j]);
            const float s8[8] = {__uint_as_float(sv[j].x << 16), __uint_as_float(sv[j].x & 0xffff0000u), __uint_as_float(sv[j].y << 16), __uint_as_float(sv[j].y & 0xffff0000u),
                                 __uint_as_float(sv[j].z << 16), __uint_as_float(sv[j].z & 0xffff0000u), __uint_as_float(sv[j].w << 16), __uint_as_float(sv[j].w & 0xffff0000u)};
#pragma unroll
            for (int k = 0; k < 8; ++k) H[k] = fmaf(H[k], dec, s8[k]);
        }
    }
}
__device__ __forceinline__ void ssd_unit_b(const Frame& F, int l, int u2) {
    const int uc = u2 >> 1, rh = u2 & 1, b = uc / 18, cid = uc % 18, r0 = ssd_row0(b, cid) + 64 * rh;
    const int lane_ = fresh_lane();
    int wv_ = F.wave; asm volatile("" : "+s"(wv_), "+s"(l));
    const int q = lane_ >> 4, c = lane_ & 15, h = wv_, g = h >> 2;
    const bf16* CC = (const bf16*)(F.ws + WS_CC); const bf16* HIN = (const bf16*)(F.ws + WS_HIN); const bf16* YI = (const bf16*)(F.ws + WS_YI); const float* ED = (const float*)(F.ws + WS_EDEC);
    LAS float* SSX = (LAS float*)F.lds;
    const size_t ui = (size_t)uc * 8 + h;
    pg8::bf16x8 hin[2][4][4];
#pragma unroll
    for (int d = 0; d < 2; ++d)
#pragma unroll
        for (int pt = 0; pt < 4; ++pt)
#pragma unroll
            for (int ks = 0; ks < 4; ++ks) hin[d][pt][ks] = *(const pg8::bf16x8*)(HIN + ((ui * 2 + d) * 64 + 16 * pt + c) * 128 + 32 * ks + 8 * q);
    pg8::bf16x8 cfr[4][4]; u32x2 yiq[4][4], zq[4][4]; f32x2 edv[4];
#define SSDB_LD(tt) do { const size_t row_ = (size_t)(r0 + 16 * (tt) + c); const int w_ = rh * 4 + (tt); \
        _Pragma("unroll") for (int ks = 0; ks < 4; ++ks) cfr[tt][ks] = *(const pg8::bf16x8*)(CC + row_ * 256 + g * 128 + 32 * ks + 8 * q); \
        edv[tt] = *(const f32x2*)(ED + (row_ * 8 + h) * 2); \
        _Pragma("unroll") for (int pt = 0; pt < 4; ++pt) yiq[tt][pt] = *(const u32x2*)(YI + ((ui * 32 + pt * 8 + w_) * 64 + lane_) * 4); } while (0)
#define SSDB_LZ(tt) do { const size_t row_ = (size_t)(r0 + 16 * (tt) + c); \
        _Pragma("unroll") for (int pt = 0; pt < 4; ++pt) zq[tt][pt] = *(const u32x2*)(F.COLS + row_ * NCOL + h * 64 + 16 * pt + 4 * q); } while (0)
    SSDB_LD(0); SSDB_LZ(0);
    __builtin_amdgcn_sched_barrier(0);
    float ssv[4];
    LAS u32x2* MVL = (LAS u32x2*)(F.lds + 4096) + (h * 16) * 64 + lane_;
#pragma unroll
    for (int tt = 0; tt < 4; ++tt) {
        if (tt == 0) SSDB_LD(1); else if (tt == 1) SSDB_LD(2); else if (tt == 2) SSDB_LD(3);
        __builtin_amdgcn_sched_barrier(0);
        const f32x2 ed = edv[tt];
        float ss = 0.f;
#pragma unroll
        for (int pt = 0; pt < 4; ++pt) {
            f32x4 a0 = {0.f, 0.f, 0.f, 0.f}, a1 = {0.f, 0.f, 0.f, 0.f};
#pragma unroll
            for (int ks = 0; ks < 4; ++ks) { a0 = __builtin_amdgcn_mfma_f32_16x16x32_bf16(hin[0][pt][ks], cfr[tt][ks], a0, 0, 0, 0); a1 = __builtin_amdgcn_mfma_f32_16x16x32_bf16(hin[1][pt][ks], cfr[tt][ks], a1, 0, 0, 0); }
            const float yi[4] = {__uint_as_float(yiq[tt][pt].x << 16), __uint_as_float(yiq[tt][pt].x & 0xffff0000u), __uint_as_float(yiq[tt][pt].y << 16), __uint_as_float(yiq[tt][pt].y & 0xffff0000u)};
            const float z[4] = {__uint_as_float(zq[tt][pt].x << 16), __uint_as_float(zq[tt][pt].x & 0xffff0000u), __uint_as_float(zq[tt][pt].y << 16), __uint_as_float(zq[tt][pt].y & 0xffff0000u)};
            float v[4];
#pragma unroll
            for (int j = 0; j < 4; ++j) { v[j] = (yi[j] + ed.x * a0[j] + ed.y * a1[j]) * siluf_(z[j]); ss = fmaf(v[j], v[j], ss); }
            u32x2 mvv; mvv.x = pk2(v[0], v[1]); mvv.y = pk2(v[2], v[3]); MVL[(tt * 4 + pt) * 64] = mvv;
            if (pt == 1) { __builtin_amdgcn_sched_barrier(0); if (tt == 0) SSDB_LZ(1); else if (tt == 1) SSDB_LZ(2); else if (tt == 2) SSDB_LZ(3); __builtin_amdgcn_sched_barrier(0); }
        }
        ss += shx(ss, 16, lane_); ss += shx(ss, 32, lane_);
        ssv[tt] = ss;
        __builtin_amdgcn_sched_barrier(0);
    }
#undef SSDB_LD
#undef SSDB_LZ
    const float* ng = GIN(F, I_SNG) + l * 512 + h * 64;
    f32x4 gn[4];
#pragma unroll
    for (int pt = 0; pt < 4; ++pt) gn[pt] = *(const f32x4*)(ng + 16 * pt + 4 * q);
    __syncthreads();
    if (q == 0) {
#pragma unroll
        for (int tt = 0; tt < 4; ++tt) SSX[h * 64 + 16 * tt + c] = ssv[tt];
    }
    __syncthreads();
#pragma unroll
    for (int tt = 0; tt < 4; ++tt) {
        float tot = 0.f;
#pragma unroll
        for (int k = 0; k < 8; ++k) tot += SSX[k * 64 + 16 * tt + c];
        const float rstd = rsqrtf(tot * (1.f / 512.f) + EPS);
#pragma unroll
        for (int pt = 0; pt < 4; ++pt) { const u32x2 mvv = MVL[(tt * 4 + pt) * 64];
            u32x2 o; o.x = pk2(__uint_as_float(mvv.x << 16) * rstd * gn[pt][0], __uint_as_float(mvv.x & 0xffff0000u) * rstd * gn[pt][1]);
            o.y = pk2(__uint_as_float(mvv.y << 16) * rstd * gn[pt][2], __uint_as_float(mvv.y & 0xffff0000u) * rstd * gn[pt][3]);
            *(u32x2*)(F.MIX + (size_t)(r0 + 16 * tt + c) * 1024 + h * 64 + 16 * pt + 4 * q) = o; }
    }
}

__device__ __forceinline__ void stage_wt16_load(const float* src, int stride, int tid, f32x4 (&v)[4096 / NTHR]) {
#pragma unroll
    for (int j = 0; j < 4096 / NTHR; ++j) { const int i = tid + j * NTHR, k = i >> 2, e4 = (i & 3) * 4; v[j] = *(const f32x4*)(src + (size_t)k * stride + e4); }
}
__device__ __forceinline__ void stage_wt16_store(LAS float* WT, int tid, const f32x4 (&v)[4096 / NTHR]) {
#pragma unroll
    for (int j = 0; j < 4096 / NTHR; ++j) { const int i = tid + j * NTHR, k = i >> 2, e4 = (i & 3) * 4;
        WT[(e4 + 0) * 1024 + k] = v[j].x; WT[(e4 + 1) * 1024 + k] = v[j].y; WT[(e4 + 2) * 1024 + k] = v[j].z; WT[(e4 + 3) * 1024 + k] = v[j].w; }
}
__device__ __forceinline__ void dot16_acc(const LAS float* WT, const f32x4& h, int j, int lane, f32x2 (&acc)[16]) {
    const f32x2 h01 = {h.x, h.y}, h23 = {h.z, h.w};
#pragma unroll
    for (int e4 = 0; e4 < 4; ++e4) {
#pragma unroll
        for (int e = 4 * e4; e < 4 * e4 + 4; ++e) { const f32x4 w = *(const LAS f32x4*)&WT[e * 1024 + 4 * lane + 256 * j];
            acc[e] = __builtin_elementwise_fma(h01, (f32x2){w.x, w.y}, acc[e]); acc[e] = __builtin_elementwise_fma(h23, (f32x2){w.z, w.w}, acc[e]); }
        asm volatile("" ::: "memory");
    }
}

__device__ __forceinline__ void expert_cvt_pair(const Frame& F, int l, int it0, int it1, LAS float* scr);
constexpr int CVT_ITEMS = 48 * 512, CVT_GU = 32 * 512, CVT_SPLIT = 7680, CVT_D0 = 10240, CVT_I1 = 18432, CVT_G0 = 2048;
__device__ __forceinline__ void expert_cvt_quad(const Frame& F, int l, int it0, int it1, int it2, int it3, LAS float* scr);
__device__ __forceinline__ void cvt_range(const Frame& F, int l, int first, int count, int crank, int nconv) {
    LAS float* scr = (LAS float*)F.lds + F.wave * (64 * 33);
    const int stride = nconv * NWAVES;
#pragma unroll 1
    for (int i = crank * NWAVES + F.wave; i < count; i += 4 * stride) {
        const int j1 = i + stride, j2 = i + 2 * stride, j3 = i + 3 * stride;
        expert_cvt_quad(F, l, first + i, j1 < count ? first + j1 : -1, j2 < count ? first + j2 : -1, j3 < count ? first + j3 : -1, scr);
    }
}
__device__ __forceinline__ void dot16_acc2(const LAS float* WT, const f32x4& ha, const f32x4& hb, int j, int lane, f32x2 (&acca)[16], f32x2 (&accb)[16]) {
    const f32x2 a01 = {ha.x, ha.y}, a23 = {ha.z, ha.w}, b01 = {hb.x, hb.y}, b23 = {hb.z, hb.w};
#pragma unroll
    for (int e4 = 0; e4 < 4; ++e4) {
#pragma unroll
        for (int e = 4 * e4; e < 4 * e4 + 4; ++e) { const f32x4 w = *(const LAS f32x4*)&WT[e * 1024 + 4 * lane + 256 * j]; const f32x2 w01 = {w.x, w.y}, w23 = {w.z, w.w};
            acca[e] = __builtin_elementwise_fma(a01, w01, acca[e]); acca[e] = __builtin_elementwise_fma(a23, w23, acca[e]);
            accb[e] = __builtin_elementwise_fma(b01, w01, accb[e]); accb[e] = __builtin_elementwise_fma(b23, w23, accb[e]); }
        asm volatile("" ::: "memory");
    }
}
__device__ __forceinline__ void phase_p0(const Frame& F0)  {
    Frame F = enter_phase(F0);
    {
        const size_t gt = (size_t)F.bid * NTHR + F.tid, NG = (size_t)F.G * NTHR;
        float* POS = (float*)(F.ws + WS_POS);
        for (size_t i = gt; i < (size_t)SEQ * 256; i += NG) {
            const int n = (int)(i >> 8), c4 = (int)(i & 255) * 4;
            const int rr = n >> 6, cc = n & 63, q = c4 >> 8, ii = c4 & 255;
            const float pos = (float)(q < 2 ? rr : cc);
            float pe[4];
#pragma unroll
            for (int k = 0; k < 4; ++k) {
                const float invf = __expf(-9.210340371976184f * (float)(ii + k) * (1.f / 256.f));
                float sn, cs; sincos_red(pos * invf, sn, cs);
                pe[k] = (q & 1) ? cs : sn;
            }
            *(f32x4*)(POS + (size_t)n * D + c4) = (f32x4){pe[0], pe[1], pe[2], pe[3]};
        }
    }
    {
        LAS float* scr = (LAS float*)F.lds + F.wave * (64 * 33);
        const int gw = F.bid * NWAVES + F.wave, NGW = F.G * NWAVES;
        constexpr int I_IN = 16 * 73, I_OUT = 16 * 32, I_PW = 4 * 8, I_GLU = 4 * 16, I_L = I_IN + I_OUT + I_PW + I_GLU;
        for (int it = gw; it < 2 * I_L; it += NGW) {
            const int l = it / I_L; int r = it % I_L;
            if (r < I_IN) { transpose_item(GIN(F, I_WIN) + (size_t)l * D * INC, D, INC, F.WIN_T + (size_t)l * NCOL * D, [](int n) { return n < 1536 ? n : (n < 1552 ? -1 : (n < INC ? n - 16 : -1)); }, scr, r, F.lane); continue; } r -= I_IN;
            if (r < I_OUT) { transpose_item(GIN(F, I_WOUT) + (size_t)l * D * D, D, D, F.WOUT_T + (size_t)l * D * D, [](int n) { return n; }, scr, r, F.lane); continue; } r -= I_OUT;
            if (r < I_PW) { transpose_item(GIN(F, I_CPW) + (size_t)l * 256 * 256, 256, 256, F.PW_T + (size_t)l * 256 * 256, [](int n) { return n; }, scr, r, F.lane); continue; } r -= I_PW;
            transpose_item(GIN(F, I_GLUW) + (size_t)l * 256 * 512, 256, 512, F.GLU_T + (size_t)l * 512 * 256, [](int n) { return n; }, scr, r, F.lane);
        }
        __syncthreads();
    }
    {
        const int gt = F.bid * NTHR + F.tid, NG = F.G * NTHR;
        f32x2* AA = (f32x2*)(F.ws + WS_S5AA); bf16* BB = (bf16*)(F.ws + WS_S5BB); bf16* CM = (bf16*)(F.ws + WS_S5CM);
        for (int i = gt; i < 2 * 2 * 16 * 64; i += NG) {
            const int p = i & 63, g = (i >> 6) & 15, dir = (i >> 10) & 1, l = i >> 11;
            const float step = expf(GIN(F, I_LSTEP)[(l * 2 + dir) * 16 + g]);
            const float lr = GIN(F, I_LRE)[i], li = GIN(F, I_LIM)[i];
            const float mag = expf(lr * step); float sn, cs; sincos_red(li * step, sn, cs);
            const float ar = mag * cs, ai = mag * sn, inv_den = 1.f / (lr * lr + li * li);
            const float cr = ((ar - 1.f) * lr + ai * li) * inv_den, ci = (ai * lr - (ar - 1.f) * li) * inv_den;
            AA[i] = (f32x2){ar, ai};
            const float* bre = GIN(F, I_BRE) + ((size_t)(l * 16 + g) * 64 + p) * 16; const float* bim = GIN(F, I_BIM) + ((size_t)(l * 16 + g) * 64 + p) * 16;
            bf16* o = BB + ((size_t)((l * 2 + dir) * 16 + g) * 128 + 2 * p) * 16;
            for (int h = 0; h < 16; ++h) { const float br = bre[h], bi = bim[h]; o[h] = (bf16)f2bf(cr * br - ci * bi); o[16 + h] = (bf16)f2bf(cr * bi + ci * br); }
        }
        for (int i = gt; i < 2 * 16 * 16 * 64; i += NG) {
            *(unsigned*)(CM + (size_t)i * 2) = pk2(GIN(F, I_CRE)[i], -GIN(F, I_CIM)[i]);
        }
    }
    {
        LAS float* sc = (LAS float*)F.lds;
        LAS float* part = sc + 9 * 1024;
        __syncthreads();
        if (F.bid < 192) { for (int t = F.tid; t < 9 * 1024; t += NTHR) { const int r9 = t >> 10, k = t & 1023; sc[t] = siluf_(r9 < 8 ? GIN(F, I_C)[r9 * D + k] : GIN(F, I_CCTX)[k]); } }
        __syncthreads();
        for (int it = F.bid; it < 192; it += F.G) {
            const int l = it / 96, cb = it % 96, col = F.tid & 63, kg = F.tid >> 6;
            float acc[9];
#pragma unroll
            for (int r9 = 0; r9 < 9; ++r9) acc[r9] = 0.f;
            const float* wp = GIN(F, I_WADA) + ((size_t)l * D + kg * 128) * 6144 + cb * 64 + col;
#pragma unroll 1
            for (int k0 = 0; k0 < 128; k0 += 32) {
                float w[32];
#pragma unroll
                for (int kk = 0; kk < 32; ++kk) w[kk] = wp[(size_t)(k0 + kk) * 6144];
#pragma unroll
                for (int kk = 0; kk < 32; ++kk)
#pragma unroll
                    for (int r9 = 0; r9 < 9; ++r9) acc[r9] = fmaf(sc[r9 * 1024 + kg * 128 + k0 + kk], w[kk], acc[r9]);
            }
#pragma unroll
            for (int r9 = 0; r9 < 9; ++r9) part[(kg * 9 + r9) * 64 + col] = acc[r9];
            __syncthreads();
            for (int t = F.tid; t < 9 * 64; t += NTHR) { const int r9 = t >> 6, cc = t & 63; float sm = GIN(F, I_BADA)[l * 6144 + cb * 64 + cc];
#pragma unroll
                for (int k8 = 0; k8 < 8; ++k8) sm += part[(k8 * 9 + r9) * 64 + cc];
                F.MOD[((size_t)l * 9 + r9) * 6144 + cb * 64 + cc] = sm; }
            __syncthreads();
        }
    }
}
__device__ __forceinline__ LAS int* moe_tables(const Frame& F, int l) {
    LAS int* tab = (LAS int*)(F.lds + TAB_OFF);
    int ecnt = 0;
    if (F.tid < NEXP) ecnt = (int)F.ctl[CW_CNT + l * 64 + F.tid];
    __syncthreads();
    if (F.tid < NEXP) tab[40 + F.tid] = ecnt;
    __syncthreads();
    if (F.tid == 0) {
        int bs = 0;
        for (int e = 0; e < NEXP; ++e) { const int c = tab[40 + e]; tab[e] = bs; bs += ((c + 255) / 256) * 256; }
        tab[16] = bs;
    }
    __syncthreads();
    return tab;
}
template <int MODE>
__device__ __forceinline__ void phase_rowA(const Frame& F0, int l)  {
    constexpr bool HAS_MOE = MODE != 0, FINAL = MODE == 2;
    auto ld_x = [](const Frame& Fr, int r, int c) -> f32x4 {
        if (MODE != 0) return ldbf4(Fr.XS + (size_t)r * D + c);
        if (r < TL) return __builtin_nontemporal_load((const f32x4*)(GIN(Fr, I_X) + (size_t)r * D + c)) + *(const f32x4*)((const float*)(Fr.ws + WS_POS) + (size_t)(r & (SEQ - 1)) * D + c);
        return __builtin_nontemporal_load((const f32x4*)(GIN(Fr, I_CTX) + (size_t)(r - TL) * D + c));
    };
    Frame F = enter_phase(F0);
    LAS int* tab = (LAS int*)(F.lds + TAB_OFF);
    LAS float* WDT = (LAS float*)F.lds;
    const int gw = F.bid * NWAVES + F.wave, NGW = F.G * NWAVES;
    const int RL = FINAL ? TL : TT;
    const int RPW = (RL + NGW - 1) / NGW, rbeg = gw * RPW, rend = (rbeg + RPW < RL) ? rbeg + RPW : RL;
    const float* gvec = FINAL ? GIN(F, I_GFIN) : GIN(F, I_GMIX) + l * D;
    LAS float* MV = (LAS float*)(F.lds + 65536);
    const int brow0 = F.bid * NWAVES * RPW, brow1 = (brow0 + NWAVES * RPW < RL ? brow0 + NWAVES * RPW : RL) - 1;
    const int mr_a = modrow(brow0 < RL ? brow0 : RL - 1), mr_b = modrow(brow1 > 0 ? brow1 : 0);
    f32x4 vn[4]; u32x2 yan[4], ybn[4]; int4 tin = make_int4(0, 0, 0, 0), tin2 = tin; f32x2 twn = {0.f, 0.f}, twn2 = twn;
    f32x4 vA[4], vB[4];
    if (rbeg < rend) {
#pragma unroll
        for (int j = 0; j < 4; ++j) vn[j] = ld_x(F, rbeg, 4 * F.lane + 256 * j);
        if (HAS_MOE) {
            tin = *(const int4*)(F.TOKI + (size_t)rbeg * 4); twn = *(const f32x2*)(F.TOKW + (size_t)rbeg * 2);
            if (rbeg + 1 < rend) { tin2 = *(const int4*)(F.TOKI + (size_t)(rbeg + 1) * 4); twn2 = *(const f32x2*)(F.TOKW + (size_t)(rbeg + 1) * 2); }
        }
    }
    if (MODE == 0) {
#pragma unroll
        for (int j = 0; j < 4; ++j) { vA[j] = (rbeg + 1 < rend) ? ld_x(F, rbeg + 1, 4 * F.lane + 256 * j) : (f32x4){0.f, 0.f, 0.f, 0.f}; vB[j] = (rbeg + 2 < rend) ? ld_x(F, rbeg + 2, 4 * F.lane + 256 * j) : (f32x4){0.f, 0.f, 0.f, 0.f}; }
    }
    {
        f32x4 wst[4096 / NTHR];
        if (!FINAL) stage_wt16_load(GIN(F, I_WIN) + (size_t)l * D * INC + 1536, INC, F.tid, wst);
        float mg[4], m1[4], m0[4], m2[4];
#pragma unroll
        for (int k = 0; k < 4; ++k) { const int i = F.tid + k * NTHR, sl = i >> 10, c = i & 1023, mr = sl ? mr_b : mr_a;
            mg[k] = gvec[c];
            m1[k] = FINAL ? 0.f : F.MOD[((size_t)l * 9 + mr) * 6144 + 1024 + c];
            m0[k] = FINAL ? 0.f : F.MOD[((size_t)l * 9 + mr) * 6144 + c];
            m2[k] = HAS_MOE ? F.MOD[((size_t)(l - 1) * 9 + mr) * 6144 + 5120 + c] : 0.f; }
        int ecnt = 0;
        if (HAS_MOE && F.tid < NEXP) ecnt = (int)F.ctl[CW_CNT + (l - 1) * 64 + F.tid];
        __syncthreads();
        if (!FINAL) stage_wt16_store(WDT, F.tid, wst);
#pragma unroll
        for (int k = 0; k < 4; ++k) { const int i = F.tid + k * NTHR, sl = i >> 10, c = i & 1023;
            MV[sl * 3072 + c] = FINAL ? mg[k] : mg[k] * (m1[k] + 1.f);
            MV[sl * 3072 + 1024 + c] = m0[k];
            MV[sl * 3072 + 2048 + c] = m2[k]; }
        if (HAS_MOE && F.tid < NEXP) tab[40 + F.tid] = ecnt;
        __syncthreads();
        if (HAS_MOE) {
            if (F.tid == 0) { int bs = 0; for (int e = 0; e < NEXP; ++e) { const int c = tab[40 + e]; tab[e] = bs; bs += ((c + 255) / 256) * 256; } tab[16] = bs; }
            __syncthreads();
        }
    }
    if (HAS_MOE && rbeg < rend) {
        const size_t ra = (size_t)(tab[tin.x] + tin.y), rb = (size_t)(tab[tin.z] + tin.w);
#pragma unroll
        for (int j = 0; j < 4; ++j) { yan[j] = *(const u32x2*)(F.YDN + ra * D + 4 * F.lane + 256 * j); ybn[j] = *(const u32x2*)(F.YDN + rb * D + 4 * F.lane + 256 * j); }
    }
#pragma unroll 1
    for (int r = rbeg; r < rend; ++r) {
        const int mr = modrow(r);
        f32x4 v[4]; u32x2 ya[4], yb[4];
#pragma unroll
        for (int j = 0; j < 4; ++j) { v[j] = vn[j]; ya[j] = yan[j]; yb[j] = ybn[j]; }
        const f32x2 tw = twn;
        if (MODE == 0) {
#pragma unroll
            for (int j = 0; j < 4; ++j) { vn[j] = vA[j]; vA[j] = vB[j]; }
            if (r + 3 < rend) {
#pragma unroll
                for (int j = 0; j < 4; ++j) vB[j] = ld_x(F, r + 3, 4 * F.lane + 256 * j);
            }
        } else if (r + 1 < rend) {
#pragma unroll
            for (int j = 0; j < 4; ++j) vn[j] = ld_x(F, r + 1, 4 * F.lane + 256 * j);
            if (HAS_MOE) {
                tin = tin2; twn = twn2;
                if (r + 2 < rend) { tin2 = *(const int4*)(F.TOKI + (size_t)(r + 2) * 4); twn2 = *(const f32x2*)(F.TOKW + (size_t)(r + 2) * 2); }
                const size_t ra = (size_t)(tab[tin.x] + tin.y), rb = (size_t)(tab[tin.z] + tin.w);
#pragma unroll
                for (int j = 0; j < 4; ++j) { yan[j] = *(const u32x2*)(F.YDN + ra * D + 4 * F.lane + 256 * j); ybn[j] = *(const u32x2*)(F.YDN + rb * D + 4 * F.lane + 256 * j); }
            }
        }
        const LAS float* mv = MV + (mr == mr_a ? 0 : 3072);
        if (HAS_MOE) {
#pragma unroll
            for (int j = 0; j < 4; ++j) {
                const float yaf[4] = {__uint_as_float(ya[j].x << 16), __uint_as_float(ya[j].x & 0xffff0000u), __uint_as_float(ya[j].y << 16), __uint_as_float(ya[j].y & 0xffff0000u)};
                const float ybf[4] = {__uint_as_float(yb[j].x << 16), __uint_as_float(yb[j].x & 0xffff0000u), __uint_as_float(yb[j].y << 16), __uint_as_float(yb[j].y & 0xffff0000u)};
                const f32x4 g2q = *(const LAS f32x4*)&mv[2048 + 4 * F.lane + 256 * j];
#pragma unroll
                for (int e = 0; e < 4; ++e) v[j][e] += g2q[e] * (yaf[e] * tw.x + ybf[e] * tw.y);
            }
            if (!FINAL) {
#pragma unroll
                for (int j = 0; j < 4; ++j) stbf4(F.XS + (size_t)r * D + 4 * F.lane + 256 * j, v[j]);
            }
        }
        if (MODE == 0) {
#pragma unroll
            for (int j = 0; j < 4; ++j) stbf4(F.XS + (size_t)r * D + 4 * F.lane + 256 * j, v[j]);
        }
        float ss = 0.f;
#pragma unroll
        for (int j = 0; j < 4; ++j) ss += (v[j].x * v[j].x + v[j].y * v[j].y) + (v[j].z * v[j].z + v[j].w * v[j].w);
        const float rstd = rsqrtf(wave_sum(ss, F.lane) * (1.f / D) + EPS);
        if (FINAL) {
#pragma unroll
            for (int j = 0; j < 4; ++j) { const int c = 4 * F.lane + 256 * j; __builtin_nontemporal_store(v[j] * rstd * *(const LAS f32x4*)&mv[c], (f32x4*)(F.out + (size_t)r * D + c)); }
        } else {
            f32x2 dtq[16];
#pragma unroll
            for (int e = 0; e < 16; ++e) dtq[e] = (f32x2){0.f, 0.f};
#pragma unroll
            for (int j = 0; j < 4; ++j) {
                const int c = 4 * F.lane + 256 * j;
                const f32x4 h = v[j] * rstd * *(const LAS f32x4*)&mv[c] + *(const LAS f32x4*)&mv[1024 + c];
                u32x2 o; o.x = pk2(h.x, h.y); o.y = pk2(h.z, h.w);
                *(u32x2*)(F.HN + (size_t)r * D + c) = o;
                dot16_acc(WDT, h, j, F.lane, dtq);
            }
            float dtp[16];
#pragma unroll
            for (int e = 0; e < 16; ++e) dtp[e] = dtq[e].x + dtq[e].y;
            const float ytot = reduce16_scatter(dtp, F.lane);
            if (F.lane < 16) F.DT[(size_t)r * 16 + (((F.lane & 1) << 3) | ((F.lane & 2) << 1) | ((F.lane & 4) >> 1) | ((F.lane & 8) >> 3))] = ytot;
        }
    }
}
__device__ __forceinline__ void phase_inproj(const Frame& F0, int l)  {
    Frame F = enter_phase(F0);
    const bool split = (F.G == 256); const int GG = split ? 216 : F.G;
    if (split && F.bid >= GG) { if (l == 0) cvt_range(F, l, 0, CVT_SPLIT, F.bid - GG, F.G - GG); else cvt_range(F, l, CVT_D0, CVT_I1 - CVT_D0, F.bid - GG, F.G - GG); return; }
    pg8::PlainSched S; S.T.init(TT / 256, NCOL / 256, GG, F.bid); S.Bt = (const char*)(F.WIN_T + (size_t)l * NCOL * D); S.K = D;
    pg8::EpiStoreBf16 E{F.COLS, NCOL, 0, nullptr};
    pg8::gemm_phase<pg8::EpiStoreBf16, pg8::PlainSched, true>(F.lds, F.HN, D, S, E, F.tid);
}
__device__ __forceinline__ void conf_unit(const Frame& Fu, int l, int uidx) {
    Frame F = Fu; { int wv_ = Fu.wave; asm volatile("" : "+s"(wv_), "+s"(l)); F.wave = wv_; } F.lane = fresh_lane(); F.tid = F.wave * 64 + F.lane;
    const int r0 = uidx * 64;
    LAS bf16* XU = (LAS bf16*)F.lds;
    LAS float* WD = (LAS float*)(F.lds + 94 * 512);
    LAS bf16* CVL = (LAS bf16*)(F.lds + 94 * 512 + 31 * 1024);
    int lo, hi; seq_bounds(r0, lo, hi);
    __syncthreads();
    const int ch = 4 * F.lane;
    f32x4 tw[4]; f32x4 db, lg, lb, pbv[2];
    {
        u32x2 av[12], gv[12];
#pragma unroll
        for (int k = 0; k < 12; ++k) { const int i = F.tid + k * NTHR, rr = r0 - 15 + (i >> 6), c = (i & 63) * 4;
            const bool ok = (i < 94 * 64) && rr >= lo && rr < hi; const int rc = ok ? rr : r0;
            av[k] = *(const u32x2*)(F.COLS + (size_t)rc * NCOL + 1536 + c); gv[k] = *(const u32x2*)(F.COLS + (size_t)rc * NCOL + 1792 + c); }
        { const float* cdw = GIN(F, I_CDW) + (size_t)l * 31 * 256;
#pragma unroll
            for (int k = 0; k < 4; ++k) { const int i = F.tid + k * NTHR; tw[k] = *(const f32x4*)(cdw + (i < 31 * 64 ? i : 0) * 4); }
            db = *(const f32x4*)(GIN(F, I_CDB) + l * 256 + ch); lg = *(const f32x4*)(GIN(F, I_CLG) + l * 256 + ch); lb = *(const f32x4*)(GIN(F, I_CLB) + l * 256 + ch);
            const float* pb = GIN(F, I_CPB) + l * 256;
#pragma unroll
            for (int nt = 0; nt < 2; ++nt) pbv[nt] = *(const f32x4*)(pb + 32 * F.wave + 16 * nt + 4 * (F.lane >> 4)); }
#pragma unroll
        for (int k = 0; k < 12; ++k) { const int i = F.tid + k * NTHR, rr = r0 - 15 + (i >> 6), c = (i & 63) * 4;
            if (i < 94 * 64) {
                const bool ok = rr >= lo && rr < hi;
                const float a0 = __uint_as_float(av[k].x << 16), a1 = __uint_as_float(av[k].x & 0xffff0000u), a2 = __uint_as_float(av[k].y << 16), a3 = __uint_as_float(av[k].y & 0xffff0000u);
                const float g0 = __uint_as_float(gv[k].x << 16), g1 = __uint_as_float(gv[k].x & 0xffff0000u), g2 = __uint_as_float(gv[k].y << 16), g3 = __uint_as_float(gv[k].y & 0xffff0000u);
                u32x2 o; o.x = pk2(a0 * sigmoidf_(g0), a1 * sigmoidf_(g1)); o.y = pk2(a2 * sigmoidf_(g2), a3 * sigmoidf_(g3));
                if (!ok) o = (u32x2){0u, 0u};
                *(LAS u32x2*)(XU + (i >> 6) * 256 + c) = o; } }
    }
#pragma unroll
    for (int k = 0; k < 4; ++k) { const int i = F.tid + k * NTHR; if (i < 31 * 64) *(LAS f32x4*)&WD[i * 4] = tw[k]; }
    __syncthreads();
    pg8::bf16x8 wf[8][2];
    { const bf16* PW = F.PW_T + (size_t)l * 256 * 256;
#pragma unroll
        for (int ks = 0; ks < 8; ++ks)
#pragma unroll
            for (int nt = 0; nt < 2; ++nt) wf[ks][nt] = *(const pg8::bf16x8*)(PW + (size_t)(32 * F.wave + 16 * nt + (F.lane & 15)) * 256 + 32 * ks + 8 * (F.lane >> 4)); }
#pragma unroll 1
    for (int i4 = 0; i4 < 2; ++i4) {
        const int lr0 = F.wave * 8 + i4 * 4;
        f32x4 acc[4] = {db, db, db, db};
        f32x4 wq[4] = {(f32x4){0.f, 0.f, 0.f, 0.f}, (f32x4){0.f, 0.f, 0.f, 0.f}, (f32x4){0.f, 0.f, 0.f, 0.f}, (f32x4){0.f, 0.f, 0.f, 0.f}};
#pragma unroll
        for (int m = 0; m < 34; ++m) {
            wq[3] = wq[2]; wq[2] = wq[1]; wq[1] = wq[0];
            wq[0] = (m < 31) ? *(const LAS f32x4*)&WD[m * 256 + ch] : (f32x4){0.f, 0.f, 0.f, 0.f};
            const u32x2 xv = *(const LAS u32x2*)(XU + (lr0 + m) * 256 + ch);
            const f32x4 xf = {__uint_as_float(xv.x << 16), __uint_as_float(xv.x & 0xffff0000u), __uint_as_float(xv.y << 16), __uint_as_float(xv.y & 0xffff0000u)};
#pragma unroll
            for (int i = 0; i < 4; ++i) { if (m - i >= 0 && m - i < 31) acc[i] = __builtin_elementwise_fma(wq[i], xf, acc[i]); }
        }
#pragma unroll
        for (int i = 0; i < 4; ++i) {
            const int lr = lr0 + i;
            const float mean = wave_sum((acc[i].x + acc[i].y) + (acc[i].z + acc[i].w), F.lane) * (1.f / 256.f);
            const f32x4 d = acc[i] - mean;
            const float var = wave_sum((d.x * d.x + d.y * d.y) + (d.z * d.z + d.w * d.w), F.lane) * (1.f / 256.f);
            const f32x4 y = d * rsqrtf(var + EPS) * lg + lb;
            u32x2 o; o.x = pk2(siluf_(y.x), siluf_(y.y)); o.y = pk2(siluf_(y.z), siluf_(y.w));
            *(LAS u32x2*)(CVL + lr * S5_US + ch) = o;
        }
    }
    __syncthreads();
    {
        int lane_ = F.lane; asm volatile("" : "+v"(lane_));
        const int q = lane_ >> 4, c16 = lane_ & 15;
        f32x4 acc[2][4];
#pragma unroll
        for (int nt = 0; nt < 2; ++nt)
#pragma unroll
            for (int rt = 0; rt < 4; ++rt) acc[nt][rt] = (f32x4){0.f, 0.f, 0.f, 0.f};
#pragma unroll
        for (int ks = 0; ks < 8; ++ks) {
            pg8::bf16x8 vf[4];
#pragma unroll
            for (int rt = 0; rt < 4; ++rt) vf[rt] = *(const LAS pg8::bf16x8*)(CVL + (16 * rt + c16) * S5_US + 32 * ks + 8 * q);
#pragma unroll
            for (int nt = 0; nt < 2; ++nt)
#pragma unroll
                for (int rt = 0; rt < 4; ++rt) acc[nt][rt] = __builtin_amdgcn_mfma_f32_16x16x32_bf16(wf[ks][nt], vf[rt], acc[nt][rt], 0, 0, 0);
        }
#pragma unroll
        for (int nt = 0; nt < 2; ++nt) { const int n0 = 32 * F.wave + 16 * nt + 4 * q; const f32x4 bv = pbv[nt];
#pragma unroll
            for (int rt = 0; rt < 4; ++rt) { u32x2 w; w.x = pk2(acc[nt][rt][0] + bv[0], acc[nt][rt][1] + bv[1]); w.y = pk2(acc[nt][rt][2] + bv[2], acc[nt][rt][3] + bv[3]);
                *(u32x2*)(F.MIX + (size_t)(r0 + 16 * rt + c16) * 1024 + 512 + n0) = w; } }
    }
}
struct CvtItem { const float* W; bf16* WT; int kind, k0, n0; };
__device__ __forceinline__ CvtItem cvt_decode(const Frame& F, int l, int it) {
    const int mtx = it >> 9, r = it & 511;
    const int e = mtx < 32 ? (mtx >> 1) : mtx - 32, kind = mtx < 32 ? (mtx & 1) : 2;
    const size_t wofs = ((size_t)l * NEXP + e) * D * D;
    CvtItem c; c.kind = kind; c.k0 = 64 * (r >> 5); c.n0 = 32 * (r & 31);
    c.W = (kind == 0 ? GIN(F, I_WG) : (kind == 1 ? GIN(F, I_WU) : GIN(F, I_WD))) + wofs;
    c.WT = kind == 2 ? F.WD_T + (size_t)e * D * D : F.WGU_T + (size_t)e * 2048 * D;
    return c;
}
__device__ __forceinline__ void cvt_load(const CvtItem& c, int lane, float (&tv)[32]) {
#pragma unroll
    for (int i = 0; i < 8; ++i) { const f32x4 t = __builtin_nontemporal_load((const f32x4*)(c.W + (size_t)(c.k0 + 8 * i + (lane >> 3)) * D + c.n0 + (lane & 7) * 4)); tv[4 * i] = t.x; tv[4 * i + 1] = t.y; tv[4 * i + 2] = t.z; tv[4 * i + 3] = t.w; }
}
__device__ __forceinline__ void cvt_store(const CvtItem& c, int lane, const float (&tv)[32], LAS float* scr) {
#pragma unroll
    for (int i = 0; i < 8; ++i)
#pragma unroll
        for (int j = 0; j < 4; ++j) scr[(8 * i + (lane >> 3)) * 33 + (lane & 7) * 4 + j] = tv[4 * i + j];
    asm volatile("s_waitcnt lgkmcnt(0)" ::: "memory");
    const int cc = lane & 7;
#pragma unroll
    for (int j = 0; j < 4; ++j) { const int n = c.n0 + (lane >> 3) + 8 * j; const LAS float* sp = scr + (8 * cc) * 33 + (lane >> 3) + 8 * j;
        u32x4 o; o.x = pk2(sp[0 * 33], sp[1 * 33]); o.y = pk2(sp[2 * 33], sp[3 * 33]); o.z = pk2(sp[4 * 33], sp[5 * 33]); o.w = pk2(sp[6 * 33], sp[7 * 33]);
        const int dr = c.kind == 2 ? n : (n >> 7) * 256 + (c.kind == 1 ? 128 : 0) + (n & 127);
        __builtin_nontemporal_store(o, (u32x4*)(c.WT + (size_t)dr * D + c.k0 + 8 * cc)); }
    asm volatile("s_waitcnt lgkmcnt(0)" ::: "memory");
}
__device__ __forceinline__ void expert_cvt_pair(const Frame& F, int l, int it0, int it1, LAS float* scr) {
    const CvtItem c0 = cvt_decode(F, l, it0); float t0[32], t1[32];
    cvt_load(c0, F.lane, t0);
    if (it1 >= 0) { const CvtItem c1 = cvt_decode(F, l, it1); cvt_load(c1, F.lane, t1); cvt_store(c0, F.lane, t0, scr); cvt_store(c1, F.lane, t1, scr); }
    else cvt_store(c0, F.lane, t0, scr);
}
__device__ __forceinline__ void expert_cvt_quad(const Frame& F, int l, int it0, int it1, int it2, int it3, LAS float* scr) {
    float t0[32], t1[32], t2[32], t3[32];
    const CvtItem c0 = cvt_decode(F, l, it0), c1 = cvt_decode(F, l, it1 < 0 ? it0 : it1), c2 = cvt_decode(F, l, it2 < 0 ? it0 : it2), c3 = cvt_decode(F, l, it3 < 0 ? it0 : it3);
    cvt_load(c0, F.lane, t0); cvt_load(c1, F.lane, t1); cvt_load(c2, F.lane, t2); cvt_load(c3, F.lane, t3);
    cvt_store(c0, F.lane, t0, scr);
    if (it1 >= 0) cvt_store(c1, F.lane, t1, scr);
    if (it2 >= 0) cvt_store(c2, F.lane, t2, scr);
    if (it3 >= 0) cvt_store(c3, F.lane, t3, scr);
}
constexpr int CW_Q = 256;
__device__ __forceinline__ unsigned q_fetch(unsigned* ctr) { return __hip_atomic_fetch_add(ctr, 1u, __ATOMIC_RELAXED, __HIP_MEMORY_SCOPE_AGENT); }
__device__ __forceinline__ void phase_scan(const Frame& F0, int l)  {
    Frame F = enter_phase(F0);
    const int RLc = (l == 0) ? TT : TL;
    const int NU = 288 + 288 + RLc / 64;
    const int gw = F.bid * NWAVES + F.wave, NGW = F.G * NWAVES;
    LAS float* scr = (LAS float*)(F.lds + 131072 - NWAVES * 8448) + F.wave * (64 * 33);
    const int cv_first = (F.G != 256) ? 0 : CVT_ITEMS, cv_end = CVT_ITEMS - cv_first;
    int cv = gw;
    const int nconf = RLc / 64, NUQ = 320 + S5NU / 4 + nconf;
    unsigned* ctr = F.ctl + CW_Q + (l * 2 + 0) * 32;
    volatile LAS unsigned* slot = (volatile LAS unsigned*)(F.lds + MISC_OFF) + 2;
    int u = F.bid;
    while (u < NUQ) {
        unsigned nx = 0u;
        if (F.tid == 0) nx = (unsigned)F.G + q_fetch(ctr);
        if (u < 256) ssd_unit_a(F, l, u, 0, 4);
        else if (u < 320) { const int j = u - 256, h_lo = (j & 1) * 2; ssd_unit_a(F, l, 256 + (j >> 1), h_lo, h_lo + 2); }
        else if (u < 320 + S5NU / 4) s5_unit<0>(F, l, 4 * (u - 320), 4);
        else conf_unit(F, l, u - 320 - S5NU / 4);
        __syncthreads();
        if (F.tid == 0) slot[0] = nx;
        __syncthreads();
        u = __builtin_amdgcn_readfirstlane((int)slot[0]);
    }
    __syncthreads();
#pragma unroll 1
    for (; cv < cv_end; cv += 2 * NGW) { const int c1 = cv + NGW < cv_end ? cv_first + cv + NGW : -1; expert_cvt_pair(F, l, cv_first + cv, c1, scr); }
}
__device__ __forceinline__ void phase_carry(const Frame& F0, int l)  {
    Frame F = enter_phase(F0);
    ssd_carry(F);
    s5_carry(F, l);
}
__device__ __forceinline__ void phase_mix1(const Frame& F0, int l)  {
    Frame F = enter_phase(F0);
    const int RL = (l == 0) ? TT : TL;
    const int nssd = (l == 0) ? 288 : NB * 16 * 2, ns5v = (l == 0) ? S5NC : S5NC - S5NCX, NUQ = nssd + NB * ns5v;
    unsigned* ctr = F.ctl + CW_Q + (l * 2 + 1) * 32;
    volatile LAS unsigned* slot = (volatile LAS unsigned*)(F.lds + MISC_OFF) + 2;
    int u = F.bid;
    while (u < NUQ) {
        unsigned nx = 0u;
        if (F.tid == 0) nx = (unsigned)F.G + q_fetch(ctr);
        if (u < nssd) { const int idx = (l == 0) ? u : ((((u >> 5) * 18 + 2 + ((u & 31) >> 1)) << 1) | (u & 1)); ssd_unit_b(F, l, idx); }
        else { const int v = u - nssd, idx = (l == 0) ? v : (v / ns5v) * S5NC + S5NCX + v % ns5v; s5_unit<1>(F, l, idx, 1); }
        __syncthreads();
        if (F.tid == 0) slot[0] = nx;
        __syncthreads();
        u = __builtin_amdgcn_readfirstlane((int)slot[0]);
    }
}
__device__ __forceinline__ void phase_wout(const Frame& F0, int l)  {
    Frame F = enter_phase(F0);
    const int RL = (l == 0) ? TT : TL;
    pg8::PlainSched S; S.T.init(RL / 256, D / 256, F.G, F.bid); S.Bt = (const char*)(F.WOUT_T + (size_t)l * D * D); S.K = D;
    pg8::EpiResidual E{F.XS, F.MOD + (size_t)l * 9 * 6144 + 2048};
    pg8::gemm_phase<pg8::EpiResidual, pg8::PlainSched, true>(F.lds, F.MIX, D, S, E, F.tid);
    if (F.G == 256 && l == 0) {
        const int nwg = S.T.nwg, rem = nwg % F.G;
        const int crank = rem ? F.bid - rem : F.bid, nfree = rem ? F.G - rem : F.G;
        if (crank >= 0) { __syncthreads(); cvt_range(F, l, CVT_SPLIT, CVT_ITEMS - CVT_G0 - CVT_SPLIT, crank, nfree); }
    }
}
__device__ __forceinline__ void phase_norm2(const Frame& F0, int l)  {
    Frame F = enter_phase(F0);
    const int RL = (l == 0) ? TT : TL;
    LAS float* RW = (LAS float*)F.lds;
    const int gw = F.bid * NWAVES + F.wave, NGW = F.G * NWAVES;
    const int RPW = (RL + NGW - 1) / NGW, rbeg = gw * RPW, rend = (rbeg + RPW < RL) ? rbeg + RPW : RL;
    const float* gvec = GIN(F, I_GFFN) + l * D;
    f32x4 gv[4], shv[4], scv[4], vn[4]; int cur_mr = -1;
    f32x4 vn2[4];
    if (rbeg < rend) {
#pragma unroll
        for (int j = 0; j < 4; ++j) vn[j] = ldbf4(F.XS + (size_t)rbeg * D + 4 * F.lane + 256 * j);
    }
    if (rbeg + 1 < rend) {
#pragma unroll
        for (int j = 0; j < 4; ++j) vn2[j] = ldbf4(F.XS + (size_t)(rbeg + 1) * D + 4 * F.lane + 256 * j);
    }
#pragma unroll
    for (int j = 0; j < 4; ++j) gv[j] = *(const f32x4*)(gvec + 4 * F.lane + 256 * j);
    {
        f32x4 wst[4096 / NTHR];
        stage_wt16_load(GIN(F, I_RW), 16, F.tid, wst);
        __syncthreads();
        stage_wt16_store(RW, F.tid, wst);
    }
    LAS int* lcnt = (LAS int*)(F.lds + 65536);
    if (F.tid < 32) lcnt[F.tid] = 0;
    __syncthreads();
    float mylg[16];
#pragma unroll
    for (int e = 0; e < 16; ++e) mylg[e] = 0.f;
#pragma unroll 1
    for (int r = rbeg; r < rend; r += 2) {
        const bool two = r + 1 < rend;
        f32x4 va[4], vb[4]; float ssa = 0.f, ssb = 0.f;
#pragma unroll
        for (int j = 0; j < 4; ++j) { va[j] = vn[j]; vb[j] = two ? vn2[j] : (f32x4){0.f, 0.f, 0.f, 0.f};
            ssa += (va[j].x * va[j].x + va[j].y * va[j].y) + (va[j].z * va[j].z + va[j].w * va[j].w); ssb += (vb[j].x * vb[j].x + vb[j].y * vb[j].y) + (vb[j].z * vb[j].z + vb[j].w * vb[j].w); }
        if (r + 2 < rend) {
#pragma unroll
            for (int j = 0; j < 4; ++j) vn[j] = ldbf4(F.XS + (size_t)(r + 2) * D + 4 * F.lane + 256 * j);
            if (r + 3 < rend) {
#pragma unroll
                for (int j = 0; j < 4; ++j) vn2[j] = ldbf4(F.XS + (size_t)(r + 3) * D + 4 * F.lane + 256 * j);
            }
        }
        const float rsa = rsqrtf(wave_sum(ssa, F.lane) * (1.f / D) + EPS), rsb = rsqrtf(wave_sum(ssb, F.lane) * (1.f / D) + EPS);
        f32x4 ha[4], hb[4];
        {   const int mr = modrow(r);
            if (mr != cur_mr) { cur_mr = mr;
#pragma unroll
                for (int j = 0; j < 4; ++j) { const int c = 4 * F.lane + 256 * j; shv[j] = *(const f32x4*)(F.MOD + ((size_t)l * 9 + mr) * 6144 + 3072 + c); scv[j] = gv[j] * (*(const f32x4*)(F.MOD + ((size_t)l * 9 + mr) * 6144 + 4096 + c) + 1.f); } }
#pragma unroll
            for (int j = 0; j < 4; ++j) { const int c = 4 * F.lane + 256 * j; ha[j] = va[j] * rsa * scv[j] + shv[j];
                u32x2 o; o.x = pk2(ha[j].x, ha[j].y); o.y = pk2(ha[j].z, ha[j].w); *(u32x2*)(F.HN + (size_t)r * D + c) = o; }
        }
        if (two) {
            const int mr = modrow(r + 1);
            if (mr != cur_mr) { cur_mr = mr;
#pragma unroll
                for (int j = 0; j < 4; ++j) { const int c = 4 * F.lane + 256 * j; shv[j] = *(const f32x4*)(F.MOD + ((size_t)l * 9 + mr) * 6144 + 3072 + c); scv[j] = gv[j] * (*(const f32x4*)(F.MOD + ((size_t)l * 9 + mr) * 6144 + 4096 + c) + 1.f); } }
#pragma unroll
            for (int j = 0; j < 4; ++j) { const int c = 4 * F.lane + 256 * j; hb[j] = vb[j] * rsb * scv[j] + shv[j];
                u32x2 o; o.x = pk2(hb[j].x, hb[j].y); o.y = pk2(hb[j].z, hb[j].w); *(u32x2*)(F.HN + (size_t)(r + 1) * D + c) = o; }
        } else {
#pragma unroll
            for (int j = 0; j < 4; ++j) hb[j] = (f32x4){0.f, 0.f, 0.f, 0.f};
        }
        f32x2 lqa[16], lqb[16];
#pragma unroll
        for (int e = 0; e < 16; ++e) { lqa[e] = (f32x2){0.f, 0.f}; lqb[e] = (f32x2){0.f, 0.f}; }
#pragma unroll
        for (int j = 0; j < 4; ++j) dot16_acc2(RW, ha[j], hb[j], j, F.lane, lqa, lqb);
        float tq[16];
#pragma unroll
        for (int e = 0; e < 16; ++e) tq[e] = lqa[e].x + lqa[e].y;
        const int ya = __float_as_int(reduce16_scatter(tq, F.lane));
#pragma unroll
        for (int e = 0; e < 16; ++e) tq[e] = lqb[e].x + lqb[e].y;
        const int yb = __float_as_int(reduce16_scatter(tq, F.lane));
#pragma unroll
        for (int e = 0; e < 16; ++e) { const float ta = __int_as_float(__builtin_amdgcn_readlane(ya, bitrev4(e))), tb = __int_as_float(__builtin_amdgcn_readlane(yb, bitrev4(e)));
            if (F.lane == r - rbeg) mylg[e] = ta; if (two && F.lane == r + 1 - rbeg) mylg[e] = tb; }
    }
    int4 myti = make_int4(0, 0, 0, 0);
    if (rbeg + F.lane < rend) {
        const int r = rbeg + F.lane;
        float lg[16]; float mx = -3.0e38f;
#pragma unroll
        for (int e = 0; e < 16; ++e) { lg[e] = mylg[e] + GIN(F, I_RB)[e]; mx = fmaxf(mx, lg[e]); }
        float den = 0.f;
#pragma unroll
        for (int e = 0; e < 16; ++e) { lg[e] = __expf(lg[e] - mx); den += lg[e]; }
        const float inv = 1.f / den;
#pragma unroll
        for (int e = 0; e < 16; ++e) lg[e] *= inv;
        float gs[4];
#pragma unroll
        for (int gI = 0; gI < 4; ++gI) {
            const float p0 = lg[gI * 4], p1 = lg[gI * 4 + 1], p2 = lg[gI * 4 + 2], p3 = lg[gI * 4 + 3];
            const float h01 = fmaxf(p0, p1), l01 = fminf(p0, p1), h23 = fmaxf(p2, p3), l23 = fminf(p2, p3);
            gs[gI] = fmaxf(h01, h23) + fmaxf(fminf(h01, h23), fmaxf(l01, l23));
        }
        int best = 0; float bsv = gs[0];
#pragma unroll
        for (int gI = 1; gI < 4; ++gI) if (gs[gI] > bsv) { bsv = gs[gI]; best = gI; }
        float q[4];
#pragma unroll
        for (int i = 0; i < 4; ++i) q[i] = best == 0 ? lg[i] : (best == 1 ? lg[4 + i] : (best == 2 ? lg[8 + i] : lg[12 + i]));
        int i0 = 0; float v0 = q[0];
#pragma unroll
        for (int i = 1; i < 4; ++i) if (q[i] > v0) { v0 = q[i]; i0 = i; }
        int i1 = -1; float v1 = -1.f;
#pragma unroll
        for (int i = 0; i < 4; ++i) if (i != i0 && q[i] > v1) { v1 = q[i]; i1 = i; }
        const float ginv = 1.f / (v0 + v1);
        const int e0 = best * 4 + i0, e1 = best * 4 + i1;
        const int p0 = __hip_atomic_fetch_add(&lcnt[e0], 1, __ATOMIC_RELAXED, __HIP_MEMORY_SCOPE_WORKGROUP), p1 = __hip_atomic_fetch_add(&lcnt[e1], 1, __ATOMIC_RELAXED, __HIP_MEMORY_SCOPE_WORKGROUP);
        *(f32x2*)(F.TOKW + (size_t)r * 2) = (f32x2){v0 * ginv, v1 * ginv};
        myti = make_int4(e0, p0, e1, p1);
    }
    __syncthreads();
    if (F.tid < 16) lcnt[16 + F.tid] = (int)atomicAdd(&F.ctl[CW_CNT + l * 64 + F.tid], (unsigned)lcnt[F.tid]);
    __syncthreads();
    if (rbeg + F.lane < rend) {
        const int r = rbeg + F.lane; int4 ti = myti;
        ti.y += lcnt[16 + ti.x]; ti.w += lcnt[16 + ti.z];
        *(int4*)(F.TOKI + (size_t)r * 4) = ti;
        F.LIST[(size_t)ti.x * TT + ti.y] = r; F.LIST[(size_t)ti.z * TT + ti.w] = r;
    }
}
__device__ __forceinline__ void phase_gateup(const Frame& F0, int l)  {
    Frame F = enter_phase(F0);
    LAS int* tab = moe_tables(F, l);
    LAS int* rows = (LAS int*)(F.lds + ROWS_OFF);
    pg8::MoeSched<true> S; S.T.init(tab[16] / 256, 8, F.G, F.bid); S.Bt = (const char*)F.WGU_T; S.K = D; S.NE = 2048; S.tab = tab; S.rows = rows;
    {
        pg8::Unit u;
        int rv[6];
#pragma unroll
        for (int i = 0; i < 6; ++i) { rv[i] = 0;
            if (S.next(i, u) && F.tid < 256) { const int sr = u.pm * 256 + F.tid, e = S.expert(u.pm), pos = sr - tab[e], cnt = tab[40 + e]; rv[i] = F.LIST[(size_t)e * TT + (pos < cnt ? pos : 0)]; } }
#pragma unroll
        for (int i = 0; i < 6; ++i) if (F.tid < 256) rows[i * 256 + F.tid] = rv[i];
        for (int i = 6; i < 15 && S.next(i, u); ++i) {
            if (F.tid < 256) { const int sr = u.pm * 256 + F.tid, e = S.expert(u.pm), pos = sr - tab[e], cnt = tab[40 + e];
                rows[i * 256 + F.tid] = F.LIST[(size_t)e * TT + (pos < cnt ? pos : 0)]; }
        }
        __syncthreads();
    }
    pg8::EpiPairBf16<0> E{F.HMID, 1024, 0, nullptr, 0};
    pg8::gemm_phase<pg8::EpiPairBf16<0>, pg8::MoeSched<true>, true>(F.lds, F.HN, D, S, E, F.tid);
    if (F.G == 256) {
        const int nwg = S.T.nwg, rem = nwg % F.G;
        const int crank = rem ? F.bid - rem : F.bid, nfree = rem ? F.G - rem : F.G;
        const int first = (l == 0) ? CVT_ITEMS - CVT_G0 : CVT_I1;
        if (crank >= 0) { __syncthreads(); cvt_range(F, l, first, CVT_ITEMS - first, crank, nfree); }
    }
}
__device__ __forceinline__ void phase_down(const Frame& F0, int l)  {
    Frame F = enter_phase(F0);
    LAS int* tab = moe_tables(F, l);
    pg8::MoeSched<false> S; S.T.init(tab[16] / 256, 4, F.G, F.bid); S.Bt = (const char*)F.WD_T; S.K = D; S.NE = 1024; S.tab = tab; S.rows = nullptr;
    pg8::EpiStoreBf16 E{F.YDN, 1024, 0, nullptr};
    pg8::gemm_phase<pg8::EpiStoreBf16, pg8::MoeSched<false>, true>(F.lds, F.HMID, D, S, E, F.tid);
    if (F.G == 256 && l + 1 < DEPTH) {
        const int nwg = S.T.nwg, rem = nwg % F.G;
        const int crank = rem ? F.bid - rem : F.bid, nfree = rem ? F.G - rem : F.G;
        if (crank >= 0) { __syncthreads(); cvt_range(F, l + 1, 0, CVT_D0, crank, nfree); }
    }
}

constexpr int PH_PER_LAYER = 9, N_PHASES = 1 + DEPTH * PH_PER_LAYER + 1;

__global__ void __launch_bounds__(NTHR, 2) fwd_kernel(Args args) {
    extern __shared__ __attribute__((aligned(16))) unsigned char lds_raw[];
    Frame F;
    F.lds = (LAS unsigned char*)lds_raw;
    F.tid = threadIdx.x; F.lane = F.tid & 63; F.wave = __builtin_amdgcn_readfirstlane(F.tid >> 6);
    F.G = gridDim.x; F.bid = blockIdx.x;
    F.in = (const CAS cfp_t*)__builtin_amdgcn_kernarg_segment_ptr(); F.out = args.out; F.ws = args.ws;
    frame_ptrs(F, args.ws);
    volatile LAS unsigned* MISC = (volatile LAS unsigned*)(F.lds + MISC_OFF);
    if (F.tid < 32) MISC[F.tid] = 0u;
    __syncthreads();
    const int lo = args.ph_lo, hi = args.ph_hi;
    const bool multi = (hi - lo) > 1;
    XcdBarrier bar; bar.bar = F.ctl + CW_BAR; bar.x = 0; bar.st = MISC + 8;
    if (multi) bar = xcd_barrier_post(F.ctl + CW_BAR, MISC + 8);
#define IN(k) (lo <= (k) && (k) < hi)
#define SEAM(k) do { if (IN(k) && IN((k) + 1)) { XcdBarrier bb_ = bar; asm volatile("" : "+s"(bb_.bar)); xcd_barrier(bb_); } } while (0)
    if (IN(0)) phase_p0(F);
    SEAM(0);
    for (int l = 0; l < DEPTH; ++l) {
        const int pb = 1 + l * PH_PER_LAYER;
        if (IN(pb + 0)) { if (l == 0) phase_rowA<0>(F, l); else phase_rowA<1>(F, l); }
        SEAM(pb + 0);
        if (IN(pb + 1)) phase_inproj(F, l);
        SEAM(pb + 1);
        if (IN(pb + 2)) phase_scan(F, l);
        SEAM(pb + 2);
        if (IN(pb + 3)) phase_carry(F, l);
        SEAM(pb + 3);
        if (IN(pb + 4)) phase_mix1(F, l);
        SEAM(pb + 4);
        if (IN(pb + 5)) phase_wout(F, l);
        SEAM(pb + 5);
        if (IN(pb + 6)) phase_norm2(F, l);
        SEAM(pb + 6);
        if (IN(pb + 7)) phase_gateup(F, l);
        SEAM(pb + 7);
        if (IN(pb + 8)) phase_down(F, l);
        SEAM(pb + 8);
    }
    if (IN(N_PHASES - 1)) phase_rowA<2>(F, DEPTH);
#undef IN
#undef SEAM
}

extern "C" void kernel_launch(void* const* d_in, const int* in_sizes, int n_in, void* d_out, int out_size, void* d_ws, size_t ws_size, hipStream_t stream) {
    static int grid = 0;
    if (grid == 0) {
        if (n_in != N_IN || out_size != TL * D || ws_size < WS_END) { fprintf(stderr, "kernel_launch: unexpected shapes (n_in %d out %d ws %zu)\n", n_in, out_size, ws_size); grid = -1; return; }
        int dev = 0, cus = 0, per_cu = 0;
        if (hipGetDevice(&dev) != hipSuccess || hipDeviceGetAttribute(&cus, hipDeviceAttributeMultiprocessorCount, dev) != hipSuccess) { grid = -1; return; }
        if (hipFuncSetAttribute((const void*)fwd_kernel, hipFuncAttributeMaxDynamicSharedMemorySize, LDS_BYTES) != hipSuccess) { fprintf(stderr, "kernel_launch: hipFuncSetAttribute failed\n"); grid = -1; return; }
        if (hipOccupancyMaxActiveBlocksPerMultiprocessor(&per_cu, (const void*)fwd_kernel, NTHR, LDS_BYTES) != hipSuccess || per_cu < 1) { fprintf(stderr, "kernel_launch: occupancy query says %d\n", per_cu); }
        (void)hipGetLastError();
        grid = cus;
    }
    if (grid < 0) return;
    if (hipMemsetAsync((char*)d_ws + WS_CTL, 0, CTL_ZERO_BYTES, stream) != hipSuccess) return;
    Args a{};
    for (int i = 0; i < N_IN; ++i) a.in[i] = (const float*)d_in[i];
    a.out = (float*)d_out; a.ws = (unsigned char*)d_ws;
#if MK_ONE_LAUNCH
    a.ph_lo = 0; a.ph_hi = N_PHASES;
    hipLaunchKernelGGL(fwd_kernel, dim3(grid), dim3(NTHR), LDS_BYTES, stream, a);
#else
    for (int p = 0; p < N_PHASES; ++p) { a.ph_lo = p; a.ph_hi = p + 1; hipLaunchKernelGGL(fwd_kernel, dim3(grid), dim3(NTHR), LDS_BYTES, stream, a); }
#endif
}
```
